# Optimizing an MI355X kernel written in HIP

```python
import math
import jax, jax.numpy as jnp
from jax import lax
import numpy as np

D_MODEL = 2048
BATCH = 8
SEQ = 2048
DEPTH = 2

HEAD_DIM = 128
N_HEADS_A = D_MODEL // HEAD_DIM
MOBA_BLOCK = 256
MOBA_TOPK = 3
MOBA_QCHUNK = 32
N_HEADS_B = D_MODEL // (2 * HEAD_DIM)
DIFF_QBLOCK = 128
D_FF = ((8 * D_MODEL // 3 + 255) // 256) * 256
N_EXPERTS = 8
TOP_K = 2
D_FF_EXPERT = 7 * D_MODEL // 2
MOE_BLOCK = 128
N_A_LAYERS = DEPTH // 2
N_B_LAYERS = DEPTH - N_A_LAYERS
N_DENSE = (DEPTH + 1) // 2
N_MOE = DEPTH // 2
RMS_EPS = 1e-6
NEG_INF = -1e30

kernel_name = 'hybrid_moba_diffattn_yoco_moe'


def rmsnorm(x, g):
    x32 = x.astype(jnp.float32)
    y = x32 * lax.rsqrt(jnp.mean(x32 * x32, axis=-1, keepdims=True) + RMS_EPS)
    return y.astype(x.dtype) * g


def alibi_slopes(n_heads):
    h = jnp.arange(1, n_heads + 1, dtype=jnp.float32)
    return jnp.exp2(-8.0 * h / n_heads)


def swiglu(h, w_gate, w_up, w_down):
    return (jax.nn.silu(h @ w_gate) * (h @ w_up)) @ w_down


def moe_swiglu(h, w_router, w_exp_gate, w_exp_up, w_exp_down):
    n_tok, d = h.shape
    logits = (h @ w_router).astype(jnp.float32)
    top_logit, top_idx = lax.top_k(logits, TOP_K)
    gates = jax.nn.softmax(top_logit, axis=-1).astype(h.dtype)
    n_asg = n_tok * TOP_K
    flat_e = top_idx.reshape(-1)
    order = jnp.argsort(flat_e)
    sorted_e = flat_e[order]
    tok = order // TOP_K
    counts = jnp.bincount(flat_e, length=N_EXPERTS)
    padded = ((counts + MOE_BLOCK - 1) // MOE_BLOCK) * MOE_BLOCK
    pend = jnp.cumsum(padded)
    pstart = pend - padded
    ustart = jnp.cumsum(counts) - counts
    dest = pstart[sorted_e] + jnp.arange(n_asg) - ustart[sorted_e]
    n_rows = n_asg + N_EXPERTS * MOE_BLOCK
    n_blocks = n_rows // MOE_BLOCK
    xs = jnp.zeros((n_rows, d), h.dtype).at[dest].set(h[tok])
    block_e = jnp.minimum(jnp.searchsorted(pend, jnp.arange(n_blocks) * MOE_BLOCK, side='right'),
                          N_EXPERTS - 1)

    def expert_block(args):
        xb, e = args
        return (jax.nn.silu(xb @ w_exp_gate[e]) * (xb @ w_exp_up[e])) @ w_exp_down[e]

    ys = lax.map(expert_block, (xs.reshape(n_blocks, MOE_BLOCK, d), block_e)).reshape(n_rows, d)
    contrib = ys[dest] * gates.reshape(-1)[order][:, None]
    return jnp.zeros((n_tok, d), h.dtype).at[tok].add(contrib)


def moba_attention(h, w_qkv, w_o):
    bsz, seq, _ = h.shape
    H, hd, blk = N_HEADS_A, HEAD_DIM, MOBA_BLOCK
    qkv = (h @ w_qkv).reshape(bsz, seq, 3, H, hd)
    q = jnp.moveaxis(qkv[:, :, 0], 2, 1)
    k = jnp.moveaxis(qkv[:, :, 1], 2, 1)
    v = jnp.moveaxis(qkv[:, :, 2], 2, 1)
    n_blk = -(-seq // blk)
    pad = n_blk * blk - seq
    k_blk = jnp.pad(k, ((0, 0), (0, 0), (0, pad), (0, 0))).reshape(bsz, H, n_blk, blk, hd)
    v_blk = jnp.pad(v, ((0, 0), (0, 0), (0, pad), (0, 0))).reshape(bsz, H, n_blk, blk, hd)
    k_mean = jnp.mean(k_blk.astype(jnp.float32), axis=3)
    gate = jnp.einsum('bhsd,bhnd->bhsn', q.astype(jnp.float32), k_mean)
    q_blk_id = jnp.arange(seq) // blk
    fully_past = jnp.arange(n_blk)[None, :] < q_blk_id[:, None]
    gate = jnp.where(fully_past, gate, -jnp.inf)
    k_sel = min(MOBA_TOPK, n_blk)
    _, sel = lax.top_k(gate, k_sel)
    qc = MOBA_QCHUNK
    n_c = seq // qc
    q_steps = q.reshape(bsz, H, n_c, qc, hd).transpose(0, 2, 1, 3, 4).reshape(bsz * n_c, H, qc, hd)
    sel_steps = sel.reshape(bsz, H, n_c, qc, k_sel).transpose(0, 2, 1, 3, 4).reshape(bsz * n_c, H, qc, k_sel)
    b_ids = jnp.repeat(jnp.arange(bsz), n_c)
    c_ids = jnp.tile(jnp.arange(n_c), bsz)
    slopes = alibi_slopes(H)
    scale = hd ** -0.5
    head_ix = jnp.arange(H)[:, None, None]
    key_off = jnp.arange(blk)

    def step(args):
        q_c, sel_c, b, c = args
        kb = k_blk[b]
        vb = v_blk[b]
        t = c * qc + jnp.arange(qc)
        own = (c * qc) // blk
        k_g = kb[head_ix, sel_c]
        v_g = vb[head_ix, sel_c]
        pos_g = sel_c[..., None] * blk + key_off
        dist_g = (t[None, :, None, None] - pos_g).astype(jnp.float32)
        s_g = (jnp.einsum('hqd,hqjkd->hqjk', q_c, k_g).astype(jnp.float32) * scale
               - slopes[:, None, None, None] * dist_g)
        slot_ok = jnp.arange(k_sel) < jnp.minimum(own, k_sel)
        s_g = jnp.where(slot_ok[None, None, :, None], s_g, NEG_INF)
        k_o = lax.dynamic_index_in_dim(kb, own, axis=1, keepdims=False)
        v_o = lax.dynamic_index_in_dim(vb, own, axis=1, keepdims=False)
        pos_o = own * blk + key_off
        dist_o = (t[:, None] - pos_o[None, :]).astype(jnp.float32)
        s_o = (jnp.einsum('hqd,hkd->hqk', q_c, k_o).astype(jnp.float32) * scale
               - slopes[:, None, None] * dist_o)
        s_o = jnp.where((dist_o >= 0)[None], s_o, NEG_INF)
        p = jax.nn.softmax(jnp.concatenate([s_g.reshape(H, qc, k_sel * blk), s_o], axis=-1),
                           axis=-1).astype(q_c.dtype)
        p_g = p[..., :k_sel * blk].reshape(H, qc, k_sel, blk)
        p_o = p[..., k_sel * blk:]
        return (jnp.einsum('hqjk,hqjkd->hqd', p_g, v_g)
                + jnp.einsum('hqk,hkd->hqd', p_o, v_o))

    o = lax.map(step, (q_steps, sel_steps, b_ids, c_ids))
    o = o.reshape(bsz, n_c, H, qc, hd).transpose(0, 1, 3, 2, 4).reshape(bsz, seq, H * hd)
    return o @ w_o


def shared_kv(h, kv_norm_g, w_kv):
    bsz, seq, _ = h.shape
    kv = rmsnorm(h, kv_norm_g) @ w_kv
    k = kv[..., :D_MODEL].reshape(bsz, seq, N_HEADS_B, 2, HEAD_DIM).transpose(0, 2, 3, 1, 4)
    v = kv[..., D_MODEL:].reshape(bsz, seq, N_HEADS_B, 2 * HEAD_DIM).transpose(0, 2, 1, 3)
    return k, v


def diff_attention(h, k, v, w_q, lam_q1, lam_k1, lam_q2, lam_k2, subln_g, w_o, lam_init):
    bsz, seq, _ = h.shape
    H, hd, qb = N_HEADS_B, HEAD_DIM, DIFF_QBLOCK
    n_qb = seq // qb
    q = (h @ w_q).reshape(bsz, n_qb, qb, H, 2, hd).transpose(1, 0, 3, 4, 2, 5)
    lam = (jnp.exp(jnp.sum(lam_q1.astype(jnp.float32) * lam_k1.astype(jnp.float32)))
           - jnp.exp(jnp.sum(lam_q2.astype(jnp.float32) * lam_k2.astype(jnp.float32)))
           + lam_init)
    slopes = alibi_slopes(H)
    scale = hd ** -0.5
    key_pos = jnp.arange(seq)

    def step(args):
        q_b, i = args
        t = i * qb + jnp.arange(qb)
        dist = (t[:, None] - key_pos[None, :]).astype(jnp.float32)
        s = (jnp.einsum('bhcqd,bhckd->bhcqk', q_b, k).astype(jnp.float32) * scale
             - slopes[:, None, None, None] * dist)
        s = jnp.where(dist >= 0, s, NEG_INF)
        a = jax.nn.softmax(s, axis=-1)
        w = (a[:, :, 0] - lam * a[:, :, 1]).astype(v.dtype)
        return jnp.einsum('bhqk,bhkd->bhqd', w, v)

    o = lax.map(step, (q, jnp.arange(n_qb)))
    o = rmsnorm(o, subln_g) * (1.0 - lam_init)
    o = o.transpose(1, 0, 3, 2, 4).reshape(bsz, seq, H * 2 * hd)
    return o @ w_o


def setup_inputs(seed: int = 0) -> dict:
    key = jax.random.key(seed)
    ks = jax.random.split(key, 32)
    f32 = jnp.float32

    def nrm(k, shape, fan_in):
        return jax.random.normal(k, shape, f32) * fan_in ** -0.5

    def gain(k, shape):
        return 1.0 + 0.02 * jax.random.normal(k, shape, f32)

    D, F, E, FE, hd = D_MODEL, D_FF, N_EXPERTS, D_FF_EXPERT, HEAD_DIM
    return {
        'x': jax.random.normal(ks[0], (BATCH, SEQ, D), f32),
        'attn_a_norm_g': gain(ks[1], (N_A_LAYERS, D)),
        'w_qkv_a': nrm(ks[2], (N_A_LAYERS, D, 3 * D), D),
        'w_o_a': nrm(ks[3], (N_A_LAYERS, D, D), D),
        'kv_norm_g': gain(ks[4], (D,)),
        'w_kv': nrm(ks[5], (D, 2 * D), D),
        'attn_b_norm_g': gain(ks[6], (N_B_LAYERS, D)),
        'w_q_b': nrm(ks[7], (N_B_LAYERS, D, D), D),
        'lam_q1': 0.1 * jax.random.normal(ks[8], (N_B_LAYERS, hd), f32),
        'lam_k1': 0.1 * jax.random.normal(ks[9], (N_B_LAYERS, hd), f32),
        'lam_q2': 0.1 * jax.random.normal(ks[10], (N_B_LAYERS, hd), f32),
        'lam_k2': 0.1 * jax.random.normal(ks[11], (N_B_LAYERS, hd), f32),
        'subln_g': gain(ks[12], (N_B_LAYERS, 2 * hd)),
        'w_o_b': nrm(ks[13], (N_B_LAYERS, D, D), D),
        'ffn_norm_g': gain(ks[14], (DEPTH, D)),
        'w_gate': nrm(ks[15], (N_DENSE, D, F), D),
        'w_up': nrm(ks[16], (N_DENSE, D, F), D),
        'w_down': nrm(ks[17], (N_DENSE, F, D), F),
        'w_router': nrm(ks[18], (N_MOE, D, E), D),
        'w_exp_gate': nrm(ks[19], (N_MOE, E, D, FE), D),
        'w_exp_up': nrm(ks[20], (N_MOE, E, D, FE), D),
        'w_exp_down': nrm(ks[21], (N_MOE, E, FE, D), FE),
        'final_norm_g': gain(ks[22], (D,)),
    }


def reference(x, attn_a_norm_g, w_qkv_a, w_o_a, kv_norm_g, w_kv, attn_b_norm_g, w_q_b,
              lam_q1, lam_k1, lam_q2, lam_k2, subln_g, w_o_b, ffn_norm_g, w_gate, w_up,
              w_down, w_router, w_exp_gate, w_exp_up, w_exp_down, final_norm_g):
    bsz, seq, d = x.shape
    kv_k, kv_v = None, None
    for layer in range(DEPTH):
        if layer < N_A_LAYERS:
            i = layer
            x = x + moba_attention(rmsnorm(x, attn_a_norm_g[i]), w_qkv_a[i], w_o_a[i])
        else:
            i = layer - N_A_LAYERS
            if i == 0:
                kv_k, kv_v = shared_kv(x, kv_norm_g, w_kv)
            lam_init = 0.8 - 0.6 * math.exp(-0.3 * layer)
            x = x + diff_attention(rmsnorm(x, attn_b_norm_g[i]), kv_k, kv_v, w_q_b[i],
                                   lam_q1[i], lam_k1[i], lam_q2[i], lam_k2[i],
                                   subln_g[i], w_o_b[i], lam_init)
        hn = rmsnorm(x, ffn_norm_g[layer])
        j = layer // 2
        if layer % 2 == 0:
            x = x + swiglu(hn, w_gate[j], w_up[j], w_down[j])
        else:
            x = x + moe_swiglu(hn.reshape(bsz * seq, d), w_router[j], w_exp_gate[j],
                               w_exp_up[j], w_exp_down[j]).reshape(bsz, seq, d)
    return rmsnorm(x, final_norm_g)
```

```cpp
#include <hip/hip_runtime.h>
#include <cstdio>
#include <cstdint>

#define GAS __attribute__((address_space(1)))
#define LAS __attribute__((address_space(3)))
typedef unsigned short bf16_t;
typedef short bf16x8 __attribute__((ext_vector_type(8)));
typedef short s16x4 __attribute__((ext_vector_type(4)));
typedef float f32x2 __attribute__((ext_vector_type(2)));
typedef float f32x4 __attribute__((ext_vector_type(4)));
typedef float f32x16 __attribute__((ext_vector_type(16)));
typedef unsigned u32x2 __attribute__((ext_vector_type(2)));
typedef unsigned u32x4 __attribute__((ext_vector_type(4)));

constexpr int NB = 8, SEQ = 2048, DM = 2048, MTOK = NB * SEQ;
constexpr int NQKV = 3 * DM, FF = 5632, FE = 7168, NE = 8;
constexpr int HA = 16, HB = 8;
constexpr float RMS_EPS = 1e-6f;
constexpr float LAM_INIT = 0.35550906759096996f;
constexpr int MAXTILES = 136;
constexpr int MOE_ROWS = 135 * 256;

constexpr size_t MiB = 1u << 20;
constexpr size_t WS_CTL = 0, CTL_ZERO_BYTES = 768 * 1024;
constexpr size_t CTL_BAR = 4096;
constexpr size_t CTL_SS = 64 * 1024;
constexpr size_t CTL_CNT = 576 * 1024;
constexpr size_t CTL_BND1 = 640 * 1024, CTL_BND2 = 704 * 1024;
constexpr size_t CTL_TILES = 768 * 1024;
constexpr size_t CTL_TOKINFO = 1 * MiB;
constexpr size_t WS_WQKV = 2 * MiB, WS_WOA = 26 * MiB, WS_WGU = 34 * MiB, WS_WDN = 78 * MiB, WS_WKVQ = 100 * MiB, WS_WOB = 124 * MiB;
constexpr size_t WS_XB = 132 * MiB, WS_XR = 196 * MiB, WS_WEGU = 324 * MiB, WS_WEDN = 548 * MiB, WS_BIG = 660 * MiB;
constexpr size_t WS_QKV = WS_BIG, WS_AO = WS_BIG + 192 * MiB, WS_ACT = WS_BIG + 256 * MiB, WS_KMEAN = WS_BIG + 432 * MiB, WS_SEL = WS_BIG + 433 * MiB;
constexpr size_t WS_ACTE = WS_BIG, WS_XS = WS_BIG + 237 * MiB, WS_YS = WS_BIG + 305 * MiB, WS_SLAB = WS_BIG + 440 * MiB, WS_END = WS_BIG + 500 * MiB;
static_assert(WS_END <= 1792 * MiB, "workspace map");
static_assert((size_t)MOE_ROWS * FE <= 237 * MiB && (size_t)MOE_ROWS * DM <= 68 * MiB && (size_t)MOE_ROWS * DM * 2 <= 135 * MiB && WS_SEL + MiB <= WS_END, "moe buffers");
constexpr float XS_SC = 16.f, WEGU_SC = 256.f, ACT_SC = 8.f, WEDN_SC = 512.f;
constexpr int TAIL_NS = 4, TAIL_MAXROWS = 31 * 256;
static_assert((size_t)TAIL_NS * 7 * 256 * DM * 4 <= 60 * MiB, "slab (nT in [128, 135] -> at most 7 tail row tiles)");

constexpr int RING_BYTES = 131072, LDS_BYTES = 147456, LDSCTL_OFF = LDS_BYTES - 512;

#define LDS_WAIT() asm volatile("s_waitcnt lgkmcnt(0)" ::: "memory")
#define VM_WAIT() asm volatile("s_waitcnt vmcnt(0)" ::: "memory")
__device__ __forceinline__ unsigned cvt_pk_bf16(float lo, float hi) { unsigned r; asm volatile("v_cvt_pk_bf16_f32 %0, %1, %2" : "=v"(r) : "v"(lo), "v"(hi)); return r; }
__device__ __forceinline__ float bf2f(unsigned short b) { return __uint_as_float(((unsigned)b) << 16); }
template <int CTRL> __device__ __forceinline__ float dppx(float v) { return __builtin_bit_cast(float, __builtin_amdgcn_update_dpp(0, __builtin_bit_cast(int, v), CTRL, 0xf, 0xf, true)); }
__device__ __forceinline__ float xor1_get(float v) { return dppx<0xB1>(v); }
__device__ __forceinline__ float sum_xor16(float v) { auto r = __builtin_amdgcn_permlane16_swap(__float_as_uint(v), __float_as_uint(v), false, false); return __uint_as_float(r[0]) + __uint_as_float(r[1]); }
__device__ __forceinline__ float sum_xor32(float v) { auto r = __builtin_amdgcn_permlane32_swap(__float_as_uint(v), __float_as_uint(v), false, false); return __uint_as_float(r[0]) + __uint_as_float(r[1]); }
__device__ __forceinline__ float row_sum16(float v) { v += dppx<0xB1>(v); v += dppx<0x4E>(v); v += dppx<0x141>(v); v += dppx<0x140>(v); return v; }
__device__ __forceinline__ float row_max16(float v) { v = __builtin_fmaxf(v, dppx<0xB1>(v)); v = __builtin_fmaxf(v, dppx<0x4E>(v)); v = __builtin_fmaxf(v, dppx<0x141>(v)); v = __builtin_fmaxf(v, dppx<0x140>(v)); return v; }
__device__ __forceinline__ float wave_sum(float v) { return sum_xor32(sum_xor16(row_sum16(v))); }
typedef unsigned long long u64;
__device__ __forceinline__ float rstd_of(float ss) { return __builtin_amdgcn_rsqf(ss * (1.0f / (float)DM) + RMS_EPS); }
__device__ __forceinline__ u64 ss_fix(float s) { return (u64)(s * 16777216.0f); }
__device__ __forceinline__ float rstd_q(u64 q) { return rstd_of((float)q * (1.0f / 16777216.0f)); }

#define XB_TMO      128
#define XB_XCNT(j)  (256  + 64 * (j))
#define XB_XSUB(j)  (1280 + 64 * (j))
#define XB_XGEN(j)  (2304 + 64 * (j))
#define XB_TOP      3328
#define XB_TOPGEN   3392
#define XCD_BAR_WORDS 3456
#define XB_SPIN_CAP (1u << 18)
__device__ __forceinline__ unsigned xb_ld(unsigned* p)              { return __hip_atomic_load(p, __ATOMIC_RELAXED, __HIP_MEMORY_SCOPE_AGENT); }
__device__ __forceinline__ unsigned xb_add(unsigned* p, unsigned v) { return __hip_atomic_fetch_add(p, v, __ATOMIC_RELAXED, __HIP_MEMORY_SCOPE_AGENT); }
__device__ __forceinline__ unsigned xb_xcc_id() { return (unsigned)__builtin_amdgcn_s_getreg((3 << 11) | 20) & 0xFu; }
#define XB_SPIN(cond, bar) do { unsigned _sp = 0; while (cond) { __builtin_amdgcn_s_sleep(1); \
    if ((++_sp & 255u) == 0u) { if (xb_ld(&(bar)[XB_TMO])) break; if (_sp > XB_SPIN_CAP) { atomicAdd(&(bar)[XB_TMO], 1u); break; } } } } while (0)
struct XcdBarrier { unsigned* bar; unsigned x; volatile LAS unsigned* st; };
__device__ __forceinline__ XcdBarrier xcd_barrier_post(unsigned* bar, volatile LAS unsigned* st) {
    XcdBarrier b; b.bar = bar; b.x = xb_xcc_id(); b.st = st;
    if (threadIdx.x == 0) (void)xb_add(&bar[XB_XCNT(b.x)], 1u);
    return b;
}
__device__ __forceinline__ void xcd_barrier_complete(unsigned* bar, unsigned x, unsigned& nloc, unsigned& nx) {
    const unsigned G = gridDim.x * gridDim.y * gridDim.z;
    unsigned sum, cnt, mine, sp = 0u;
    for (;;) {
        sum = 0u; cnt = 0u; mine = 0u;
#pragma unroll
        for (unsigned j = 0; j < 16; ++j) { const unsigned c = xb_ld(&bar[XB_XCNT(j)]); sum += c; cnt += (c > 0u) ? 1u : 0u; mine = (j == x) ? c : mine; }
        if (sum == G) break;
        __builtin_amdgcn_s_sleep(1);
        if ((++sp & 255u) == 0u) { if (xb_ld(&bar[XB_TMO])) break; if (sp > XB_SPIN_CAP) { atomicAdd(&bar[XB_TMO], 1u); break; } }
    }
    nloc = mine > 0u ? mine : 1u; nx = cnt > 0u ? cnt : 1u;
}
__device__ __forceinline__ void xcd_barrier(const XcdBarrier& b) {
    asm volatile("s_waitcnt vmcnt(0)" ::: "memory");
    __syncthreads();
    if (threadIdx.x == 0) {
        unsigned* bar = b.bar;
        __builtin_amdgcn_s_waitcnt(0);
        unsigned nloc = b.st[0], nx = b.st[1];
        if (nloc == 0u) { xcd_barrier_complete(bar, b.x, nloc, nx); b.st[0] = nloc; b.st[1] = nx; }
        const unsigned old = xb_add(&bar[XB_XSUB(b.x)], 1u);
        const unsigned gen = old / nloc;
        if (old + 1u == (gen + 1u) * nloc) {
            __builtin_amdgcn_fence(__ATOMIC_RELEASE, "agent");
            asm volatile("s_waitcnt vmcnt(0)" ::: "memory");
            const unsigned og = xb_add(&bar[XB_TOP], 1u);
            const unsigned tg = og / nx;
            if (og + 1u == (tg + 1u) * nx) xb_add(&bar[XB_TOPGEN], 1u);
            else XB_SPIN(xb_ld(&bar[XB_TOPGEN]) == tg, bar);
            __builtin_amdgcn_fence(__ATOMIC_ACQUIRE, "agent");
            xb_add(&bar[XB_XGEN(b.x)], 1u);
            asm volatile("s_waitcnt vmcnt(0)" ::: "memory");
        } else {
            XB_SPIN(xb_ld(&bar[XB_XGEN(b.x)]) == gen, bar);
            __builtin_amdgcn_fence(__ATOMIC_ACQUIRE, "agent");
            asm volatile("s_waitcnt vmcnt(0)" ::: "memory");
        }
    }
    __syncthreads();
}

namespace pg8 {
constexpr int BM = 256, BK = 64, HALF = 128, HTB = HALF * BK * 2, STAGE_BYTES = 8 * HTB, NXCD = 8, WGM = 8;
__host__ __device__ __forceinline__ int lds_byte(int r, int c) { const int st = (r >> 4) * 2 + (c >> 5), rr = r & 15, cc = c & 31, ob = rr * 64 + cc * 2; return st * 1024 + (ob ^ (((ob >> 9) & 1) << 5)); }
__host__ __device__ __forceinline__ void stage_rc(int b, int& R, int& C) { const int st = b / 1024, sb = b % 1024, swz = sb ^ (((sb >> 9) & 1) << 5); R = (st >> 1) * 16 + swz / 64; C = (st & 1) * 32 + (swz % 64) / 2; }
__host__ __device__ __forceinline__ int perm32(int rho) { const int n = rho >> 4, i = rho & 15; return 8 * (i >> 2) + 4 * n + (i & 3); }

struct Unit { int pm, pn, e, ks; };

struct Order {
    int nM, nN, nwg, G, c; const char* A; const char* B; size_t tstep, estride; const int* tile_e;
    __device__ __forceinline__ void init(int nM_, int nN_, int KB, int G_, int c_, const void* A_, const void* B_, size_t estride_, const int* tile_e_) {
        nM = nM_; nN = nN_; nwg = nM * nN; G = G_; c = c_; A = (const char*)A_; B = (const char*)B_; tstep = (size_t)BM * KB; estride = estride_; tile_e = tile_e_; }
    __device__ __forceinline__ bool next(int i, Unit& u) const {
        const long L = (long)i * G + c; if (L >= nwg) return false;
        int wgid = (int)L; { const int q = nwg / NXCD, r = nwg % NXCD, xcd = wgid % NXCD, off = wgid / NXCD; wgid = (xcd < r ? xcd * (q + 1) : r * (q + 1) + (xcd - r) * q) + off; }
        const int nig = WGM * nN, gid = wgid / nig, fm = gid * WGM, gsz = (nM - fm) < WGM ? (nM - fm) : WGM;
        u.pm = fm + ((wgid % nig) % gsz); u.pn = (wgid % nig) / gsz; u.e = tile_e ? tile_e[u.pm] : 0; u.ks = 0; return true;
    }
    __device__ __forceinline__ const char* a_base(const Unit& u) const { return A + (size_t)u.pm * tstep; }
    __device__ __forceinline__ const char* b_base(const Unit& u) const { return B + (size_t)u.e * estride + (size_t)u.pn * tstep; }
};

struct TailOrder {
    int nsub, G, c, pm0, NS; const char* A; const char* B; size_t tstep, estride, kslice; const int* tile_e;
    __device__ __forceinline__ bool next(int i, Unit& u) const { const int L = i * G + c; if (L >= nsub) return false; const int per = 8 * NS; u.pm = pm0 + L / per; const int rem = L % per; u.pn = rem / NS; u.ks = rem % NS; u.e = tile_e[u.pm]; return true; }
    __device__ __forceinline__ const char* a_base(const Unit& u) const { return A + (size_t)u.pm * tstep + (size_t)u.ks * kslice; }
    __device__ __forceinline__ const char* b_base(const Unit& u) const { return B + (size_t)u.e * estride + (size_t)u.pn * tstep + (size_t)u.ks * kslice; }
};

template <bool SCALE, bool BOUND = false> struct EpiBf16Out {
    static constexpr bool PERM = true;
    bf16_t* O; int ldc; const u64* ss; float csc; unsigned* bnd;
    __device__ __forceinline__ void operator()(const f32x4 (&acc)[2][2][4][2], const Unit& u, int wr, int wc, int fr, int fq) const {
        const int row0 = u.pm * BM + wr * 64 + fr, col0 = u.pn * BM + wc * 32 + 8 * fq; float mx[2] = {0.f, 0.f};
#pragma unroll
        for (int ai = 0; ai < 2; ++ai)
#pragma unroll
            for (int m = 0; m < 4; ++m) { const int row = row0 + ai * HALF + m * 16; float rs = csc; if (SCALE) rs = rstd_q(ss[row]);
                bf16_t* rowp = O + (size_t)row * ldc + col0;
#pragma unroll
                for (int bj = 0; bj < 2; ++bj) { const f32x4 v0 = acc[ai][bj][m][0] * rs, v1 = acc[ai][bj][m][1] * rs;
                    u32x4 w; w.x = cvt_pk_bf16(v0[0], v0[1]); w.y = cvt_pk_bf16(v0[2], v0[3]); w.z = cvt_pk_bf16(v1[0], v1[1]); w.w = cvt_pk_bf16(v1[2], v1[3]);
                    *(u32x4*)(rowp + bj * HALF) = w;
                    if (BOUND) { float sq = ((v0[0] * v0[0] + v0[1] * v0[1]) + (v0[2] * v0[2] + v0[3] * v0[3])) + ((v1[0] * v1[0] + v1[1] * v1[1]) + (v1[2] * v1[2] + v1[3] * v1[3]));
                        sq = sum_xor32(sum_xor16(sq)); mx[bj] = __builtin_fmaxf(mx[bj], sq); } } }
        if (BOUND) {
#pragma unroll
            for (int bj = 0; bj < 2; ++bj) { const float v = row_max16(mx[bj]);
                if (fr == 0 && fq == 0) __hip_atomic_fetch_max(bnd + ((size_t)(2 * u.pn + bj) * 64 + u.pm) * 4 + wc, __float_as_uint(v), __ATOMIC_RELAXED, __HIP_MEMORY_SCOPE_AGENT); } }
    }
};
__device__ __forceinline__ float clamp448(float x) { return __builtin_fminf(__builtin_fmaxf(x, -448.0f), 448.0f); }
__device__ __forceinline__ unsigned pk4_fp8(float a, float b, float c, float d) { int v = __builtin_amdgcn_cvt_pk_fp8_f32(clamp448(a), clamp448(b), 0, false); v = __builtin_amdgcn_cvt_pk_fp8_f32(clamp448(c), clamp448(d), v, true); return (unsigned)v; }
__device__ __forceinline__ float silu_mul(float g, float u) { return g * __builtin_amdgcn_rcpf(1.0f + __builtin_amdgcn_exp2f(-1.4426950408889634f * g)) * u; }
__device__ __forceinline__ float silu_mul_c(float g, float u, float c1, float c2) { return (g * u) * (c2 * __builtin_amdgcn_rcpf(1.0f + __builtin_amdgcn_exp2f(g * c1))); }
template <bool RAW> struct EpiSwiGLU {
    static constexpr bool PERM = true;
    bf16_t* O; int ldc; const void* rsrc;
    __device__ __forceinline__ void operator()(const f32x4 (&acc)[2][2][4][2], const Unit& u, int wr, int wc, int fr, int fq) const {
        const int row0 = u.pm * BM + wr * 64 + fr, col0 = u.pn * HALF + wc * 32 + 8 * fq;
#pragma unroll
        for (int ai = 0; ai < 2; ++ai)
#pragma unroll
            for (int m = 0; m < 4; ++m) { const int row = row0 + ai * HALF + m * 16; float rs; if (RAW) rs = ((const float*)rsrc)[row]; else rs = rstd_q(((const u64*)rsrc)[row]);
                f32x4 a0, a1; const float c1 = -1.4426950408889634f * rs, c2 = rs * rs;
#pragma unroll
                for (int j = 0; j < 4; ++j) { a0[j] = silu_mul_c(acc[ai][0][m][0][j], acc[ai][1][m][0][j], c1, c2); a1[j] = silu_mul_c(acc[ai][0][m][1][j], acc[ai][1][m][1][j], c1, c2); }
                u32x4 w; w.x = cvt_pk_bf16(a0[0], a0[1]); w.y = cvt_pk_bf16(a0[2], a0[3]); w.z = cvt_pk_bf16(a1[0], a1[1]); w.w = cvt_pk_bf16(a1[2], a1[3]);
                *(u32x4*)(O + (size_t)row * ldc + col0) = w; }
    }
};
struct EpiSwiGLU8 {
    static constexpr bool PERM = true;
    unsigned char* O; int ldc; float isc, osc; int skip;
    __device__ __forceinline__ void operator()(const f32x4 (&acc)[2][2][4][2], const Unit& u, int wr, int wc, int fr, int fq) const {
        if (skip) return;
        const int row0 = u.pm * BM + wr * 64 + fr, col0 = u.pn * HALF + wc * 32 + 8 * fq; const float c1 = -1.4426950408889634f * isc, c2 = isc * isc * osc;
#pragma unroll
        for (int ai = 0; ai < 2; ++ai)
#pragma unroll
            for (int m = 0; m < 4; ++m) { const int row = row0 + ai * HALF + m * 16;
                f32x4 a0, a1;
#pragma unroll
                for (int j = 0; j < 4; ++j) { a0[j] = silu_mul_c(acc[ai][0][m][0][j], acc[ai][1][m][0][j], c1, c2); a1[j] = silu_mul_c(acc[ai][0][m][1][j], acc[ai][1][m][1][j], c1, c2); }
                u32x2 w; w.x = pk4_fp8(a0[0], a0[1], a0[2], a0[3]); w.y = pk4_fp8(a1[0], a1[1], a1[2], a1[3]);
                *(u32x2*)(O + (size_t)row * ldc + col0) = w; }
    }
};
struct EpiPart {
    static constexpr bool PERM = false;
    float* slab; int row_base; size_t ks_stride;
    __device__ __forceinline__ void operator()(const f32x4 (&acc)[2][2][4][2], const Unit& u, int wr, int wc, int fr, int fq) const {
        const int row0 = u.pm * BM + wr * 64 + fr - row_base, col0 = u.pn * BM + wc * 32 + 4 * fq; float* sp = slab + (size_t)u.ks * ks_stride;
#pragma unroll
        for (int ai = 0; ai < 2; ++ai)
#pragma unroll
            for (int m = 0; m < 4; ++m) { float* rowp = sp + (size_t)(row0 + ai * HALF + m * 16) * DM + col0;
#pragma unroll
                for (int bj = 0; bj < 2; ++bj)
#pragma unroll
                    for (int n = 0; n < 2; ++n) *(f32x4*)(rowp + bj * HALF + n * 16) = acc[ai][bj][m][n]; }
    }
};
struct EpiResid {
    static constexpr bool PERM = false;
    const float* base; float* xr; bf16_t* xb; u64* ssout;
    __device__ __forceinline__ void operator()(const f32x4 (&acc)[2][2][4][2], const Unit& u, int wr, int wc, int fr, int fq) const {
        const int row0 = u.pm * BM + wr * 64 + fr, col0 = u.pn * BM + wc * 32 + 4 * fq;
#pragma unroll
        for (int ai = 0; ai < 2; ++ai)
#pragma unroll
            for (int m = 0; m < 4; ++m) { const int row = row0 + ai * HALF + m * 16; const size_t off = (size_t)row * DM + col0; float s = 0.f;
#pragma unroll
                for (int bj = 0; bj < 2; ++bj)
#pragma unroll
                    for (int n = 0; n < 2; ++n) { const int c = bj * HALF + n * 16; const f32x4 b = *(const f32x4*)(base + off + c); const f32x4 o = b + acc[ai][bj][m][n];
                        *(f32x4*)(xr + off + c) = o; u32x2 w; w.x = cvt_pk_bf16(o[0], o[1]); w.y = cvt_pk_bf16(o[2], o[3]); *(u32x2*)(xb + off + c) = w;
                        s += (o[0] * o[0] + o[1] * o[1]) + (o[2] * o[2] + o[3] * o[3]); }
                s = sum_xor32(sum_xor16(s));
                if (fq == 0) __hip_atomic_fetch_add(ssout + row, ss_fix(s), __ATOMIC_RELAXED, __HIP_MEMORY_SCOPE_AGENT); }
    }
};

typedef int i32x8 __attribute__((ext_vector_type(8)));
__device__ __forceinline__ i32x8 cat16(bf16x8 lo, bf16x8 hi) { typedef int i32x4 __attribute__((ext_vector_type(4))); const i32x4 a = __builtin_bit_cast(i32x4, lo), b = __builtin_bit_cast(i32x4, hi); return (i32x8){a[0], a[1], a[2], a[3], b[0], b[1], b[2], b[3]}; }
__device__ __forceinline__ void mfma_fp8(f32x4& acc, i32x8 a, i32x8 b) { asm volatile("v_mfma_f32_16x16x128_f8f6f4 %0, %1, %2, %0" : "+v"(acc) : "v"(a), "v"(b)); }
template <class Epi, bool ALIGN_EPI, bool SP2, bool FP8 = false, class Sched = Order>
__device__ __forceinline__ void gemm_phase(LAS unsigned char* lds, const int KB, const Sched& S, const Epi& E, const int nt_override = 0) {
    int tid_ = threadIdx.x; asm volatile("" : "+v"(tid_));
    const int tid = tid_, wid = __builtin_amdgcn_readfirstlane(tid >> 6), lane = tid & 63, wr = wid >> 2, wc = wid & 3, fr = lane & 15, fq = lane >> 4;
    const int nt = nt_override ? nt_override : KB / 128;
    unsigned voffA[2], voffB[2];
#pragma unroll
    for (int i = 0; i < 2; ++i) { int R, C; stage_rc(tid * 16 + i * 8192, R, C); const int Rb = Epi::PERM ? ((R & ~31) + perm32(R & 31)) : R;
        voffA[i] = (unsigned)(R * KB + C * 2); voffB[i] = (unsigned)(Rb * KB + C * 2); }
    const size_t kstep = (size_t)(BK * 2);
    const size_t hstep = (size_t)HALF * KB;
    const unsigned ldsw = (unsigned)wid * 1024u;
    const int aoff = lds_byte(wr * 64 + fr, fq * 8), boff = lds_byte(wc * 32 + fr, fq * 8);
#define PG8_SA(b, h) (((b) * 2 + (h)) * HTB)
#define PG8_SB(b, h) ((4 + (b) * 2 + (h)) * HTB)
#define PG8_STAGE(bufoff, gbase, voff) do { _Pragma("unroll") for (int _i = 0; _i < 2; ++_i) \
        __builtin_amdgcn_global_load_lds((const unsigned*)((const char*)(gbase) + (voff)[_i]), (LAS unsigned*)(lds + (bufoff) + ldsw + _i * 8192), 16, 0, 0); } while (0)
#define PG8_LDA(dst, b, h) do { _Pragma("unroll") for (int m = 0; m < 4; ++m) _Pragma("unroll") for (int k = 0; k < 2; ++k) dst[m][k] = *(const LAS bf16x8*)(lds + PG8_SA(b, h) + aoff + m * 2048 + k * 1024); } while (0)
#define PG8_LDB(dst, b, h) do { _Pragma("unroll") for (int n = 0; n < 2; ++n) _Pragma("unroll") for (int k = 0; k < 2; ++k) dst[n][k] = *(const LAS bf16x8*)(lds + PG8_SB(b, h) + boff + n * 2048 + k * 1024); } while (0)
#define PG8_MMA(ai, bj, At, Bt) do { __builtin_amdgcn_s_setprio(1); _Pragma("unroll") for (int m = 0; m < 4; ++m) _Pragma("unroll") for (int n = 0; n < 2; ++n) { \
        if constexpr (FP8) mfma_fp8(acc[ai][bj][m][n], cat16(Bt[n][0], Bt[n][1]), cat16(At[m][0], At[m][1])); \
        else { _Pragma("unroll") for (int k = 0; k < 2; ++k) acc[ai][bj][m][n] = __builtin_amdgcn_mfma_f32_16x16x32_bf16(Bt[n][k], At[m][k], acc[ai][bj][m][n], 0, 0, 0); } } \
        __builtin_amdgcn_s_setprio(0); } while (0)
#define PG8_WAIT_V(n) asm volatile("s_waitcnt vmcnt(" #n ")" ::: "memory")
#define PG8_WAIT_L(n) asm volatile("s_waitcnt lgkmcnt(" #n ")" ::: "memory")
#define PG8_BAR __builtin_amdgcn_s_barrier()
#define PG8_SCHED __builtin_amdgcn_sched_barrier(0)
    Unit cur, nxt; int ui = 0;
    if (!S.next(0, cur)) return;
    f32x4 acc[2][2][4][2];
#pragma unroll
    for (int a = 0; a < 2; ++a)
#pragma unroll
        for (int b = 0; b < 2; ++b)
#pragma unroll
            for (int m = 0; m < 4; ++m)
#pragma unroll
                for (int n = 0; n < 2; ++n) acc[a][b][m][n] = (f32x4){0.f, 0.f, 0.f, 0.f};
    bf16x8 At[4][2], B0[2][2], B1[2][2];
    const char* cA = S.a_base(cur); const char* cB = S.b_base(cur);
    if constexpr (SP2) {
        PG8_STAGE(PG8_SB(0, 0), cB, voffB); PG8_STAGE(PG8_SB(0, 1), cB + hstep, voffB); PG8_STAGE(PG8_SA(0, 0), cA, voffA); PG8_STAGE(PG8_SA(0, 1), cA + hstep, voffA);
        if (wr == 1) PG8_BAR;
        PG8_WAIT_V(2); PG8_BAR;
        PG8_STAGE(PG8_SB(1, 0), cB + kstep, voffB); PG8_STAGE(PG8_SA(1, 0), cA + kstep, voffA); PG8_STAGE(PG8_SB(1, 1), cB + hstep + kstep, voffB);
        PG8_WAIT_V(6); PG8_BAR;
    } else {
        PG8_STAGE(PG8_SB(0, 0), cB, voffB); PG8_STAGE(PG8_SA(0, 0), cA, voffA); PG8_STAGE(PG8_SB(0, 1), cB + hstep, voffB); PG8_STAGE(PG8_SA(0, 1), cA + hstep, voffA);
        if (wr == 1) PG8_BAR;
        PG8_WAIT_V(4); PG8_BAR;
        PG8_STAGE(PG8_SB(1, 0), cB + kstep, voffB); PG8_STAGE(PG8_SA(1, 0), cA + kstep, voffA); PG8_STAGE(PG8_SB(1, 1), cB + hstep + kstep, voffB);
        PG8_WAIT_V(6); PG8_BAR;
    }
    for (;;) {
        const bool has_next = S.next(ui + 1, nxt);
        const char* nA = has_next ? S.a_base(nxt) : cA; const char* nB = has_next ? S.b_base(nxt) : cB;
        for (int t = 0; t < nt; t += 2) {
            const bool last = (t == nt - 2);
            const char* a1 = cA + (size_t)(t + 1) * kstep;
            const char* a2 = last ? nA : cA + (size_t)(t + 2) * kstep; const char* b2 = last ? nB : cB + (size_t)(t + 2) * kstep;
            const char* a3 = a2 + kstep; const char* b3 = b2 + kstep;
            if constexpr (SP2) {
            PG8_LDB(B0, 0, 0); PG8_LDB(B1, 0, 1); PG8_SCHED; PG8_LDA(At, 0, 0); PG8_STAGE(PG8_SA(1, 1), a1 + hstep, voffA);
            PG8_WAIT_V(8); PG8_WAIT_L(0); PG8_BAR; PG8_MMA(0, 0, At, B0); PG8_MMA(0, 1, At, B1); PG8_BAR; PG8_SCHED;
            PG8_LDA(At, 0, 1); PG8_STAGE(PG8_SB(0, 0), b2, voffB); PG8_STAGE(PG8_SB(0, 1), b2 + hstep, voffB); PG8_STAGE(PG8_SA(0, 0), a2, voffA);
            PG8_WAIT_V(8); PG8_WAIT_L(0); PG8_BAR; PG8_MMA(1, 0, At, B0); PG8_MMA(1, 1, At, B1); PG8_BAR; PG8_SCHED;
            PG8_LDB(B0, 1, 0); PG8_LDB(B1, 1, 1); PG8_SCHED; PG8_LDA(At, 1, 0); PG8_STAGE(PG8_SA(0, 1), a2 + hstep, voffA);
            PG8_WAIT_V(8); PG8_WAIT_L(0); PG8_BAR; PG8_MMA(0, 0, At, B0); PG8_MMA(0, 1, At, B1); PG8_BAR; PG8_SCHED;
            PG8_LDA(At, 1, 1); PG8_STAGE(PG8_SB(1, 0), b3, voffB); PG8_STAGE(PG8_SB(1, 1), b3 + hstep, voffB); PG8_STAGE(PG8_SA(1, 0), a3, voffA);
            PG8_WAIT_V(8); PG8_WAIT_L(0); PG8_BAR; PG8_MMA(1, 0, At, B0); PG8_MMA(1, 1, At, B1); PG8_BAR; PG8_SCHED;
            } else {
            PG8_LDB(B0, 0, 0); PG8_SCHED; PG8_LDA(At, 0, 0); PG8_STAGE(PG8_SA(1, 1), a1 + hstep, voffA);
            PG8_WAIT_L(8); PG8_BAR; PG8_WAIT_L(0); PG8_MMA(0, 0, At, B0); PG8_BAR; PG8_SCHED;
            PG8_LDB(B1, 0, 1); PG8_STAGE(PG8_SB(0, 0), b2, voffB);
            PG8_BAR; PG8_WAIT_L(0); PG8_MMA(0, 1, At, B1); PG8_BAR;
            PG8_LDA(At, 0, 1); PG8_STAGE(PG8_SA(0, 0), a2, voffA);
            PG8_BAR; PG8_WAIT_L(0); PG8_MMA(1, 0, At, B0); PG8_BAR; PG8_SCHED;
            PG8_STAGE(PG8_SB(0, 1), b2 + hstep, voffB);
            PG8_WAIT_V(6); PG8_BAR; PG8_MMA(1, 1, At, B1); PG8_BAR;
            PG8_LDB(B0, 1, 0); PG8_SCHED; PG8_LDA(At, 1, 0); PG8_STAGE(PG8_SA(0, 1), a2 + hstep, voffA);
            PG8_WAIT_L(8); PG8_BAR; PG8_WAIT_L(0); PG8_MMA(0, 0, At, B0); PG8_BAR; PG8_SCHED;
            PG8_LDB(B1, 1, 1); PG8_STAGE(PG8_SB(1, 0), b3, voffB);
            PG8_BAR; PG8_WAIT_L(0); PG8_MMA(0, 1, At, B1); PG8_BAR;
            PG8_LDA(At, 1, 1); PG8_STAGE(PG8_SA(1, 0), a3, voffA);
            PG8_BAR; PG8_WAIT_L(0); PG8_MMA(1, 0, At, B0); PG8_BAR; PG8_SCHED;
            PG8_STAGE(PG8_SB(1, 1), b3 + hstep, voffB);
            PG8_WAIT_V(6); PG8_BAR; PG8_MMA(1, 1, At, B1); PG8_BAR;
            }
        }
        if constexpr (FP8) asm volatile("s_nop 15\n\ts_nop 15" ::: "memory");
        if constexpr (ALIGN_EPI) { if (wr == 0) PG8_BAR; }
        E(acc, cur, wr, wc, fr, fq);
        if (!has_next) break;
#pragma unroll
        for (int a = 0; a < 2; ++a)
#pragma unroll
            for (int b = 0; b < 2; ++b)
#pragma unroll
                for (int m = 0; m < 4; ++m)
#pragma unroll
                    for (int n = 0; n < 2; ++n) acc[a][b][m][n] = (f32x4){0.f, 0.f, 0.f, 0.f};
        cur = nxt; cA = nA; cB = nB; ++ui;
        if constexpr (ALIGN_EPI) { if (wr == 1) PG8_BAR; }
    }
    PG8_WAIT_V(0);
    if constexpr (!ALIGN_EPI) { if (wr == 0) PG8_BAR; }
    PG8_BAR;
#undef PG8_SA
#undef PG8_SB
#undef PG8_STAGE
#undef PG8_LDA
#undef PG8_LDB
#undef PG8_MMA
#undef PG8_WAIT_V
#undef PG8_WAIT_L
#undef PG8_BAR
#undef PG8_SCHED
}
}
constexpr bool GEMM_SP2 = true, GEMM_ALIGN = true;

namespace att {
constexpr int D = 128, LDQ = NQKV, LDO = DM;
constexpr float SCALE = 0.08838834764831845f, THR = 8.f;
constexpr int NW = 8, QBLK = 32, KVBLK = 64, QB = NW * QBLK;
constexpr int SHM_V = KVBLK * D * 2, SHM_K = KVBLK * D * 2;
constexpr int LDS_ATT = 2 * SHM_V + 2 * SHM_K + NW * 64 * 4;
constexpr unsigned BIGW = 0x40000000u;
#define KSWZ(row, colB) ((row) * 256 + ((colB) ^ (((row) & 7) << 4)))
#define SBAR() __builtin_amdgcn_sched_barrier(0)
__device__ __forceinline__ int v_st(int k, int c) { const int kk = (k & ~0xC) | ((k & 4) << 1) | ((k & 8) >> 1); return ((kk >> 3) * 4 + (c >> 5)) * 512 + ((kk & 7) * 32 + (c & 31)) * 2; }
__device__ __forceinline__ int v_rd_base(int lane) { return ((lane & 3) << 3) | (((lane >> 2) & 3) << 6) | (((lane >> 4) & 1) << 5) | (((lane >> 5) & 1) << 8); }
constexpr int v_rd_off(int d0, int ks, int half) { return d0 * 512 + ks * 4096 + half * 2048; }
__device__ __forceinline__ int crow(int r, int hi) { return (r & 3) + 8 * (r >> 2) + 4 * hi; }
__device__ __forceinline__ bf16x8 ld8(const bf16_t* p) { return *reinterpret_cast<const bf16x8*>(p); }
__device__ __forceinline__ void mask_tile(f32x16& p0, f32x16& p1, int dq) {
    const float NEG = -__builtin_inff();
#pragma unroll
    for (int r = 0; r < 16; ++r) {
        const int c = (r & 3) + 8 * (r >> 2);
        if ((unsigned)(dq - c) >= BIGW) p0[r] = NEG;
        if ((unsigned)(dq - c - 32) >= BIGW) p1[r] = NEG;
    }
}
__device__ __forceinline__ void mask_lane(f32x16& p0, f32x16& p1, bool keep) {
    const float NEG = -__builtin_inff();
#pragma unroll
    for (int r = 0; r < 16; ++r) { p0[r] = keep ? p0[r] : NEG; p1[r] = keep ? p1[r] : NEG; }
}
__device__ __forceinline__ void partialSM(f32x16& p0, f32x16& p1, float& m_reg, float& mn, float& alpha) {
    float pmax = p0[0]; for (int r = 1; r < 16; ++r) pmax = fmaxf(pmax, p0[r]); for (int r = 0; r < 16; ++r) pmax = fmaxf(pmax, p1[r]);
    { auto rr = __builtin_amdgcn_permlane32_swap(__float_as_uint(pmax), __float_as_uint(pmax), false, false);
      pmax = fmaxf(__uint_as_float(rr[0]), __uint_as_float(rr[1])); }
    constexpr float C2 = 1.4426950408889634f * SCALE;
    if (__builtin_expect(__all((pmax - m_reg) * SCALE <= THR), 1)) { mn = m_reg; alpha = 1.f; }
    else { mn = fmaxf(m_reg, pmax); alpha = __builtin_amdgcn_exp2f((m_reg - mn) * C2); m_reg = mn; }
    const float mnL = -mn * C2;
    for (int r = 0; r < 16; ++r) p0[r] = fmaf(p0[r], C2, mnL); for (int r = 0; r < 16; ++r) p1[r] = fmaf(p1[r], C2, mnL);
    for (int r = 0; r < 16; ++r) p0[r] = __builtin_amdgcn_exp2f(p0[r]);
}
__device__ __forceinline__ void finishSM(f32x16& p0, f32x16& p1, float alpha, float& l_reg, bf16x8& pa0, bf16x8& pa1, bf16x8& pa2, bf16x8& pa3) {
    for (int r = 0; r < 16; ++r) p1[r] = __builtin_amdgcn_exp2f(p1[r]);
    float ps = 0; for (int r = 0; r < 16; ++r) ps += p0[r]; for (int r = 0; r < 16; ++r) ps += p1[r];
    { auto rr = __builtin_amdgcn_permlane32_swap(__float_as_uint(ps), __float_as_uint(ps), false, false);
      ps = __uint_as_float(rr[0]) + __uint_as_float(rr[1]); }
    l_reg = l_reg * alpha + ps;
#define PK4(P, B_, OUT) do { unsigned a0 = cvt_pk_bf16(P[B_+0], P[B_+1]), a1 = cvt_pk_bf16(P[B_+2], P[B_+3]);                          \
        unsigned b0 = cvt_pk_bf16(P[B_+4], P[B_+5]), b1 = cvt_pk_bf16(P[B_+6], P[B_+7]);                                             \
        auto r0 = __builtin_amdgcn_permlane32_swap(a0, b0, false, false); auto r1 = __builtin_amdgcn_permlane32_swap(a1, b1, false, false); \
        u32x4 w = {r0[0], r1[0], r0[1], r1[1]}; OUT = *reinterpret_cast<bf16x8*>(&w); } while (0)
    PK4(p0, 0, pa0); PK4(p0, 8, pa1); PK4(p1, 0, pa2); PK4(p1, 8, pa3);
#undef PK4
}
template <int KB>
__device__ __forceinline__ void qkt(f32x16& p0, f32x16& p1, const char* K_lds, int r32, int hi, const bf16x8* qr, float a, float bias0) {
#pragma unroll
    for (int r = 0; r < 16; ++r) { const float c = (float)((r & 3) + 8 * (r >> 2)); p0[r] = fmaf(a, c, bias0); p1[r] = fmaf(a, c + 32.f, bias0); }
    const char* kb[4];
#pragma unroll
    for (int dd = 0; dd < 4; ++dd) kb[dd] = K_lds + KB * SHM_K + KSWZ(r32, (dd * 16 + hi * 8) * 2);
#pragma unroll
    for (int d0 = 0; d0 < 8; ++d0) { const char* ap = kb[d0 & 3] + (d0 >> 2) * 128;
        bf16x8 b0 = *reinterpret_cast<const bf16x8*>(ap);
        bf16x8 b1 = *reinterpret_cast<const bf16x8*>(ap + 32 * 256);
        p0 = __builtin_amdgcn_mfma_f32_32x32x16_bf16(b0, qr[d0], p0, 0, 0, 0);
        p1 = __builtin_amdgcn_mfma_f32_32x32x16_bf16(b1, qr[d0], p1, 0, 0, 0); }
}
template <int VB>
__device__ __forceinline__ void pv_tile(f32x16* o, int vb0, bf16x8 pa0, bf16x8 pa1, bf16x8 pa2, bf16x8 pa3) {
#define TRRD(dst, off) asm volatile("ds_read_b64_tr_b16 %0, %1 offset:%2" : "=&v"(dst) : "v"(vb0), "i"(off) : "memory")
#define PV_D0(d0) do { s16x4 l0, l1, l2, l3, h0, h1, h2, h3; constexpr int b_ = VB * SHM_V + v_rd_off(d0, 0, 0); \
        TRRD(l0, b_); TRRD(h0, b_ + 2048); TRRD(l1, b_ + 4096); TRRD(h1, b_ + 6144); TRRD(l2, b_ + 8192); TRRD(h2, b_ + 10240); TRRD(l3, b_ + 12288); TRRD(h3, b_ + 14336); \
        asm volatile("s_waitcnt lgkmcnt(0)" ::: "memory"); SBAR();   \
        o[d0] = __builtin_amdgcn_mfma_f32_32x32x16_bf16(pa0, (bf16x8){l0[0], l0[1], l0[2], l0[3], h0[0], h0[1], h0[2], h0[3]}, o[d0], 0, 0, 0);   \
        o[d0] = __builtin_amdgcn_mfma_f32_32x32x16_bf16(pa1, (bf16x8){l1[0], l1[1], l1[2], l1[3], h1[0], h1[1], h1[2], h1[3]}, o[d0], 0, 0, 0);   \
        o[d0] = __builtin_amdgcn_mfma_f32_32x32x16_bf16(pa2, (bf16x8){l2[0], l2[1], l2[2], l2[3], h2[0], h2[1], h2[2], h2[3]}, o[d0], 0, 0, 0);   \
        o[d0] = __builtin_amdgcn_mfma_f32_32x32x16_bf16(pa3, (bf16x8){l3[0], l3[1], l3[2], l3[3], h3[0], h3[1], h3[2], h3[3]}, o[d0], 0, 0, 0); } while (0)
    PV_D0(0); PV_D0(1); PV_D0(2); PV_D0(3);
#undef PV_D0
#undef TRRD
}
struct BlockRef { const bf16_t* Q; const bf16_t* K; const bf16_t* V; bf16_t* O; const unsigned char* sel; int P0; float a; int jlo; };
struct Seam { bf16x8 qr[8]; bf16x8 st_v0, st_v1, st_k0, st_k1; };
#define AROW(p, k0, rr) (((p) + (size_t)((k0) + (rr)) * LDQ) + toff)
#define VMW() asm volatile("s_waitcnt vmcnt(0)" ::: "memory")
#define VMWN(n) asm volatile("s_waitcnt vmcnt(%0)" :: "i"(n) : "memory")
#define SLOAD_H(Kp, Vp, k0) do { S.st_v0 = ld8(AROW(Vp, k0, 0)); S.st_v1 = ld8(AROW(Vp, k0, 32));              \
                         S.st_k0 = ld8(AROW(Kp, k0, 0)); S.st_k1 = ld8(AROW(Kp, k0, 32)); } while (0)
#define SWRITE_HK(bf) do { *(bf16x8*)(K_lds + (bf) * SHM_K + kws) = S.st_k0; *(bf16x8*)(K_lds + (bf) * SHM_K + kws + 32 * 256) = S.st_k1; } while (0)
#define SWRITE_HV(bf) do { *(bf16x8*)(V_lds + (bf) * SHM_V + vst0) = S.st_v0; *(bf16x8*)(V_lds + (bf) * SHM_V + vst1) = S.st_v1; } while (0)
#define SWRITE_H(bf) do { SWRITE_HV(bf); SWRITE_HK(bf); } while (0)
__device__ __forceinline__ void attn_prime(const BlockRef& cur, char* lds, Seam& S) {
    int tid_ = threadIdx.x; asm volatile("" : "+v"(tid_));
    const int tid = tid_, wid = __builtin_amdgcn_readfirstlane(tid >> 6), lane = tid & 63, r32 = lane & 31, hi = lane >> 5;
    const int sr = tid >> 4, sc = (tid & 15) * 8, kws = KSWZ(sr, sc * 2); char* K_lds = lds + 2 * SHM_V; const unsigned toff = (unsigned)(sr * LDQ + sc);
    { const unsigned qoff = (unsigned)(r32 * LDQ + hi * 8); const bf16_t* qb_ = cur.Q + (size_t)(wid * QBLK) * LDQ;
      for (int d0 = 0; d0 < 8; ++d0) S.qr[d0] = ld8(qb_ + qoff + d0 * 16); }
    SLOAD_H(cur.K, cur.V, cur.jlo * KVBLK); VMW(); SWRITE_HK(0);
    __syncthreads();
}
template <bool MOBA>
__device__ __forceinline__ void attn_block(const BlockRef& cur, const BlockRef& nxt, char* lds, Seam& S) {
    int tid_ = threadIdx.x; asm volatile("" : "+v"(tid_));
    const int tid = tid_, wid = __builtin_amdgcn_readfirstlane(tid >> 6), lane = tid & 63, r32 = lane & 31, hi = lane >> 5;
    const int NT = (cur.P0 + QB) / KVBLK - cur.jlo;
    const int qlo = cur.P0 + wid * QBLK, qm = qlo + r32 - 4 * hi;
    char* V_lds = lds; char* K_lds = lds + 2 * SHM_V;
    float* ws = (float*)(lds + 2 * SHM_V + 2 * SHM_K) + wid * 64; float* li_l = ws, * al_l = ws + 32;
    float m_reg = -1e30f, l_reg = 0; f32x16 o[4] = {};
    const int sr = tid >> 4, sc = (tid & 15) * 8, vst0 = v_st(sr, sc), vst1 = v_st(32 + sr, sc), kws = KSWZ(sr, sc * 2); const unsigned toff = (unsigned)(sr * LDQ + sc);
    const int vb0 = (int)(uintptr_t)V_lds + v_rd_base(lane);
    const bf16_t* Kh = cur.K; const bf16_t* Vh = cur.V;
    unsigned selm = 0xffu; if (MOBA) selm = cur.sel[cur.P0 + wid * QBLK + r32];
    const float aa = cur.a, abase = -aa * (float)qm;
#define RESC(a) do { if (__any((a) < 1.f)) { if (hi == 0) al_l[r32] = (a); asm volatile("s_waitcnt lgkmcnt(0)" ::: "memory");              \
                     for (int d_ = 0; d_ < 4; ++d_) for (int r = 0; r < 16; ++r) o[d_][r] *= al_l[crow(r, hi)]; } } while (0)
#define KBASE(t) ((cur.jlo + (t)) * KVBLK)
#define BIAS(t) fmaf(aa, (float)KBASE(t), abase)
#define MASKT(P0_, P1_, t) do { const int kb_ = KBASE(t); \
        if (!MOBA || kb_ >= cur.P0) { if (kb_ + KVBLK - 1 > qlo) mask_tile(P0_, P1_, qm - kb_); } \
        else { const bool keep_ = ((selm >> (kb_ >> 8)) & 1u) != 0u; if (!__all(keep_)) mask_lane(P0_, P1_, keep_); } } while (0)
#define SEAM_K0() do { VMWN(8); SWRITE_HK(0); SBAR(); } while (0)
    f32x16 pA0, pA1, pB0, pB1; float mnA, mnB, alA, alB; bf16x8 pa0, pa1, pa2, pa3;
    SWRITE_HV(0); SBAR();
    if (NT > 1) { SLOAD_H(Kh, Vh, KBASE(1)); }
    SBAR(); qkt<0>(pA0, pA1, K_lds, r32, hi, S.qr, aa, BIAS(0));
    MASKT(pA0, pA1, 0); partialSM(pA0, pA1, m_reg, mnA, alA);
    if (NT > 1) { VMW(); SWRITE_H(1); }
    __syncthreads();
#define HALF_STEP(PX0, PX1, mnX, alX, PY0, PY1, alY, t, KB, VB, SB) do {                                                      \
        SBAR(); qkt<KB>(PX0, PX1, K_lds, r32, hi, S.qr, aa, BIAS(t));                                                         \
        finishSM(PY0, PY1, alY, l_reg, pa0, pa1, pa2, pa3); SBAR();                                                           \
        if ((t) + 1 < NT) { SLOAD_H(Kh, Vh, KBASE((t) + 1)); SBAR(); }                                                        \
        pv_tile<VB>(o, vb0, pa0, pa1, pa2, pa3); MASKT(PX0, PX1, (t)); partialSM(PX0, PX1, m_reg, mnX, alX);                  \
        __syncthreads();                                                                                                      \
        if ((t) + 1 < NT) { VMW(); SWRITE_H(SB); }                                                                            \
        RESC(alX); __syncthreads(); } while (0)
    for (int t = 1; t + 1 < NT; t += 2) {
        HALF_STEP(pB0, pB1, mnB, alB, pA0, pA1, alA, t, 1, 0, 0);
        HALF_STEP(pA0, pA1, mnA, alA, pB0, pB1, alB, t + 1, 0, 1, 1);
    }
    const bool even = (NT & 1) == 0;
    if (even) { SBAR(); qkt<1>(pB0, pB1, K_lds, r32, hi, S.qr, aa, BIAS(NT - 1)); SBAR(); }
    SLOAD_H(nxt.K, nxt.V, nxt.jlo * KVBLK); SBAR();
    { const unsigned qoff = (unsigned)(r32 * LDQ + hi * 8); const bf16_t* qb_ = nxt.Q + (size_t)(wid * QBLK) * LDQ;
      _Pragma("unroll") for (int d0 = 0; d0 < 8; ++d0) S.qr[d0] = ld8(qb_ + qoff + d0 * 16); }
    SBAR();
    finishSM(pA0, pA1, alA, l_reg, pa0, pa1, pa2, pa3); SBAR();
    pv_tile<0>(o, vb0, pa0, pa1, pa2, pa3);
    if (even) { MASKT(pB0, pB1, NT - 1); partialSM(pB0, pB1, m_reg, mnB, alB); __syncthreads(); RESC(alB);
        finishSM(pB0, pB1, alB, l_reg, pa0, pa1, pa2, pa3); SBAR(); pv_tile<1>(o, vb0, pa0, pa1, pa2, pa3); }
    SBAR(); SEAM_K0();
    if (hi == 0) li_l[r32] = l_reg; asm volatile("s_waitcnt lgkmcnt(0)" ::: "memory");
    float rli[16];
#pragma unroll
    for (int r = 0; r < 16; ++r) rli[r] = __builtin_amdgcn_rcpf(li_l[crow(r, hi)]);
    bf16_t* Ow = cur.O + (size_t)(wid * QBLK) * LDO;
#pragma unroll
    for (int r = 0; r < 16; ++r) { const int orow = crow(r, hi);
#pragma unroll
        for (int d0 = 0; d0 < 4; ++d0) { const float v = o[d0][r] * rli[r];
            const float vn = xor1_get(v);
            if ((r32 & 1) == 0) *(unsigned*)(Ow + (size_t)orow * LDO + d0 * 32 + r32) = cvt_pk_bf16(v, vn); } }
    __syncthreads();
#undef RESC
#undef KBASE
#undef BIAS
#undef MASKT
#undef SEAM_K0
#undef HALF_STEP
}
#undef AROW
#undef VMW
#undef VMWN
#undef SLOAD_H
#undef SWRITE_HK
#undef SWRITE_HV
#undef SWRITE_H
}

constexpr int NWAVES = 8, NTHREADS = NWAVES * 64, NPHASE = 17;
struct Args { const float* in[23]; float* out; unsigned char* ws; int ph_lo, ph_hi; };
struct Frame { LAS unsigned char* lds; int tid, lane, wave, G, vc, gw, NGW; };
typedef const __attribute__((address_space(4))) Args* KAP;

struct WJob { const float* src; void* dst; const float* gain; float sc; int K, N, mode, kb, nb, f8; };
__device__ __forceinline__ int wdrow(int n, int mode) { return mode == 0 ? n : ((n >> 7) * 256 + (mode == 2 ? 128 : 0) + (n & 127)); }
constexpr int I_QKV = 32 * 24, I_OA = 32 * 8, I_G = 32 * 22, I_DN = 88 * 8, I_KV = 32 * 16, I_QB = 32 * 8, I_OB = 32 * 8, I_E1 = 32 * 28, I_EG = 8 * I_E1, I_ED1 = 112 * 8, I_ED = 8 * I_ED1;
constexpr int W_NITEMS = I_QKV + I_OA + 2 * I_G + I_DN + I_KV + I_QB + I_OB + 2 * I_EG + I_ED;
__device__ __forceinline__ void wjob_decode(KAP ap, int item, WJob& j) {
    unsigned char* ws = ap->ws; int r = item; int nbn; j.f8 = 0; j.sc = 1.0f;
    if (r < I_QKV) { j.src = ap->in[2]; j.dst = (bf16_t*)(ws + WS_WQKV); j.gain = ap->in[1]; j.K = DM; j.N = NQKV; j.mode = 0; }
    else if ((r -= I_QKV) < I_OA) { j.src = ap->in[3]; j.dst = (bf16_t*)(ws + WS_WOA); j.gain = nullptr; j.K = DM; j.N = DM; j.mode = 0; }
    else if ((r -= I_OA) < I_G) { j.src = ap->in[15]; j.dst = (bf16_t*)(ws + WS_WGU); j.gain = ap->in[14]; j.K = DM; j.N = FF; j.mode = 1; }
    else if ((r -= I_G) < I_G) { j.src = ap->in[16]; j.dst = (bf16_t*)(ws + WS_WGU); j.gain = ap->in[14]; j.K = DM; j.N = FF; j.mode = 2; }
    else if ((r -= I_G) < I_DN) { j.src = ap->in[17]; j.dst = (bf16_t*)(ws + WS_WDN); j.gain = nullptr; j.K = FF; j.N = DM; j.mode = 0; }
    else if ((r -= I_DN) < I_KV) { j.src = ap->in[5]; j.dst = (bf16_t*)(ws + WS_WKVQ); j.gain = ap->in[4]; j.K = DM; j.N = 2 * DM; j.mode = 0; }
    else if ((r -= I_KV) < I_QB) { j.src = ap->in[7]; j.dst = (bf16_t*)(ws + WS_WKVQ) + (size_t)2 * DM * DM; j.gain = ap->in[6]; j.K = DM; j.N = DM; j.mode = 0; }
    else if ((r -= I_QB) < I_OB) { j.src = ap->in[13]; j.dst = (bf16_t*)(ws + WS_WOB); j.gain = nullptr; j.K = DM; j.N = DM; j.mode = 0; }
    else if ((r -= I_OB) < I_EG) { const int e = r / I_E1; r -= e * I_E1; j.src = ap->in[19] + (size_t)e * DM * FE; j.dst = ws + WS_WEGU + (size_t)e * 2 * FE * DM; j.gain = ap->in[14] + DM; j.K = DM; j.N = FE; j.mode = 1; j.f8 = 1; j.sc = WEGU_SC; }
    else if ((r -= I_EG) < I_EG) { const int e = r / I_E1; r -= e * I_E1; j.src = ap->in[20] + (size_t)e * DM * FE; j.dst = ws + WS_WEGU + (size_t)e * 2 * FE * DM; j.gain = ap->in[14] + DM; j.K = DM; j.N = FE; j.mode = 2; j.f8 = 1; j.sc = WEGU_SC; }
    else { r -= I_EG; const int e = r / I_ED1; r -= e * I_ED1; j.src = ap->in[21] + (size_t)e * FE * DM; j.dst = ws + WS_WEDN + (size_t)e * DM * FE; j.gain = nullptr; j.K = FE; j.N = DM; j.mode = 0; j.f8 = 1; j.sc = WEDN_SC; }
    nbn = j.N >> 8; j.kb = r / nbn; j.nb = r - j.kb * nbn;
}
__device__ __forceinline__ void p0_weights(KAP a, Frame& F) {
    LAS float* tile = (LAS float*)F.lds;
    const int w = F.wave, l = F.lane;
    float v[32];
    int item = F.vc; bool have = item < W_NITEMS; WJob j;
#define W_LOAD() do { const float* sp = j.src + (size_t)(j.kb * 64 + w) * j.N + j.nb * 256 + l; \
        _Pragma("unroll") for (int i = 0; i < 8; ++i) _Pragma("unroll") for (int c = 0; c < 4; ++c) v[i * 4 + c] = __builtin_nontemporal_load(sp + (size_t)(8 * i) * j.N + 64 * c); } while (0)
    if (have) { wjob_decode(a, item, j); W_LOAD(); }
    while (have) {
        __syncthreads();
#pragma unroll
        for (int i = 0; i < 8; ++i) { const int k = w + 8 * i; const float g = (j.gain ? j.gain[j.kb * 64 + k] : 1.0f) * j.sc;
#pragma unroll
            for (int c = 0; c < 4; ++c) tile[k * 257 + l + 64 * c] = v[i * 4 + c] * g; }
        void* cdst = j.dst; const int cK = j.K, cmode = j.mode, ckb = j.kb, cnb = j.nb, cf8 = j.f8;
        item += F.G; const bool have_next = item < W_NITEMS;
        if (have_next) { wjob_decode(a, item, j); W_LOAD(); }
        __syncthreads();
        if (cf8) {
            const int c4 = l >> 4, n16 = l & 15;
#pragma unroll
            for (int jj = 0; jj < 2; ++jj) { const int n = n16 + 16 * w + 128 * jj; const LAS float* s = tile + (16 * c4) * 257 + n;
                u32x4 o; o.x = pg8::pk4_fp8(s[0], s[257], s[2 * 257], s[3 * 257]); o.y = pg8::pk4_fp8(s[4 * 257], s[5 * 257], s[6 * 257], s[7 * 257]);
                o.z = pg8::pk4_fp8(s[8 * 257], s[9 * 257], s[10 * 257], s[11 * 257]); o.w = pg8::pk4_fp8(s[12 * 257], s[13 * 257], s[14 * 257], s[15 * 257]);
                *(u32x4*)((unsigned char*)cdst + (size_t)wdrow(cnb * 256 + n, cmode) * cK + ckb * 64 + 16 * c4) = o; }
        } else {
        const int c8 = l >> 3, nn = l & 7;
#pragma unroll
        for (int jj = 0; jj < 4; ++jj) { const int n = nn + 8 * w + 64 * jj; const LAS float* s = tile + (8 * c8) * 257 + n;
            u32x4 o; o.x = cvt_pk_bf16(s[0], s[257]); o.y = cvt_pk_bf16(s[2 * 257], s[3 * 257]); o.z = cvt_pk_bf16(s[4 * 257], s[5 * 257]); o.w = cvt_pk_bf16(s[6 * 257], s[7 * 257]);
            *(u32x4*)((bf16_t*)cdst + (size_t)wdrow(cnb * 256 + n, cmode) * cK + ckb * 64 + 8 * c8) = o; }
        }
        have = have_next;
    }
#undef W_LOAD
    __syncthreads();
}
__device__ __forceinline__ void p0_x(const float* x, bf16_t* xb, u64* ss0, Frame& F) {
    for (int row = F.gw; row < MTOK; row += F.NGW) {
        const f32x4* xr = (const f32x4*)(x + (size_t)row * DM) + F.lane; f32x4 v[8]; float s = 0.f;
#pragma unroll
        for (int j = 0; j < 8; ++j) { v[j] = __builtin_nontemporal_load(xr + 64 * j); s += (v[j].x * v[j].x + v[j].y * v[j].y) + (v[j].z * v[j].z + v[j].w * v[j].w); }
        s = wave_sum(s);
        u32x2* o8 = (u32x2*)(xb + (size_t)row * DM) + F.lane;
#pragma unroll
        for (int j = 0; j < 8; ++j) { u32x2 w; w.x = cvt_pk_bf16(v[j].x, v[j].y); w.y = cvt_pk_bf16(v[j].z, v[j].w); o8[64 * j] = w; }
        if (F.lane == 0) ss0[row] = ss_fix(s);
    }
}
__device__ __forceinline__ void p2_kmean(const bf16_t* qkv, float* kmean, Frame& F) {
    const int c16 = F.lane & 15, rg = F.lane >> 4;
    for (int u = F.gw; u < NB * HA * 8; u += F.NGW) {
        const int bh = u >> 3, jb = u & 7, b = bh / HA, h = bh % HA;
        const bf16_t* kp = qkv + (size_t)(b * SEQ + jb * 256 + rg) * NQKV + DM + h * 128 + 8 * c16;
        float s[8] = {0.f, 0.f, 0.f, 0.f, 0.f, 0.f, 0.f, 0.f};
#pragma unroll 8
        for (int i = 0; i < 64; ++i) { const u32x4 q = *(const u32x4*)(kp + (size_t)(4 * i) * NQKV);
            s[0] += __uint_as_float(q.x << 16); s[1] += __uint_as_float(q.x & 0xffff0000u); s[2] += __uint_as_float(q.y << 16); s[3] += __uint_as_float(q.y & 0xffff0000u);
            s[4] += __uint_as_float(q.z << 16); s[5] += __uint_as_float(q.z & 0xffff0000u); s[6] += __uint_as_float(q.w << 16); s[7] += __uint_as_float(q.w & 0xffff0000u); }
#pragma unroll
        for (int e = 0; e < 8; ++e) s[e] = sum_xor32(sum_xor16(s[e]));
        if (rg == 0) { float* kd = kmean + (size_t)u * 128 + 8 * c16;
            *(f32x4*)kd = (f32x4){s[0], s[1], s[2], s[3]} * (1.0f / 256.0f); *(f32x4*)(kd + 4) = (f32x4){s[4], s[5], s[6], s[7]} * (1.0f / 256.0f); }
    }
}
__device__ __forceinline__ void p3_select(const bf16_t* qkv, const float* kmean, unsigned char* sel, Frame& F) {
    LAS float* km = (LAS float*)F.lds;
    for (int u = F.vc; u < NB * HA * 4; u += F.G) {
        const int bh = u >> 2, ch = u & 3, b = bh / HA, h = bh % HA;
        __syncthreads();
        km[F.tid] = kmean[(size_t)bh * 1024 + F.tid]; km[F.tid + 512] = kmean[(size_t)bh * 1024 + 512 + F.tid];
        __syncthreads();
        const int s = ch * 512 + F.tid, own = s >> 8;
        const bf16_t* qp = qkv + (size_t)(b * SEQ + s) * NQKV + h * 128;
        float gate[8] = {0.f, 0.f, 0.f, 0.f, 0.f, 0.f, 0.f, 0.f};
        if (own > 0) {
#pragma unroll 4
            for (int c = 0; c < 16; ++c) { const u32x4 q = *(const u32x4*)(qp + 8 * c);
                const float q0 = __uint_as_float(q.x << 16), q1 = __uint_as_float(q.x & 0xffff0000u), q2 = __uint_as_float(q.y << 16), q3 = __uint_as_float(q.y & 0xffff0000u);
                const float q4 = __uint_as_float(q.z << 16), q5 = __uint_as_float(q.z & 0xffff0000u), q6 = __uint_as_float(q.w << 16), q7 = __uint_as_float(q.w & 0xffff0000u);
#pragma unroll
                for (int jb = 0; jb < 8; ++jb) { const f32x4 k0 = *(const LAS f32x4*)(km + jb * 128 + 8 * c), k1 = *(const LAS f32x4*)(km + jb * 128 + 8 * c + 4);
                    gate[jb] += (q0 * k0.x + q1 * k0.y) + (q2 * k0.z + q3 * k0.w) + (q4 * k1.x + q5 * k1.y) + (q6 * k1.z + q7 * k1.w); } }
        }
        unsigned mask = 0u; const int nsel = own < 3 ? own : 3;
#pragma unroll
        for (int it = 0; it < 3; ++it) { if (it < nsel) { int best = -1; float bv = -__builtin_inff();
#pragma unroll
                for (int jb = 0; jb < 8; ++jb) { const bool ok = (jb < own) && (((mask >> jb) & 1u) == 0u) && (best < 0 || gate[jb] > bv); if (ok) { bv = gate[jb]; best = jb; } }
                if (best >= 0) mask |= 1u << best; } }
        sel[(size_t)bh * SEQ + s] = (unsigned char)mask;
    }
    __syncthreads();
}
__device__ __forceinline__ int attn_jlo(const unsigned* bnd, int qseg, int kseg, int b, int qb, float slope) {
    float q2 = 0.f, k2 = 0.f;
#pragma unroll
    for (int w = 0; w < 4; ++w) q2 += __uint_as_float(bnd[((size_t)qseg * 64 + b * 8 + qb) * 4 + w]);
    for (int t = 0; t <= qb; ++t) { float s2 = 0.f;
#pragma unroll
        for (int w = 0; w < 4; ++w) s2 += __uint_as_float(bnd[((size_t)kseg * 64 + b * 8 + t) * 4 + w]);
        k2 = __builtin_fmaxf(k2, s2); }
    const float W = (2.0f * 1.02f * __builtin_sqrtf(q2 * k2) * att::SCALE + 30.0f) / slope, lo = (float)(qb * 256) - W;
    return lo > 0.f ? (int)(lo * (1.0f / 64.0f)) : 0;
}
template <bool MOBA> __device__ __forceinline__ att::BlockRef attn_ref(int L, int pass, const bf16_t* qkv, bf16_t* out, const unsigned char* sel, const unsigned* bnd) {
    const int bh = L >> 2, y = L & 3, qb = pass ? 7 - y : y; att::BlockRef r;
    if (MOBA) { const int b = bh / HA, h = ((bh % HA) + 8 * (bh >> 6)) % HA; const size_t t0 = (size_t)b * SEQ; const float slope = __builtin_amdgcn_exp2f(-0.5f * (float)(h + 1));
        r.Q = qkv + (t0 + qb * 256) * NQKV + h * 128; r.K = qkv + t0 * NQKV + DM + h * 128; r.V = qkv + t0 * NQKV + 2 * DM + h * 128;
        r.O = out + (t0 + qb * 256) * DM + h * 128; r.sel = sel + (size_t)(b * HA + h) * SEQ; r.P0 = qb * 256; r.a = slope * (1.0f / att::SCALE); r.jlo = attn_jlo(bnd, h, 16 + h, b, qb, slope); }
    else { const int b = bh >> 5, sh = bh & 31, hn = sh >> 2, c = (sh >> 1) & 1, vh = sh & 1, h = (((hn & 1) ? 0x7621 : 0x5430) >> (4 * (((hn >> 1) + (bh >> 6)) & 3))) & 7; const size_t t0 = (size_t)b * SEQ; const float slope = __builtin_amdgcn_exp2f(-(float)(h + 1));
        r.Q = qkv + (t0 + qb * 256) * NQKV + 2 * DM + h * 256 + c * 128; r.K = qkv + t0 * NQKV + h * 256 + c * 128; r.V = qkv + t0 * NQKV + DM + h * 256 + vh * 128;
        r.O = out + (size_t)c * MTOK * DM + (t0 + qb * 256) * DM + h * 256 + vh * 128; r.sel = nullptr; r.P0 = qb * 256; r.a = slope * (1.0f / att::SCALE); r.jlo = attn_jlo(bnd, 32 + 2 * h + c, 2 * h + c, b, qb, slope); }
    return r;
}
template <bool MOBA> __device__ __forceinline__ void attn_phase(char* lds, const bf16_t* qkv, bf16_t* out, const unsigned char* sel, const unsigned* bnd, Frame& F) {
    constexpr int NITEMS = (MOBA ? NB * HA : NB * HB * 4) * 4;
    int L = F.vc; if (L >= NITEMS) return;
    int pass = 0; att::BlockRef cur = attn_ref<MOBA>(L, 0, qkv, out, sel, bnd); att::Seam S;
    att::attn_prime(cur, lds, S);
    for (;;) {
        const bool more_pass = pass == 0, more_item = L + F.G < NITEMS, last = !more_pass && !more_item;
        int passn = pass + 1, Ln = L; if (!more_pass) { passn = 0; Ln = more_item ? L + F.G : L; }
        const att::BlockRef nxt = last ? cur : attn_ref<MOBA>(Ln, passn, qkv, out, sel, bnd);
        att::attn_block<MOBA>(cur, nxt, lds, S);
        if (last) break;
        cur = nxt; pass = passn; L = Ln;
    }
}
__device__ __forceinline__ void p10_combine(KAP a, const bf16_t* omap, bf16_t* ao, Frame& F) {
    const int l = F.lane;
    float d1 = a->in[8][l] * a->in[9][l] + a->in[8][l + 64] * a->in[9][l + 64], d2 = a->in[10][l] * a->in[11][l] + a->in[10][l + 64] * a->in[11][l + 64];
    d1 = wave_sum(d1); d2 = wave_sum(d2);
    const float lam = __expf(d1) - __expf(d2) + LAM_INIT;
    const f32x4 g = *(const f32x4*)(a->in[12] + 4 * l);
    for (int tok = F.gw; tok < MTOK; tok += F.NGW) {
        const bf16_t* p1 = omap + (size_t)tok * DM + 4 * l; const bf16_t* p2 = p1 + (size_t)MTOK * DM; bf16_t* po = ao + (size_t)tok * DM + 4 * l;
#pragma unroll
        for (int h = 0; h < HB; ++h) { const u32x2 x1 = *(const u32x2*)(p1 + h * 256), x2 = *(const u32x2*)(p2 + h * 256);
            f32x4 d; d.x = __uint_as_float(x1.x << 16) - lam * __uint_as_float(x2.x << 16); d.y = __uint_as_float(x1.x & 0xffff0000u) - lam * __uint_as_float(x2.x & 0xffff0000u);
            d.z = __uint_as_float(x1.y << 16) - lam * __uint_as_float(x2.y << 16); d.w = __uint_as_float(x1.y & 0xffff0000u) - lam * __uint_as_float(x2.y & 0xffff0000u);
            float ss = wave_sum((d.x * d.x + d.y * d.y) + (d.z * d.z + d.w * d.w));
            const float r = __builtin_amdgcn_rsqf(ss * (1.0f / 256.0f) + RMS_EPS) * (1.0f - LAM_INIT);
            u32x2 w; w.x = cvt_pk_bf16(d.x * r * g.x, d.y * r * g.y); w.y = cvt_pk_bf16(d.z * r * g.z, d.w * r * g.w); *(u32x2*)(po + h * 256) = w; }
    }
}
__device__ __forceinline__ void p12_router(KAP a, const float* xr, const u64* ss3, unsigned* gcnt, int* tokinfo, Frame& F) {
    LAS float* gwt = (LAS float*)F.lds;
    LAS unsigned* cnt = (LAS unsigned*)(F.lds + 65536); LAS unsigned* base = cnt + 8;
    const float* wr = a->in[18]; const float* g1 = a->in[14] + DM;
    __syncthreads();
    for (int idx = F.tid; idx < DM * NE; idx += NTHREADS) gwt[idx] = wr[idx] * g1[idx >> 3];
    if (F.tid < 8) cnt[F.tid] = 0u;
    __syncthreads();
    const int l = F.lane;
    for (int chunk = F.vc; chunk < MTOK / 64; chunk += F.G) {
        int e0v = 0, e1v = 0, i0v = 0, i1v = 0; float g0v = 0.f, g1v = 0.f;
        for (int i = 0; i < 8; ++i) {
            const int tok = chunk * 64 + F.wave * 8 + i; const float* xp = xr + (size_t)tok * DM + l;
            float lg[8] = {0.f, 0.f, 0.f, 0.f, 0.f, 0.f, 0.f, 0.f};
#pragma unroll 8
            for (int j = 0; j < 32; ++j) { const float xv = xp[64 * j]; const LAS f32x4* wp = (const LAS f32x4*)(gwt + (l + 64 * j) * 8); const f32x4 w0 = wp[0], w1 = wp[1];
                lg[0] += xv * w0.x; lg[1] += xv * w0.y; lg[2] += xv * w0.z; lg[3] += xv * w0.w; lg[4] += xv * w1.x; lg[5] += xv * w1.y; lg[6] += xv * w1.z; lg[7] += xv * w1.w; }
            const float rs = rstd_q(ss3[tok]);
#pragma unroll
            for (int e = 0; e < 8; ++e) lg[e] = wave_sum(lg[e]) * rs;
            int b0 = 0; float v0 = lg[0];
#pragma unroll
            for (int e = 1; e < 8; ++e) if (lg[e] > v0) { v0 = lg[e]; b0 = e; }
            int b1 = -1; float v1 = -__builtin_inff();
#pragma unroll
            for (int e = 0; e < 8; ++e) if (e != b0 && (b1 < 0 || lg[e] > v1)) { v1 = lg[e]; b1 = e; }
            const float ga = 1.0f / (1.0f + __expf(v1 - v0));
            unsigned i0 = 0u, i1 = 0u;
            if (l == 0) { i0 = __hip_atomic_fetch_add(&cnt[b0], 1u, __ATOMIC_RELAXED, __HIP_MEMORY_SCOPE_WORKGROUP); i1 = __hip_atomic_fetch_add(&cnt[b1], 1u, __ATOMIC_RELAXED, __HIP_MEMORY_SCOPE_WORKGROUP); }
            i0 = __builtin_amdgcn_readfirstlane(i0); i1 = __builtin_amdgcn_readfirstlane(i1);
            if (l == i) { e0v = b0; e1v = b1; i0v = (int)i0; i1v = (int)i1; g0v = ga; g1v = 1.0f - ga; }
        }
        __syncthreads();
        if (F.tid < 8) base[F.tid] = __hip_atomic_fetch_add(gcnt + 64 * F.tid, cnt[F.tid], __ATOMIC_RELAXED, __HIP_MEMORY_SCOPE_AGENT);
        __syncthreads();
        if (l < 8) { const int tok = chunk * 64 + F.wave * 8 + l; int* ti = tokinfo + (size_t)tok * 8;
            ti[0] = e0v; ti[1] = e1v; ti[2] = (int)base[e0v] + i0v; ti[3] = (int)base[e1v] + i1v; ti[4] = __float_as_int(g0v); ti[5] = __float_as_int(g1v); }
        __syncthreads();
        if (F.tid < 8) cnt[F.tid] = 0u;
        __syncthreads();
    }
}
__device__ __forceinline__ void p13_gather(const bf16_t* xb, const u64* ss3, unsigned* gcnt, int* tiles, int* tokinfo, unsigned char* xs, Frame& F) {
    LAS int* pst = (LAS int*)F.lds;
    __syncthreads();
    if (F.tid == 0) { int acc = 0;
        for (int e = 0; e < NE; ++e) { const int c = (int)__hip_atomic_load(gcnt + 64 * e, __ATOMIC_RELAXED, __HIP_MEMORY_SCOPE_AGENT); const int p = (c + 255) & ~255;
            pst[e] = acc; pst[8 + e] = c; pst[16 + e] = p;
            if (blockIdx.x == 0) for (int t = acc >> 8; t < (acc + p) >> 8; ++t) tiles[1 + t] = e;
            acc += p; }
        if (blockIdx.x == 0) tiles[0] = acc >> 8; }
    __syncthreads();
    const int l = F.lane;
    for (int tok = F.gw; tok < MTOK; tok += F.NGW) {
        int* ti = tokinfo + (size_t)tok * 8;
        const int row0 = pst[ti[0]] + ti[2], row1 = pst[ti[1]] + ti[3];
        if (l == 0) { ti[6] = row0; ti[7] = row1; }
        const float rs = rstd_q(ss3[tok]) * XS_SC;
        const u32x2* sp = (const u32x2*)(xb + (size_t)tok * DM) + l; unsigned* d0 = (unsigned*)(xs + (size_t)row0 * DM) + l; unsigned* d1 = (unsigned*)(xs + (size_t)row1 * DM) + l;
#pragma unroll
        for (int j = 0; j < 8; ++j) { const u32x2 b = sp[64 * j];
            const unsigned q = pg8::pk4_fp8(__uint_as_float(b.x << 16) * rs, __uint_as_float(b.x & 0xffff0000u) * rs, __uint_as_float(b.y << 16) * rs, __uint_as_float(b.y & 0xffff0000u) * rs); d0[64 * j] = q; d1[64 * j] = q; }
    }
    for (int e = 0; e < NE; ++e) { const int lo = pst[e] + pst[8 + e], hi = pst[e] + pst[16 + e];
        for (int r = lo + F.gw; r < hi; r += F.NGW) { u32x4* d = (u32x4*)(xs + (size_t)r * DM) + l; d[0] = (u32x4){0u, 0u, 0u, 0u}; d[64] = (u32x4){0u, 0u, 0u, 0u}; } }
    __syncthreads();
}
__device__ __forceinline__ void ys_row(const bf16_t* ys, const float* slab, int split0, size_t ks_stride, int row, int l, f32x4 (&a)[8]) {
    if (row >= split0) { const float* p = slab + (size_t)(row - split0) * DM + 4 * l;
#pragma unroll
        for (int j = 0; j < 8; ++j) { f32x4 t = *(const f32x4*)(p + 256 * j);
#pragma unroll
            for (int ks = 1; ks < TAIL_NS; ++ks) t = t + *(const f32x4*)(p + 256 * j + (size_t)ks * ks_stride);
            a[j] = t * (1.0f / (ACT_SC * WEDN_SC)); } }
    else { const u32x2* p = (const u32x2*)(ys + (size_t)row * DM) + l;
#pragma unroll
        for (int j = 0; j < 8; ++j) { const u32x2 q = p[64 * j]; a[j] = (f32x4){__uint_as_float(q.x << 16), __uint_as_float(q.x & 0xffff0000u), __uint_as_float(q.y << 16), __uint_as_float(q.y & 0xffff0000u)}; } }
}
__device__ __forceinline__ void p16_final(const bf16_t* xb, const bf16_t* ys, const float* slab, const int* tiles, const int* tokinfo, const float* fg, float* out, Frame& F) {
    const int l = F.lane; const int nT = tiles[0]; int rt = nT & 31; if (rt > 7) rt = 0; const int split0 = (nT - rt) * 256; const size_t ks_stride = (size_t)rt * 256 * DM;
    for (int tok = F.gw; tok < MTOK; tok += F.NGW) {
        const int* ti = tokinfo + (size_t)tok * 8; const float g0 = __int_as_float(ti[4]), g1 = __int_as_float(ti[5]); const int row0 = ti[6], row1 = ti[7];
        const u32x2* xp = (const u32x2*)(xb + (size_t)tok * DM) + l;
        f32x4 v[8], a0[8], a1[8]; float s = 0.f;
#pragma unroll
        for (int j = 0; j < 8; ++j) { const u32x2 q = xp[64 * j]; v[j] = (f32x4){__uint_as_float(q.x << 16), __uint_as_float(q.x & 0xffff0000u), __uint_as_float(q.y << 16), __uint_as_float(q.y & 0xffff0000u)}; }
        ys_row(ys, slab, split0, ks_stride, row0, l, a0); ys_row(ys, slab, split0, ks_stride, row1, l, a1);
#pragma unroll
        for (int j = 0; j < 8; ++j) { v[j] = v[j] + g0 * a0[j] + g1 * a1[j]; s += (v[j].x * v[j].x + v[j].y * v[j].y) + (v[j].z * v[j].z + v[j].w * v[j].w); }
        const float r = rstd_of(wave_sum(s));
        f32x4* op = (f32x4*)(out + (size_t)tok * DM) + l; const f32x4* gp = (const f32x4*)fg + l;
#pragma unroll
        for (int j = 0; j < 8; ++j) op[64 * j] = v[j] * r * gp[64 * j];
    }
}

#ifndef PH_MASK
#define PH_MASK 0x1ffff
#endif
__global__ void __launch_bounds__(NTHREADS, 2) mega_fwd(Args args_by_value) {
    extern __shared__ __attribute__((aligned(16))) unsigned char lds[];
    (void)args_by_value;
    const KAP kap0 = (KAP)__builtin_amdgcn_kernarg_segment_ptr();
#define KARGS() ({ KAP p_ = kap0; asm volatile("" : "+s"(p_)); p_; })
    Frame F0;
#define F F0
    F.lds = (LAS unsigned char*)lds;
    F.tid = threadIdx.x; F.lane = F.tid & 63; F.wave = __builtin_amdgcn_readfirstlane(F.tid >> 6);
    F.G = gridDim.x; { const int bx = blockIdx.x; F.vc = (F.G % 8 == 0) ? (bx % 8) * (F.G / 8) + bx / 8 : bx; }
    F.gw = F.vc * NWAVES + F.wave; F.NGW = F.G * NWAVES;
    volatile LAS unsigned* MISC = (volatile LAS unsigned*)(F.lds + LDSCTL_OFF);
    for (int u = F.tid; u < (LDS_BYTES - LDSCTL_OFF) / 4; u += NTHREADS) ((LAS unsigned*)(F.lds + LDSCTL_OFF))[u] = 0u;
    __syncthreads();
    const int lo = kap0->ph_lo, hi = kap0->ph_hi;
    const bool use_bar = (hi - lo) > 1;
    XcdBarrier bar; bar.bar = (unsigned*)(kap0->ws + CTL_BAR); bar.x = 0; bar.st = MISC + 8;
    if (use_bar) bar = xcd_barrier_post((unsigned*)(kap0->ws + CTL_BAR), MISC + 8);
#ifndef DUP_MASK
#define DUP_MASK 0
#endif
#ifndef PROBE_SKIP_EPI
#define PROBE_SKIP_EPI 0
#endif
#define IN(k) (((PH_MASK >> (k)) & 1) && lo <= (k) && (k) < hi)
#define REP(k) for (int rep_ = 0; rep_ < (((DUP_MASK >> (k)) & 1) ? 2 : 1); ++rep_)
#define SEAM(k) do { if (IN(k) && IN((k) + 1)) xcd_barrier(bar); } while (0)
#define WSP(T, off) ((T*)(ws + (off)))
#define FRL() ({ Frame f_ = F0; asm volatile("" : "+v"(f_.tid), "+v"(f_.lane)); f_; })
#undef F
    const int bx = blockIdx.x;

    if (IN(0)) REP(0) { KAP ap = KARGS(); Frame F = FRL(); unsigned char* ws = ap->ws; p0_weights(ap, F); p0_x(ap->in[0], WSP(bf16_t, WS_XB), WSP(u64, CTL_SS), F); }
    SEAM(0);
    if (IN(1)) REP(1) {
        KAP ap = KARGS(); Frame F = FRL(); unsigned char* ws = ap->ws;
        pg8::Order S; S.init(MTOK / 256, NQKV / 256, 2 * DM, F.G, bx, ws + WS_XB, ws + WS_WQKV, 0, nullptr);
        pg8::EpiBf16Out<true, true> E{WSP(bf16_t, WS_QKV), NQKV, WSP(u64, CTL_SS), 1.f, WSP(unsigned, CTL_BND1)};
        pg8::gemm_phase<pg8::EpiBf16Out<true, true>, GEMM_ALIGN, GEMM_SP2>(F.lds, 2 * DM, S, E);
    }
    SEAM(1);
    if (IN(2)) REP(2) { KAP ap = KARGS(); Frame F = FRL(); unsigned char* ws = ap->ws; p2_kmean(WSP(bf16_t, WS_QKV), WSP(float, WS_KMEAN), F); }
    SEAM(2);
    if (IN(3)) REP(3) { KAP ap = KARGS(); Frame F = FRL(); unsigned char* ws = ap->ws; p3_select(WSP(bf16_t, WS_QKV), WSP(float, WS_KMEAN), WSP(unsigned char, WS_SEL), F); }
    SEAM(3);
    if (IN(4)) REP(4) { KAP ap = KARGS(); Frame F = FRL(); unsigned char* ws = ap->ws; attn_phase<true>((char*)lds, WSP(bf16_t, WS_QKV), WSP(bf16_t, WS_AO), WSP(unsigned char, WS_SEL), WSP(unsigned, CTL_BND1), F); }
    SEAM(4);
    if (IN(5)) REP(5) {
        KAP ap = KARGS(); Frame F = FRL(); unsigned char* ws = ap->ws;
        pg8::Order S; S.init(MTOK / 256, DM / 256, 2 * DM, F.G, bx, ws + WS_AO, ws + WS_WOA, 0, nullptr);
        pg8::EpiResid E{ap->in[0], WSP(float, WS_XR), WSP(bf16_t, WS_XB), WSP(u64, CTL_SS) + MTOK};
        pg8::gemm_phase<pg8::EpiResid, GEMM_ALIGN, GEMM_SP2>(F.lds, 2 * DM, S, E);
    }
    SEAM(5);
    if (IN(6)) REP(6) {
        KAP ap = KARGS(); Frame F = FRL(); unsigned char* ws = ap->ws;
        pg8::Order S; S.init(MTOK / 256, 2 * FF / 256, 2 * DM, F.G, bx, ws + WS_XB, ws + WS_WGU, 0, nullptr);
        pg8::EpiSwiGLU<false> E{WSP(bf16_t, WS_ACT), FF, WSP(u64, CTL_SS) + MTOK};
        pg8::gemm_phase<pg8::EpiSwiGLU<false>, GEMM_ALIGN, GEMM_SP2>(F.lds, 2 * DM, S, E);
    }
    SEAM(6);
    if (IN(7)) REP(7) {
        KAP ap = KARGS(); Frame F = FRL(); unsigned char* ws = ap->ws;
        pg8::Order S; S.init(MTOK / 256, DM / 256, 2 * FF, F.G, bx, ws + WS_ACT, ws + WS_WDN, 0, nullptr);
        pg8::EpiResid E{WSP(float, WS_XR), WSP(float, WS_XR), WSP(bf16_t, WS_XB), WSP(u64, CTL_SS) + 2 * MTOK};
        pg8::gemm_phase<pg8::EpiResid, GEMM_ALIGN, GEMM_SP2>(F.lds, 2 * FF, S, E);
    }
    SEAM(7);
    if (IN(8)) REP(8) {
        KAP ap = KARGS(); Frame F = FRL(); unsigned char* ws = ap->ws;
        pg8::Order S; S.init(MTOK / 256, NQKV / 256, 2 * DM, F.G, bx, ws + WS_XB, ws + WS_WKVQ, 0, nullptr);
        pg8::EpiBf16Out<true, true> E{WSP(bf16_t, WS_QKV), NQKV, WSP(u64, CTL_SS) + 2 * MTOK, 1.f, WSP(unsigned, CTL_BND2)};
        pg8::gemm_phase<pg8::EpiBf16Out<true, true>, GEMM_ALIGN, GEMM_SP2>(F.lds, 2 * DM, S, E);
    }
    SEAM(8);
    if (IN(9)) REP(9) { KAP ap = KARGS(); Frame F = FRL(); unsigned char* ws = ap->ws; attn_phase<false>((char*)lds, WSP(bf16_t, WS_QKV), WSP(bf16_t, WS_ACT), nullptr, WSP(unsigned, CTL_BND2), F); }
    SEAM(9);
    if (IN(10)) REP(10) { KAP ap = KARGS(); Frame F = FRL(); unsigned char* ws = ap->ws; p10_combine(ap, WSP(bf16_t, WS_ACT), WSP(bf16_t, WS_AO), F); }
    SEAM(10);
    if (IN(11)) REP(11) {
        KAP ap = KARGS(); Frame F = FRL(); unsigned char* ws = ap->ws;
        pg8::Order S; S.init(MTOK / 256, DM / 256, 2 * DM, F.G, bx, ws + WS_AO, ws + WS_WOB, 0, nullptr);
        pg8::EpiResid E{WSP(float, WS_XR), WSP(float, WS_XR), WSP(bf16_t, WS_XB), WSP(u64, CTL_SS) + 3 * MTOK};
        pg8::gemm_phase<pg8::EpiResid, GEMM_ALIGN, GEMM_SP2>(F.lds, 2 * DM, S, E);
    }
    SEAM(11);
    if (IN(12)) REP(12) { KAP ap = KARGS(); Frame F = FRL(); unsigned char* ws = ap->ws; p12_router(ap, WSP(float, WS_XR), WSP(u64, CTL_SS) + 3 * MTOK, WSP(unsigned, CTL_CNT), WSP(int, CTL_TOKINFO), F); }
    SEAM(12);
    if (IN(13)) REP(13) { KAP ap = KARGS(); Frame F = FRL(); unsigned char* ws = ap->ws; p13_gather(WSP(bf16_t, WS_XB), WSP(u64, CTL_SS) + 3 * MTOK, WSP(unsigned, CTL_CNT), WSP(int, CTL_TILES), WSP(int, CTL_TOKINFO), WSP(unsigned char, WS_XS), F); }
    SEAM(13);
    if (IN(14)) REP(14) {
        KAP ap = KARGS(); Frame F = FRL(); unsigned char* ws = ap->ws;
        const int* tiles = WSP(int, CTL_TILES); const int nT = tiles[0];
        pg8::Order S; S.init(nT, 2 * FE / 256, DM, F.G, bx, ws + WS_XS, ws + WS_WEGU, (size_t)2 * FE * DM, tiles + 1);
        pg8::EpiSwiGLU8 E{WSP(unsigned char, WS_ACTE), FE, 1.0f / (XS_SC * WEGU_SC), ACT_SC, (PROBE_SKIP_EPI && rep_ == 1) ? 1 : 0};
        pg8::gemm_phase<pg8::EpiSwiGLU8, GEMM_ALIGN, false, true>(F.lds, DM, S, E);
    }
    SEAM(14);
    if (IN(15)) REP(15) {
        KAP ap = KARGS(); Frame F = FRL(); unsigned char* ws = ap->ws;
        const int* tiles = WSP(int, CTL_TILES); const int nT = tiles[0];
        int rt = nT & 31; if (rt > 7) rt = 0;
        pg8::Order S; S.init(nT - rt, DM / 256, FE, F.G, bx, ws + WS_ACTE, ws + WS_WEDN, (size_t)DM * FE, tiles + 1);
        pg8::EpiBf16Out<false> E{WSP(bf16_t, WS_YS), DM, nullptr, 1.0f / (ACT_SC * WEDN_SC), nullptr};
        pg8::gemm_phase<pg8::EpiBf16Out<false>, GEMM_ALIGN, false, true>(F.lds, FE, S, E);
        if (rt) { pg8::TailOrder S2{rt * 8 * TAIL_NS, F.G, bx, nT - rt, TAIL_NS, (const char*)(ws + WS_ACTE), (const char*)(ws + WS_WEDN), (size_t)256 * FE, (size_t)DM * FE, (size_t)(FE / TAIL_NS), tiles + 1};
            pg8::EpiPart E2{WSP(float, WS_SLAB), (nT - rt) * 256, (size_t)rt * 256 * DM};
            pg8::gemm_phase<pg8::EpiPart, GEMM_ALIGN, false, true, pg8::TailOrder>(F.lds, FE, S2, E2, FE / TAIL_NS / 128); }
    }
    SEAM(15);
    if (IN(16)) REP(16) { KAP ap = KARGS(); Frame F = FRL(); unsigned char* ws = ap->ws; p16_final(WSP(bf16_t, WS_XB), WSP(bf16_t, WS_YS), WSP(float, WS_SLAB), WSP(int, CTL_TILES), WSP(int, CTL_TOKINFO), ap->in[22], ap->out, F); }
#undef IN
#undef REP
#undef SEAM
#undef WSP
#undef FRL
#undef KARGS
}

#ifndef MK_ONE_LAUNCH
#define MK_ONE_LAUNCH 1
#endif
extern "C" void kernel_launch(void* const* d_in, const int* in_sizes, int n_in, void* d_out, int out_size, void* d_ws, size_t ws_size, hipStream_t stream) {
    static int grid = 0;
    if (grid == 0) {
        if (n_in != 23 || out_size != MTOK * DM || ws_size < WS_END) { fprintf(stderr, "kernel_launch: unexpected shapes (n_in %d, out %d, ws %zu)\n", n_in, out_size, ws_size); grid = -1; return; }
        int dev = 0, cus = 0, per_cu = 0;
        if (hipGetDevice(&dev) != hipSuccess || hipDeviceGetAttribute(&cus, hipDeviceAttributeMultiprocessorCount, dev) != hipSuccess) { grid = -1; return; }
        if (hipFuncSetAttribute((const void*)mega_fwd, hipFuncAttributeMaxDynamicSharedMemorySize, LDS_BYTES) != hipSuccess) { fprintf(stderr, "kernel_launch: hipFuncSetAttribute failed\n"); grid = -1; return; }
        if (hipOccupancyMaxActiveBlocksPerMultiprocessor(&per_cu, (const void*)mega_fwd, NTHREADS, LDS_BYTES) != hipSuccess || per_cu < 1) { fprintf(stderr, "kernel_launch: occupancy query reports %d\n", per_cu); (void)hipGetLastError(); per_cu = 1; }
        grid = cus;
    }
    if (grid < 0) return;
    if (hipMemsetAsync((char*)d_ws + WS_CTL, 0, CTL_ZERO_BYTES, stream) != hipSuccess) return;
    Args a{};
    for (int i = 0; i < 23; ++i) a.in[i] = (const float*)d_in[i];
    a.out = (float*)d_out; a.ws = (unsigned char*)d_ws;
#if MK_ONE_LAUNCH
    a.ph_lo = 0; a.ph_hi = NPHASE;
    hipLaunchKernelGGL(mega_fwd, dim3(grid), dim3(NTHREADS), LDS_BYTES, stream, a);
#else
    for (int p = 0; p < NPHASE; ++p) { a.ph_lo = p; a.ph_hi = p + 1; hipLaunchKernelGGL(mega_fwd, dim3(grid), dim3(NTHREADS), LDS_BYTES, stream, a); }
#endif
}
```

```cpp
#include <hip/hip_runtime.h>
#include <cstdio>
#include <cstdint>

#define GAS __attribute__((address_space(1)))
#define LAS __attribute__((address_space(3)))
typedef unsigned short bf16_t;
typedef short bf16x8 __attribute__((ext_vector_type(8)));
typedef short s16x4 __attribute__((ext_vector_type(4)));
typedef float f32x2 __attribute__((ext_vector_type(2)));
typedef float f32x4 __attribute__((ext_vector_type(4)));
typedef float f32x16 __attribute__((ext_vector_type(16)));
typedef unsigned u32x2 __attribute__((ext_vector_type(2)));
typedef unsigned u32x4 __attribute__((ext_vector_type(4)));

constexpr int NB = 8, SEQ = 2048, DM = 2048, MTOK = NB * SEQ;
constexpr int NQKV = 3 * DM, FF = 5632, FE = 7168, NE = 8;
constexpr int HA = 16, HB = 8;
constexpr float RMS_EPS = 1e-6f;
constexpr float LAM_INIT = 0.35550906759096996f;
constexpr int MAXTILES = 136;
constexpr int MOE_ROWS = 135 * 256;

constexpr size_t MiB = 1u << 20;
constexpr size_t WS_CTL = 0, CTL_ZERO_BYTES = 2 * MiB;
constexpr size_t CTL_BAR = 4096;
constexpr size_t CTL_SS = 64 * 1024;
constexpr size_t CTL_CNT = 576 * 1024;
constexpr size_t CTL_BND1 = 640 * 1024, CTL_BND2 = 704 * 1024;
constexpr size_t CTL_TILES = 768 * 1024;
constexpr size_t CTL_KQ = 1 * MiB;
constexpr size_t WS_WQKV = 2 * MiB, WS_WOA = 26 * MiB, WS_WGU = 34 * MiB, WS_WDN = 78 * MiB, WS_WKVQ = 100 * MiB, WS_WOB = 124 * MiB;
constexpr size_t WS_XB = 132 * MiB, WS_XR = 196 * MiB, WS_WEGU = 324 * MiB, WS_WEDN = 548 * MiB, WS_BIG = 660 * MiB;
constexpr size_t WS_QKV = WS_BIG, WS_AO = WS_BIG + 192 * MiB, WS_ACT = WS_BIG + 256 * MiB, WS_KMEAN = WS_BIG + 432 * MiB, WS_SEL = WS_BIG + 433 * MiB;
constexpr size_t WS_ACTE = WS_BIG, WS_XS = WS_BIG + 237 * MiB, WS_YS = WS_BIG + 305 * MiB, WS_SLAB = WS_BIG + 440 * MiB, WS_END = WS_BIG + 501 * MiB;
constexpr size_t CTL_TOKINFO = WS_BIG + 500 * MiB;
static_assert(WS_END <= 1792 * MiB, "workspace map");
static_assert((size_t)MOE_ROWS * FE <= 237 * MiB && (size_t)MOE_ROWS * DM <= 68 * MiB && (size_t)MOE_ROWS * DM * 2 <= 135 * MiB && WS_SEL + MiB <= WS_END, "moe buffers");
constexpr float XS_SC = 16.f, WEGU_SC = 256.f, ACT_SC = 8.f, WEDN_SC = 512.f;
constexpr int TAIL_NS = 4, TAIL_MAXROWS = 31 * 256;
static_assert((size_t)TAIL_NS * 7 * 256 * DM * 4 <= 60 * MiB, "slab (nT in [128, 135] -> at most 7 tail row tiles)");

constexpr int RING_BYTES = 131072, LDS_BYTES = 147456, LDSCTL_OFF = LDS_BYTES - 512;

#define LDS_WAIT() asm volatile("s_waitcnt lgkmcnt(0)" ::: "memory")
#define VM_WAIT() asm volatile("s_waitcnt vmcnt(0)" ::: "memory")
__device__ __forceinline__ unsigned cvt_pk_bf16(float lo, float hi) { unsigned r; asm volatile("v_cvt_pk_bf16_f32 %0, %1, %2" : "=v"(r) : "v"(lo), "v"(hi)); return r; }
__device__ __forceinline__ float bf2f(unsigned short b) { return __uint_as_float(((unsigned)b) << 16); }
template <int CTRL> __device__ __forceinline__ float dppx(float v) { return __builtin_bit_cast(float, __builtin_amdgcn_update_dpp(0, __builtin_bit_cast(int, v), CTRL, 0xf, 0xf, true)); }
__device__ __forceinline__ float xor1_get(float v) { return dppx<0xB1>(v); }
__device__ __forceinline__ float sum_xor16(float v) { auto r = __builtin_amdgcn_permlane16_swap(__float_as_uint(v), __float_as_uint(v), false, false); return __uint_as_float(r[0]) + __uint_as_float(r[1]); }
__device__ __forceinline__ float sum_xor32(float v) { auto r = __builtin_amdgcn_permlane32_swap(__float_as_uint(v), __float_as_uint(v), false, false); return __uint_as_float(r[0]) + __uint_as_float(r[1]); }
__device__ __forceinline__ float row_sum16(float v) { v += dppx<0xB1>(v); v += dppx<0x4E>(v); v += dppx<0x141>(v); v += dppx<0x140>(v); return v; }
__device__ __forceinline__ float row_max16(float v) { v = __builtin_fmaxf(v, dppx<0xB1>(v)); v = __builtin_fmaxf(v, dppx<0x4E>(v)); v = __builtin_fmaxf(v, dppx<0x141>(v)); v = __builtin_fmaxf(v, dppx<0x140>(v)); return v; }
__device__ __forceinline__ float wave_sum(float v) { return sum_xor32(sum_xor16(row_sum16(v))); }
typedef unsigned long long u64;
__device__ __forceinline__ float rstd_of(float ss) { return __builtin_amdgcn_rsqf(ss * (1.0f / (float)DM) + RMS_EPS); }
__device__ __forceinline__ u64 ss_fix(float s) { return (u64)(s * 16777216.0f); }
__device__ __forceinline__ float rstd_q(u64 q) { return rstd_of((float)q * (1.0f / 16777216.0f)); }

#define XB_TMO      128
#define XB_XCNT(j)  (256  + 64 * (j))
#define XB_XSUB(j)  (1280 + 64 * (j))
#define XB_XGEN(j)  (2304 + 64 * (j))
#define XB_TOP      3328
#define XB_TOPGEN   3392
#define XCD_BAR_WORDS 3456
#define XB_SPIN_CAP (1u << 18)
__device__ __forceinline__ unsigned xb_ld(unsigned* p)              { return __hip_atomic_load(p, __ATOMIC_RELAXED, __HIP_MEMORY_SCOPE_AGENT); }
__device__ __forceinline__ unsigned xb_add(unsigned* p, unsigned v) { return __hip_atomic_fetch_add(p, v, __ATOMIC_RELAXED, __HIP_MEMORY_SCOPE_AGENT); }
__device__ __forceinline__ unsigned xb_xcc_id() { return (unsigned)__builtin_amdgcn_s_getreg((3 << 11) | 20) & 0xFu; }
#define XB_SPIN(cond, bar) do { unsigned _sp = 0; while (cond) { __builtin_amdgcn_s_sleep(1); \
    if ((++_sp & 255u) == 0u) { if (xb_ld(&(bar)[XB_TMO])) break; if (_sp > XB_SPIN_CAP) { atomicAdd(&(bar)[XB_TMO], 1u); break; } } } } while (0)
struct XcdBarrier { unsigned* bar; unsigned x; volatile LAS unsigned* st; };
__device__ __forceinline__ XcdBarrier xcd_barrier_post(unsigned* bar, volatile LAS unsigned* st) {
    XcdBarrier b; b.bar = bar; b.x = xb_xcc_id(); b.st = st;
    if (threadIdx.x == 0) (void)xb_add(&bar[XB_XCNT(b.x)], 1u);
    return b;
}
__device__ __forceinline__ void xcd_barrier_complete(unsigned* bar, unsigned x, unsigned& nloc, unsigned& nx) {
    const unsigned G = gridDim.x * gridDim.y * gridDim.z;
    unsigned sum, cnt, mine, sp = 0u;
    for (;;) {
        sum = 0u; cnt = 0u; mine = 0u;
#pragma unroll
        for (unsigned j = 0; j < 16; ++j) { const unsigned c = xb_ld(&bar[XB_XCNT(j)]); sum += c; cnt += (c > 0u) ? 1u : 0u; mine = (j == x) ? c : mine; }
        if (sum == G) break;
        __builtin_amdgcn_s_sleep(1);
        if ((++sp & 255u) == 0u) { if (xb_ld(&bar[XB_TMO])) break; if (sp > XB_SPIN_CAP) { atomicAdd(&bar[XB_TMO], 1u); break; } }
    }
    nloc = mine > 0u ? mine : 1u; nx = cnt > 0u ? cnt : 1u;
}
__device__ __forceinline__ void xcd_barrier(const XcdBarrier& b) {
    asm volatile("s_waitcnt vmcnt(0)" ::: "memory");
    __syncthreads();
    if (threadIdx.x == 0) {
        unsigned* bar = b.bar;
        __builtin_amdgcn_s_waitcnt(0);
        unsigned nloc = b.st[0], nx = b.st[1];
        if (nloc == 0u) { xcd_barrier_complete(bar, b.x, nloc, nx); b.st[0] = nloc; b.st[1] = nx; }
        const unsigned old = xb_add(&bar[XB_XSUB(b.x)], 1u);
        const unsigned gen = old / nloc;
        if (old + 1u == (gen + 1u) * nloc) {
            __builtin_amdgcn_fence(__ATOMIC_RELEASE, "agent");
            asm volatile("s_waitcnt vmcnt(0)" ::: "memory");
            const unsigned og = xb_add(&bar[XB_TOP], 1u);
            const unsigned tg = og / nx;
            if (og + 1u == (tg + 1u) * nx) xb_add(&bar[XB_TOPGEN], 1u);
            else XB_SPIN(xb_ld(&bar[XB_TOPGEN]) == tg, bar);
            __builtin_amdgcn_fence(__ATOMIC_ACQUIRE, "agent");
            xb_add(&bar[XB_XGEN(b.x)], 1u);
            asm volatile("s_waitcnt vmcnt(0)" ::: "memory");
        } else {
            XB_SPIN(xb_ld(&bar[XB_XGEN(b.x)]) == gen, bar);
            __builtin_amdgcn_fence(__ATOMIC_ACQUIRE, "agent");
            asm volatile("s_waitcnt vmcnt(0)" ::: "memory");
        }
    }
    __syncthreads();
}

namespace pg8 {
constexpr int BM = 256, BK = 64, HALF = 128, HTB = HALF * BK * 2, STAGE_BYTES = 8 * HTB, NXCD = 8, WGM = 8;
__host__ __device__ __forceinline__ int lds_byte(int r, int c) { const int st = (r >> 4) * 2 + (c >> 5), rr = r & 15, cc = c & 31, ob = rr * 64 + cc * 2; return st * 1024 + (ob ^ (((ob >> 9) & 1) << 5)); }
__host__ __device__ __forceinline__ void stage_rc(int b, int& R, int& C) { const int st = b / 1024, sb = b % 1024, swz = sb ^ (((sb >> 9) & 1) << 5); R = (st >> 1) * 16 + swz / 64; C = (st & 1) * 32 + (swz % 64) / 2; }
__host__ __device__ __forceinline__ int perm32(int rho) { const int n = rho >> 4, i = rho & 15; return 8 * (i >> 2) + 4 * n + (i & 3); }

struct Unit { int pm, pn, e, ks; };

struct Order {
    int nM, nN, nwg, G, c; const char* A; const char* B; size_t tstep, estride; const int* tile_e;
    __device__ __forceinline__ void init(int nM_, int nN_, int KB, int G_, int c_, const void* A_, const void* B_, size_t estride_, const int* tile_e_) {
        nM = nM_; nN = nN_; nwg = nM * nN; G = G_; c = c_; A = (const char*)A_; B = (const char*)B_; tstep = (size_t)BM * KB; estride = estride_; tile_e = tile_e_; }
    __device__ __forceinline__ bool next(int i, Unit& u) const {
        const long L = (long)i * G + c; if (L >= nwg) return false;
        int wgid = (int)L; { const int q = nwg / NXCD, r = nwg % NXCD, xcd = wgid % NXCD, off = wgid / NXCD; wgid = (xcd < r ? xcd * (q + 1) : r * (q + 1) + (xcd - r) * q) + off; }
        const int nig = WGM * nN, gid = wgid / nig, fm = gid * WGM, gsz = (nM - fm) < WGM ? (nM - fm) : WGM;
        u.pm = fm + ((wgid % nig) % gsz); u.pn = (wgid % nig) / gsz; u.e = tile_e ? tile_e[u.pm] : 0; u.ks = 0; return true;
    }
    __device__ __forceinline__ const char* a_base(const Unit& u) const { return A + (size_t)u.pm * tstep; }
    __device__ __forceinline__ const char* b_base(const Unit& u) const { return B + (size_t)u.e * estride + (size_t)u.pn * tstep; }
};

struct TailOrder {
    int nsub, G, c, pm0, NS; const char* A; const char* B; size_t tstep, estride, kslice; const int* tile_e;
    __device__ __forceinline__ bool next(int i, Unit& u) const { const int L = i * G + c; if (L >= nsub) return false; const int per = 8 * NS; u.pm = pm0 + L / per; const int rem = L % per; u.pn = rem / NS; u.ks = rem % NS; u.e = tile_e[u.pm]; return true; }
    __device__ __forceinline__ const char* a_base(const Unit& u) const { return A + (size_t)u.pm * tstep + (size_t)u.ks * kslice; }
    __device__ __forceinline__ const char* b_base(const Unit& u) const { return B + (size_t)u.e * estride + (size_t)u.pn * tstep + (size_t)u.ks * kslice; }
};

template <bool SCALE, bool BOUND = false, bool KMEAN = false> struct EpiBf16Out {
    static constexpr bool PERM = true;
    bf16_t* O; int ldc; const u64* ss; float csc; unsigned* bnd; u64* kq;
    __device__ __forceinline__ void operator()(const f32x4 (&acc)[2][2][4][2], const Unit& u, int wr, int wc, int fr, int fq) const {
        const int row0 = u.pm * BM + wr * 64 + fr, col0 = u.pn * BM + wc * 32 + 8 * fq; float mx[2] = {0.f, 0.f};
        const bool ktile = KMEAN && u.pn >= 8 && u.pn < 16; float cs[2][8];
#pragma unroll
        for (int i = 0; i < 16; ++i) cs[i >> 3][i & 7] = 0.f;
#pragma unroll
        for (int ai = 0; ai < 2; ++ai)
#pragma unroll
            for (int m = 0; m < 4; ++m) { const int row = row0 + ai * HALF + m * 16; float rs = csc; if (SCALE) rs = rstd_q(ss[row]);
                bf16_t* rowp = O + (size_t)row * ldc + col0;
#pragma unroll
                for (int bj = 0; bj < 2; ++bj) { const f32x4 v0 = acc[ai][bj][m][0] * rs, v1 = acc[ai][bj][m][1] * rs;
                    u32x4 w; w.x = cvt_pk_bf16(v0[0], v0[1]); w.y = cvt_pk_bf16(v0[2], v0[3]); w.z = cvt_pk_bf16(v1[0], v1[1]); w.w = cvt_pk_bf16(v1[2], v1[3]);
                    *(u32x4*)(rowp + bj * HALF) = w;
                    if (KMEAN) {
#pragma unroll
                        for (int j = 0; j < 4; ++j) { cs[bj][j] += v0[j]; cs[bj][4 + j] += v1[j]; } }
                    if (BOUND) { float sq = ((v0[0] * v0[0] + v0[1] * v0[1]) + (v0[2] * v0[2] + v0[3] * v0[3])) + ((v1[0] * v1[0] + v1[1] * v1[1]) + (v1[2] * v1[2] + v1[3] * v1[3]));
                        sq = sum_xor32(sum_xor16(sq)); mx[bj] = __builtin_fmaxf(mx[bj], sq); } } }
        if (BOUND) {
#pragma unroll
            for (int bj = 0; bj < 2; ++bj) { const float v = row_max16(mx[bj]);
                if (fr == 0 && fq == 0) __hip_atomic_fetch_max(bnd + ((size_t)(2 * u.pn + bj) * 64 + u.pm) * 4 + wc, __float_as_uint(v), __ATOMIC_RELAXED, __HIP_MEMORY_SCOPE_AGENT); } }
        if (KMEAN) { if (ktile) {
#pragma unroll
            for (int bj = 0; bj < 2; ++bj) { u64* kp = kq + ((size_t)((u.pm >> 3) * HA + (u.pn - 8) * 2 + bj) * 8 + (u.pm & 7)) * 128 + wc * 32 + 8 * fq;
#pragma unroll
                for (int j = 0; j < 8; ++j) { const float t = row_sum16(cs[bj][j]); if (fr == 0) __hip_atomic_fetch_add(kp + j, (u64)(long long)(t * 4294967296.0f), __ATOMIC_RELAXED, __HIP_MEMORY_SCOPE_AGENT); } } } }
    }
};
__device__ __forceinline__ float clamp448(float x) { return __builtin_fminf(__builtin_fmaxf(x, -448.0f), 448.0f); }
__device__ __forceinline__ unsigned pk4_fp8(float a, float b, float c, float d) { int v = __builtin_amdgcn_cvt_pk_fp8_f32(clamp448(a), clamp448(b), 0, false); v = __builtin_amdgcn_cvt_pk_fp8_f32(clamp448(c), clamp448(d), v, true); return (unsigned)v; }
__device__ __forceinline__ float silu_mul(float g, float u) { return g * __builtin_amdgcn_rcpf(1.0f + __builtin_amdgcn_exp2f(-1.4426950408889634f * g)) * u; }
__device__ __forceinline__ float silu_mul_c(float g, float u, float c1, float c2) { return (g * u) * (c2 * __builtin_amdgcn_rcpf(1.0f + __builtin_amdgcn_exp2f(g * c1))); }
template <bool RAW> struct EpiSwiGLU {
    static constexpr bool PERM = true;
    bf16_t* O; int ldc; const void* rsrc;
    __device__ __forceinline__ void operator()(const f32x4 (&acc)[2][2][4][2], const Unit& u, int wr, int wc, int fr, int fq) const {
        const int row0 = u.pm * BM + wr * 64 + fr, col0 = u.pn * HALF + wc * 32 + 8 * fq;
#pragma unroll
        for (int ai = 0; ai < 2; ++ai)
#pragma unroll
            for (int m = 0; m < 4; ++m) { const int row = row0 + ai * HALF + m * 16; float rs; if (RAW) rs = ((const float*)rsrc)[row]; else rs = rstd_q(((const u64*)rsrc)[row]);
                f32x4 a0, a1; const float c1 = -1.4426950408889634f * rs, c2 = rs * rs;
#pragma unroll
                for (int j = 0; j < 4; ++j) { a0[j] = silu_mul_c(acc[ai][0][m][0][j], acc[ai][1][m][0][j], c1, c2); a1[j] = silu_mul_c(acc[ai][0][m][1][j], acc[ai][1][m][1][j], c1, c2); }
                u32x4 w; w.x = cvt_pk_bf16(a0[0], a0[1]); w.y = cvt_pk_bf16(a0[2], a0[3]); w.z = cvt_pk_bf16(a1[0], a1[1]); w.w = cvt_pk_bf16(a1[2], a1[3]);
                *(u32x4*)(O + (size_t)row * ldc + col0) = w; }
    }
};
struct EpiSwiGLU8 {
    static constexpr bool PERM = true;
    unsigned char* O; int ldc; float isc, osc; int skip;
    __device__ __forceinline__ void operator()(const f32x4 (&acc)[2][2][4][2], const Unit& u, int wr, int wc, int fr, int fq) const {
        if (skip) return;
        const int row0 = u.pm * BM + wr * 64 + fr, col0 = u.pn * HALF + wc * 32 + 8 * fq; const float c1 = -1.4426950408889634f * isc, c2 = isc * isc * osc;
#pragma unroll
        for (int ai = 0; ai < 2; ++ai)
#pragma unroll
            for (int m = 0; m < 4; ++m) { const int row = row0 + ai * HALF + m * 16;
                f32x4 a0, a1;
#pragma unroll
                for (int j = 0; j < 4; ++j) { a0[j] = silu_mul_c(acc[ai][0][m][0][j], acc[ai][1][m][0][j], c1, c2); a1[j] = silu_mul_c(acc[ai][0][m][1][j], acc[ai][1][m][1][j], c1, c2); }
                u32x2 w; w.x = pk4_fp8(a0[0], a0[1], a0[2], a0[3]); w.y = pk4_fp8(a1[0], a1[1], a1[2], a1[3]);
                *(u32x2*)(O + (size_t)row * ldc + col0) = w; }
    }
};
struct EpiPart {
    static constexpr bool PERM = false;
    float* slab; int row_base; size_t ks_stride;
    __device__ __forceinline__ void operator()(const f32x4 (&acc)[2][2][4][2], const Unit& u, int wr, int wc, int fr, int fq) const {
        const int row0 = u.pm * BM + wr * 64 + fr - row_base, col0 = u.pn * BM + wc * 32 + 4 * fq; float* sp = slab + (size_t)u.ks * ks_stride;
#pragma unroll
        for (int ai = 0; ai < 2; ++ai)
#pragma unroll
            for (int m = 0; m < 4; ++m) { float* rowp = sp + (size_t)(row0 + ai * HALF + m * 16) * DM + col0;
#pragma unroll
                for (int bj = 0; bj < 2; ++bj)
#pragma unroll
                    for (int n = 0; n < 2; ++n) *(f32x4*)(rowp + bj * HALF + n * 16) = acc[ai][bj][m][n]; }
    }
};
struct EpiResid {
    static constexpr bool PERM = false;
    const float* base; float* xr; bf16_t* xb; u64* ssout;
    __device__ __forceinline__ void operator()(const f32x4 (&acc)[2][2][4][2], const Unit& u, int wr, int wc, int fr, int fq) const {
        const int row0 = u.pm * BM + wr * 64 + fr, col0 = u.pn * BM + wc * 32 + 4 * fq;
#pragma unroll
        for (int ai = 0; ai < 2; ++ai)
#pragma unroll
            for (int m = 0; m < 4; ++m) { const int row = row0 + ai * HALF + m * 16; const size_t off = (size_t)row * DM + col0; float s = 0.f;
#pragma unroll
                for (int bj = 0; bj < 2; ++bj)
#pragma unroll
                    for (int n = 0; n < 2; ++n) { const int c = bj * HALF + n * 16; const f32x4 b = *(const f32x4*)(base + off + c); const f32x4 o = b + acc[ai][bj][m][n];
                        *(f32x4*)(xr + off + c) = o; u32x2 w; w.x = cvt_pk_bf16(o[0], o[1]); w.y = cvt_pk_bf16(o[2], o[3]); *(u32x2*)(xb + off + c) = w;
                        s += (o[0] * o[0] + o[1] * o[1]) + (o[2] * o[2] + o[3] * o[3]); }
                s = sum_xor32(sum_xor16(s));
                if (fq == 0) __hip_atomic_fetch_add(ssout + row, ss_fix(s), __ATOMIC_RELAXED, __HIP_MEMORY_SCOPE_AGENT); }
    }
};

typedef int i32x8 __attribute__((ext_vector_type(8)));
__device__ __forceinline__ i32x8 cat16(bf16x8 lo, bf16x8 hi) { typedef int i32x4 __attribute__((ext_vector_type(4))); const i32x4 a = __builtin_bit_cast(i32x4, lo), b = __builtin_bit_cast(i32x4, hi); return (i32x8){a[0], a[1], a[2], a[3], b[0], b[1], b[2], b[3]}; }
__device__ __forceinline__ void mfma_fp8(f32x4& acc, i32x8 a, i32x8 b) { asm volatile("v_mfma_f32_16x16x128_f8f6f4 %0, %1, %2, %0" : "+v"(acc) : "v"(a), "v"(b)); }
template <class Epi, bool ALIGN_EPI, bool SP2, bool FP8 = false, class Sched = Order>
__device__ __forceinline__ void gemm_phase(LAS unsigned char* lds, const int KB, const Sched& S, const Epi& E, const int nt_override = 0) {
    int tid_ = threadIdx.x; asm volatile("" : "+v"(tid_));
    const int tid = tid_, wid = __builtin_amdgcn_readfirstlane(tid >> 6), lane = tid & 63, wr = wid >> 2, wc = wid & 3, fr = lane & 15, fq = lane >> 4;
    const int nt = nt_override ? nt_override : KB / 128;
    unsigned voffA[2], voffB[2];
#pragma unroll
    for (int i = 0; i < 2; ++i) { int R, C; stage_rc(tid * 16 + i * 8192, R, C); const int Rb = Epi::PERM ? ((R & ~31) + perm32(R & 31)) : R;
        voffA[i] = (unsigned)(R * KB + C * 2); voffB[i] = (unsigned)(Rb * KB + C * 2); }
    const size_t kstep = (size_t)(BK * 2);
    const size_t hstep = (size_t)HALF * KB;
    const unsigned ldsw = (unsigned)wid * 1024u;
    const int aoff = lds_byte(wr * 64 + fr, fq * 8), boff = lds_byte(wc * 32 + fr, fq * 8);
#define PG8_SA(b, h) (((b) * 2 + (h)) * HTB)
#define PG8_SB(b, h) ((4 + (b) * 2 + (h)) * HTB)
#define PG8_STAGE(bufoff, gbase, voff) do { _Pragma("unroll") for (int _i = 0; _i < 2; ++_i) \
        __builtin_amdgcn_global_load_lds((const unsigned*)((const char*)(gbase) + (voff)[_i]), (LAS unsigned*)(lds + (bufoff) + ldsw + _i * 8192), 16, 0, 0); } while (0)
#define PG8_LDA(dst, b, h) do { _Pragma("unroll") for (int m = 0; m < 4; ++m) _Pragma("unroll") for (int k = 0; k < 2; ++k) dst[m][k] = *(const LAS bf16x8*)(lds + PG8_SA(b, h) + aoff + m * 2048 + k * 1024); } while (0)
#define PG8_LDB(dst, b, h) do { _Pragma("unroll") for (int n = 0; n < 2; ++n) _Pragma("unroll") for (int k = 0; k < 2; ++k) dst[n][k] = *(const LAS bf16x8*)(lds + PG8_SB(b, h) + boff + n * 2048 + k * 1024); } while (0)
#define PG8_MMA(ai, bj, At, Bt) do { __builtin_amdgcn_s_setprio(1); _Pragma("unroll") for (int m = 0; m < 4; ++m) _Pragma("unroll") for (int n = 0; n < 2; ++n) { \
        if constexpr (FP8) mfma_fp8(acc[ai][bj][m][n], cat16(Bt[n][0], Bt[n][1]), cat16(At[m][0], At[m][1])); \
        else { _Pragma("unroll") for (int k = 0; k < 2; ++k) acc[ai][bj][m][n] = __builtin_amdgcn_mfma_f32_16x16x32_bf16(Bt[n][k], At[m][k], acc[ai][bj][m][n], 0, 0, 0); } } \
        __builtin_amdgcn_s_setprio(0); } while (0)
#define PG8_WAIT_V(n) asm volatile("s_waitcnt vmcnt(" #n ")" ::: "memory")
#define PG8_WAIT_L(n) asm volatile("s_waitcnt lgkmcnt(" #n ")" ::: "memory")
#define PG8_BAR __builtin_amdgcn_s_barrier()
#define PG8_SCHED __builtin_amdgcn_sched_barrier(0)
    Unit cur, nxt; int ui = 0;
    if (!S.next(0, cur)) return;
    f32x4 acc[2][2][4][2];
#pragma unroll
    for (int a = 0; a < 2; ++a)
#pragma unroll
        for (int b = 0; b < 2; ++b)
#pragma unroll
            for (int m = 0; m < 4; ++m)
#pragma unroll
                for (int n = 0; n < 2; ++n) acc[a][b][m][n] = (f32x4){0.f, 0.f, 0.f, 0.f};
    bf16x8 At[4][2], B0[2][2], B1[2][2];
    const char* cA = S.a_base(cur); const char* cB = S.b_base(cur);
    if constexpr (SP2) {
        PG8_STAGE(PG8_SB(0, 0), cB, voffB); PG8_STAGE(PG8_SB(0, 1), cB + hstep, voffB); PG8_STAGE(PG8_SA(0, 0), cA, voffA); PG8_STAGE(PG8_SA(0, 1), cA + hstep, voffA);
        if (wr == 1) PG8_BAR;
        PG8_WAIT_V(2); PG8_BAR;
        PG8_STAGE(PG8_SB(1, 0), cB + kstep, voffB); PG8_STAGE(PG8_SA(1, 0), cA + kstep, voffA); PG8_STAGE(PG8_SB(1, 1), cB + hstep + kstep, voffB);
        PG8_WAIT_V(6); PG8_BAR;
    } else {
        PG8_STAGE(PG8_SB(0, 0), cB, voffB); PG8_STAGE(PG8_SA(0, 0), cA, voffA); PG8_STAGE(PG8_SB(0, 1), cB + hstep, voffB); PG8_STAGE(PG8_SA(0, 1), cA + hstep, voffA);
        if (wr == 1) PG8_BAR;
        PG8_WAIT_V(4); PG8_BAR;
        PG8_STAGE(PG8_SB(1, 0), cB + kstep, voffB); PG8_STAGE(PG8_SA(1, 0), cA + kstep, voffA); PG8_STAGE(PG8_SB(1, 1), cB + hstep + kstep, voffB);
        PG8_WAIT_V(6); PG8_BAR;
    }
    for (;;) {
        const bool has_next = S.next(ui + 1, nxt);
        const char* nA = has_next ? S.a_base(nxt) : cA; const char* nB = has_next ? S.b_base(nxt) : cB;
        for (int t = 0; t < nt; t += 2) {
            const bool last = (t == nt - 2);
            const char* a1 = cA + (size_t)(t + 1) * kstep;
            const char* a2 = last ? nA : cA + (size_t)(t + 2) * kstep; const char* b2 = last ? nB : cB + (size_t)(t + 2) * kstep;
            const char* a3 = a2 + kstep; const char* b3 = b2 + kstep;
            if constexpr (SP2) {
            PG8_LDB(B0, 0, 0); PG8_LDB(B1, 0, 1); PG8_SCHED; PG8_LDA(At, 0, 0); PG8_STAGE(PG8_SA(1, 1), a1 + hstep, voffA);
            PG8_WAIT_V(8); PG8_WAIT_L(0); PG8_BAR; PG8_MMA(0, 0, At, B0); PG8_MMA(0, 1, At, B1); PG8_BAR; PG8_SCHED;
            PG8_LDA(At, 0, 1); PG8_STAGE(PG8_SB(0, 0), b2, voffB); PG8_STAGE(PG8_SB(0, 1), b2 + hstep, voffB); PG8_STAGE(PG8_SA(0, 0), a2, voffA);
            PG8_WAIT_V(8); PG8_WAIT_L(0); PG8_BAR; PG8_MMA(1, 0, At, B0); PG8_MMA(1, 1, At, B1); PG8_BAR; PG8_SCHED;
            PG8_LDB(B0, 1, 0); PG8_LDB(B1, 1, 1); PG8_SCHED; PG8_LDA(At, 1, 0); PG8_STAGE(PG8_SA(0, 1), a2 + hstep, voffA);
            PG8_WAIT_V(8); PG8_WAIT_L(0); PG8_BAR; PG8_MMA(0, 0, At, B0); PG8_MMA(0, 1, At, B1); PG8_BAR; PG8_SCHED;
            PG8_LDA(At, 1, 1); PG8_STAGE(PG8_SB(1, 0), b3, voffB); PG8_STAGE(PG8_SB(1, 1), b3 + hstep, voffB); PG8_STAGE(PG8_SA(1, 0), a3, voffA);
            PG8_WAIT_V(8); PG8_WAIT_L(0); PG8_BAR; PG8_MMA(1, 0, At, B0); PG8_MMA(1, 1, At, B1); PG8_BAR; PG8_SCHED;
            } else {
            PG8_LDB(B0, 0, 0); PG8_SCHED; PG8_LDA(At, 0, 0); PG8_STAGE(PG8_SA(1, 1), a1 + hstep, voffA);
            PG8_WAIT_L(8); PG8_BAR; PG8_WAIT_L(0); PG8_MMA(0, 0, At, B0); PG8_BAR; PG8_SCHED;
            PG8_LDB(B1, 0, 1); PG8_STAGE(PG8_SB(0, 0), b2, voffB);
            PG8_BAR; PG8_WAIT_L(0); PG8_MMA(0, 1, At, B1); PG8_BAR;
            PG8_LDA(At, 0, 1); PG8_STAGE(PG8_SA(0, 0), a2, voffA);
            PG8_BAR; PG8_WAIT_L(0); PG8_MMA(1, 0, At, B0); PG8_BAR; PG8_SCHED;
            PG8_STAGE(PG8_SB(0, 1), b2 + hstep, voffB);
            PG8_WAIT_V(6); PG8_BAR; PG8_MMA(1, 1, At, B1); PG8_BAR;
            PG8_LDB(B0, 1, 0); PG8_SCHED; PG8_LDA(At, 1, 0); PG8_STAGE(PG8_SA(0, 1), a2 + hstep, voffA);
            PG8_WAIT_L(8); PG8_BAR; PG8_WAIT_L(0); PG8_MMA(0, 0, At, B0); PG8_BAR; PG8_SCHED;
            PG8_LDB(B1, 1, 1); PG8_STAGE(PG8_SB(1, 0), b3, voffB);
            PG8_BAR; PG8_WAIT_L(0); PG8_MMA(0, 1, At, B1); PG8_BAR;
            PG8_LDA(At, 1, 1); PG8_STAGE(PG8_SA(1, 0), a3, voffA);
            PG8_BAR; PG8_WAIT_L(0); PG8_MMA(1, 0, At, B0); PG8_BAR; PG8_SCHED;
            PG8_STAGE(PG8_SB(1, 1), b3 + hstep, voffB);
            PG8_WAIT_V(6); PG8_BAR; PG8_MMA(1, 1, At, B1); PG8_BAR;
            }
        }
        if constexpr (FP8) asm volatile("s_nop 15\n\ts_nop 15" ::: "memory");
        if constexpr (ALIGN_EPI) { if (wr == 0) PG8_BAR; }
        E(acc, cur, wr, wc, fr, fq);
        if (!has_next) break;
#pragma unroll
        for (int a = 0; a < 2; ++a)
#pragma unroll
            for (int b = 0; b < 2; ++b)
#pragma unroll
                for (int m = 0; m < 4; ++m)
#pragma unroll
                    for (int n = 0; n < 2; ++n) acc[a][b][m][n] = (f32x4){0.f, 0.f, 0.f, 0.f};
        cur = nxt; cA = nA; cB = nB; ++ui;
        if constexpr (ALIGN_EPI) { if (wr == 1) PG8_BAR; }
    }
    PG8_WAIT_V(0);
    if constexpr (!ALIGN_EPI) { if (wr == 0) PG8_BAR; }
    PG8_BAR;
#undef PG8_SA
#undef PG8_SB
#undef PG8_STAGE
#undef PG8_LDA
#undef PG8_LDB
#undef PG8_MMA
#undef PG8_WAIT_V
#undef PG8_WAIT_L
#undef PG8_BAR
#undef PG8_SCHED
}
}
constexpr bool GEMM_SP2 = true, GEMM_ALIGN = true;

namespace att {
constexpr int D = 128, LDQ = NQKV, LDO = DM;
constexpr float SCALE = 0.08838834764831845f, THR = 8.f;
constexpr int NW = 8, QBLK = 32, KVBLK = 64, QB = NW * QBLK;
constexpr int SHM_V = KVBLK * D * 2, SHM_K = KVBLK * D * 2;
constexpr int LDS_ATT = 2 * SHM_V + 2 * SHM_K + NW * 64 * 4;
constexpr unsigned BIGW = 0x40000000u;
#define KSWZ(row, colB) ((row) * 256 + ((colB) ^ (((row) & 7) << 4)))
#define SBAR() __builtin_amdgcn_sched_barrier(0)
__device__ __forceinline__ int v_st(int k, int c) { const int kk = (k & ~0xC) | ((k & 4) << 1) | ((k & 8) >> 1); return ((kk >> 3) * 4 + (c >> 5)) * 512 + ((kk & 7) * 32 + (c & 31)) * 2; }
__device__ __forceinline__ int v_rd_base(int lane) { return ((lane & 3) << 3) | (((lane >> 2) & 3) << 6) | (((lane >> 4) & 1) << 5) | (((lane >> 5) & 1) << 8); }
constexpr int v_rd_off(int d0, int ks, int half) { return d0 * 512 + ks * 4096 + half * 2048; }
__device__ __forceinline__ int crow(int r, int hi) { return (r & 3) + 8 * (r >> 2) + 4 * hi; }
__device__ __forceinline__ bf16x8 ld8(const bf16_t* p) { return *reinterpret_cast<const bf16x8*>(p); }
__device__ __forceinline__ void mask_tile(f32x16& p0, f32x16& p1, int dq) {
    const float NEG = -__builtin_inff();
#pragma unroll
    for (int r = 0; r < 16; ++r) {
        const int c = (r & 3) + 8 * (r >> 2);
        if ((unsigned)(dq - c) >= BIGW) p0[r] = NEG;
        if ((unsigned)(dq - c - 32) >= BIGW) p1[r] = NEG;
    }
}
__device__ __forceinline__ void mask_lane(f32x16& p0, f32x16& p1, bool keep) {
    const float NEG = -__builtin_inff();
#pragma unroll
    for (int r = 0; r < 16; ++r) { p0[r] = keep ? p0[r] : NEG; p1[r] = keep ? p1[r] : NEG; }
}
__device__ __forceinline__ void partialSM(f32x16& p0, f32x16& p1, float& m_reg, float& mn, float& alpha) {
    float pmax = p0[0]; for (int r = 1; r < 16; ++r) pmax = fmaxf(pmax, p0[r]); for (int r = 0; r < 16; ++r) pmax = fmaxf(pmax, p1[r]);
    { auto rr = __builtin_amdgcn_permlane32_swap(__float_as_uint(pmax), __float_as_uint(pmax), false, false);
      pmax = fmaxf(__uint_as_float(rr[0]), __uint_as_float(rr[1])); }
    constexpr float C2 = 1.4426950408889634f * SCALE;
    if (__builtin_expect(__all((pmax - m_reg) * SCALE <= THR), 1)) { mn = m_reg; alpha = 1.f; }
    else { mn = fmaxf(m_reg, pmax); alpha = __builtin_amdgcn_exp2f((m_reg - mn) * C2); m_reg = mn; }
    const float mnL = -mn * C2;
    for (int r = 0; r < 16; ++r) p0[r] = fmaf(p0[r], C2, mnL); for (int r = 0; r < 16; ++r) p1[r] = fmaf(p1[r], C2, mnL);
    for (int r = 0; r < 16; ++r) p0[r] = __builtin_amdgcn_exp2f(p0[r]);
}
__device__ __forceinline__ void finishSM(f32x16& p0, f32x16& p1, float alpha, float& l_reg, bf16x8& pa0, bf16x8& pa1, bf16x8& pa2, bf16x8& pa3) {
    for (int r = 0; r < 16; ++r) p1[r] = __builtin_amdgcn_exp2f(p1[r]);
    float ps = 0; for (int r = 0; r < 16; ++r) ps += p0[r]; for (int r = 0; r < 16; ++r) ps += p1[r];
    { auto rr = __builtin_amdgcn_permlane32_swap(__float_as_uint(ps), __float_as_uint(ps), false, false);
      ps = __uint_as_float(rr[0]) + __uint_as_float(rr[1]); }
    l_reg = l_reg * alpha + ps;
#define PK4(P, B_, OUT) do { unsigned a0 = cvt_pk_bf16(P[B_+0], P[B_+1]), a1 = cvt_pk_bf16(P[B_+2], P[B_+3]);                          \
        unsigned b0 = cvt_pk_bf16(P[B_+4], P[B_+5]), b1 = cvt_pk_bf16(P[B_+6], P[B_+7]);                                             \
        auto r0 = __builtin_amdgcn_permlane32_swap(a0, b0, false, false); auto r1 = __builtin_amdgcn_permlane32_swap(a1, b1, false, false); \
        u32x4 w = {r0[0], r1[0], r0[1], r1[1]}; OUT = *reinterpret_cast<bf16x8*>(&w); } while (0)
    PK4(p0, 0, pa0); PK4(p0, 8, pa1); PK4(p1, 0, pa2); PK4(p1, 8, pa3);
#undef PK4
}
template <int KB>
__device__ __forceinline__ void qkt(f32x16& p0, f32x16& p1, const char* K_lds, int r32, int hi, const bf16x8* qr, float a, float bias0) {
#pragma unroll
    for (int r = 0; r < 16; ++r) { const float c = (float)((r & 3) + 8 * (r >> 2)); p0[r] = fmaf(a, c, bias0); p1[r] = fmaf(a, c + 32.f, bias0); }
    const char* kb[4];
#pragma unroll
    for (int dd = 0; dd < 4; ++dd) kb[dd] = K_lds + KB * SHM_K + KSWZ(r32, (dd * 16 + hi * 8) * 2);
#pragma unroll
    for (int d0 = 0; d0 < 8; ++d0) { const char* ap = kb[d0 & 3] + (d0 >> 2) * 128;
        bf16x8 b0 = *reinterpret_cast<const bf16x8*>(ap);
        bf16x8 b1 = *reinterpret_cast<const bf16x8*>(ap + 32 * 256);
        p0 = __builtin_amdgcn_mfma_f32_32x32x16_bf16(b0, qr[d0], p0, 0, 0, 0);
        p1 = __builtin_amdgcn_mfma_f32_32x32x16_bf16(b1, qr[d0], p1, 0, 0, 0); }
}
template <int VB>
__device__ __forceinline__ void pv_tile(f32x16* o, int vb0, bf16x8 pa0, bf16x8 pa1, bf16x8 pa2, bf16x8 pa3) {
#define TRRD(dst, off) asm volatile("ds_read_b64_tr_b16 %0, %1 offset:%2" : "=&v"(dst) : "v"(vb0), "i"(off) : "memory")
#define PV_D0(d0) do { s16x4 l0, l1, l2, l3, h0, h1, h2, h3; constexpr int b_ = VB * SHM_V + v_rd_off(d0, 0, 0); \
        TRRD(l0, b_); TRRD(h0, b_ + 2048); TRRD(l1, b_ + 4096); TRRD(h1, b_ + 6144); TRRD(l2, b_ + 8192); TRRD(h2, b_ + 10240); TRRD(l3, b_ + 12288); TRRD(h3, b_ + 14336); \
        asm volatile("s_waitcnt lgkmcnt(0)" ::: "memory"); SBAR();   \
        o[d0] = __builtin_amdgcn_mfma_f32_32x32x16_bf16(pa0, (bf16x8){l0[0], l0[1], l0[2], l0[3], h0[0], h0[1], h0[2], h0[3]}, o[d0], 0, 0, 0);   \
        o[d0] = __builtin_amdgcn_mfma_f32_32x32x16_bf16(pa1, (bf16x8){l1[0], l1[1], l1[2], l1[3], h1[0], h1[1], h1[2], h1[3]}, o[d0], 0, 0, 0);   \
        o[d0] = __builtin_amdgcn_mfma_f32_32x32x16_bf16(pa2, (bf16x8){l2[0], l2[1], l2[2], l2[3], h2[0], h2[1], h2[2], h2[3]}, o[d0], 0, 0, 0);   \
        o[d0] = __builtin_amdgcn_mfma_f32_32x32x16_bf16(pa3, (bf16x8){l3[0], l3[1], l3[2], l3[3], h3[0], h3[1], h3[2], h3[3]}, o[d0], 0, 0, 0); } while (0)
    PV_D0(0); PV_D0(1); PV_D0(2); PV_D0(3);
#undef PV_D0
#undef TRRD
}
struct BlockRef { const bf16_t* Q; const bf16_t* K; const bf16_t* V; bf16_t* O; const unsigned char* sel; int P0; float a; int jlo; };
struct Seam { bf16x8 qr[8]; bf16x8 st_v0, st_v1, st_k0, st_k1; };
#define AROW(p, k0, rr) (((p) + (size_t)((k0) + (rr)) * LDQ) + toff)
#define VMW() asm volatile("s_waitcnt vmcnt(0)" ::: "memory")
#define VMWN(n) asm volatile("s_waitcnt vmcnt(%0)" :: "i"(n) : "memory")
#define SLOAD_H(Kp, Vp, k0) do { S.st_v0 = ld8(AROW(Vp, k0, 0)); S.st_v1 = ld8(AROW(Vp, k0, 32));              \
                         S.st_k0 = ld8(AROW(Kp, k0, 0)); S.st_k1 = ld8(AROW(Kp, k0, 32)); } while (0)
#define SWRITE_HK(bf) do { *(bf16x8*)(K_lds + (bf) * SHM_K + kws) = S.st_k0; *(bf16x8*)(K_lds + (bf) * SHM_K + kws + 32 * 256) = S.st_k1; } while (0)
#define SWRITE_HV(bf) do { *(bf16x8*)(V_lds + (bf) * SHM_V + vst0) = S.st_v0; *(bf16x8*)(V_lds + (bf) * SHM_V + vst1) = S.st_v1; } while (0)
#define SWRITE_H(bf) do { SWRITE_HV(bf); SWRITE_HK(bf); } while (0)
__device__ __forceinline__ void attn_prime(const BlockRef& cur, char* lds, Seam& S) {
    int tid_ = threadIdx.x; asm volatile("" : "+v"(tid_));
    const int tid = tid_, wid = __builtin_amdgcn_readfirstlane(tid >> 6), lane = tid & 63, r32 = lane & 31, hi = lane >> 5;
    const int sr = tid >> 4, sc = (tid & 15) * 8, kws = KSWZ(sr, sc * 2); char* K_lds = lds + 2 * SHM_V; const unsigned toff = (unsigned)(sr * LDQ + sc);
    { const unsigned qoff = (unsigned)(r32 * LDQ + hi * 8); const bf16_t* qb_ = cur.Q + (size_t)(wid * QBLK) * LDQ;
      for (int d0 = 0; d0 < 8; ++d0) S.qr[d0] = ld8(qb_ + qoff + d0 * 16); }
    SLOAD_H(cur.K, cur.V, cur.jlo * KVBLK); VMW(); SWRITE_HK(0);
    __syncthreads();
}
template <bool MOBA>
__device__ __forceinline__ void attn_block(const BlockRef& cur, const BlockRef& nxt, char* lds, Seam& S) {
    int tid_ = threadIdx.x; asm volatile("" : "+v"(tid_));
    const int tid = tid_, wid = __builtin_amdgcn_readfirstlane(tid >> 6), lane = tid & 63, r32 = lane & 31, hi = lane >> 5;
    const int NT = (cur.P0 + QB) / KVBLK - cur.jlo;
    const int qlo = cur.P0 + wid * QBLK, qm = qlo + r32 - 4 * hi;
    char* V_lds = lds; char* K_lds = lds + 2 * SHM_V;
    float* ws = (float*)(lds + 2 * SHM_V + 2 * SHM_K) + wid * 64; float* li_l = ws, * al_l = ws + 32;
    float m_reg = -1e30f, l_reg = 0; f32x16 o[4] = {};
    const int sr = tid >> 4, sc = (tid & 15) * 8, vst0 = v_st(sr, sc), vst1 = v_st(32 + sr, sc), kws = KSWZ(sr, sc * 2); const unsigned toff = (unsigned)(sr * LDQ + sc);
    const int vb0 = (int)(uintptr_t)V_lds + v_rd_base(lane);
    const bf16_t* Kh = cur.K; const bf16_t* Vh = cur.V;
    unsigned selm = 0xffu; if (MOBA) selm = cur.sel[cur.P0 + wid * QBLK + r32];
    const float aa = cur.a, abase = -aa * (float)qm;
#define RESC(a) do { if (__any((a) < 1.f)) { if (hi == 0) al_l[r32] = (a); asm volatile("s_waitcnt lgkmcnt(0)" ::: "memory");              \
                     for (int d_ = 0; d_ < 4; ++d_) for (int r = 0; r < 16; ++r) o[d_][r] *= al_l[crow(r, hi)]; } } while (0)
#define KBASE(t) ((cur.jlo + (t)) * KVBLK)
#define BIAS(t) fmaf(aa, (float)KBASE(t), abase)
#define MASKT(P0_, P1_, t) do { const int kb_ = KBASE(t); \
        if (!MOBA || kb_ >= cur.P0) { if (kb_ + KVBLK - 1 > qlo) mask_tile(P0_, P1_, qm - kb_); } \
        else { const bool keep_ = ((selm >> (kb_ >> 8)) & 1u) != 0u; if (!__all(keep_)) mask_lane(P0_, P1_, keep_); } } while (0)
#define SEAM_K0() do { VMWN(8); SWRITE_HK(0); SBAR(); } while (0)
    f32x16 pA0, pA1, pB0, pB1; float mnA, mnB, alA, alB; bf16x8 pa0, pa1, pa2, pa3;
    SWRITE_HV(0); SBAR();
    if (NT > 1) { SLOAD_H(Kh, Vh, KBASE(1)); }
    SBAR(); qkt<0>(pA0, pA1, K_lds, r32, hi, S.qr, aa, BIAS(0));
    MASKT(pA0, pA1, 0); partialSM(pA0, pA1, m_reg, mnA, alA);
    if (NT > 1) { VMW(); SWRITE_H(1); }
    __syncthreads();
#define HALF_STEP(PX0, PX1, mnX, alX, PY0, PY1, alY, t, KB, VB, SB) do {                                                      \
        SBAR(); qkt<KB>(PX0, PX1, K_lds, r32, hi, S.qr, aa, BIAS(t));                                                         \
        finishSM(PY0, PY1, alY, l_reg, pa0, pa1, pa2, pa3); SBAR();                                                           \
        if ((t) + 1 < NT) { SLOAD_H(Kh, Vh, KBASE((t) + 1)); SBAR(); }                                                        \
        pv_tile<VB>(o, vb0, pa0, pa1, pa2, pa3); MASKT(PX0, PX1, (t)); partialSM(PX0, PX1, m_reg, mnX, alX);                  \
        __syncthreads();                                                                                                      \
        if ((t) + 1 < NT) { VMW(); SWRITE_H(SB); }                                                                            \
        RESC(alX); __syncthreads(); } while (0)
    for (int t = 1; t + 1 < NT; t += 2) {
        HALF_STEP(pB0, pB1, mnB, alB, pA0, pA1, alA, t, 1, 0, 0);
        HALF_STEP(pA0, pA1, mnA, alA, pB0, pB1, alB, t + 1, 0, 1, 1);
    }
    const bool even = (NT & 1) == 0;
    if (even) { SBAR(); qkt<1>(pB0, pB1, K_lds, r32, hi, S.qr, aa, BIAS(NT - 1)); SBAR(); }
    SLOAD_H(nxt.K, nxt.V, nxt.jlo * KVBLK); SBAR();
    { const unsigned qoff = (unsigned)(r32 * LDQ + hi * 8); const bf16_t* qb_ = nxt.Q + (size_t)(wid * QBLK) * LDQ;
      _Pragma("unroll") for (int d0 = 0; d0 < 8; ++d0) S.qr[d0] = ld8(qb_ + qoff + d0 * 16); }
    SBAR();
    finishSM(pA0, pA1, alA, l_reg, pa0, pa1, pa2, pa3); SBAR();
    pv_tile<0>(o, vb0, pa0, pa1, pa2, pa3);
    if (even) { MASKT(pB0, pB1, NT - 1); partialSM(pB0, pB1, m_reg, mnB, alB); __syncthreads(); RESC(alB);
        finishSM(pB0, pB1, alB, l_reg, pa0, pa1, pa2, pa3); SBAR(); pv_tile<1>(o, vb0, pa0, pa1, pa2, pa3); }
    SBAR(); SEAM_K0();
    if (hi == 0) li_l[r32] = l_reg; asm volatile("s_waitcnt lgkmcnt(0)" ::: "memory");
    float rli[16];
#pragma unroll
    for (int r = 0; r < 16; ++r) rli[r] = __builtin_amdgcn_rcpf(li_l[crow(r, hi)]);
    bf16_t* Ow = cur.O + (size_t)(wid * QBLK) * LDO;
#pragma unroll
    for (int r = 0; r < 16; ++r) { const int orow = crow(r, hi);
#pragma unroll
        for (int d0 = 0; d0 < 4; ++d0) { const float v = o[d0][r] * rli[r];
            const float vn = xor1_get(v);
            if ((r32 & 1) == 0) *(unsigned*)(Ow + (size_t)orow * LDO + d0 * 32 + r32) = cvt_pk_bf16(v, vn); } }
    __syncthreads();
#undef RESC
#undef KBASE
#undef BIAS
#undef MASKT
#undef SEAM_K0
#undef HALF_STEP
}
#undef AROW
#undef VMW
#undef VMWN
#undef SLOAD_H
#undef SWRITE_HK
#undef SWRITE_HV
#undef SWRITE_H
}

constexpr int NWAVES = 8, NTHREADS = NWAVES * 64, NPHASE = 17;
struct Args { const float* in[23]; float* out; unsigned char* ws; int ph_lo, ph_hi; };
struct Frame { LAS unsigned char* lds; int tid, lane, wave, G, vc, gw, NGW; };
typedef const __attribute__((address_space(4))) Args* KAP;

struct WJob { const float* src; void* dst; const float* gain; float sc; int K, N, mode, kb, nb, f8; };
__device__ __forceinline__ int wdrow(int n, int mode) { return mode == 0 ? n : ((n >> 7) * 256 + (mode == 2 ? 128 : 0) + (n & 127)); }
constexpr int I_QKV = 32 * 24, I_OA = 32 * 8, I_G = 32 * 22, I_DN = 88 * 8, I_KV = 32 * 16, I_QB = 32 * 8, I_OB = 32 * 8, I_E1 = 32 * 28, I_EG = 8 * I_E1, I_ED1 = 112 * 8, I_ED = 8 * I_ED1;
constexpr int W_NITEMS = I_QKV + I_OA + 2 * I_G + I_DN + I_KV + I_QB + I_OB + 2 * I_EG + I_ED;
__device__ __forceinline__ void wjob_decode(KAP ap, int item, WJob& j) {
    unsigned char* ws = ap->ws; int r = item; int nbn; j.f8 = 0; j.sc = 1.0f;
    if (r < I_QKV) { j.src = ap->in[2]; j.dst = (bf16_t*)(ws + WS_WQKV); j.gain = ap->in[1]; j.K = DM; j.N = NQKV; j.mode = 0; }
    else if ((r -= I_QKV) < I_OA) { j.src = ap->in[3]; j.dst = (bf16_t*)(ws + WS_WOA); j.gain = nullptr; j.K = DM; j.N = DM; j.mode = 0; }
    else if ((r -= I_OA) < I_G) { j.src = ap->in[15]; j.dst = (bf16_t*)(ws + WS_WGU); j.gain = ap->in[14]; j.K = DM; j.N = FF; j.mode = 1; }
    else if ((r -= I_G) < I_G) { j.src = ap->in[16]; j.dst = (bf16_t*)(ws + WS_WGU); j.gain = ap->in[14]; j.K = DM; j.N = FF; j.mode = 2; }
    else if ((r -= I_G) < I_DN) { j.src = ap->in[17]; j.dst = (bf16_t*)(ws + WS_WDN); j.gain = nullptr; j.K = FF; j.N = DM; j.mode = 0; }
    else if ((r -= I_DN) < I_KV) { j.src = ap->in[5]; j.dst = (bf16_t*)(ws + WS_WKVQ); j.gain = ap->in[4]; j.K = DM; j.N = 2 * DM; j.mode = 0; }
    else if ((r -= I_KV) < I_QB) { j.src = ap->in[7]; j.dst = (bf16_t*)(ws + WS_WKVQ) + (size_t)2 * DM * DM; j.gain = ap->in[6]; j.K = DM; j.N = DM; j.mode = 0; }
    else if ((r -= I_QB) < I_OB) { j.src = ap->in[13]; j.dst = (bf16_t*)(ws + WS_WOB); j.gain = nullptr; j.K = DM; j.N = DM; j.mode = 0; }
    else if ((r -= I_OB) < I_EG) { const int e = r / I_E1; r -= e * I_E1; j.src = ap->in[19] + (size_t)e * DM * FE; j.dst = ws + WS_WEGU + (size_t)e * 2 * FE * DM; j.gain = ap->in[14] + DM; j.K = DM; j.N = FE; j.mode = 1; j.f8 = 1; j.sc = WEGU_SC; }
    else if ((r -= I_EG) < I_EG) { const int e = r / I_E1; r -= e * I_E1; j.src = ap->in[20] + (size_t)e * DM * FE; j.dst = ws + WS_WEGU + (size_t)e * 2 * FE * DM; j.gain = ap->in[14] + DM; j.K = DM; j.N = FE; j.mode = 2; j.f8 = 1; j.sc = WEGU_SC; }
    else { r -= I_EG; const int e = r / I_ED1; r -= e * I_ED1; j.src = ap->in[21] + (size_t)e * FE * DM; j.dst = ws + WS_WEDN + (size_t)e * DM * FE; j.gain = nullptr; j.K = FE; j.N = DM; j.mode = 0; j.f8 = 1; j.sc = WEDN_SC; }
    nbn = j.N >> 8; j.kb = r / nbn; j.nb = r - j.kb * nbn;
}
__device__ __forceinline__ void p0_weights(KAP a, Frame& F) {
    LAS float* tile = (LAS float*)F.lds;
    const int w = F.wave, l = F.lane;
    float v[32];
    int item = F.vc; bool have = item < W_NITEMS; WJob j;
#define W_LOAD() do { const float* sp = j.src + (size_t)(j.kb * 64 + w) * j.N + j.nb * 256 + l; \
        _Pragma("unroll") for (int i = 0; i < 8; ++i) _Pragma("unroll") for (int c = 0; c < 4; ++c) v[i * 4 + c] = __builtin_nontemporal_load(sp + (size_t)(8 * i) * j.N + 64 * c); } while (0)
    if (have) { wjob_decode(a, item, j); W_LOAD(); }
    while (have) {
        __syncthreads();
#pragma unroll
        for (int i = 0; i < 8; ++i) { const int k = w + 8 * i; const float g = (j.gain ? j.gain[j.kb * 64 + k] : 1.0f) * j.sc;
#pragma unroll
            for (int c = 0; c < 4; ++c) tile[k * 257 + l + 64 * c] = v[i * 4 + c] * g; }
        void* cdst = j.dst; const int cK = j.K, cmode = j.mode, ckb = j.kb, cnb = j.nb, cf8 = j.f8;
        item += F.G; const bool have_next = item < W_NITEMS;
        if (have_next) { wjob_decode(a, item, j); W_LOAD(); }
        __syncthreads();
        if (cf8) {
            const int c4 = l >> 4, n16 = l & 15;
#pragma unroll
            for (int jj = 0; jj < 2; ++jj) { const int n = n16 + 16 * w + 128 * jj; const LAS float* s = tile + (16 * c4) * 257 + n;
                u32x4 o; o.x = pg8::pk4_fp8(s[0], s[257], s[2 * 257], s[3 * 257]); o.y = pg8::pk4_fp8(s[4 * 257], s[5 * 257], s[6 * 257], s[7 * 257]);
                o.z = pg8::pk4_fp8(s[8 * 257], s[9 * 257], s[10 * 257], s[11 * 257]); o.w = pg8::pk4_fp8(s[12 * 257], s[13 * 257], s[14 * 257], s[15 * 257]);
                *(u32x4*)((unsigned char*)cdst + (size_t)wdrow(cnb * 256 + n, cmode) * cK + ckb * 64 + 16 * c4) = o; }
        } else {
        const int c8 = l >> 3, nn = l & 7;
#pragma unroll
        for (int jj = 0; jj < 4; ++jj) { const int n = nn + 8 * w + 64 * jj; const LAS float* s = tile + (8 * c8) * 257 + n;
            u32x4 o; o.x = cvt_pk_bf16(s[0], s[257]); o.y = cvt_pk_bf16(s[2 * 257], s[3 * 257]); o.z = cvt_pk_bf16(s[4 * 257], s[5 * 257]); o.w = cvt_pk_bf16(s[6 * 257], s[7 * 257]);
            *(u32x4*)((bf16_t*)cdst + (size_t)wdrow(cnb * 256 + n, cmode) * cK + ckb * 64 + 8 * c8) = o; }
        }
        have = have_next;
    }
#undef W_LOAD
    __syncthreads();
}
__device__ __forceinline__ void p0_x(const float* x, bf16_t* xb, u64* ss0, Frame& F) {
    for (int row = F.gw; row < MTOK; row += F.NGW) {
        const f32x4* xr = (const f32x4*)(x + (size_t)row * DM) + F.lane; f32x4 v[8]; float s = 0.f;
#pragma unroll
        for (int j = 0; j < 8; ++j) { v[j] = __builtin_nontemporal_load(xr + 64 * j); s += (v[j].x * v[j].x + v[j].y * v[j].y) + (v[j].z * v[j].z + v[j].w * v[j].w); }
        s = wave_sum(s);
        u32x2* o8 = (u32x2*)(xb + (size_t)row * DM) + F.lane;
#pragma unroll
        for (int j = 0; j < 8; ++j) { u32x2 w; w.x = cvt_pk_bf16(v[j].x, v[j].y); w.y = cvt_pk_bf16(v[j].z, v[j].w); o8[64 * j] = w; }
        if (F.lane == 0) ss0[row] = ss_fix(s);
    }
}
__device__ __forceinline__ void p2_kmean(const bf16_t* qkv, float* kmean, Frame& F) {
    const int c16 = F.lane & 15, rg = F.lane >> 4;
    for (int u = F.gw; u < NB * HA * 8; u += F.NGW) {
        const int bh = u >> 3, jb = u & 7, b = bh / HA, h = bh % HA;
        const bf16_t* kp = qkv + (size_t)(b * SEQ + jb * 256 + rg) * NQKV + DM + h * 128 + 8 * c16;
        float s[8] = {0.f, 0.f, 0.f, 0.f, 0.f, 0.f, 0.f, 0.f};
#pragma unroll 8
        for (int i = 0; i < 64; ++i) { const u32x4 q = *(const u32x4*)(kp + (size_t)(4 * i) * NQKV);
            s[0] += __uint_as_float(q.x << 16); s[1] += __uint_as_float(q.x & 0xffff0000u); s[2] += __uint_as_float(q.y << 16); s[3] += __uint_as_float(q.y & 0xffff0000u);
            s[4] += __uint_as_float(q.z << 16); s[5] += __uint_as_float(q.z & 0xffff0000u); s[6] += __uint_as_float(q.w << 16); s[7] += __uint_as_float(q.w & 0xffff0000u); }
#pragma unroll
        for (int e = 0; e < 8; ++e) s[e] = sum_xor32(sum_xor16(s[e]));
        if (rg == 0) { float* kd = kmean + (size_t)u * 128 + 8 * c16;
            *(f32x4*)kd = (f32x4){s[0], s[1], s[2], s[3]} * (1.0f / 256.0f); *(f32x4*)(kd + 4) = (f32x4){s[4], s[5], s[6], s[7]} * (1.0f / 256.0f); }
    }
}
__device__ __forceinline__ void p3_select(const bf16_t* qkv, const u64* kq, unsigned char* sel, Frame& F) {
    LAS float* km = (LAS float*)F.lds;
    for (int u = F.vc; u < NB * HA * 4; u += F.G) {
        const int bh = u >> 2, ch = u & 3, b = bh / HA, h = bh % HA;
        __syncthreads();
        km[F.tid] = (float)(long long)kq[(size_t)bh * 1024 + F.tid] * (1.0f / (4294967296.0f * 256.0f)); km[F.tid + 512] = (float)(long long)kq[(size_t)bh * 1024 + 512 + F.tid] * (1.0f / (4294967296.0f * 256.0f));
        __syncthreads();
        const int s = ch * 512 + F.tid, own = s >> 8;
        const bf16_t* qp = qkv + (size_t)(b * SEQ + s) * NQKV + h * 128;
        float gate[8] = {0.f, 0.f, 0.f, 0.f, 0.f, 0.f, 0.f, 0.f};
        if (own > 0) {
#pragma unroll 4
            for (int c = 0; c < 16; ++c) { const u32x4 q = *(const u32x4*)(qp + 8 * c);
                const float q0 = __uint_as_float(q.x << 16), q1 = __uint_as_float(q.x & 0xffff0000u), q2 = __uint_as_float(q.y << 16), q3 = __uint_as_float(q.y & 0xffff0000u);
                const float q4 = __uint_as_float(q.z << 16), q5 = __uint_as_float(q.z & 0xffff0000u), q6 = __uint_as_float(q.w << 16), q7 = __uint_as_float(q.w & 0xffff0000u);
#pragma unroll
                for (int jb = 0; jb < 8; ++jb) { const f32x4 k0 = *(const LAS f32x4*)(km + jb * 128 + 8 * c), k1 = *(const LAS f32x4*)(km + jb * 128 + 8 * c + 4);
                    gate[jb] += (q0 * k0.x + q1 * k0.y) + (q2 * k0.z + q3 * k0.w) + (q4 * k1.x + q5 * k1.y) + (q6 * k1.z + q7 * k1.w); } }
        }
        unsigned mask = 0u; const int nsel = own < 3 ? own : 3;
#pragma unroll
        for (int it = 0; it < 3; ++it) { if (it < nsel) { int best = -1; float bv = -__builtin_inff();
#pragma unroll
                for (int jb = 0; jb < 8; ++jb) { const bool ok = (jb < own) && (((mask >> jb) & 1u) == 0u) && (best < 0 || gate[jb] > bv); if (ok) { bv = gate[jb]; best = jb; } }
                if (best >= 0) mask |= 1u << best; } }
        sel[(size_t)bh * SEQ + s] = (unsigned char)mask;
    }
    __syncthreads();
}
__device__ __forceinline__ int attn_jlo(const unsigned* bnd, int qseg, int kseg, int b, int qb, float slope) {
    float q2 = 0.f, k2 = 0.f;
#pragma unroll
    for (int w = 0; w < 4; ++w) q2 += __uint_as_float(bnd[((size_t)qseg * 64 + b * 8 + qb) * 4 + w]);
    for (int t = 0; t <= qb; ++t) { float s2 = 0.f;
#pragma unroll
        for (int w = 0; w < 4; ++w) s2 += __uint_as_float(bnd[((size_t)kseg * 64 + b * 8 + t) * 4 + w]);
        k2 = __builtin_fmaxf(k2, s2); }
    const float W = (2.0f * 1.02f * __builtin_sqrtf(q2 * k2) * att::SCALE + 30.0f) / slope, lo = (float)(qb * 256) - W;
    return lo > 0.f ? (int)(lo * (1.0f / 64.0f)) : 0;
}
template <bool MOBA> __device__ __forceinline__ att::BlockRef attn_ref(int L, int pass, const bf16_t* qkv, bf16_t* out, const unsigned char* sel, const unsigned* bnd) {
    const int bh = L >> 2, y = L & 3, qb = pass ? 7 - y : y; att::BlockRef r;
    if (MOBA) { const int b = bh / HA, h = ((bh % HA) + 8 * (bh >> 6)) % HA; const size_t t0 = (size_t)b * SEQ; const float slope = __builtin_amdgcn_exp2f(-0.5f * (float)(h + 1));
        r.Q = qkv + (t0 + qb * 256) * NQKV + h * 128; r.K = qkv + t0 * NQKV + DM + h * 128; r.V = qkv + t0 * NQKV + 2 * DM + h * 128;
        r.O = out + (t0 + qb * 256) * DM + h * 128; r.sel = sel + (size_t)(b * HA + h) * SEQ; r.P0 = qb * 256; r.a = slope * (1.0f / att::SCALE); r.jlo = attn_jlo(bnd, h, 16 + h, b, qb, slope); }
    else { const int b = bh >> 5, sh = bh & 31, hn = sh >> 2, c = (sh >> 1) & 1, vh = sh & 1, h = (((hn & 1) ? 0x7621 : 0x5430) >> (4 * (((hn >> 1) + (bh >> 6)) & 3))) & 7; const size_t t0 = (size_t)b * SEQ; const float slope = __builtin_amdgcn_exp2f(-(float)(h + 1));
        r.Q = qkv + (t0 + qb * 256) * NQKV + 2 * DM + h * 256 + c * 128; r.K = qkv + t0 * NQKV + h * 256 + c * 128; r.V = qkv + t0 * NQKV + DM + h * 256 + vh * 128;
        r.O = out + (size_t)c * MTOK * DM + (t0 + qb * 256) * DM + h * 256 + vh * 128; r.sel = nullptr; r.P0 = qb * 256; r.a = slope * (1.0f / att::SCALE); r.jlo = attn_jlo(bnd, 32 + 2 * h + c, 2 * h + c, b, qb, slope); }
    return r;
}
template <bool MOBA> __device__ __forceinline__ void attn_phase(char* lds, const bf16_t* qkv, bf16_t* out, const unsigned char* sel, const unsigned* bnd, Frame& F) {
    constexpr int NITEMS = (MOBA ? NB * HA : NB * HB * 4) * 4;
    int L = F.vc; if (L >= NITEMS) return;
    int pass = 0; att::BlockRef cur = attn_ref<MOBA>(L, 0, qkv, out, sel, bnd); att::Seam S;
    att::attn_prime(cur, lds, S);
    for (;;) {
        const bool more_pass = pass == 0, more_item = L + F.G < NITEMS, last = !more_pass && !more_item;
        int passn = pass + 1, Ln = L; if (!more_pass) { passn = 0; Ln = more_item ? L + F.G : L; }
        const att::BlockRef nxt = last ? cur : attn_ref<MOBA>(Ln, passn, qkv, out, sel, bnd);
        att::attn_block<MOBA>(cur, nxt, lds, S);
        if (last) break;
        cur = nxt; pass = passn; L = Ln;
    }
}
__device__ __forceinline__ void p10_combine(KAP a, const bf16_t* omap, bf16_t* ao, Frame& F) {
    const int l = F.lane;
    float d1 = a->in[8][l] * a->in[9][l] + a->in[8][l + 64] * a->in[9][l + 64], d2 = a->in[10][l] * a->in[11][l] + a->in[10][l + 64] * a->in[11][l + 64];
    d1 = wave_sum(d1); d2 = wave_sum(d2);
    const float lam = __expf(d1) - __expf(d2) + LAM_INIT;
    const f32x4 g = *(const f32x4*)(a->in[12] + 4 * l);
    for (int tok = F.gw; tok < MTOK; tok += F.NGW) {
        const bf16_t* p1 = omap + (size_t)tok * DM + 4 * l; const bf16_t* p2 = p1 + (size_t)MTOK * DM; bf16_t* po = ao + (size_t)tok * DM + 4 * l;
#pragma unroll
        for (int h = 0; h < HB; ++h) { const u32x2 x1 = *(const u32x2*)(p1 + h * 256), x2 = *(const u32x2*)(p2 + h * 256);
            f32x4 d; d.x = __uint_as_float(x1.x << 16) - lam * __uint_as_float(x2.x << 16); d.y = __uint_as_float(x1.x & 0xffff0000u) - lam * __uint_as_float(x2.x & 0xffff0000u);
            d.z = __uint_as_float(x1.y << 16) - lam * __uint_as_float(x2.y << 16); d.w = __uint_as_float(x1.y & 0xffff0000u) - lam * __uint_as_float(x2.y & 0xffff0000u);
            float ss = wave_sum((d.x * d.x + d.y * d.y) + (d.z * d.z + d.w * d.w));
            const float r = __builtin_amdgcn_rsqf(ss * (1.0f / 256.0f) + RMS_EPS) * (1.0f - LAM_INIT);
            u32x2 w; w.x = cvt_pk_bf16(d.x * r * g.x, d.y * r * g.y); w.y = cvt_pk_bf16(d.z * r * g.z, d.w * r * g.w); *(u32x2*)(po + h * 256) = w; }
    }
}
__device__ __forceinline__ void p12_router(KAP a, const float* xr, const u64* ss3, unsigned* gcnt, int* tokinfo, Frame& F) {
    LAS float* gwt = (LAS float*)F.lds;
    LAS unsigned* cnt = (LAS unsigned*)(F.lds + 65536); LAS unsigned* base = cnt + 8;
    const float* wr = a->in[18]; const float* g1 = a->in[14] + DM;
    __syncthreads();
    for (int idx = F.tid; idx < DM * NE; idx += NTHREADS) gwt[idx] = wr[idx] * g1[idx >> 3];
    if (F.tid < 8) cnt[F.tid] = 0u;
    __syncthreads();
    const int l = F.lane;
    for (int chunk = F.vc; chunk < MTOK / 64; chunk += F.G) {
        int e0v = 0, e1v = 0, i0v = 0, i1v = 0; float g0v = 0.f, g1v = 0.f;
        for (int i = 0; i < 8; ++i) {
            const int tok = chunk * 64 + F.wave * 8 + i; const float* xp = xr + (size_t)tok * DM + l;
            float lg[8] = {0.f, 0.f, 0.f, 0.f, 0.f, 0.f, 0.f, 0.f};
#pragma unroll 8
            for (int j = 0; j < 32; ++j) { const float xv = xp[64 * j]; const LAS f32x4* wp = (const LAS f32x4*)(gwt + (l + 64 * j) * 8); const f32x4 w0 = wp[0], w1 = wp[1];
                lg[0] += xv * w0.x; lg[1] += xv * w0.y; lg[2] += xv * w0.z; lg[3] += xv * w0.w; lg[4] += xv * w1.x; lg[5] += xv * w1.y; lg[6] += xv * w1.z; lg[7] += xv * w1.w; }
            const float rs = rstd_q(ss3[tok]);
#pragma unroll
            for (int e = 0; e < 8; ++e) lg[e] = wave_sum(lg[e]) * rs;
            int b0 = 0; float v0 = lg[0];
#pragma unroll
            for (int e = 1; e < 8; ++e) if (lg[e] > v0) { v0 = lg[e]; b0 = e; }
            int b1 = -1; float v1 = -__builtin_inff();
#pragma unroll
            for (int e = 0; e < 8; ++e) if (e != b0 && (b1 < 0 || lg[e] > v1)) { v1 = lg[e]; b1 = e; }
            const float ga = 1.0f / (1.0f + __expf(v1 - v0));
            unsigned i0 = 0u, i1 = 0u;
            if (l == 0) { i0 = __hip_atomic_fetch_add(&cnt[b0], 1u, __ATOMIC_RELAXED, __HIP_MEMORY_SCOPE_WORKGROUP); i1 = __hip_atomic_fetch_add(&cnt[b1], 1u, __ATOMIC_RELAXED, __HIP_MEMORY_SCOPE_WORKGROUP); }
            i0 = __builtin_amdgcn_readfirstlane(i0); i1 = __builtin_amdgcn_readfirstlane(i1);
            if (l == i) { e0v = b0; e1v = b1; i0v = (int)i0; i1v = (int)i1; g0v = ga; g1v = 1.0f - ga; }
        }
        __syncthreads();
        if (F.tid < 8) base[F.tid] = __hip_atomic_fetch_add(gcnt + 64 * F.tid, cnt[F.tid], __ATOMIC_RELAXED, __HIP_MEMORY_SCOPE_AGENT);
        __syncthreads();
        if (l < 8) { const int tok = chunk * 64 + F.wave * 8 + l; int* ti = tokinfo + (size_t)tok * 8;
            ti[0] = e0v; ti[1] = e1v; ti[2] = (int)base[e0v] + i0v; ti[3] = (int)base[e1v] + i1v; ti[4] = __float_as_int(g0v); ti[5] = __float_as_int(g1v); }
        __syncthreads();
        if (F.tid < 8) cnt[F.tid] = 0u;
        __syncthreads();
    }
}
__device__ __forceinline__ void p13_gather(const bf16_t* xb, const u64* ss3, unsigned* gcnt, int* tiles, int* tokinfo, unsigned char* xs, Frame& F) {
    LAS int* pst = (LAS int*)F.lds;
    __syncthreads();
    if (F.tid == 0) { int acc = 0;
        for (int e = 0; e < NE; ++e) { const int c = (int)__hip_atomic_load(gcnt + 64 * e, __ATOMIC_RELAXED, __HIP_MEMORY_SCOPE_AGENT); const int p = (c + 255) & ~255;
            pst[e] = acc; pst[8 + e] = c; pst[16 + e] = p;
            if (blockIdx.x == 0) for (int t = acc >> 8; t < (acc + p) >> 8; ++t) tiles[1 + t] = e;
            acc += p; }
        if (blockIdx.x == 0) tiles[0] = acc >> 8; }
    __syncthreads();
    const int l = F.lane;
    for (int tok = F.gw; tok < MTOK; tok += F.NGW) {
        int* ti = tokinfo + (size_t)tok * 8;
        const int row0 = pst[ti[0]] + ti[2], row1 = pst[ti[1]] + ti[3];
        if (l == 0) { ti[6] = row0; ti[7] = row1; }
        const float rs = rstd_q(ss3[tok]) * XS_SC;
        const u32x2* sp = (const u32x2*)(xb + (size_t)tok * DM) + l; unsigned* d0 = (unsigned*)(xs + (size_t)row0 * DM) + l; unsigned* d1 = (unsigned*)(xs + (size_t)row1 * DM) + l;
#pragma unroll
        for (int j = 0; j < 8; ++j) { const u32x2 b = sp[64 * j];
            const unsigned q = pg8::pk4_fp8(__uint_as_float(b.x << 16) * rs, __uint_as_float(b.x & 0xffff0000u) * rs, __uint_as_float(b.y << 16) * rs, __uint_as_float(b.y & 0xffff0000u) * rs); d0[64 * j] = q; d1[64 * j] = q; }
    }
    for (int e = 0; e < NE; ++e) { const int lo = pst[e] + pst[8 + e], hi = pst[e] + pst[16 + e];
        for (int r = lo + F.gw; r < hi; r += F.NGW) { u32x4* d = (u32x4*)(xs + (size_t)r * DM) + l; d[0] = (u32x4){0u, 0u, 0u, 0u}; d[64] = (u32x4){0u, 0u, 0u, 0u}; } }
    __syncthreads();
}
__device__ __forceinline__ void ys_row(const bf16_t* ys, const float* slab, int split0, size_t ks_stride, int row, int l, f32x4 (&a)[8]) {
    if (row >= split0) { const float* p = slab + (size_t)(row - split0) * DM + 4 * l;
#pragma unroll
        for (int j = 0; j < 8; ++j) { f32x4 t = *(const f32x4*)(p + 256 * j);
#pragma unroll
            for (int ks = 1; ks < TAIL_NS; ++ks) t = t + *(const f32x4*)(p + 256 * j + (size_t)ks * ks_stride);
            a[j] = t * (1.0f / (ACT_SC * WEDN_SC)); } }
    else { const u32x2* p = (const u32x2*)(ys + (size_t)row * DM) + l;
#pragma unroll
        for (int j = 0; j < 8; ++j) { const u32x2 q = p[64 * j]; a[j] = (f32x4){__uint_as_float(q.x << 16), __uint_as_float(q.x & 0xffff0000u), __uint_as_float(q.y << 16), __uint_as_float(q.y & 0xffff0000u)}; } }
}
__device__ __forceinline__ void p16_final(const bf16_t* xb, const bf16_t* ys, const float* slab, const int* tiles, const int* tokinfo, const float* fg, float* out, Frame& F) {
    const int l = F.lane; const int nT = tiles[0]; int rt = nT & 31; if (rt > 7) rt = 0; const int split0 = (nT - rt) * 256; const size_t ks_stride = (size_t)rt * 256 * DM;
    for (int tok = F.gw; tok < MTOK; tok += F.NGW) {
        const int* ti = tokinfo + (size_t)tok * 8; const float g0 = __int_as_float(ti[4]), g1 = __int_as_float(ti[5]); const int row0 = ti[6], row1 = ti[7];
        const u32x2* xp = (const u32x2*)(xb + (size_t)tok * DM) + l;
        f32x4 v[8], a0[8], a1[8]; float s = 0.f;
#pragma unroll
        for (int j = 0; j < 8; ++j) { const u32x2 q = xp[64 * j]; v[j] = (f32x4){__uint_as_float(q.x << 16), __uint_as_float(q.x & 0xffff0000u), __uint_as_float(q.y << 16), __uint_as_float(q.y & 0xffff0000u)}; }
        ys_row(ys, slab, split0, ks_stride, row0, l, a0); ys_row(ys, slab, split0, ks_stride, row1, l, a1);
#pragma unroll
        for (int j = 0; j < 8; ++j) { v[j] = v[j] + g0 * a0[j] + g1 * a1[j]; s += (v[j].x * v[j].x + v[j].y * v[j].y) + (v[j].z * v[j].z + v[j].w * v[j].w); }
        const float r = rstd_of(wave_sum(s));
        f32x4* op = (f32x4*)(out + (size_t)tok * DM) + l; const f32x4* gp = (const f32x4*)fg + l;
#pragma unroll
        for (int j = 0; j < 8; ++j) op[64 * j] = v[j] * r * gp[64 * j];
    }
}

#ifndef PH_MASK
#define PH_MASK 0x1ffff
#endif
__global__ void __launch_bounds__(NTHREADS, 2) mega_fwd(Args args_by_value) {
    extern __shared__ __attribute__((aligned(16))) unsigned char lds[];
    (void)args_by_value;
    const KAP kap0 = (KAP)__builtin_amdgcn_kernarg_segment_ptr();
#define KARGS() ({ KAP p_ = kap0; asm volatile("" : "+s"(p_)); p_; })
    Frame F0;
#define F F0
    F.lds = (LAS unsigned char*)lds;
    F.tid = threadIdx.x; F.lane = F.tid & 63; F.wave = __builtin_amdgcn_readfirstlane(F.tid >> 6);
    F.G = gridDim.x; { const int bx = blockIdx.x; F.vc = (F.G % 8 == 0) ? (bx % 8) * (F.G / 8) + bx / 8 : bx; }
    F.gw = F.vc * NWAVES + F.wave; F.NGW = F.G * NWAVES;
    volatile LAS unsigned* MISC = (volatile LAS unsigned*)(F.lds + LDSCTL_OFF);
    for (int u = F.tid; u < (LDS_BYTES - LDSCTL_OFF) / 4; u += NTHREADS) ((LAS unsigned*)(F.lds + LDSCTL_OFF))[u] = 0u;
    __syncthreads();
    const int lo = kap0->ph_lo, hi = kap0->ph_hi;
    const bool use_bar = (hi - lo) > 1;
    XcdBarrier bar; bar.bar = (unsigned*)(kap0->ws + CTL_BAR); bar.x = 0; bar.st = MISC + 8;
    if (use_bar) bar = xcd_barrier_post((unsigned*)(kap0->ws + CTL_BAR), MISC + 8);
#ifndef DUP_MASK
#define DUP_MASK 0
#endif
#ifndef PROBE_SKIP_EPI
#define PROBE_SKIP_EPI 0
#endif
#define IN(k) (((PH_MASK >> (k)) & 1) && lo <= (k) && (k) < hi)
#define REP(k) for (int rep_ = 0; rep_ < (((DUP_MASK >> (k)) & 1) ? 2 : 1); ++rep_)
#define SEAM(k) do { if (IN(k) && IN((k) + 1)) xcd_barrier(bar); } while (0)
#define WSP(T, off) ((T*)(ws + (off)))
#define FRL() ({ Frame f_ = F0; asm volatile("" : "+v"(f_.tid), "+v"(f_.lane)); f_; })
#undef F
    const int bx = blockIdx.x;

    if (IN(0)) REP(0) { KAP ap = KARGS(); Frame F = FRL(); unsigned char* ws = ap->ws; p0_weights(ap, F); p0_x(ap->in[0], WSP(bf16_t, WS_XB), WSP(u64, CTL_SS), F); }
    SEAM(0);
    if (IN(1)) REP(1) {
        KAP ap = KARGS(); Frame F = FRL(); unsigned char* ws = ap->ws;
        pg8::Order S; S.init(MTOK / 256, NQKV / 256, 2 * DM, F.G, bx, ws + WS_XB, ws + WS_WQKV, 0, nullptr);
        pg8::EpiBf16Out<true, true, true> E{WSP(bf16_t, WS_QKV), NQKV, WSP(u64, CTL_SS), 1.f, WSP(unsigned, CTL_BND1), WSP(u64, CTL_KQ)};
        pg8::gemm_phase<pg8::EpiBf16Out<true, true, true>, GEMM_ALIGN, GEMM_SP2>(F.lds, 2 * DM, S, E);
    }
    SEAM(1);
    if (IN(3)) REP(3) { KAP ap = KARGS(); Frame F = FRL(); unsigned char* ws = ap->ws; p3_select(WSP(bf16_t, WS_QKV), WSP(u64, CTL_KQ), WSP(unsigned char, WS_SEL), F); }
    SEAM(3);
    if (IN(4)) REP(4) { KAP ap = KARGS(); Frame F = FRL(); unsigned char* ws = ap->ws; attn_phase<true>((char*)lds, WSP(bf16_t, WS_QKV), WSP(bf16_t, WS_AO), WSP(unsigned char, WS_SEL), WSP(unsigned, CTL_BND1), F); }
    SEAM(4);
    if (IN(5)) REP(5) {
        KAP ap = KARGS(); Frame F = FRL(); unsigned char* ws = ap->ws;
        pg8::Order S; S.init(MTOK / 256, DM / 256, 2 * DM, F.G, bx, ws + WS_AO, ws + WS_WOA, 0, nullptr);
        pg8::EpiResid E{ap->in[0], WSP(float, WS_XR), WSP(bf16_t, WS_XB), WSP(u64, CTL_SS) + MTOK};
        pg8::gemm_phase<pg8::EpiResid, GEMM_ALIGN, GEMM_SP2>(F.lds, 2 * DM, S, E);
    }
    SEAM(5);
    if (IN(6)) REP(6) {
        KAP ap = KARGS(); Frame F = FRL(); unsigned char* ws = ap->ws;
        pg8::Order S; S.init(MTOK / 256, 2 * FF / 256, 2 * DM, F.G, bx, ws + WS_XB, ws + WS_WGU, 0, nullptr);
        pg8::EpiSwiGLU<false> E{WSP(bf16_t, WS_ACT), FF, WSP(u64, CTL_SS) + MTOK};
        pg8::gemm_phase<pg8::EpiSwiGLU<false>, GEMM_ALIGN, GEMM_SP2>(F.lds, 2 * DM, S, E);
    }
    SEAM(6);
    if (IN(7)) REP(7) {
        KAP ap = KARGS(); Frame F = FRL(); unsigned char* ws = ap->ws;
        pg8::Order S; S.init(MTOK / 256, DM / 256, 2 * FF, F.G, bx, ws + WS_ACT, ws + WS_WDN, 0, nullptr);
        pg8::EpiResid E{WSP(float, WS_XR), WSP(float, WS_XR), WSP(bf16_t, WS_XB), WSP(u64, CTL_SS) + 2 * MTOK};
        pg8::gemm_phase<pg8::EpiResid, GEMM_ALIGN, GEMM_SP2>(F.lds, 2 * FF, S, E);
    }
    SEAM(7);
    if (IN(8)) REP(8) {
        KAP ap = KARGS(); Frame F = FRL(); unsigned char* ws = ap->ws;
        pg8::Order S; S.init(MTOK / 256, NQKV / 256, 2 * DM, F.G, bx, ws + WS_XB, ws + WS_WKVQ, 0, nullptr);
        pg8::EpiBf16Out<true, true> E{WSP(bf16_t, WS_QKV), NQKV, WSP(u64, CTL_SS) + 2 * MTOK, 1.f, WSP(unsigned, CTL_BND2), nullptr};
        pg8::gemm_phase<pg8::EpiBf16Out<true, true>, GEMM_ALIGN, GEMM_SP2>(F.lds, 2 * DM, S, E);
    }
    SEAM(8);
    if (IN(9)) REP(9) { KAP ap = KARGS(); Frame F = FRL(); unsigned char* ws = ap->ws; attn_phase<false>((char*)lds, WSP(bf16_t, WS_QKV), WSP(bf16_t, WS_ACT), nullptr, WSP(unsigned, CTL_BND2), F); }
    SEAM(9);
    if (IN(10)) REP(10) { KAP ap = KARGS(); Frame F = FRL(); unsigned char* ws = ap->ws; p10_combine(ap, WSP(bf16_t, WS_ACT), WSP(bf16_t, WS_AO), F); }
    SEAM(10);
    if (IN(11)) REP(11) {
        KAP ap = KARGS(); Frame F = FRL(); unsigned char* ws = ap->ws;
        pg8::Order S; S.init(MTOK / 256, DM / 256, 2 * DM, F.G, bx, ws + WS_AO, ws + WS_WOB, 0, nullptr);
        pg8::EpiResid E{WSP(float, WS_XR), WSP(float, WS_XR), WSP(bf16_t, WS_XB), WSP(u64, CTL_SS) + 3 * MTOK};
        pg8::gemm_phase<pg8::EpiResid, GEMM_ALIGN, GEMM_SP2>(F.lds, 2 * DM, S, E);
    }
    SEAM(11);
    if (IN(12)) REP(12) { KAP ap = KARGS(); Frame F = FRL(); unsigned char* ws = ap->ws; p12_router(ap, WSP(float, WS_XR), WSP(u64, CTL_SS) + 3 * MTOK, WSP(unsigned, CTL_CNT), WSP(int, CTL_TOKINFO), F); }
    SEAM(12);
    if (IN(13)) REP(13) { KAP ap = KARGS(); Frame F = FRL(); unsigned char* ws = ap->ws; p13_gather(WSP(bf16_t, WS_XB), WSP(u64, CTL_SS) + 3 * MTOK, WSP(unsigned, CTL_CNT), WSP(int, CTL_TILES), WSP(int, CTL_TOKINFO), WSP(unsigned char, WS_XS), F); }
    SEAM(13);
    if (IN(14)) REP(14) {
        KAP ap = KARGS(); Frame F = FRL(); unsigned char* ws = ap->ws;
        const int* tiles = WSP(int, CTL_TILES); const int nT = tiles[0];
        pg8::Order S; S.init(nT, 2 * FE / 256, DM, F.G, bx, ws + WS_XS, ws + WS_WEGU, (size_t)2 * FE * DM, tiles + 1);
        pg8::EpiSwiGLU8 E{WSP(unsigned char, WS_ACTE), FE, 1.0f / (XS_SC * WEGU_SC), ACT_SC, (PROBE_SKIP_EPI && rep_ == 1) ? 1 : 0};
        pg8::gemm_phase<pg8::EpiSwiGLU8, GEMM_ALIGN, false, true>(F.lds, DM, S, E);
    }
    SEAM(14);
    if (IN(15)) REP(15) {
        KAP ap = KARGS(); Frame F = FRL(); unsigned char* ws = ap->ws;
        const int* tiles = WSP(int, CTL_TILES); const int nT = tiles[0];
        int rt = nT & 31; if (rt > 7) rt = 0;
        pg8::Order S; S.init(nT - rt, DM / 256, FE, F.G, bx, ws + WS_ACTE, ws + WS_WEDN, (size_t)DM * FE, tiles + 1);
        pg8::EpiBf16Out<false> E{WSP(bf16_t, WS_YS), DM, nullptr, 1.0f / (ACT_SC * WEDN_SC), nullptr, nullptr};
        pg8::gemm_phase<pg8::EpiBf16Out<false>, GEMM_ALIGN, false, true>(F.lds, FE, S, E);
        if (rt) { pg8::TailOrder S2{rt * 8 * TAIL_NS, F.G, bx, nT - rt, TAIL_NS, (const char*)(ws + WS_ACTE), (const char*)(ws + WS_WEDN), (size_t)256 * FE, (size_t)DM * FE, (size_t)(FE / TAIL_NS), tiles + 1};
            pg8::EpiPart E2{WSP(float, WS_SLAB), (nT - rt) * 256, (size_t)rt * 256 * DM};
            pg8::gemm_phase<pg8::EpiPart, GEMM_ALIGN, false, true, pg8::TailOrder>(F.lds, FE, S2, E2, FE / TAIL_NS / 128); }
    }
    SEAM(15);
    if (IN(16)) REP(16) { KAP ap = KARGS(); Frame F = FRL(); unsigned char* ws = ap->ws; p16_final(WSP(bf16_t, WS_XB), WSP(bf16_t, WS_YS), WSP(float, WS_SLAB), WSP(int, CTL_TILES), WSP(int, CTL_TOKINFO), ap->in[22], ap->out, F); }
#undef IN
#undef REP
#undef SEAM
#undef WSP
#undef FRL
#undef KARGS
}

#ifndef MK_ONE_LAUNCH
#define MK_ONE_LAUNCH 1
#endif
extern "C" void kernel_launch(void* const* d_in, const int* in_sizes, int n_in, void* d_out, int out_size, void* d_ws, size_t ws_size, hipStream_t stream) {
    static int grid = 0;
    if (grid == 0) {
        if (n_in != 23 || out_size != MTOK * DM || ws_size < WS_END) { fprintf(stderr, "kernel_launch: unexpected shapes (n_in %d, out %d, ws %zu)\n", n_in, out_size, ws_size); grid = -1; return; }
        int dev = 0, cus = 0, per_cu = 0;
        if (hipGetDevice(&dev) != hipSuccess || hipDeviceGetAttribute(&cus, hipDeviceAttributeMultiprocessorCount, dev) != hipSuccess) { grid = -1; return; }
        if (hipFuncSetAttribute((const void*)mega_fwd, hipFuncAttributeMaxDynamicSharedMemorySize, LDS_BYTES) != hipSuccess) { fprintf(stderr, "kernel_launch: hipFuncSetAttribute failed\n"); grid = -1; return; }
        if (hipOccupancyMaxActiveBlocksPerMultiprocessor(&per_cu, (const void*)mega_fwd, NTHREADS, LDS_BYTES) != hipSuccess || per_cu < 1) { fprintf(stderr, "kernel_launch: occupancy query reports %d\n", per_cu); (void)hipGetLastError(); per_cu = 1; }
        grid = cus;
    }
    if (grid < 0) return;
    if (hipMemsetAsync((char*)d_ws + WS_CTL, 0, CTL_ZERO_BYTES, stream) != hipSuccess) return;
    Args a{};
    for (int i = 0; i < 23; ++i) a.in[i] = (const float*)d_in[i];
    a.out = (float*)d_out; a.ws = (unsigned char*)d_ws;
#if MK_ONE_LAUNCH
    a.ph_lo = 0; a.ph_hi = NPHASE;
    hipLaunchKernelGGL(mega_fwd, dim3(grid), dim3(NTHREADS), LDS_BYTES, stream, a);
#else
    for (int p = 0; p < NPHASE; ++p) { a.ph_lo = p; a.ph_hi = p + 1; hipLaunchKernelGGL(mega_fwd, dim3(grid), dim3(NTHREADS), LDS_BYTES, stream, a); }
#endif
}
```

```cpp
#include <hip/hip_runtime.h>
#include <cstdio>
#include <cstdint>

#define GAS __attribute__((address_space(1)))
#define LAS __attribute__((address_space(3)))
#ifndef PROBE_KIND
#define PROBE_KIND 0
#endif
typedef unsigned short bf16_t;
typedef short bf16x8 __attribute__((ext_vector_type(8)));
typedef short s16x4 __attribute__((ext_vector_type(4)));
typedef float f32x2 __attribute__((ext_vector_type(2)));
typedef float f32x4 __attribute__((ext_vector_type(4)));
typedef float f32x16 __attribute__((ext_vector_type(16)));
typedef unsigned u32x2 __attribute__((ext_vector_type(2)));
typedef unsigned u32x4 __attribute__((ext_vector_type(4)));

constexpr int NB = 8, SEQ = 2048, DM = 2048, MTOK = NB * SEQ;
constexpr int NQKV = 3 * DM, FF = 5632, FE = 7168, NE = 8;
constexpr int HA = 16, HB = 8;
constexpr float RMS_EPS = 1e-6f;
constexpr float LAM_INIT = 0.35550906759096996f;
constexpr int MAXTILES = 136;
constexpr int MOE_ROWS = 135 * 256;

constexpr size_t MiB = 1u << 20;
constexpr size_t WS_CTL = 0, CTL_ZERO_BYTES = 960 * 1024;
constexpr size_t CTL_BAR = 4096;
constexpr size_t CTL_BARH = 832 * 1024, CTL_BARH_STRIDE = 16384;
constexpr size_t CTL_SS = 64 * 1024;
constexpr size_t CTL_AQ = 580 * 1024;
constexpr size_t CTL_CNT = 576 * 1024;
constexpr size_t CTL_BND1 = 640 * 1024, CTL_BND2 = 704 * 1024;
constexpr size_t CTL_TILES = 768 * 1024;
constexpr size_t CTL_TOKINFO = 1 * MiB;
constexpr size_t WS_WQKV = 2 * MiB, WS_WOA = 26 * MiB, WS_WGU = 34 * MiB, WS_WDN = 78 * MiB, WS_WKVQ = 100 * MiB, WS_WOB = 124 * MiB;
constexpr size_t WS_XB = 132 * MiB, WS_XR = 196 * MiB, WS_WEGU = 324 * MiB, WS_WEDN = 548 * MiB, WS_BIG = 660 * MiB;
constexpr size_t WS_QKV = WS_BIG, WS_AO = WS_BIG + 192 * MiB, WS_ACT = WS_BIG + 256 * MiB, WS_KMEAN = WS_BIG + 432 * MiB, WS_SEL = WS_BIG + 433 * MiB;
constexpr size_t WS_ACTE = WS_BIG, WS_XS = WS_BIG + 237 * MiB, WS_YS = WS_BIG + 305 * MiB, WS_SLAB = WS_BIG + 440 * MiB, WS_XSC = WS_BIG + 500 * MiB, WS_END = WS_XSC + 256 * MiB;
static_assert(WS_END <= 1792 * MiB, "workspace map");
static_assert((size_t)MOE_ROWS * FE <= 237 * MiB && (size_t)MOE_ROWS * DM <= 68 * MiB && (size_t)MOE_ROWS * DM * 2 <= 135 * MiB && WS_SEL + MiB <= WS_END, "moe buffers");
constexpr float XS_SC = 16.f, WEGU_SC = 256.f, ACT_SC = 8.f, WEDN_SC = 512.f;
constexpr int TAIL_NS = 4, TAIL_MAXROWS = 31 * 256;
static_assert((size_t)TAIL_NS * 7 * 256 * DM * 4 <= 60 * MiB, "slab (nT in [128, 135] -> at most 7 tail row tiles)");

constexpr int RING_BYTES = 131072, LDS_BYTES = 147456, LDSCTL_OFF = LDS_BYTES - 512;

#define LDS_WAIT() asm volatile("s_waitcnt lgkmcnt(0)" ::: "memory")
#define VM_WAIT() asm volatile("s_waitcnt vmcnt(0)" ::: "memory")
__device__ __forceinline__ unsigned cvt_pk_bf16(float lo, float hi) { unsigned r; asm volatile("v_cvt_pk_bf16_f32 %0, %1, %2" : "=v"(r) : "v"(lo), "v"(hi)); return r; }
__device__ __forceinline__ float bf2f(unsigned short b) { return __uint_as_float(((unsigned)b) << 16); }
template <int CTRL> __device__ __forceinline__ float dppx(float v) { return __builtin_bit_cast(float, __builtin_amdgcn_update_dpp(0, __builtin_bit_cast(int, v), CTRL, 0xf, 0xf, true)); }
__device__ __forceinline__ float xor1_get(float v) { return dppx<0xB1>(v); }
__device__ __forceinline__ float sum_xor16(float v) { auto r = __builtin_amdgcn_permlane16_swap(__float_as_uint(v), __float_as_uint(v), false, false); return __uint_as_float(r[0]) + __uint_as_float(r[1]); }
__device__ __forceinline__ float sum_xor32(float v) { auto r = __builtin_amdgcn_permlane32_swap(__float_as_uint(v), __float_as_uint(v), false, false); return __uint_as_float(r[0]) + __uint_as_float(r[1]); }
__device__ __forceinline__ float row_sum16(float v) { v += dppx<0xB1>(v); v += dppx<0x4E>(v); v += dppx<0x141>(v); v += dppx<0x140>(v); return v; }
__device__ __forceinline__ float row_max16(float v) { v = __builtin_fmaxf(v, dppx<0xB1>(v)); v = __builtin_fmaxf(v, dppx<0x4E>(v)); v = __builtin_fmaxf(v, dppx<0x141>(v)); v = __builtin_fmaxf(v, dppx<0x140>(v)); return v; }
__device__ __forceinline__ float wave_sum(float v) { return sum_xor32(sum_xor16(row_sum16(v))); }
typedef unsigned long long u64;
__device__ __forceinline__ float rstd_of(float ss) { return __builtin_amdgcn_rsqf(ss * (1.0f / (float)DM) + RMS_EPS); }
__device__ __forceinline__ u64 ss_fix(float s) { return (u64)(s * 16777216.0f); }
__device__ __forceinline__ float rstd_q(u64 q) { return rstd_of((float)q * (1.0f / 16777216.0f)); }

#define XB_TMO      128
#define XB_XCNT(j)  (256  + 64 * (j))
#define XB_XSUB(j)  (1280 + 64 * (j))
#define XB_XGEN(j)  (2304 + 64 * (j))
#define XB_TOP      3328
#define XB_TOPGEN   3392
#define XCD_BAR_WORDS 3456
#define XB_SPIN_CAP (1u << 18)
__device__ __forceinline__ unsigned xb_ld(unsigned* p)              { return __hip_atomic_load(p, __ATOMIC_RELAXED, __HIP_MEMORY_SCOPE_AGENT); }
__device__ __forceinline__ unsigned xb_add(unsigned* p, unsigned v) { return __hip_atomic_fetch_add(p, v, __ATOMIC_RELAXED, __HIP_MEMORY_SCOPE_AGENT); }
__device__ __forceinline__ unsigned xb_xcc_id() { return (unsigned)__builtin_amdgcn_s_getreg((3 << 11) | 20) & 0xFu; }
#define XB_SPIN(cond, bar) do { unsigned _sp = 0; while (cond) { __builtin_amdgcn_s_sleep(1); \
    if ((++_sp & 255u) == 0u) { if (xb_ld(&(bar)[XB_TMO])) break; if (_sp > XB_SPIN_CAP) { atomicAdd(&(bar)[XB_TMO], 1u); break; } } } } while (0)
struct XcdBarrier { unsigned* bar; unsigned x; volatile LAS unsigned* st; unsigned members; };
__device__ __forceinline__ XcdBarrier xcd_barrier_post(unsigned* bar, volatile LAS unsigned* st, unsigned members) {
    XcdBarrier b; b.bar = bar; b.x = xb_xcc_id(); b.st = st; b.members = members;
    if (threadIdx.x == 0) (void)xb_add(&bar[XB_XCNT(b.x)], 1u);
    return b;
}
__device__ __forceinline__ void xcd_barrier_complete(unsigned* bar, unsigned x, unsigned& nloc, unsigned& nx, const unsigned G) {
    unsigned sum, cnt, mine, sp = 0u;
    for (;;) {
        sum = 0u; cnt = 0u; mine = 0u;
#pragma unroll
        for (unsigned j = 0; j < 16; ++j) { const unsigned c = xb_ld(&bar[XB_XCNT(j)]); sum += c; cnt += (c > 0u) ? 1u : 0u; mine = (j == x) ? c : mine; }
        if (sum == G) break;
        __builtin_amdgcn_s_sleep(1);
        if ((++sp & 255u) == 0u) { if (xb_ld(&bar[XB_TMO])) break; if (sp > XB_SPIN_CAP) { atomicAdd(&bar[XB_TMO], 1u); break; } }
    }
    nloc = mine > 0u ? mine : 1u; nx = cnt > 0u ? cnt : 1u;
}
__device__ __forceinline__ void xcd_barrier(const XcdBarrier& b) {
    asm volatile("s_waitcnt vmcnt(0)" ::: "memory");
    __syncthreads();
    if (threadIdx.x == 0) {
        unsigned* bar = b.bar;
        __builtin_amdgcn_s_waitcnt(0);
        unsigned nloc = b.st[0], nx = b.st[1];
        if (nloc == 0u) { xcd_barrier_complete(bar, b.x, nloc, nx, b.members); b.st[0] = nloc; b.st[1] = nx; }
        const unsigned old = xb_add(&bar[XB_XSUB(b.x)], 1u);
        const unsigned gen = old / nloc;
        if (old + 1u == (gen + 1u) * nloc) {
            __builtin_amdgcn_fence(__ATOMIC_RELEASE, "agent");
            asm volatile("s_waitcnt vmcnt(0)" ::: "memory");
            const unsigned og = xb_add(&bar[XB_TOP], 1u);
            const unsigned tg = og / nx;
            if (og + 1u == (tg + 1u) * nx) xb_add(&bar[XB_TOPGEN], 1u);
            else XB_SPIN(xb_ld(&bar[XB_TOPGEN]) == tg, bar);
            __builtin_amdgcn_fence(__ATOMIC_ACQUIRE, "agent");
            xb_add(&bar[XB_XGEN(b.x)], 1u);
            asm volatile("s_waitcnt vmcnt(0)" ::: "memory");
        } else {
            XB_SPIN(xb_ld(&bar[XB_XGEN(b.x)]) == gen, bar);
            __builtin_amdgcn_fence(__ATOMIC_ACQUIRE, "agent");
            asm volatile("s_waitcnt vmcnt(0)" ::: "memory");
        }
    }
    __syncthreads();
}

namespace pg8 {
constexpr int BM = 256, BK = 64, HALF = 128, HTB = HALF * BK * 2, STAGE_BYTES = 8 * HTB, NXCD = 8, WGM = 8;
__host__ __device__ __forceinline__ int lds_byte(int r, int c) { const int st = (r >> 4) * 2 + (c >> 5), rr = r & 15, cc = c & 31, ob = rr * 64 + cc * 2; return st * 1024 + (ob ^ (((ob >> 9) & 1) << 5)); }
__host__ __device__ __forceinline__ void stage_rc(int b, int& R, int& C) { const int st = b / 1024, sb = b % 1024, swz = sb ^ (((sb >> 9) & 1) << 5); R = (st >> 1) * 16 + swz / 64; C = (st & 1) * 32 + (swz % 64) / 2; }
__host__ __device__ __forceinline__ int perm32(int rho) { const int n = rho >> 4, i = rho & 15; return 8 * (i >> 2) + 4 * n + (i & 3); }

struct Unit { int pm, pn, e, ks, ar; };

struct Order {
    int nM, nN, nwg, G, c, nx, use_ar; const char* A; const char* B; size_t tstep, estride; const int* tile_e;
    __device__ __forceinline__ void init(int nM_, int nN_, int KB, int G_, int c_, const void* A_, const void* B_, size_t estride_, const int* tile_e_, int nx_ = NXCD, int use_ar_ = 0) {
        use_ar = use_ar_; nM = nM_; nN = nN_; nwg = nM * nN; G = G_; c = c_; nx = nx_; A = (const char*)A_; B = (const char*)B_; tstep = (size_t)BM * KB; estride = estride_; tile_e = tile_e_; }
    __device__ __forceinline__ bool next(int i, Unit& u) const {
        const long L = (long)i * G + c; if (L >= nwg) return false;
        int wgid = (int)L; { const int q = nwg / nx, r = nwg % nx, xcd = wgid % nx, off = wgid / nx; wgid = (xcd < r ? xcd * (q + 1) : r * (q + 1) + (xcd - r) * q) + off; }
        const int nig = WGM * nN, gid = wgid / nig, fm = gid * WGM, gsz = (nM - fm) < WGM ? (nM - fm) : WGM;
        u.pm = fm + ((wgid % nig) % gsz); u.pn = (wgid % nig) / gsz; const int v = tile_e ? tile_e[u.pm] : 0; u.e = v & 15; u.ar = use_ar ? (v >> 4) : u.pm; u.ks = 0; return true;
    }
    __device__ __forceinline__ const char* a_base(const Unit& u) const { return A + (size_t)u.ar * tstep; }
    __device__ __forceinline__ const char* b_base(const Unit& u) const { return B + (size_t)u.e * estride + (size_t)u.pn * tstep; }
};

struct TailOrder {
    int nsub, G, c, pm0, NS; const char* A; const char* B; size_t tstep, estride, kslice; const int* tile_e;
    __device__ __forceinline__ bool next(int i, Unit& u) const { const int L = i * G + c; if (L >= nsub) return false; const int per = 8 * NS; u.pm = pm0 + L / per; const int rem = L % per; u.pn = rem / NS; u.ks = rem % NS; u.e = tile_e[u.pm] & 15; u.ar = u.pm; return true; }
    __device__ __forceinline__ const char* a_base(const Unit& u) const { return A + (size_t)u.pm * tstep + (size_t)u.ks * kslice; }
    __device__ __forceinline__ const char* b_base(const Unit& u) const { return B + (size_t)u.e * estride + (size_t)u.pn * tstep + (size_t)u.ks * kslice; }
};

template <bool SCALE, bool BOUND = false> struct EpiBf16Out {
    static constexpr bool PERM = true;
    bf16_t* O; int ldc; const u64* ss; float csc; unsigned* bnd; int pm0;
    __device__ __forceinline__ void operator()(const f32x4 (&acc)[2][2][4][2], const Unit& u, int wr, int wc, int fr, int fq) const {
        const int row0 = u.pm * BM + wr * 64 + fr, col0 = u.pn * BM + wc * 32 + 8 * fq; float mx[2] = {0.f, 0.f};
        u64 ssv[2][4];
#pragma unroll
        for (int ai = 0; ai < 2; ++ai)
#pragma unroll
            for (int m = 0; m < 4; ++m) ssv[ai][m] = SCALE ? ss[row0 + ai * HALF + m * 16] : 0ull;
#pragma unroll
        for (int ai = 0; ai < 2; ++ai)
#pragma unroll
            for (int m = 0; m < 4; ++m) { const int row = row0 + ai * HALF + m * 16; float rs = csc; if (SCALE) rs = rstd_q(ssv[ai][m]);
                bf16_t* rowp = O + (size_t)row * ldc + col0;
#pragma unroll
                for (int bj = 0; bj < 2; ++bj) { const f32x4 v0 = acc[ai][bj][m][0] * rs, v1 = acc[ai][bj][m][1] * rs;
                    u32x4 w; w.x = cvt_pk_bf16(v0[0], v0[1]); w.y = cvt_pk_bf16(v0[2], v0[3]); w.z = cvt_pk_bf16(v1[0], v1[1]); w.w = cvt_pk_bf16(v1[2], v1[3]);
                    *(u32x4*)(rowp + bj * HALF) = w;
                    if (BOUND) { float sq = ((v0[0] * v0[0] + v0[1] * v0[1]) + (v0[2] * v0[2] + v0[3] * v0[3])) + ((v1[0] * v1[0] + v1[1] * v1[1]) + (v1[2] * v1[2] + v1[3] * v1[3]));
                        sq = sum_xor32(sum_xor16(sq)); mx[bj] = __builtin_fmaxf(mx[bj], sq); } } }
        if (BOUND) {
#pragma unroll
            for (int bj = 0; bj < 2; ++bj) { const float v = row_max16(mx[bj]);
                if (fr == 0 && fq == 0) __hip_atomic_fetch_max(bnd + ((size_t)(2 * u.pn + bj) * 64 + u.pm + pm0) * 4 + wc, __float_as_uint(v), __ATOMIC_RELAXED, __HIP_MEMORY_SCOPE_AGENT); } }
    }
};
__device__ __forceinline__ float clamp448(float x) { return __builtin_fminf(__builtin_fmaxf(x, -448.0f), 448.0f); }
__device__ __forceinline__ unsigned pk4_fp8(float a, float b, float c, float d) { int v = __builtin_amdgcn_cvt_pk_fp8_f32(clamp448(a), clamp448(b), 0, false); v = __builtin_amdgcn_cvt_pk_fp8_f32(clamp448(c), clamp448(d), v, true); return (unsigned)v; }
__device__ __forceinline__ float silu_mul(float g, float u) { return g * __builtin_amdgcn_rcpf(1.0f + __builtin_amdgcn_exp2f(-1.4426950408889634f * g)) * u; }
__device__ __forceinline__ float silu_mul_c(float g, float u, float c1, float c2) { return (g * u) * (c2 * __builtin_amdgcn_rcpf(1.0f + __builtin_amdgcn_exp2f(g * c1))); }
typedef float f32x2 __attribute__((ext_vector_type(2)));
__device__ __forceinline__ f32x2 silu_mul2(f32x2 g, f32x2 u, float c1, float k) {
    const f32x2 t = g * c1; f32x2 e; e.x = __builtin_amdgcn_exp2f(t.x); e.y = __builtin_amdgcn_exp2f(t.y);
    const f32x2 d = e * k + k; f32x2 r; r.x = __builtin_amdgcn_rcpf(d.x); r.y = __builtin_amdgcn_rcpf(d.y);
    return (g * u) * r;
}
__device__ __forceinline__ f32x4 silu_mul4(f32x4 g, f32x4 u, float c1, float k) { const f32x2 a = silu_mul2(g.xy, u.xy, c1, k), b = silu_mul2(g.zw, u.zw, c1, k); return (f32x4){a.x, a.y, b.x, b.y}; }
template <bool RAW> struct EpiSwiGLU {
    static constexpr bool PERM = true;
    bf16_t* O; int ldc; const void* rsrc;
    __device__ __forceinline__ void operator()(const f32x4 (&acc)[2][2][4][2], const Unit& u, int wr, int wc, int fr, int fq) const {
        const int row0 = u.pm * BM + wr * 64 + fr, col0 = u.pn * HALF + wc * 32 + 8 * fq;
        float rsv[2][4];
#pragma unroll
        for (int ai = 0; ai < 2; ++ai)
#pragma unroll
            for (int m = 0; m < 4; ++m) { const int row = row0 + ai * HALF + m * 16; if (RAW) rsv[ai][m] = ((const float*)rsrc)[row]; else rsv[ai][m] = rstd_q(((const u64*)rsrc)[row]); }
#pragma unroll
        for (int ai = 0; ai < 2; ++ai)
#pragma unroll
            for (int m = 0; m < 4; ++m) { const int row = row0 + ai * HALF + m * 16; const float rs = rsv[ai][m];
                const float c1 = -1.4426950408889634f * rs, kk = __builtin_amdgcn_rcpf(rs * rs);
                const f32x4 a0 = silu_mul4(acc[ai][0][m][0], acc[ai][1][m][0], c1, kk), a1 = silu_mul4(acc[ai][0][m][1], acc[ai][1][m][1], c1, kk);
                u32x4 w; w.x = cvt_pk_bf16(a0[0], a0[1]); w.y = cvt_pk_bf16(a0[2], a0[3]); w.z = cvt_pk_bf16(a1[0], a1[1]); w.w = cvt_pk_bf16(a1[2], a1[3]);
                *(u32x4*)(O + (size_t)row * ldc + col0) = w; }
    }
};
struct EpiSwiGLU8 {
    static constexpr bool PERM = true;
    unsigned char* O; int ldc; float isc, osc; int skip;
    __device__ __forceinline__ void operator()(const f32x4 (&acc)[2][2][4][2], const Unit& u, int wr, int wc, int fr, int fq) const {
        if (skip) return;
        const int row0 = u.pm * BM + wr * 64 + fr, col0 = u.pn * HALF + wc * 32 + 8 * fq; const float c1 = -1.4426950408889634f * isc, kk = 1.0f / (isc * isc * osc);
#pragma unroll
        for (int ai = 0; ai < 2; ++ai)
#pragma unroll
            for (int m = 0; m < 4; ++m) { const int row = row0 + ai * HALF + m * 16;
                const f32x4 a0 = silu_mul4(acc[ai][0][m][0], acc[ai][1][m][0], c1, kk), a1 = silu_mul4(acc[ai][0][m][1], acc[ai][1][m][1], c1, kk);
                u32x2 w; w.x = pk4_fp8(a0[0], a0[1], a0[2], a0[3]); w.y = pk4_fp8(a1[0], a1[1], a1[2], a1[3]);
                *(u32x2*)(O + (size_t)row * ldc + col0) = w; }
    }
};
struct EpiPart {
    static constexpr bool PERM = false;
    float* slab; int row_base; size_t ks_stride;
    __device__ __forceinline__ void operator()(const f32x4 (&acc)[2][2][4][2], const Unit& u, int wr, int wc, int fr, int fq) const {
        const int row0 = u.pm * BM + wr * 64 + fr - row_base, col0 = u.pn * BM + wc * 32 + 4 * fq; float* sp = slab + (size_t)u.ks * ks_stride;
#pragma unroll
        for (int ai = 0; ai < 2; ++ai)
#pragma unroll
            for (int m = 0; m < 4; ++m) { float* rowp = sp + (size_t)(row0 + ai * HALF + m * 16) * DM + col0;
#pragma unroll
                for (int bj = 0; bj < 2; ++bj)
#pragma unroll
                    for (int n = 0; n < 2; ++n) *(f32x4*)(rowp + bj * HALF + n * 16) = acc[ai][bj][m][n]; }
    }
};
template <bool BASE_BF16, bool WRITE_F32> struct EpiResid {
    static constexpr bool PERM = true;
    const void* base; float* xr; bf16_t* xb; u64* ssout;
    __device__ __forceinline__ void operator()(const f32x4 (&acc)[2][2][4][2], const Unit& u, int wr, int wc, int fr, int fq) const {
        const int row0 = u.pm * BM + wr * 64 + fr, col0 = u.pn * BM + wc * 32 + 8 * fq;
#pragma unroll
        for (int ai = 0; ai < 2; ++ai) { u32x4 qv[4][2];
            if (BASE_BF16) {
#pragma unroll
                for (int m = 0; m < 4; ++m)
#pragma unroll
                    for (int bj = 0; bj < 2; ++bj) qv[m][bj] = *(const u32x4*)((const bf16_t*)base + (size_t)(row0 + ai * HALF + m * 16) * DM + col0 + bj * HALF); }
#pragma unroll
            for (int m = 0; m < 4; ++m) { const int row = row0 + ai * HALF + m * 16; const size_t off = (size_t)row * DM + col0; float s = 0.f;
#pragma unroll
                for (int bj = 0; bj < 2; ++bj) { const int c = bj * HALF; f32x4 b0, b1;
                    if (BASE_BF16) { const u32x4 q = qv[m][bj];
                        b0 = (f32x4){__uint_as_float(q.x << 16), __uint_as_float(q.x & 0xffff0000u), __uint_as_float(q.y << 16), __uint_as_float(q.y & 0xffff0000u)};
                        b1 = (f32x4){__uint_as_float(q.z << 16), __uint_as_float(q.z & 0xffff0000u), __uint_as_float(q.w << 16), __uint_as_float(q.w & 0xffff0000u)}; }
                    else { b0 = *(const f32x4*)((const float*)base + off + c); b1 = *(const f32x4*)((const float*)base + off + c + 4); }
                    const f32x4 o0 = b0 + acc[ai][bj][m][0], o1 = b1 + acc[ai][bj][m][1];
                    if (WRITE_F32) { *(f32x4*)(xr + off + c) = o0; *(f32x4*)(xr + off + c + 4) = o1; }
                    u32x4 w; w.x = cvt_pk_bf16(o0[0], o0[1]); w.y = cvt_pk_bf16(o0[2], o0[3]); w.z = cvt_pk_bf16(o1[0], o1[1]); w.w = cvt_pk_bf16(o1[2], o1[3]); *(u32x4*)(xb + off + c) = w;
                    s += (o0[0] * o0[0] + o0[1] * o0[1]) + (o0[2] * o0[2] + o0[3] * o0[3]); s += (o1[0] * o1[0] + o1[1] * o1[1]) + (o1[2] * o1[2] + o1[3] * o1[3]); }
                s = sum_xor32(sum_xor16(s));
                if (fq == 0) __hip_atomic_fetch_add(ssout + row, ss_fix(s), __ATOMIC_RELAXED, __HIP_MEMORY_SCOPE_AGENT); } }
    }
};

typedef int i32x8 __attribute__((ext_vector_type(8)));
__device__ __forceinline__ i32x8 cat16(bf16x8 lo, bf16x8 hi) { typedef int i32x4 __attribute__((ext_vector_type(4))); const i32x4 a = __builtin_bit_cast(i32x4, lo), b = __builtin_bit_cast(i32x4, hi); return (i32x8){a[0], a[1], a[2], a[3], b[0], b[1], b[2], b[3]}; }
__device__ __forceinline__ void mfma_fp8(f32x4& acc, i32x8 a, i32x8 b) { asm volatile("v_mfma_f32_16x16x128_f8f6f4 %0, %1, %2, %0" : "+v"(acc) : "v"(a), "v"(b)); }
template <class Epi, bool ALIGN_EPI, bool SP2, bool FP8 = false, class Sched = Order>
__device__ __forceinline__ void gemm_phase(LAS unsigned char* lds, const int KB, const Sched& S, const Epi& E, const int nt_override = 0, volatile LAS unsigned* prb = nullptr) {
    unsigned long long pk_ = 0, pg_ = 0, pl_ = 0; unsigned pnk_ = 0, png_ = 0;
#define PG8_STAMP(x) do { if (prb) { asm volatile("s_memtime %0\n\ts_waitcnt lgkmcnt(0)" : "=s"(x) :: "memory"); } } while (0)
    int tid_ = threadIdx.x; asm volatile("" : "+v"(tid_));
    const int tid = tid_, wid = __builtin_amdgcn_readfirstlane(tid >> 6), lane = tid & 63, wr = wid >> 2, wc = wid & 3, fr = lane & 15, fq = lane >> 4;
    const int nt = nt_override ? nt_override : KB / 128;
    unsigned voffA[2], voffB[2];
#pragma unroll
    for (int i = 0; i < 2; ++i) { int R, C; stage_rc(tid * 16 + i * 8192, R, C); const int Rb = Epi::PERM ? ((R & ~31) + perm32(R & 31)) : R;
        voffA[i] = (unsigned)(R * KB + C * 2); voffB[i] = (unsigned)(Rb * KB + C * 2); }
    const size_t kstep = (size_t)(BK * 2);
    const size_t hstep = (size_t)HALF * KB;
    const unsigned ldsw = (unsigned)wid * 1024u;
    const int aoff = lds_byte(wr * 64 + fr, fq * 8), boff = lds_byte(wc * 32 + fr, fq * 8);
#define PG8_SA(b, h) (((b) * 2 + (h)) * HTB)
#define PG8_SB(b, h) ((4 + (b) * 2 + (h)) * HTB)
#define PG8_STAGE(bufoff, gbase, voff) do { _Pragma("unroll") for (int _i = 0; _i < 2; ++_i) \
        __builtin_amdgcn_global_load_lds((const unsigned*)((const char*)(gbase) + (voff)[_i]), (LAS unsigned*)(lds + (bufoff) + ldsw + _i * 8192), 16, 0, 0); } while (0)
#define PG8_LDA(dst, b, h) do { _Pragma("unroll") for (int m = 0; m < 4; ++m) _Pragma("unroll") for (int k = 0; k < 2; ++k) dst[m][k] = *(const LAS bf16x8*)(lds + PG8_SA(b, h) + aoff + m * 2048 + k * 1024); } while (0)
#define PG8_LDB(dst, b, h) do { _Pragma("unroll") for (int n = 0; n < 2; ++n) _Pragma("unroll") for (int k = 0; k < 2; ++k) dst[n][k] = *(const LAS bf16x8*)(lds + PG8_SB(b, h) + boff + n * 2048 + k * 1024); } while (0)
#define PG8_MMA(ai, bj, At, Bt) do { __builtin_amdgcn_s_setprio(1); _Pragma("unroll") for (int m = 0; m < 4; ++m) _Pragma("unroll") for (int n = 0; n < 2; ++n) { \
        if constexpr (FP8) mfma_fp8(acc[ai][bj][m][n], cat16(Bt[n][0], Bt[n][1]), cat16(At[m][0], At[m][1])); \
        else { _Pragma("unroll") for (int k = 0; k < 2; ++k) acc[ai][bj][m][n] = __builtin_amdgcn_mfma_f32_16x16x32_bf16(Bt[n][k], At[m][k], acc[ai][bj][m][n], 0, 0, 0); } } \
        __builtin_amdgcn_s_setprio(0); } while (0)
#define PG8_WAIT_V(n) asm volatile("s_waitcnt vmcnt(" #n ")" ::: "memory")
#define PG8_WAIT_L(n) asm volatile("s_waitcnt lgkmcnt(" #n ")" ::: "memory")
#define PG8_BAR __builtin_amdgcn_s_barrier()
#define PG8_SCHED __builtin_amdgcn_sched_barrier(0)
    Unit cur, nxt; int ui = 0;
    if (!S.next(0, cur)) return;
    f32x4 acc[2][2][4][2];
#pragma unroll
    for (int a = 0; a < 2; ++a)
#pragma unroll
        for (int b = 0; b < 2; ++b)
#pragma unroll
            for (int m = 0; m < 4; ++m)
#pragma unroll
                for (int n = 0; n < 2; ++n) acc[a][b][m][n] = (f32x4){0.f, 0.f, 0.f, 0.f};
    bf16x8 At[4][2], B0[2][2], B1[2][2];
    const char* cA = S.a_base(cur); const char* cB = S.b_base(cur);
    if constexpr (SP2) {
        PG8_STAGE(PG8_SB(0, 0), cB, voffB); PG8_STAGE(PG8_SB(0, 1), cB + hstep, voffB); PG8_STAGE(PG8_SA(0, 0), cA, voffA); PG8_STAGE(PG8_SA(0, 1), cA + hstep, voffA);
        if (wr == 1) PG8_BAR;
        PG8_WAIT_V(2); PG8_BAR;
        PG8_STAGE(PG8_SB(1, 0), cB + kstep, voffB); PG8_STAGE(PG8_SA(1, 0), cA + kstep, voffA); PG8_STAGE(PG8_SB(1, 1), cB + hstep + kstep, voffB);
        PG8_WAIT_V(6); PG8_BAR;
    } else {
        PG8_STAGE(PG8_SB(0, 0), cB, voffB); PG8_STAGE(PG8_SA(0, 0), cA, voffA); PG8_STAGE(PG8_SB(0, 1), cB + hstep, voffB); PG8_STAGE(PG8_SA(0, 1), cA + hstep, voffA);
        if (wr == 1) PG8_BAR;
        PG8_WAIT_V(4); PG8_BAR;
        PG8_STAGE(PG8_SB(1, 0), cB + kstep, voffB); PG8_STAGE(PG8_SA(1, 0), cA + kstep, voffA); PG8_STAGE(PG8_SB(1, 1), cB + hstep + kstep, voffB);
        PG8_WAIT_V(6); PG8_BAR;
    }
    for (;;) {
        const bool has_next = S.next(ui + 1, nxt);
        const char* nA = has_next ? S.a_base(nxt) : cA; const char* nB = has_next ? S.b_base(nxt) : cB;
        { unsigned long long ts_; PG8_STAMP(ts_); if (prb && pl_) { pg_ += ts_ - pl_; ++png_; } pl_ = ts_; }
        for (int t = 0; t < nt; t += 2) {
            const bool last = (t == nt - 2);
            const char* a1 = cA + (size_t)(t + 1) * kstep;
            const char* a2 = last ? nA : cA + (size_t)(t + 2) * kstep; const char* b2 = last ? nB : cB + (size_t)(t + 2) * kstep;
            const char* a3 = a2 + kstep; const char* b3 = b2 + kstep;
            if constexpr (SP2) {
            PG8_LDB(B0, 0, 0); PG8_LDB(B1, 0, 1); PG8_SCHED; PG8_LDA(At, 0, 0); PG8_STAGE(PG8_SA(1, 1), a1 + hstep, voffA);
            PG8_WAIT_V(8); PG8_WAIT_L(0); PG8_BAR; PG8_MMA(0, 0, At, B0); PG8_MMA(0, 1, At, B1); PG8_BAR; PG8_SCHED;
            PG8_LDA(At, 0, 1); PG8_STAGE(PG8_SB(0, 0), b2, voffB); PG8_STAGE(PG8_SB(0, 1), b2 + hstep, voffB); PG8_STAGE(PG8_SA(0, 0), a2, voffA);
            PG8_WAIT_V(8); PG8_WAIT_L(0); PG8_BAR; PG8_MMA(1, 0, At, B0); PG8_MMA(1, 1, At, B1); PG8_BAR; PG8_SCHED;
            PG8_LDB(B0, 1, 0); PG8_LDB(B1, 1, 1); PG8_SCHED; PG8_LDA(At, 1, 0); PG8_STAGE(PG8_SA(0, 1), a2 + hstep, voffA);
            PG8_WAIT_V(8); PG8_WAIT_L(0); PG8_BAR; PG8_MMA(0, 0, At, B0); PG8_MMA(0, 1, At, B1); PG8_BAR; PG8_SCHED;
            PG8_LDA(At, 1, 1); PG8_STAGE(PG8_SB(1, 0), b3, voffB); PG8_STAGE(PG8_SB(1, 1), b3 + hstep, voffB); PG8_STAGE(PG8_SA(1, 0), a3, voffA);
            PG8_WAIT_V(8); PG8_WAIT_L(0); PG8_BAR; PG8_MMA(1, 0, At, B0); PG8_MMA(1, 1, At, B1); PG8_BAR; PG8_SCHED;
            } else {
            PG8_LDB(B0, 0, 0); PG8_SCHED; PG8_LDA(At, 0, 0); PG8_STAGE(PG8_SA(1, 1), a1 + hstep, voffA);
            PG8_WAIT_L(8); PG8_BAR; PG8_WAIT_L(0); PG8_MMA(0, 0, At, B0); PG8_BAR; PG8_SCHED;
            PG8_LDB(B1, 0, 1); PG8_STAGE(PG8_SB(0, 0), b2, voffB);
            PG8_BAR; PG8_WAIT_L(0); PG8_MMA(0, 1, At, B1); PG8_BAR;
            PG8_LDA(At, 0, 1); PG8_STAGE(PG8_SA(0, 0), a2, voffA);
            PG8_BAR; PG8_WAIT_L(0); PG8_MMA(1, 0, At, B0); PG8_BAR; PG8_SCHED;
            PG8_STAGE(PG8_SB(0, 1), b2 + hstep, voffB);
            PG8_WAIT_V(6); PG8_BAR; PG8_MMA(1, 1, At, B1); PG8_BAR;
            PG8_LDB(B0, 1, 0); PG8_SCHED; PG8_LDA(At, 1, 0); PG8_STAGE(PG8_SA(0, 1), a2 + hstep, voffA);
            PG8_WAIT_L(8); PG8_BAR; PG8_WAIT_L(0); PG8_MMA(0, 0, At, B0); PG8_BAR; PG8_SCHED;
            PG8_LDB(B1, 1, 1); PG8_STAGE(PG8_SB(1, 0), b3, voffB);
            PG8_BAR; PG8_WAIT_L(0); PG8_MMA(0, 1, At, B1); PG8_BAR;
            PG8_LDA(At, 1, 1); PG8_STAGE(PG8_SA(1, 0), a3, voffA);
            PG8_BAR; PG8_WAIT_L(0); PG8_MMA(1, 0, At, B0); PG8_BAR; PG8_SCHED;
            PG8_STAGE(PG8_SB(1, 1), b3 + hstep, voffB);
            PG8_WAIT_V(6); PG8_BAR; PG8_MMA(1, 1, At, B1); PG8_BAR;
            }
        }
        { unsigned long long ts_; PG8_STAMP(ts_); if (prb) { pk_ += ts_ - pl_; pnk_ += (unsigned)nt; pl_ = ts_; } }
        if constexpr (FP8) asm volatile("s_nop 15\n\ts_nop 15" ::: "memory");
        if constexpr (ALIGN_EPI) { if (wr == 0) PG8_BAR; }
        E(acc, cur, wr, wc, fr, fq);
        if (!has_next) break;
#pragma unroll
        for (int a = 0; a < 2; ++a)
#pragma unroll
            for (int b = 0; b < 2; ++b)
#pragma unroll
                for (int m = 0; m < 4; ++m)
#pragma unroll
                    for (int n = 0; n < 2; ++n) acc[a][b][m][n] = (f32x4){0.f, 0.f, 0.f, 0.f};
        cur = nxt; cA = nA; cB = nB; ++ui;
        if constexpr (ALIGN_EPI) { if (wr == 1) PG8_BAR; }
    }
    PG8_WAIT_V(0);
    if constexpr (!ALIGN_EPI) { if (wr == 0) PG8_BAR; }
    PG8_BAR;
    if (prb && blockIdx.x == 0 && tid == 0) { if (PROBE_KIND == 4) prb[20] = (unsigned)((pk_ / (pnk_ ? pnk_ : 1u)) * 100ull); if (PROBE_KIND == 5) prb[20] = (unsigned)((pg_ / (png_ ? png_ : 1u)) * 10ull); }
#undef PG8_STAMP
#undef PG8_SA
#undef PG8_SB
#undef PG8_STAGE
#undef PG8_LDA
#undef PG8_LDB
#undef PG8_MMA
#undef PG8_WAIT_V
#undef PG8_WAIT_L
#undef PG8_BAR
#undef PG8_SCHED
}
}
constexpr bool GEMM_SP2 = true, GEMM_ALIGN = true;

namespace att {
constexpr int D = 128, LDQ = NQKV, LDO = DM;
constexpr float SCALE = 0.08838834764831845f, THR = 8.f;
constexpr int NW = 8, QBLK = 32, KVBLK = 64, QB = NW * QBLK;
constexpr int SHM_V = KVBLK * D * 2, SHM_K = KVBLK * D * 2;
constexpr int LDS_ATT = 2 * SHM_V + 2 * SHM_K + NW * 64 * 4;
constexpr unsigned BIGW = 0x40000000u;
#define KSWZ(row, colB) ((row) * 256 + ((colB) ^ (((row) & 7) << 4)))
#define SBAR() __builtin_amdgcn_sched_barrier(0)
__device__ __forceinline__ int v_st(int k, int c) { const int kk = (k & ~0xC) | ((k & 4) << 1) | ((k & 8) >> 1); return ((kk >> 3) * 4 + (c >> 5)) * 512 + ((kk & 7) * 32 + (c & 31)) * 2; }
__device__ __forceinline__ int v_rd_base(int lane) { return ((lane & 3) << 3) | (((lane >> 2) & 3) << 6) | (((lane >> 4) & 1) << 5) | (((lane >> 5) & 1) << 8); }
constexpr int v_rd_off(int d0, int ks, int half) { return d0 * 512 + ks * 4096 + half * 2048; }
__device__ __forceinline__ int crow(int r, int hi) { return (r & 3) + 8 * (r >> 2) + 4 * hi; }
__device__ __forceinline__ bf16x8 ld8(const bf16_t* p) { return *reinterpret_cast<const bf16x8*>(p); }
__device__ __forceinline__ void mask_tile(f32x16& p0, f32x16& p1, int dq) {
    const float NEG = -__builtin_inff();
#pragma unroll
    for (int r = 0; r < 16; ++r) {
        const int c = (r & 3) + 8 * (r >> 2);
        if ((unsigned)(dq - c) >= BIGW) p0[r] = NEG;
        if ((unsigned)(dq - c - 32) >= BIGW) p1[r] = NEG;
    }
}
__device__ __forceinline__ void mask_lane(f32x16& p0, f32x16& p1, bool keep) {
    const float NEG = -__builtin_inff();
#pragma unroll
    for (int r = 0; r < 16; ++r) { p0[r] = keep ? p0[r] : NEG; p1[r] = keep ? p1[r] : NEG; }
}
__device__ __forceinline__ void partialSM(f32x16& p0, f32x16& p1, float& m_reg, float& mn, float& alpha) {
    float pmax = p0[0]; for (int r = 1; r < 16; ++r) pmax = fmaxf(pmax, p0[r]); for (int r = 0; r < 16; ++r) pmax = fmaxf(pmax, p1[r]);
    { auto rr = __builtin_amdgcn_permlane32_swap(__float_as_uint(pmax), __float_as_uint(pmax), false, false);
      pmax = fmaxf(__uint_as_float(rr[0]), __uint_as_float(rr[1])); }
    constexpr float C2 = 1.4426950408889634f * SCALE;
    if (__builtin_expect(__all((pmax - m_reg) * SCALE <= THR), 1)) { mn = m_reg; alpha = 1.f; }
    else { mn = fmaxf(m_reg, pmax); alpha = __builtin_amdgcn_exp2f((m_reg - mn) * C2); m_reg = mn; }
    const float mnL = -mn * C2;
    for (int r = 0; r < 16; ++r) p0[r] = fmaf(p0[r], C2, mnL); for (int r = 0; r < 16; ++r) p1[r] = fmaf(p1[r], C2, mnL);
    for (int r = 0; r < 16; ++r) p0[r] = __builtin_amdgcn_exp2f(p0[r]);
}
__device__ __forceinline__ void finishSM(f32x16& p0, f32x16& p1, float alpha, float& l_reg, bf16x8& pa0, bf16x8& pa1, bf16x8& pa2, bf16x8& pa3) {
    for (int r = 0; r < 16; ++r) p1[r] = __builtin_amdgcn_exp2f(p1[r]);
    float ps = 0; for (int r = 0; r < 16; ++r) ps += p0[r]; for (int r = 0; r < 16; ++r) ps += p1[r];
    { auto rr = __builtin_amdgcn_permlane32_swap(__float_as_uint(ps), __float_as_uint(ps), false, false);
      ps = __uint_as_float(rr[0]) + __uint_as_float(rr[1]); }
    l_reg = l_reg * alpha + ps;
#define PK4(P, B_, OUT) do { unsigned a0 = cvt_pk_bf16(P[B_+0], P[B_+1]), a1 = cvt_pk_bf16(P[B_+2], P[B_+3]);                          \
        unsigned b0 = cvt_pk_bf16(P[B_+4], P[B_+5]), b1 = cvt_pk_bf16(P[B_+6], P[B_+7]);                                             \
        auto r0 = __builtin_amdgcn_permlane32_swap(a0, b0, false, false); auto r1 = __builtin_amdgcn_permlane32_swap(a1, b1, false, false); \
        u32x4 w = {r0[0], r1[0], r0[1], r1[1]}; OUT = *reinterpret_cast<bf16x8*>(&w); } while (0)
    PK4(p0, 0, pa0); PK4(p0, 8, pa1); PK4(p1, 0, pa2); PK4(p1, 8, pa3);
#undef PK4
}
template <int KB>
__device__ __forceinline__ void qkt(f32x16& p0, f32x16& p1, const char* K_lds, int r32, int hi, const bf16x8* qr, float a, float bias0) {
#pragma unroll
    for (int r = 0; r < 16; ++r) { const float c = (float)((r & 3) + 8 * (r >> 2)); p0[r] = fmaf(a, c, bias0); p1[r] = fmaf(a, c + 32.f, bias0); }
    const char* kb[4];
#pragma unroll
    for (int dd = 0; dd < 4; ++dd) kb[dd] = K_lds + KB * SHM_K + KSWZ(r32, (dd * 16 + hi * 8) * 2);
#pragma unroll
    for (int d0 = 0; d0 < 8; ++d0) { const char* ap = kb[d0 & 3] + (d0 >> 2) * 128;
        bf16x8 b0 = *reinterpret_cast<const bf16x8*>(ap);
        bf16x8 b1 = *reinterpret_cast<const bf16x8*>(ap + 32 * 256);
        p0 = __builtin_amdgcn_mfma_f32_32x32x16_bf16(b0, qr[d0], p0, 0, 0, 0);
        p1 = __builtin_amdgcn_mfma_f32_32x32x16_bf16(b1, qr[d0], p1, 0, 0, 0); }
}
template <int VB>
__device__ __forceinline__ void pv_tile(f32x16* o, int vb0, bf16x8 pa0, bf16x8 pa1, bf16x8 pa2, bf16x8 pa3) {
#define TRRD(dst, off) asm volatile("ds_read_b64_tr_b16 %0, %1 offset:%2" : "=&v"(dst) : "v"(vb0), "i"(off) : "memory")
#define PV_D0(d0) do { s16x4 l0, l1, l2, l3, h0, h1, h2, h3; constexpr int b_ = VB * SHM_V + v_rd_off(d0, 0, 0); \
        TRRD(l0, b_); TRRD(h0, b_ + 2048); TRRD(l1, b_ + 4096); TRRD(h1, b_ + 6144); TRRD(l2, b_ + 8192); TRRD(h2, b_ + 10240); TRRD(l3, b_ + 12288); TRRD(h3, b_ + 14336); \
        asm volatile("s_waitcnt lgkmcnt(0)" ::: "memory"); SBAR();   \
        o[d0] = __builtin_amdgcn_mfma_f32_32x32x16_bf16(pa0, (bf16x8){l0[0], l0[1], l0[2], l0[3], h0[0], h0[1], h0[2], h0[3]}, o[d0], 0, 0, 0);   \
        o[d0] = __builtin_amdgcn_mfma_f32_32x32x16_bf16(pa1, (bf16x8){l1[0], l1[1], l1[2], l1[3], h1[0], h1[1], h1[2], h1[3]}, o[d0], 0, 0, 0);   \
        o[d0] = __builtin_amdgcn_mfma_f32_32x32x16_bf16(pa2, (bf16x8){l2[0], l2[1], l2[2], l2[3], h2[0], h2[1], h2[2], h2[3]}, o[d0], 0, 0, 0);   \
        o[d0] = __builtin_amdgcn_mfma_f32_32x32x16_bf16(pa3, (bf16x8){l3[0], l3[1], l3[2], l3[3], h3[0], h3[1], h3[2], h3[3]}, o[d0], 0, 0, 0); } while (0)
    PV_D0(0); PV_D0(1); PV_D0(2); PV_D0(3);
#undef PV_D0
#undef TRRD
}
struct BlockRef { const bf16_t* Q; const bf16_t* K; const bf16_t* V; bf16_t* O; const unsigned char* sel; int P0; float a; int jlo; };
struct Seam { bf16x8 qr[8]; bf16x8 st_v0, st_v1, st_k0, st_k1; };
#define AROW(p, k0, rr) (((p) + (size_t)((k0) + (rr)) * LDQ) + toff)
#define VMW() asm volatile("s_waitcnt vmcnt(0)" ::: "memory")
#define VMWN(n) asm volatile("s_waitcnt vmcnt(%0)" :: "i"(n) : "memory")
#define SLOAD_H(Kp, Vp, k0) do { S.st_v0 = ld8(AROW(Vp, k0, 0)); S.st_v1 = ld8(AROW(Vp, k0, 32));              \
                         S.st_k0 = ld8(AROW(Kp, k0, 0)); S.st_k1 = ld8(AROW(Kp, k0, 32)); } while (0)
#define SWRITE_HK(bf) do { *(bf16x8*)(K_lds + (bf) * SHM_K + kws) = S.st_k0; *(bf16x8*)(K_lds + (bf) * SHM_K + kws + 32 * 256) = S.st_k1; } while (0)
#define SWRITE_HV(bf) do { *(bf16x8*)(V_lds + (bf) * SHM_V + vst0) = S.st_v0; *(bf16x8*)(V_lds + (bf) * SHM_V + vst1) = S.st_v1; } while (0)
#define SWRITE_H(bf) do { SWRITE_HV(bf); SWRITE_HK(bf); } while (0)
__device__ __forceinline__ int attn_jlo(const unsigned* bnd, int qseg, int kseg, int b, int qb, float slope) {
    float q2 = 0.f, k2 = 0.f;
#pragma unroll
    for (int w = 0; w < 4; ++w) q2 += __uint_as_float(bnd[((size_t)qseg * 64 + b * 8 + qb) * 4 + w]);
    for (int t = 0; t <= qb; ++t) { float s2 = 0.f;
#pragma unroll
        for (int w = 0; w < 4; ++w) s2 += __uint_as_float(bnd[((size_t)kseg * 64 + b * 8 + t) * 4 + w]);
        k2 = __builtin_fmaxf(k2, s2); }
    const float W = (2.0f * 1.02f * __builtin_sqrtf(q2 * k2) * SCALE + 30.0f) / slope, lo = (float)(qb * 256) - W;
    return lo > 0.f ? (int)(lo * (1.0f / 64.0f)) : 0;
}
struct DynCtx { const bf16_t* qkv; bf16_t* out; const unsigned char* sel; const unsigned* bnd; unsigned* qctr; volatile LAS int* nw; int q0, qb0, nq; };
template <bool MOBA> __device__ __forceinline__ BlockRef attn_ref_blk(int code, const DynCtx& C) {
    constexpr int NH = MOBA ? HA : HB * 4, NPB = NH * 8;
    const int b = code / NPB, idx = code % NPB, qb = 7 - idx / NH, hh = NH - 1 - idx % NH; BlockRef r; const size_t t0 = (size_t)b * SEQ;
    if (MOBA) { const int h = hh; const float slope = __builtin_amdgcn_exp2f(-0.5f * (float)(h + 1));
        r.Q = C.qkv + (t0 + qb * 256) * NQKV + h * 128; r.K = C.qkv + t0 * NQKV + DM + h * 128; r.V = C.qkv + t0 * NQKV + 2 * DM + h * 128;
        r.O = C.out + (t0 + qb * 256) * DM + h * 128; r.sel = C.sel + (size_t)(b * HA + h) * SEQ; r.P0 = qb * 256; r.a = slope * (1.0f / SCALE); r.jlo = attn_jlo(C.bnd, h, 16 + h, b, qb, slope); }
    else { const int h = hh >> 2, c = (hh >> 1) & 1, vh = hh & 1; const float slope = __builtin_amdgcn_exp2f(-(float)(h + 1));
        r.Q = C.qkv + (t0 + qb * 256) * NQKV + 2 * DM + h * 256 + c * 128; r.K = C.qkv + t0 * NQKV + h * 256 + c * 128; r.V = C.qkv + t0 * NQKV + DM + h * 256 + vh * 128;
        r.O = C.out + (size_t)c * MTOK * DM + (t0 + qb * 256) * DM + h * 256 + vh * 128; r.sel = nullptr; r.P0 = qb * 256; r.a = slope * (1.0f / SCALE); r.jlo = attn_jlo(C.bnd, 32 + 2 * h + c, 2 * h + c, b, qb, slope); }
    return r;
}
__device__ __forceinline__ int attn_pull_from(unsigned* qctr, int q0, int k0, int npb, int qb0, int nq) {
    for (int k = k0; k < nq; ++k) { const int q = qb0 + ((q0 - qb0 + k) & (nq - 1)); if (xb_ld(qctr + 64 * q) >= (unsigned)npb) continue;
        const unsigned i = xb_add(qctr + 64 * q, 1u); if (i < (unsigned)npb) return q * npb + (int)i; }
    return -1;
}
__device__ __forceinline__ void attn_prime(const BlockRef& cur, char* lds, Seam& S) {
    int tid_ = threadIdx.x; asm volatile("" : "+v"(tid_));
    const int tid = tid_, wid = __builtin_amdgcn_readfirstlane(tid >> 6), lane = tid & 63, r32 = lane & 31, hi = lane >> 5;
    const int sr = tid >> 4, sc = (tid & 15) * 8, kws = KSWZ(sr, sc * 2); char* K_lds = lds + 2 * SHM_V; const unsigned toff = (unsigned)(sr * LDQ + sc);
    { const unsigned qoff = (unsigned)(r32 * LDQ + hi * 8); const bf16_t* qb_ = cur.Q + (size_t)(wid * QBLK) * LDQ;
      for (int d0 = 0; d0 < 8; ++d0) S.qr[d0] = ld8(qb_ + qoff + d0 * 16); }
    SLOAD_H(cur.K, cur.V, cur.jlo * KVBLK); VMW(); SWRITE_HK(0);
    __syncthreads();
}
template <bool MOBA>
__device__ __forceinline__ int attn_block(const BlockRef& cur, const DynCtx& C, char* lds, Seam& S) {
    int tid_ = threadIdx.x; asm volatile("" : "+v"(tid_));
    const int tid = tid_, wid = __builtin_amdgcn_readfirstlane(tid >> 6), lane = tid & 63, r32 = lane & 31, hi = lane >> 5;
    const int NT = (cur.P0 + QB) / KVBLK - cur.jlo;
    const int qlo = cur.P0 + wid * QBLK, qm = qlo + r32 - 4 * hi;
    char* V_lds = lds; char* K_lds = lds + 2 * SHM_V;
    float* ws = (float*)(lds + 2 * SHM_V + 2 * SHM_K) + wid * 64; float* li_l = ws, * al_l = ws + 32;
    float m_reg = -1e30f, l_reg = 0; f32x16 o[4] = {};
    const int sr = tid >> 4, sc = (tid & 15) * 8, vst0 = v_st(sr, sc), vst1 = v_st(32 + sr, sc), kws = KSWZ(sr, sc * 2); const unsigned toff = (unsigned)(sr * LDQ + sc);
    const int vb0 = (int)(uintptr_t)V_lds + v_rd_base(lane);
    const bf16_t* Kh = cur.K; const bf16_t* Vh = cur.V;
    unsigned selm = 0xffu; if (MOBA) selm = cur.sel[cur.P0 + wid * QBLK + r32];
    const float aa = cur.a, abase = -aa * (float)qm;
#define RESC(a) do { if (__any((a) < 1.f)) { if (hi == 0) al_l[r32] = (a); asm volatile("s_waitcnt lgkmcnt(0)" ::: "memory");              \
                     for (int d_ = 0; d_ < 4; ++d_) for (int r = 0; r < 16; ++r) o[d_][r] *= al_l[crow(r, hi)]; } } while (0)
#define KBASE(t) ((cur.jlo + (t)) * KVBLK)
#define BIAS(t) fmaf(aa, (float)KBASE(t), abase)
#define MASKT(P0_, P1_, t) do { const int kb_ = KBASE(t); \
        if (!MOBA || kb_ >= cur.P0) { if (kb_ + KVBLK - 1 > qlo) mask_tile(P0_, P1_, qm - kb_); } \
        else { const bool keep_ = ((selm >> (kb_ >> 8)) & 1u) != 0u; if (!__all(keep_)) mask_lane(P0_, P1_, keep_); } } while (0)
#define SEAM_K0() do { VMWN(8); SWRITE_HK(0); SBAR(); } while (0)
    f32x16 pA0, pA1, pB0, pB1; float mnA, mnB, alA, alB; bf16x8 pa0, pa1, pa2, pa3;
    SWRITE_HV(0); SBAR();
    if (NT > 1) { SLOAD_H(Kh, Vh, KBASE(1)); }
    constexpr int NPB_ = (MOBA ? HA : HB * 4) * 8; unsigned pi_ = 0u; if (tid == 0) pi_ = xb_add(C.qctr + 64 * C.q0, 1u);
    SBAR(); qkt<0>(pA0, pA1, K_lds, r32, hi, S.qr, aa, BIAS(0));
    MASKT(pA0, pA1, 0); partialSM(pA0, pA1, m_reg, mnA, alA);
    if (NT > 1) { VMW(); SWRITE_H(1); }
    if (tid == 0) *C.nw = pi_ < (unsigned)NPB_ ? C.q0 * NPB_ + (int)pi_ : attn_pull_from(C.qctr, C.q0, 1, NPB_, C.qb0, C.nq);
    __syncthreads();
#define HALF_STEP(PX0, PX1, mnX, alX, PY0, PY1, alY, t, KB, VB, SB) do {                                                      \
        SBAR(); qkt<KB>(PX0, PX1, K_lds, r32, hi, S.qr, aa, BIAS(t));                                                         \
        finishSM(PY0, PY1, alY, l_reg, pa0, pa1, pa2, pa3); SBAR();                                                           \
        if ((t) + 1 < NT) { SLOAD_H(Kh, Vh, KBASE((t) + 1)); SBAR(); }                                                        \
        pv_tile<VB>(o, vb0, pa0, pa1, pa2, pa3); MASKT(PX0, PX1, (t)); partialSM(PX0, PX1, m_reg, mnX, alX);                  \
        __syncthreads();                                                                                                      \
        if ((t) + 1 < NT) { VMW(); SWRITE_H(SB); }                                                                            \
        RESC(alX); __syncthreads(); } while (0)
    for (int t = 1; t + 1 < NT; t += 2) {
        HALF_STEP(pB0, pB1, mnB, alB, pA0, pA1, alA, t, 1, 0, 0);
        HALF_STEP(pA0, pA1, mnA, alA, pB0, pB1, alB, t + 1, 0, 1, 1);
    }
    const bool even = (NT & 1) == 0;
    if (even) { SBAR(); qkt<1>(pB0, pB1, K_lds, r32, hi, S.qr, aa, BIAS(NT - 1)); SBAR(); }
    const int nc_ = __builtin_amdgcn_readfirstlane(*C.nw); const BlockRef nxt = nc_ >= 0 ? attn_ref_blk<MOBA>(nc_, C) : cur;
    SLOAD_H(nxt.K, nxt.V, nxt.jlo * KVBLK); SBAR();
    { const unsigned qoff = (unsigned)(r32 * LDQ + hi * 8); const bf16_t* qb_ = nxt.Q + (size_t)(wid * QBLK) * LDQ;
      _Pragma("unroll") for (int d0 = 0; d0 < 8; ++d0) S.qr[d0] = ld8(qb_ + qoff + d0 * 16); }
    SBAR();
    finishSM(pA0, pA1, alA, l_reg, pa0, pa1, pa2, pa3); SBAR();
    pv_tile<0>(o, vb0, pa0, pa1, pa2, pa3);
    if (even) { MASKT(pB0, pB1, NT - 1); partialSM(pB0, pB1, m_reg, mnB, alB); __syncthreads(); RESC(alB);
        finishSM(pB0, pB1, alB, l_reg, pa0, pa1, pa2, pa3); SBAR(); pv_tile<1>(o, vb0, pa0, pa1, pa2, pa3); }
    SBAR(); SEAM_K0();
    if (hi == 0) li_l[r32] = l_reg; asm volatile("s_waitcnt lgkmcnt(0)" ::: "memory");
    float rli[16];
#pragma unroll
    for (int r = 0; r < 16; ++r) rli[r] = __builtin_amdgcn_rcpf(li_l[crow(r, hi)]);
    bf16_t* Ow = cur.O + (size_t)(wid * QBLK) * LDO;
#pragma unroll
    for (int r = 0; r < 16; ++r) { const int orow = crow(r, hi);
#pragma unroll
        for (int d0 = 0; d0 < 4; ++d0) { const float v = o[d0][r] * rli[r];
            const float vn = xor1_get(v);
            if ((r32 & 1) == 0) *(unsigned*)(Ow + (size_t)orow * LDO + d0 * 32 + r32) = cvt_pk_bf16(v, vn); } }
    __syncthreads();
    return nc_;
#undef RESC
#undef KBASE
#undef BIAS
#undef MASKT
#undef SEAM_K0
#undef HALF_STEP
}
#undef AROW
#undef VMW
#undef VMWN
#undef SLOAD_H
#undef SWRITE_HK
#undef SWRITE_HV
#undef SWRITE_H
}

constexpr int NWAVES = 8, NTHREADS = NWAVES * 64, NPHASE = 17;
struct Args { const float* in[23]; float* out; unsigned char* ws; int ph_lo, ph_hi; };
struct Frame { LAS unsigned char* lds; int tid, lane, wave, G, vc, gw, NGW; };
typedef const __attribute__((address_space(4))) Args* KAP;

struct WJob { const float* src; void* dst; const float* gain; float sc; int K, N, mode, kb, nb, f8; };
__device__ __forceinline__ int wdrow(int n, int mode) { return mode == 0 ? n : ((n >> 7) * 256 + (mode == 2 ? 128 : 0) + (n & 127)); }
constexpr int I_QKV = 32 * 24, I_OA = 32 * 8, I_G = 32 * 22, I_DN = 88 * 8, I_KV = 32 * 16, I_QB = 32 * 8, I_OB = 32 * 8, I_E1 = 32 * 28, I_EG = 8 * I_E1, I_ED1 = 112 * 8, I_ED = 8 * I_ED1;
constexpr int W_NITEMS0 = I_QKV + I_OA + 2 * I_G + I_DN + I_KV + I_QB + I_OB;
constexpr int W_NEXP = 2 * I_EG + I_ED, W_NITEMS = W_NITEMS0 + W_NEXP;
__device__ __forceinline__ void wjob_decode(KAP ap, int item, WJob& j) {
    unsigned char* ws = ap->ws; int r = item; int nbn; j.f8 = 0; j.sc = 1.0f;
    if (r < I_QKV) { j.src = ap->in[2]; j.dst = (bf16_t*)(ws + WS_WQKV); j.gain = ap->in[1]; j.K = DM; j.N = NQKV; j.mode = 0; }
    else if ((r -= I_QKV) < I_OA) { j.src = ap->in[3]; j.dst = (bf16_t*)(ws + WS_WOA); j.gain = nullptr; j.K = DM; j.N = DM; j.mode = 0; }
    else if ((r -= I_OA) < I_G) { j.src = ap->in[15]; j.dst = (bf16_t*)(ws + WS_WGU); j.gain = ap->in[14]; j.K = DM; j.N = FF; j.mode = 1; }
    else if ((r -= I_G) < I_G) { j.src = ap->in[16]; j.dst = (bf16_t*)(ws + WS_WGU); j.gain = ap->in[14]; j.K = DM; j.N = FF; j.mode = 2; }
    else if ((r -= I_G) < I_DN) { j.src = ap->in[17]; j.dst = (bf16_t*)(ws + WS_WDN); j.gain = nullptr; j.K = FF; j.N = DM; j.mode = 0; }
    else if ((r -= I_DN) < I_KV) { j.src = ap->in[5]; j.dst = (bf16_t*)(ws + WS_WKVQ); j.gain = ap->in[4]; j.K = DM; j.N = 2 * DM; j.mode = 0; }
    else if ((r -= I_KV) < I_QB) { j.src = ap->in[7]; j.dst = (bf16_t*)(ws + WS_WKVQ) + (size_t)2 * DM * DM; j.gain = ap->in[6]; j.K = DM; j.N = DM; j.mode = 0; }
    else if ((r -= I_QB) < I_OB) { j.src = ap->in[13]; j.dst = (bf16_t*)(ws + WS_WOB); j.gain = nullptr; j.K = DM; j.N = DM; j.mode = 0; }
    else if ((r -= I_OB) < I_EG) { const int e = r / I_E1; r -= e * I_E1; j.src = ap->in[19] + (size_t)e * DM * FE; j.dst = ws + WS_WEGU + (size_t)e * 2 * FE * DM; j.gain = ap->in[14] + DM; j.K = DM; j.N = FE; j.mode = 1; j.f8 = 1; j.sc = WEGU_SC; }
    else if ((r -= I_EG) < I_EG) { const int e = r / I_E1; r -= e * I_E1; j.src = ap->in[20] + (size_t)e * DM * FE; j.dst = ws + WS_WEGU + (size_t)e * 2 * FE * DM; j.gain = ap->in[14] + DM; j.K = DM; j.N = FE; j.mode = 2; j.f8 = 1; j.sc = WEGU_SC; }
    else { r -= I_EG; const int e = r / I_ED1; r -= e * I_ED1; j.src = ap->in[21] + (size_t)e * FE * DM; j.dst = ws + WS_WEDN + (size_t)e * DM * FE; j.gain = nullptr; j.K = FE; j.N = DM; j.mode = 0; j.f8 = 1; j.sc = WEDN_SC; }
    nbn = j.N >> 8; j.kb = r / nbn; j.nb = r - j.kb * nbn;
}
__device__ __forceinline__ void p0_weights(KAP a, Frame& F, int first, const int end, const int stride) {
    LAS float* tile = (LAS float*)F.lds;
    const int w = F.wave, l = F.lane;
    float v[32];
    int item = first; bool have = item < end; WJob j;
#define W_LOAD() do { const float* sp = j.src + (size_t)(j.kb * 64 + w) * j.N + j.nb * 256 + l; \
        _Pragma("unroll") for (int i = 0; i < 8; ++i) _Pragma("unroll") for (int c = 0; c < 4; ++c) v[i * 4 + c] = __builtin_nontemporal_load(sp + (size_t)(8 * i) * j.N + 64 * c); } while (0)
    if (have) { wjob_decode(a, item, j); W_LOAD(); }
    while (have) {
        __syncthreads();
#pragma unroll
        for (int i = 0; i < 8; ++i) { const int k = w + 8 * i; const float g = (j.gain ? j.gain[j.kb * 64 + k] : 1.0f) * j.sc;
#pragma unroll
            for (int c = 0; c < 4; ++c) tile[k * 257 + l + 64 * c] = v[i * 4 + c] * g; }
        void* cdst = j.dst; const int cK = j.K, cmode = j.mode, ckb = j.kb, cnb = j.nb, cf8 = j.f8;
        item += stride; const bool have_next = item < end;
        if (have_next) { wjob_decode(a, item, j); W_LOAD(); }
        __syncthreads();
        if (cf8) {
            const int c4 = l >> 4, n16 = l & 15;
#pragma unroll
            for (int jj = 0; jj < 2; ++jj) { const int n = n16 + 16 * w + 128 * jj; const LAS float* s = tile + (16 * c4) * 257 + n;
                u32x4 o; o.x = pg8::pk4_fp8(s[0], s[257], s[2 * 257], s[3 * 257]); o.y = pg8::pk4_fp8(s[4 * 257], s[5 * 257], s[6 * 257], s[7 * 257]);
                o.z = pg8::pk4_fp8(s[8 * 257], s[9 * 257], s[10 * 257], s[11 * 257]); o.w = pg8::pk4_fp8(s[12 * 257], s[13 * 257], s[14 * 257], s[15 * 257]);
                *(u32x4*)((unsigned char*)cdst + (size_t)wdrow(cnb * 256 + n, cmode) * cK + ckb * 64 + 16 * c4) = o; }
        } else {
        const int c8 = l >> 3, nn = l & 7;
#pragma unroll
        for (int jj = 0; jj < 4; ++jj) { const int n = nn + 8 * w + 64 * jj; const LAS float* s = tile + (8 * c8) * 257 + n;
            u32x4 o; o.x = cvt_pk_bf16(s[0], s[257]); o.y = cvt_pk_bf16(s[2 * 257], s[3 * 257]); o.z = cvt_pk_bf16(s[4 * 257], s[5 * 257]); o.w = cvt_pk_bf16(s[6 * 257], s[7 * 257]);
            *(u32x4*)((bf16_t*)cdst + (size_t)wdrow(cnb * 256 + n, cmode) * cK + ckb * 64 + 8 * c8) = o; }
        }
        have = have_next;
    }
#undef W_LOAD
    __syncthreads();
}
#ifndef W_DEEP4
#define W_DEEP4 1
#endif
__device__ __forceinline__ void p0_weights2(KAP a, Frame& F, int first, const int end, const int stride) {
    const int w = F.wave, l = F.lane;
    float va[32], vb[32];
    WJob ja, jb;
#define W_LOAD2(J, V) do { const float* sp = (J).src + (size_t)((J).kb * 64 + w) * (J).N + (J).nb * 256 + l; \
        _Pragma("unroll") for (int i = 0; i < 8; ++i) _Pragma("unroll") for (int c = 0; c < 4; ++c) (V)[i * 4 + c] = __builtin_nontemporal_load(sp + (size_t)(8 * i) * (J).N + 64 * c); } while (0)
#define W_ITEM2(J, V, TILE, NEXT_ITEM) do { \
        LAS float* tile = (LAS float*)F.lds + (TILE) * (64 * 257); \
        _Pragma("unroll") for (int i = 0; i < 8; ++i) { const int k = w + 8 * i; const float g = ((J).gain ? (J).gain[(J).kb * 64 + k] : 1.0f) * (J).sc; \
            _Pragma("unroll") for (int c = 0; c < 4; ++c) tile[k * 257 + l + 64 * c] = (V)[i * 4 + c] * g; } \
        void* cdst = (J).dst; const int cK = (J).K, cmode = (J).mode, ckb = (J).kb, cnb = (J).nb, cf8 = (J).f8; \
        if ((NEXT_ITEM) < end) { wjob_decode(a, (NEXT_ITEM), (J)); W_LOAD2(J, V); } \
        __syncthreads(); \
        if (cf8) { const int c4 = l >> 4, n16 = l & 15; \
            _Pragma("unroll") for (int jj = 0; jj < 2; ++jj) { const int n = n16 + 16 * w + 128 * jj; const LAS float* s = tile + (16 * c4) * 257 + n; \
                u32x4 o; o.x = pg8::pk4_fp8(s[0], s[257], s[2 * 257], s[3 * 257]); o.y = pg8::pk4_fp8(s[4 * 257], s[5 * 257], s[6 * 257], s[7 * 257]); \
                o.z = pg8::pk4_fp8(s[8 * 257], s[9 * 257], s[10 * 257], s[11 * 257]); o.w = pg8::pk4_fp8(s[12 * 257], s[13 * 257], s[14 * 257], s[15 * 257]); \
                *(u32x4*)((unsigned char*)cdst + (size_t)wdrow(cnb * 256 + n, cmode) * cK + ckb * 64 + 16 * c4) = o; } \
        } else { const int c8 = l >> 3, nn = l & 7; \
            _Pragma("unroll") for (int jj = 0; jj < 4; ++jj) { const int n = nn + 8 * w + 64 * jj; const LAS float* s = tile + (8 * c8) * 257 + n; \
                u32x4 o; o.x = cvt_pk_bf16(s[0], s[257]); o.y = cvt_pk_bf16(s[2 * 257], s[3 * 257]); o.z = cvt_pk_bf16(s[4 * 257], s[5 * 257]); o.w = cvt_pk_bf16(s[6 * 257], s[7 * 257]); \
                *(u32x4*)((bf16_t*)cdst + (size_t)wdrow(cnb * 256 + n, cmode) * cK + ckb * 64 + 8 * c8) = o; } } \
    } while (0)
    int item = first;
    __syncthreads();
#if W_DEEP4
    float vc[32], vd[32]; WJob jc, jd;
    if (item < end) { wjob_decode(a, item, ja); W_LOAD2(ja, va); }
    if (item + stride < end) { wjob_decode(a, item + stride, jb); W_LOAD2(jb, vb); }
    if (item + 2 * stride < end) { wjob_decode(a, item + 2 * stride, jc); W_LOAD2(jc, vc); }
    if (item + 3 * stride < end) { wjob_decode(a, item + 3 * stride, jd); W_LOAD2(jd, vd); }
    for (; item < end; item += 4 * stride) {
        W_ITEM2(ja, va, 0, item + 4 * stride);
        if (item + stride < end) W_ITEM2(jb, vb, 1, item + 5 * stride);
        if (item + 2 * stride < end) W_ITEM2(jc, vc, 0, item + 6 * stride);
        if (item + 3 * stride < end) W_ITEM2(jd, vd, 1, item + 7 * stride);
    }
#else
    if (item < end) { wjob_decode(a, item, ja); W_LOAD2(ja, va); }
    if (item + stride < end) { wjob_decode(a, item + stride, jb); W_LOAD2(jb, vb); }
    for (; item < end; item += 2 * stride) {
        W_ITEM2(ja, va, 0, item + 2 * stride);
        if (item + stride < end) W_ITEM2(jb, vb, 1, item + 3 * stride);
    }
#endif
#undef W_LOAD2
#undef W_ITEM2
    __syncthreads();
}
__device__ __forceinline__ void p0_weights_r(KAP a, Frame& F, int first, const int end, const int wg, const int nwg) {
    const int t = F.tid & 255, half = __builtin_amdgcn_readfirstlane(F.tid >> 8), nq = t & 15, kq = (t >> 4) & 3, ng = t >> 6;
    const int n0 = ng * 64 + nq * 4, k0 = kq * 16, nworkers = 2 * nwg;
    f32x4 va[16], vb[16], ga[4], gb[4]; WJob ja, jb;
#define WR_LOAD(J, V, G) do { const char* ub = (const char*)((J).src + (size_t)(J).kb * 64 * (J).N + (J).nb * 256); const unsigned loff = (unsigned)(k0 * (J).N + n0) * 4u; \
        _Pragma("unroll") for (int i = 0; i < 16; ++i) (V)[i] = __builtin_nontemporal_load((const f32x4*)(ub + (size_t)i * (J).N * 4 + loff)); \
        _Pragma("unroll") for (int i = 0; i < 4; ++i) (G)[i] = (J).gain ? *(const f32x4*)((J).gain + (J).kb * 64 + k0 + 4 * i) : (f32x4){1.f, 1.f, 1.f, 1.f}; } while (0)
#define WR_ITEM(J, V, G, NEXT_ITEM) do { \
        _Pragma("unroll") for (int i = 0; i < 4; ++i) (G)[i] = (G)[i] * (J).sc; \
        unsigned char* cdst = (unsigned char*)(J).dst; const int cK = (J).K, cmode = (J).mode, ckb = (J).kb, cnb = (J).nb; \
        _Pragma("unroll") for (int j = 0; j < 4; ++j) { u32x4 o; \
            o.x = pg8::pk4_fp8((V)[0][j] * (G)[0][0], (V)[1][j] * (G)[0][1], (V)[2][j] * (G)[0][2], (V)[3][j] * (G)[0][3]); o.y = pg8::pk4_fp8((V)[4][j] * (G)[1][0], (V)[5][j] * (G)[1][1], (V)[6][j] * (G)[1][2], (V)[7][j] * (G)[1][3]); \
            o.z = pg8::pk4_fp8((V)[8][j] * (G)[2][0], (V)[9][j] * (G)[2][1], (V)[10][j] * (G)[2][2], (V)[11][j] * (G)[2][3]); o.w = pg8::pk4_fp8((V)[12][j] * (G)[3][0], (V)[13][j] * (G)[3][1], (V)[14][j] * (G)[3][2], (V)[15][j] * (G)[3][3]); \
            *(u32x4*)(cdst + (size_t)wdrow(cnb * 256 + n0 + j, cmode) * cK + ckb * 64 + k0) = o; } \
        if ((NEXT_ITEM) < end) { wjob_decode(a, (NEXT_ITEM), (J)); WR_LOAD(J, V, G); } \
    } while (0)
    int item = first + 2 * wg + half;
    if (item < end) { wjob_decode(a, item, ja); WR_LOAD(ja, va, ga); }
    if (item + nworkers < end) { wjob_decode(a, item + nworkers, jb); WR_LOAD(jb, vb, gb); }
    for (; item < end; item += 2 * nworkers) {
        WR_ITEM(ja, va, ga, item + 2 * nworkers);
        if (item + nworkers < end) WR_ITEM(jb, vb, gb, item + 3 * nworkers);
    }
#undef WR_LOAD
#undef WR_ITEM
}
struct WPool { int shn, per, Gh, ngrp, total; };
__device__ __forceinline__ int wpool_bef(const WPool& P, int g) { const int nb = (P.ngrp == 8) ? (P.per * g) / 7 : P.per; const int b = nb * P.Gh; return b < P.shn ? b : P.shn; }
__device__ __forceinline__ int wpool_item(const WPool& P, int p) {
    if (p < 0 || p >= P.total) return -1;
    for (int g = 0; g < P.ngrp; ++g) { const int bef = wpool_bef(P, g), rem = P.shn - bef; if (p < rem) return W_NITEMS0 + g * P.shn + bef + p; p -= rem; }
    return -1;
}
__device__ __forceinline__ void p0_weights_rp(KAP a, Frame& F, unsigned* ctr, const WPool& P) {
    if (P.total <= 0) return;
    const int t = F.lane, nq = t & 15, kq = t >> 4, k0 = kq * 16;
    f32x4 va[16], vb[16], ga[4], gb[4]; WJob ja, jb; int n0a = 0, n0b = 0;
#define WQ_PULL() ({ unsigned r_ = 0u; if (F.lane == 0) r_ = __hip_atomic_fetch_add(ctr, 1u, __ATOMIC_RELAXED, __HIP_MEMORY_SCOPE_AGENT); r_; })
#define WQ_LOAD(J, V, G, N0) do { const char* ub = (const char*)((J).src + (size_t)(J).kb * 64 * (J).N + (J).nb * 256); const unsigned loff = (unsigned)(k0 * (J).N + (N0)) * 4u; \
        _Pragma("unroll") for (int i = 0; i < 16; ++i) (V)[i] = __builtin_nontemporal_load((const f32x4*)(ub + (size_t)i * (J).N * 4 + loff)); \
        _Pragma("unroll") for (int i = 0; i < 4; ++i) (G)[i] = (J).gain ? *(const f32x4*)((J).gain + (J).kb * 64 + k0 + 4 * i) : (f32x4){1.f, 1.f, 1.f, 1.f}; } while (0)
#define WQ_ITEM(J, V, G, N0, QN, QEND) do { \
        _Pragma("unroll") for (int i = 0; i < 4; ++i) (G)[i] = (G)[i] * (J).sc; \
        unsigned char* cdst = (unsigned char*)(J).dst; const int cK = (J).K, cmode = (J).mode, ckb = (J).kb, cnb = (J).nb, cn0 = (N0); \
        _Pragma("unroll") for (int j = 0; j < 4; ++j) { u32x4 o; \
            o.x = pg8::pk4_fp8((V)[0][j] * (G)[0][0], (V)[1][j] * (G)[0][1], (V)[2][j] * (G)[0][2], (V)[3][j] * (G)[0][3]); o.y = pg8::pk4_fp8((V)[4][j] * (G)[1][0], (V)[5][j] * (G)[1][1], (V)[6][j] * (G)[1][2], (V)[7][j] * (G)[1][3]); \
            o.z = pg8::pk4_fp8((V)[8][j] * (G)[2][0], (V)[9][j] * (G)[2][1], (V)[10][j] * (G)[2][2], (V)[11][j] * (G)[2][3]); o.w = pg8::pk4_fp8((V)[12][j] * (G)[3][0], (V)[13][j] * (G)[3][1], (V)[14][j] * (G)[3][2], (V)[15][j] * (G)[3][3]); \
            *(u32x4*)(cdst + (size_t)wdrow(cnb * 256 + cn0 + j, cmode) * cK + ckb * 64 + k0) = o; } \
        if ((QN) < (QEND)) { wjob_decode(a, wpool_item(P, (QN) >> 2), (J)); (N0) = ((QN) & 3) * 64 + nq * 4; WQ_LOAD(J, V, G, N0); } \
    } while (0)
    constexpr int WQ_CH = 32; const int nq4 = 4 * P.total;
    int c = (int)__builtin_amdgcn_readfirstlane(WQ_PULL());
    while (c * WQ_CH < nq4) {
        const unsigned rn = WQ_PULL();
        const int q0 = c * WQ_CH, q1 = (q0 + WQ_CH < nq4) ? q0 + WQ_CH : nq4;
        { wjob_decode(a, wpool_item(P, q0 >> 2), ja); n0a = (q0 & 3) * 64 + nq * 4; WQ_LOAD(ja, va, ga, n0a); }
        if (q0 + 1 < q1) { wjob_decode(a, wpool_item(P, (q0 + 1) >> 2), jb); n0b = ((q0 + 1) & 3) * 64 + nq * 4; WQ_LOAD(jb, vb, gb, n0b); }
        for (int q = q0; q < q1; q += 2) {
            WQ_ITEM(ja, va, ga, n0a, q + 2, q1);
            if (q + 1 < q1) WQ_ITEM(jb, vb, gb, n0b, q + 3, q1);
        }
        c = (int)__builtin_amdgcn_readfirstlane(rn);
    }
#undef WQ_PULL
#undef WQ_LOAD
#undef WQ_ITEM
}
__device__ __forceinline__ void p0_x(const float* x, bf16_t* xb, u64* ss0, Frame& F) {
    for (int row = F.gw; row < MTOK; row += F.NGW) {
        const f32x4* xr = (const f32x4*)(x + (size_t)row * DM) + F.lane; f32x4 v[8]; float s = 0.f;
#pragma unroll
        for (int j = 0; j < 8; ++j) { v[j] = __builtin_nontemporal_load(xr + 64 * j); s += (v[j].x * v[j].x + v[j].y * v[j].y) + (v[j].z * v[j].z + v[j].w * v[j].w); }
        s = wave_sum(s);
        u32x2* o8 = (u32x2*)(xb + (size_t)row * DM) + F.lane;
#pragma unroll
        for (int j = 0; j < 8; ++j) { u32x2 w; w.x = cvt_pk_bf16(v[j].x, v[j].y); w.y = cvt_pk_bf16(v[j].z, v[j].w); o8[64 * j] = w; }
        if (F.lane == 0) ss0[row] = ss_fix(s);
    }
}
__device__ __forceinline__ void p2_kmean(const bf16_t* qkv, float* kmean, Frame& F, int u0, int nu) {
    const int c16 = F.lane & 15, rg = F.lane >> 4;
    for (int u = u0 + F.gw; u < u0 + nu; u += F.NGW) {
        const int bh = u >> 3, jb = u & 7, b = bh / HA, h = bh % HA;
        const bf16_t* kp = qkv + (size_t)(b * SEQ + jb * 256 + rg) * NQKV + DM + h * 128 + 8 * c16;
        float s[8] = {0.f, 0.f, 0.f, 0.f, 0.f, 0.f, 0.f, 0.f};
#pragma unroll 8
        for (int i = 0; i < 64; ++i) { const u32x4 q = *(const u32x4*)(kp + (size_t)(4 * i) * NQKV);
            s[0] += __uint_as_float(q.x << 16); s[1] += __uint_as_float(q.x & 0xffff0000u); s[2] += __uint_as_float(q.y << 16); s[3] += __uint_as_float(q.y & 0xffff0000u);
            s[4] += __uint_as_float(q.z << 16); s[5] += __uint_as_float(q.z & 0xffff0000u); s[6] += __uint_as_float(q.w << 16); s[7] += __uint_as_float(q.w & 0xffff0000u); }
#pragma unroll
        for (int e = 0; e < 8; ++e) s[e] = sum_xor32(sum_xor16(s[e]));
        if (rg == 0) { float* kd = kmean + (size_t)u * 128 + 8 * c16;
            *(f32x4*)kd = (f32x4){s[0], s[1], s[2], s[3]} * (1.0f / 256.0f); *(f32x4*)(kd + 4) = (f32x4){s[4], s[5], s[6], s[7]} * (1.0f / 256.0f); }
    }
}
__device__ __forceinline__ void p3_select(const bf16_t* qkv, const float* kmean, unsigned char* sel, Frame& F, int u0, int nu) {
    LAS float* km = (LAS float*)F.lds;
    for (int u = u0 + F.vc; u < u0 + nu; u += F.G) {
        const int bh = u >> 2, ch = u & 3, b = bh / HA, h = bh % HA;
        __syncthreads();
        km[F.tid] = kmean[(size_t)bh * 1024 + F.tid]; km[F.tid + 512] = kmean[(size_t)bh * 1024 + 512 + F.tid];
        __syncthreads();
        const int s = ch * 512 + F.tid, own = s >> 8;
        const bf16_t* qp = qkv + (size_t)(b * SEQ + s) * NQKV + h * 128;
        float gate[8] = {0.f, 0.f, 0.f, 0.f, 0.f, 0.f, 0.f, 0.f};
        if (own > 0) {
#pragma unroll 4
            for (int c = 0; c < 16; ++c) { const u32x4 q = *(const u32x4*)(qp + 8 * c);
                const float q0 = __uint_as_float(q.x << 16), q1 = __uint_as_float(q.x & 0xffff0000u), q2 = __uint_as_float(q.y << 16), q3 = __uint_as_float(q.y & 0xffff0000u);
                const float q4 = __uint_as_float(q.z << 16), q5 = __uint_as_float(q.z & 0xffff0000u), q6 = __uint_as_float(q.w << 16), q7 = __uint_as_float(q.w & 0xffff0000u);
#pragma unroll
                for (int jb = 0; jb < 8; ++jb) { const f32x4 k0 = *(const LAS f32x4*)(km + jb * 128 + 8 * c), k1 = *(const LAS f32x4*)(km + jb * 128 + 8 * c + 4);
                    gate[jb] += (q0 * k0.x + q1 * k0.y) + (q2 * k0.z + q3 * k0.w) + (q4 * k1.x + q5 * k1.y) + (q6 * k1.z + q7 * k1.w); } }
        }
        unsigned mask = 0u; const int nsel = own < 3 ? own : 3;
#pragma unroll
        for (int it = 0; it < 3; ++it) { if (it < nsel) { int best = -1; float bv = -__builtin_inff();
#pragma unroll
                for (int jb = 0; jb < 8; ++jb) { const bool ok = (jb < own) && (((mask >> jb) & 1u) == 0u) && (best < 0 || gate[jb] > bv); if (ok) { bv = gate[jb]; best = jb; } }
                if (best >= 0) mask |= 1u << best; } }
        sel[(size_t)bh * SEQ + s] = (unsigned char)mask;
    }
    __syncthreads();
}
template <bool MOBA> __device__ __forceinline__ void attn_phase(char* lds, const bf16_t* qkv, bf16_t* out, const unsigned char* sel, const unsigned* bnd, unsigned* qctr, int qb0, int nq, Frame& F) {
    constexpr int NPB = (MOBA ? HA : HB * 4) * 8;
    att::DynCtx C{qkv, out, sel, bnd, qctr, (volatile LAS int*)(F.lds + 70000), qb0 + (int)(xb_xcc_id() & (unsigned)(nq - 1)), qb0, nq};
    __syncthreads();
    if (F.tid == 0) *C.nw = att::attn_pull_from(qctr, C.q0, 0, NPB, qb0, nq);
    __syncthreads();
    int code = __builtin_amdgcn_readfirstlane(*C.nw); if (code < 0) return;
    att::BlockRef cur = att::attn_ref_blk<MOBA>(code, C); att::Seam S;
    att::attn_prime(cur, lds, S);
    for (;;) {
        code = att::attn_block<MOBA>(cur, C, lds, S);
        if (code < 0) break;
        cur = att::attn_ref_blk<MOBA>(code, C);
    }
}
__device__ __forceinline__ void p10_combine(KAP a, const bf16_t* omap, bf16_t* ao, Frame& F, int t0, int nt) {
    const int l = F.lane;
    float d1 = a->in[8][l] * a->in[9][l] + a->in[8][l + 64] * a->in[9][l + 64], d2 = a->in[10][l] * a->in[11][l] + a->in[10][l + 64] * a->in[11][l + 64];
    d1 = wave_sum(d1); d2 = wave_sum(d2);
    const float lam = __expf(d1) - __expf(d2) + LAM_INIT;
    const f32x4 g = *(const f32x4*)(a->in[12] + 4 * l);
    for (int tok = t0 + F.gw; tok < t0 + nt; tok += F.NGW) {
        const bf16_t* p1 = omap + (size_t)tok * DM + 4 * l; const bf16_t* p2 = p1 + (size_t)MTOK * DM; bf16_t* po = ao + (size_t)tok * DM + 4 * l;
        u32x2 x1v[HB], x2v[HB];
#pragma unroll
        for (int h = 0; h < HB; ++h) { x1v[h] = *(const u32x2*)(p1 + h * 256); x2v[h] = *(const u32x2*)(p2 + h * 256); }
#pragma unroll
        for (int h = 0; h < HB; ++h) { const u32x2 x1 = x1v[h], x2 = x2v[h];
            f32x4 d; d.x = __uint_as_float(x1.x << 16) - lam * __uint_as_float(x2.x << 16); d.y = __uint_as_float(x1.x & 0xffff0000u) - lam * __uint_as_float(x2.x & 0xffff0000u);
            d.z = __uint_as_float(x1.y << 16) - lam * __uint_as_float(x2.y << 16); d.w = __uint_as_float(x1.y & 0xffff0000u) - lam * __uint_as_float(x2.y & 0xffff0000u);
            float ss = wave_sum((d.x * d.x + d.y * d.y) + (d.z * d.z + d.w * d.w));
            const float r = __builtin_amdgcn_rsqf(ss * (1.0f / 256.0f) + RMS_EPS) * (1.0f - LAM_INIT);
            u32x2 w; w.x = cvt_pk_bf16(d.x * r * g.x, d.y * r * g.y); w.y = cvt_pk_bf16(d.z * r * g.z, d.w * r * g.w); *(u32x2*)(po + h * 256) = w; }
    }
}
__device__ __forceinline__ void p12_router(KAP a, const bf16_t* xb, const u64* ss3, unsigned* gcnt, int* tokinfo, unsigned char* xs, Frame& F, int c0, int nc) {
    LAS float* gwt = (LAS float*)F.lds;
    LAS unsigned* cnt = (LAS unsigned*)(F.lds + 65536); LAS unsigned* base = cnt + 8;
    const float* wr = a->in[18]; const float* g1 = a->in[14] + DM;
    __syncthreads();
    for (int idx = F.tid; idx < DM * NE; idx += NTHREADS) gwt[idx] = wr[idx] * g1[idx >> 3];
    if (F.tid < 8) cnt[F.tid] = 0u;
    __syncthreads();
    const int l = F.lane;
    for (int chunk = c0 + F.vc; chunk < c0 + nc; chunk += F.G) {
        int e0v = 0, e1v = 0, i0v = 0, i1v = 0; float g0v = 0.f, g1v = 0.f;
        float lgs[8][8];
#pragma unroll
        for (int i = 0; i < 8; ++i)
#pragma unroll
            for (int e = 0; e < 8; ++e) lgs[i][e] = 0.f;
        { const bf16_t* xp0 = xb + (size_t)(chunk * 64 + F.wave * 8) * DM + l;
#pragma unroll 4
          for (int j = 0; j < 32; ++j) { const LAS f32x4* wp = (const LAS f32x4*)(gwt + (l + 64 * j) * 8); const f32x4 w0 = wp[0], w1 = wp[1];
#pragma unroll
              for (int i = 0; i < 8; ++i) { const float xv = bf2f(xp0[(size_t)i * DM + 64 * j]);
                  lgs[i][0] += xv * w0.x; lgs[i][1] += xv * w0.y; lgs[i][2] += xv * w0.z; lgs[i][3] += xv * w0.w; lgs[i][4] += xv * w1.x; lgs[i][5] += xv * w1.y; lgs[i][6] += xv * w1.z; lgs[i][7] += xv * w1.w; } } }
#pragma unroll
        for (int i = 0; i < 8; ++i) {
            const int tok = chunk * 64 + F.wave * 8 + i;
            float lg[8];
            const float rs = rstd_q(ss3[tok]);
#pragma unroll
            for (int e = 0; e < 8; ++e) lg[e] = wave_sum(lgs[i][e]) * rs;
            int b0 = 0; float v0 = lg[0];
#pragma unroll
            for (int e = 1; e < 8; ++e) if (lg[e] > v0) { v0 = lg[e]; b0 = e; }
            int b1 = -1; float v1 = -__builtin_inff();
#pragma unroll
            for (int e = 0; e < 8; ++e) if (e != b0 && (b1 < 0 || lg[e] > v1)) { v1 = lg[e]; b1 = e; }
            const float ga = 1.0f / (1.0f + __expf(v1 - v0));
            unsigned i0 = 0u, i1 = 0u;
            if (l == 0) { i0 = __hip_atomic_fetch_add(&cnt[b0], 1u, __ATOMIC_RELAXED, __HIP_MEMORY_SCOPE_WORKGROUP); i1 = __hip_atomic_fetch_add(&cnt[b1], 1u, __ATOMIC_RELAXED, __HIP_MEMORY_SCOPE_WORKGROUP); }
            i0 = __builtin_amdgcn_readfirstlane(i0); i1 = __builtin_amdgcn_readfirstlane(i1);
            if (l == i) { e0v = b0; e1v = b1; i0v = (int)i0; i1v = (int)i1; g0v = ga; g1v = 1.0f - ga; }
        }
        __syncthreads();
        if (F.tid < 8) base[F.tid] = __hip_atomic_fetch_add(gcnt + 64 * F.tid, cnt[F.tid], __ATOMIC_RELAXED, __HIP_MEMORY_SCOPE_AGENT);
        __syncthreads();
        if (l < 8) { const int tok = chunk * 64 + F.wave * 8 + l; int* ti = tokinfo + (size_t)tok * 8;
            ti[0] = e0v; ti[1] = e1v; ti[2] = (int)base[e0v] + i0v; ti[3] = (int)base[e1v] + i1v; ti[4] = __float_as_int(g0v); ti[5] = __float_as_int(g1v); }
#pragma unroll
        for (int h = 0; h < 2; ++h) { u32x2 xv[4][8];
#pragma unroll
            for (int i = 0; i < 4; ++i) { const u32x2* sp = (const u32x2*)(xb + (size_t)(chunk * 64 + F.wave * 8 + 4 * h + i) * DM) + l;
#pragma unroll
                for (int j = 0; j < 8; ++j) xv[i][j] = sp[64 * j]; }
#pragma unroll
            for (int i = 0; i < 4; ++i) { const int ii = 4 * h + i, tok = chunk * 64 + F.wave * 8 + ii;
                const int e0 = __builtin_amdgcn_readlane(e0v, ii), e1 = __builtin_amdgcn_readlane(e1v, ii), q0 = __builtin_amdgcn_readlane(i0v, ii), q1 = __builtin_amdgcn_readlane(i1v, ii);
                const size_t row0 = (size_t)e0 * MTOK + base[e0] + q0, row1 = (size_t)e1 * MTOK + base[e1] + q1;
                const float rs = rstd_q(ss3[tok]) * XS_SC;
                unsigned* d0 = (unsigned*)(xs + row0 * DM) + l; unsigned* d1 = (unsigned*)(xs + row1 * DM) + l;
#pragma unroll
                for (int j = 0; j < 8; ++j) { const u32x2 b = xv[i][j];
                    const unsigned q = pg8::pk4_fp8(__uint_as_float(b.x << 16) * rs, __uint_as_float(b.x & 0xffff0000u) * rs, __uint_as_float(b.y << 16) * rs, __uint_as_float(b.y & 0xffff0000u) * rs); d0[64 * j] = q; d1[64 * j] = q; } } }
        __syncthreads();
        if (F.tid < 8) cnt[F.tid] = 0u;
        __syncthreads();
    }
}
__device__ __forceinline__ void p13_gather(const bf16_t* xb, const u64* ss3, unsigned* gcnt, int* tiles, int* tokinfo, unsigned char* xs, Frame& F) {
    LAS int* pst = (LAS int*)F.lds;
    __syncthreads();
    if (F.tid == 0) { int acc = 0;
        for (int e = 0; e < NE; ++e) { const int c = (int)__hip_atomic_load(gcnt + 64 * e, __ATOMIC_RELAXED, __HIP_MEMORY_SCOPE_AGENT); const int p = (c + 255) & ~255;
            pst[e] = acc; pst[8 + e] = c; pst[16 + e] = p;
            if (blockIdx.x == 0) for (int t = acc >> 8; t < (acc + p) >> 8; ++t) tiles[1 + t] = e;
            acc += p; }
        if (blockIdx.x == 0) tiles[0] = acc >> 8; }
    __syncthreads();
    const int l = F.lane;
    for (int tok = F.gw; tok < MTOK; tok += F.NGW) {
        int* ti = tokinfo + (size_t)tok * 8;
        const int row0 = pst[ti[0]] + ti[2], row1 = pst[ti[1]] + ti[3];
        if (l == 0) { ti[6] = row0; ti[7] = row1; }
        const float rs = rstd_q(ss3[tok]) * XS_SC;
        const u32x2* sp = (const u32x2*)(xb + (size_t)tok * DM) + l; unsigned* d0 = (unsigned*)(xs + (size_t)row0 * DM) + l; unsigned* d1 = (unsigned*)(xs + (size_t)row1 * DM) + l;
#pragma unroll
        for (int j = 0; j < 8; ++j) { const u32x2 b = sp[64 * j];
            const unsigned q = pg8::pk4_fp8(__uint_as_float(b.x << 16) * rs, __uint_as_float(b.x & 0xffff0000u) * rs, __uint_as_float(b.y << 16) * rs, __uint_as_float(b.y & 0xffff0000u) * rs); d0[64 * j] = q; d1[64 * j] = q; }
    }
    for (int e = 0; e < NE; ++e) { const int lo = pst[e] + pst[8 + e], hi = pst[e] + pst[16 + e];
        for (int r = lo + F.gw; r < hi; r += F.NGW) { u32x4* d = (u32x4*)(xs + (size_t)r * DM) + l; d[0] = (u32x4){0u, 0u, 0u, 0u}; d[64] = (u32x4){0u, 0u, 0u, 0u}; } }
    __syncthreads();
}
__device__ __forceinline__ void ys_row(const bf16_t* ys, const float* slab, int split0, size_t ks_stride, int row, int l, f32x4 (&a)[8]) {
    if (row >= split0) { const float* p = slab + (size_t)(row - split0) * DM + 4 * l;
#pragma unroll
        for (int j = 0; j < 8; ++j) { f32x4 t = *(const f32x4*)(p + 256 * j);
#pragma unroll
            for (int ks = 1; ks < TAIL_NS; ++ks) t = t + *(const f32x4*)(p + 256 * j + (size_t)ks * ks_stride);
            a[j] = t * (1.0f / (ACT_SC * WEDN_SC)); } }
    else { const u32x2* p = (const u32x2*)(ys + (size_t)row * DM) + l;
#pragma unroll
        for (int j = 0; j < 8; ++j) { const u32x2 q = p[64 * j]; a[j] = (f32x4){__uint_as_float(q.x << 16), __uint_as_float(q.x & 0xffff0000u), __uint_as_float(q.y << 16), __uint_as_float(q.y & 0xffff0000u)}; } }
}
constexpr int MOE_T_OFF = 131072;
__device__ __forceinline__ void moe_tables(const unsigned* gcnt, LAS int* T, Frame& F) {
    __syncthreads();
    if (F.tid == 0) { int acc = 0;
        for (int e = 0; e < NE; ++e) { const int c = (int)__hip_atomic_load(gcnt + 64 * e, __ATOMIC_RELAXED, __HIP_MEMORY_SCOPE_AGENT); const int p = (c + 255) & ~255;
            T[256 + e] = acc;
            for (int j = 0; j < (p >> 8); ++j) T[1 + (acc >> 8) + j] = e + 16 * (e * (MTOK / 256) + j);
            acc += p; }
        T[0] = acc >> 8; }
    __syncthreads();
}
__device__ __forceinline__ void p16_final(const bf16_t* xb, const bf16_t* ys, const float* slab, const int* tiles, const int* tokinfo, const float* fg, float* out, Frame& F) {
    const int l = F.lane; const int nT = tiles[0]; int rt = nT & 31; if (rt > 7) rt = 0; const int split0 = (nT - rt) * 256; const size_t ks_stride = (size_t)rt * 256 * DM;
    for (int tok = F.gw; tok < MTOK; tok += F.NGW) {
        const int* ti = tokinfo + (size_t)tok * 8; const float g0 = __int_as_float(ti[4]), g1 = __int_as_float(ti[5]); const int row0 = tiles[256 + ti[0]] + ti[2], row1 = tiles[256 + ti[1]] + ti[3];
        const u32x2* xp = (const u32x2*)(xb + (size_t)tok * DM) + l;
        f32x4 v[8], a0[8], a1[8]; float s = 0.f;
#pragma unroll
        for (int j = 0; j < 8; ++j) { const u32x2 q = xp[64 * j]; v[j] = (f32x4){__uint_as_float(q.x << 16), __uint_as_float(q.x & 0xffff0000u), __uint_as_float(q.y << 16), __uint_as_float(q.y & 0xffff0000u)}; }
        ys_row(ys, slab, split0, ks_stride, row0, l, a0); ys_row(ys, slab, split0, ks_stride, row1, l, a1);
#pragma unroll
        for (int j = 0; j < 8; ++j) { v[j] = v[j] + g0 * a0[j] + g1 * a1[j]; s += (v[j].x * v[j].x + v[j].y * v[j].y) + (v[j].z * v[j].z + v[j].w * v[j].w); }
        const float r = rstd_of(wave_sum(s));
        f32x4* op = (f32x4*)(out + (size_t)tok * DM) + l; const f32x4* gp = (const f32x4*)fg + l;
#pragma unroll
        for (int j = 0; j < 8; ++j) op[64 * j] = v[j] * r * gp[64 * j];
    }
}

#ifndef PH_MASK
#define PH_MASK 0x1ffff
#endif
__global__ void __launch_bounds__(NTHREADS, 2) mega_fwd(Args args_by_value) {
    extern __shared__ __attribute__((aligned(16))) unsigned char lds[];
    (void)args_by_value;
    const KAP kap0 = (KAP)__builtin_amdgcn_kernarg_segment_ptr();
#define KARGS() ({ KAP p_ = kap0; asm volatile("" : "+s"(p_)); p_; })
    Frame F0;
#define F F0
    F.lds = (LAS unsigned char*)lds;
    F.tid = threadIdx.x; F.lane = F.tid & 63; F.wave = __builtin_amdgcn_readfirstlane(F.tid >> 6);
    F.G = gridDim.x; { const int bx = blockIdx.x; F.vc = (F.G % 8 == 0) ? (bx % 8) * (F.G / 8) + bx / 8 : bx; }
    F.gw = F.vc * NWAVES + F.wave; F.NGW = F.G * NWAVES;
    volatile LAS unsigned* MISC = (volatile LAS unsigned*)(F.lds + LDSCTL_OFF);
    for (int u = F.tid; u < (LDS_BYTES - LDSCTL_OFF) / 4; u += NTHREADS) ((LAS unsigned*)(F.lds + LDSCTL_OFF))[u] = 0u;
    __syncthreads();
    const int lo = kap0->ph_lo, hi = kap0->ph_hi;
    const bool use_bar = (hi - lo) > 1;
    XcdBarrier bar; bar.bar = (unsigned*)(kap0->ws + CTL_BAR); bar.x = 0; bar.st = MISC + 8;
    if (use_bar) bar = xcd_barrier_post((unsigned*)(kap0->ws + CTL_BAR), MISC + 8, (unsigned)F.G);
#ifndef DUP_MASK
#define DUP_MASK 0
#endif
#ifndef PROBE_SKIP_EPI
#define PROBE_SKIP_EPI 0
#endif
#ifndef PROBE_KIND
#define PROBE_KIND 4
#endif
#ifndef PROBE_PH
#define PROBE_PH 6
#endif
#ifndef PROBE_AMP
#define PROBE_AMP 4
#endif
#ifndef PROBE_PHM
#define PROBE_PHM (1 << PROBE_PH)
#endif
#define PROBE_SEL(k) ((PROBE_KIND == 2 || PROBE_KIND == 3) ? ((PROBE_PHM >> (k)) & 1) : ((k) == PROBE_PH))
#if PROBE_KIND
#define PROBE_ME (blockIdx.x == 0 && F0.tid == 0)
#define PROBE_B(k) do { if (PROBE_SEL(k) && PROBE_ME) { const unsigned long long r_ = __builtin_amdgcn_s_memrealtime(), t_ = __builtin_amdgcn_s_memtime(); MISC[16] = (unsigned)r_; MISC[17] = (unsigned)(r_ >> 32); MISC[18] = (unsigned)t_; MISC[19] = (unsigned)(t_ >> 32); } } while (0)
#define PROBE_E(k) do { if (PROBE_SEL(k) && PROBE_ME) { const unsigned long long r_ = __builtin_amdgcn_s_memrealtime(), t_ = __builtin_amdgcn_s_memtime(); \
        const unsigned long long r0_ = ((unsigned long long)MISC[17] << 32) | MISC[16], t0_ = ((unsigned long long)MISC[19] << 32) | MISC[18]; const unsigned long long dr_ = r_ - r0_, dt_ = t_ - t0_; \
        if (PROBE_KIND == 1) MISC[20] = (unsigned)((dt_ * 10000ull) / (dr_ ? dr_ : 1ull));   \
        if (PROBE_KIND == 2) MISC[20] = MISC[20] + (unsigned)(dr_ * PROBE_AMP); \
        if (PROBE_KIND == 3) { MISC[16] = (unsigned)r_; MISC[17] = (unsigned)(r_ >> 32); } } } while (0)
#define PROBE_S(k) do { if (PROBE_KIND == 3 && PROBE_SEL(k) && PROBE_ME) { const unsigned long long r_ = __builtin_amdgcn_s_memrealtime(); const unsigned long long r0_ = ((unsigned long long)MISC[17] << 32) | MISC[16]; MISC[20] = MISC[20] + (unsigned)((r_ - r0_) * PROBE_AMP); } } while (0)
#define PROBE_FIN() do { if (PROBE_ME) { const unsigned long long r0_ = __builtin_amdgcn_s_memrealtime(); const unsigned long long d_ = MISC[20]; while (__builtin_amdgcn_s_memrealtime() - r0_ < d_) __builtin_amdgcn_s_sleep(8); } } while (0)
#else
#define PROBE_B(k) do { } while (0)
#define PROBE_E(k) do { } while (0)
#define PROBE_S(k) do { } while (0)
#define PROBE_FIN() do { } while (0)
#endif
#define PRB(k) (((PROBE_KIND == 4 || PROBE_KIND == 5) && (k) == PROBE_PH) ? MISC : (volatile LAS unsigned*)nullptr)
#define IN(k) (((PH_MASK >> (k)) & 1) && lo <= (k) && (k) < hi)
#define REP(k) for (int rep_ = 0; rep_ < (((DUP_MASK >> (k)) & 1) ? 2 : 1); ++rep_)
#define SEAM(k) do { if (IN(k) && IN((k) + 1)) { if ((k) >= 1 && (k) <= 10) xcd_barrier(barh); else xcd_barrier(bar); } } while (0)
#define WSP(T, off) ((T*)(ws + (off)))
#define FRL() ({ Frame f_ = F0; asm volatile("" : "+v"(f_.tid), "+v"(f_.lane)); f_; })
#undef F
    const int bx = blockIdx.x;
    const int ngrp = (F0.G % 8 == 0) ? 8 : 1, hb = (ngrp == 8) ? (bx & 7) : 0, nxh = 8 / ngrp, Gh = F0.G / ngrp;
    const int hidx = (ngrp == 8) ? (bx >> 3) : bx;
    const int Mh = MTOK / ngrp, R0 = hb * Mh, nMh = Mh / 256, pm0 = hb * nMh;
    Frame FH0 = F0; FH0.G = Gh; FH0.vc = (Gh % nxh == 0) ? (hidx % nxh) * (Gh / nxh) + hidx / nxh : hidx; FH0.gw = FH0.vc * NWAVES + F0.wave; FH0.NGW = Gh * NWAVES;
#define FRH() ({ Frame f_ = FH0; asm volatile("" : "+v"(f_.tid), "+v"(f_.lane)); f_; })
    const int shn = W_NEXP / ngrp, sh0 = W_NITEMS0 + hb * shn;
    const int per = (shn + Gh - 1) / Gh, nbef = (ngrp == 8) ? (per * hb) / 7 : per;
    XcdBarrier barh = bar;
    if (use_bar) barh = xcd_barrier_post((unsigned*)(kap0->ws + CTL_BARH + (size_t)hb * CTL_BARH_STRIDE), MISC + 10, (unsigned)Gh);

    PROBE_B(0); if (IN(0)) REP(0) { KAP ap = KARGS(); Frame F = FRL(); unsigned char* ws = ap->ws; p0_weights(ap, F, F.vc, W_NITEMS0, F.G); p0_x(ap->in[0], WSP(bf16_t, WS_XB), WSP(u64, CTL_SS), F); }
    PROBE_E(0); SEAM(0); PROBE_S(0);
    if (IN(0)) { KAP ap = KARGS(); Frame F = FRH(); const int e_ = sh0 + nbef * Gh < sh0 + shn ? sh0 + nbef * Gh : sh0 + shn; p0_weights_r(ap, F, sh0, e_, hidx, Gh); }
    PROBE_B(1); if (IN(1)) REP(1) {
        KAP ap = KARGS(); Frame F = FRH(); unsigned char* ws = ap->ws;
        pg8::Order S; S.init(nMh, NQKV / 256, 2 * DM, F.G, hidx, ws + WS_XB + (size_t)R0 * DM * 2, ws + WS_WQKV, 0, nullptr, nxh);
        pg8::EpiBf16Out<true, true> E{WSP(bf16_t, WS_QKV) + (size_t)R0 * NQKV, NQKV, WSP(u64, CTL_SS) + R0, 1.f, WSP(unsigned, CTL_BND1), pm0};
        pg8::gemm_phase<pg8::EpiBf16Out<true, true>, GEMM_ALIGN, GEMM_SP2>(F.lds, 2 * DM, S, E, 0, PRB(1));
    }
    PROBE_E(1); SEAM(1); PROBE_S(1);
    PROBE_B(2); if (IN(2)) REP(2) { KAP ap = KARGS(); Frame F = FRH(); unsigned char* ws = ap->ws; p2_kmean(WSP(bf16_t, WS_QKV), WSP(float, WS_KMEAN), F, hb * nxh * HA * 8, nxh * HA * 8); }
    PROBE_E(2); SEAM(2); PROBE_S(2);
    PROBE_B(3); if (IN(3)) REP(3) { KAP ap = KARGS(); Frame F = FRH(); unsigned char* ws = ap->ws; p3_select(WSP(bf16_t, WS_QKV), WSP(float, WS_KMEAN), WSP(unsigned char, WS_SEL), F, hb * nxh * HA * 4, nxh * HA * 4); }
    PROBE_E(3); SEAM(3); PROBE_S(3);
    PROBE_B(4); if (IN(4)) REP(4) { KAP ap = KARGS(); Frame F = FRH(); unsigned char* ws = ap->ws; attn_phase<true>((char*)lds, WSP(bf16_t, WS_QKV), WSP(bf16_t, WS_AO), WSP(unsigned char, WS_SEL), WSP(unsigned, CTL_BND1), WSP(unsigned, CTL_AQ), hb * nxh, nxh, F); }
    PROBE_E(4); SEAM(4); PROBE_S(4);
    PROBE_B(5); if (IN(5)) REP(5) {
        KAP ap = KARGS(); Frame F = FRH(); unsigned char* ws = ap->ws;
        pg8::Order S; S.init(nMh, DM / 256, 2 * DM, F.G, hidx, ws + WS_AO + (size_t)R0 * DM * 2, ws + WS_WOA, 0, nullptr, nxh);
        pg8::EpiResid<true, false> E{WSP(bf16_t, WS_XB) + (size_t)R0 * DM, nullptr, WSP(bf16_t, WS_XB) + (size_t)R0 * DM, WSP(u64, CTL_SS) + MTOK + R0};
        pg8::gemm_phase<pg8::EpiResid<true, false>, GEMM_ALIGN, GEMM_SP2>(F.lds, 2 * DM, S, E);
    }
    PROBE_E(5); SEAM(5); PROBE_S(5);
    PROBE_B(6); if (IN(6)) REP(6) {
        KAP ap = KARGS(); Frame F = FRH(); unsigned char* ws = ap->ws;
        pg8::Order S; S.init(nMh, 2 * FF / 256, 2 * DM, F.G, hidx, ws + WS_XB + (size_t)R0 * DM * 2, ws + WS_WGU, 0, nullptr, nxh);
        pg8::EpiSwiGLU<false> E{WSP(bf16_t, WS_ACT) + (size_t)R0 * FF, FF, WSP(u64, CTL_SS) + MTOK + R0};
        pg8::gemm_phase<pg8::EpiSwiGLU<false>, GEMM_ALIGN, GEMM_SP2>(F.lds, 2 * DM, S, E, 0, PRB(6));
    }
    PROBE_E(6); SEAM(6); PROBE_S(6);
    PROBE_B(7); if (IN(7)) REP(7) {
        KAP ap = KARGS(); Frame F = FRH(); unsigned char* ws = ap->ws;
        pg8::Order S; S.init(nMh, DM / 256, 2 * FF, F.G, hidx, ws + WS_ACT + (size_t)R0 * FF * 2, ws + WS_WDN, 0, nullptr, nxh);
        pg8::EpiResid<true, false> E{WSP(bf16_t, WS_XB) + (size_t)R0 * DM, nullptr, WSP(bf16_t, WS_XB) + (size_t)R0 * DM, WSP(u64, CTL_SS) + 2 * MTOK + R0};
        pg8::gemm_phase<pg8::EpiResid<true, false>, GEMM_ALIGN, GEMM_SP2>(F.lds, 2 * FF, S, E);
    }
    PROBE_E(7); SEAM(7); PROBE_S(7);
    PROBE_B(8); if (IN(8)) REP(8) {
        KAP ap = KARGS(); Frame F = FRH(); unsigned char* ws = ap->ws;
        pg8::Order S; S.init(nMh, NQKV / 256, 2 * DM, F.G, hidx, ws + WS_XB + (size_t)R0 * DM * 2, ws + WS_WKVQ, 0, nullptr, nxh);
        pg8::EpiBf16Out<true, true> E{WSP(bf16_t, WS_QKV) + (size_t)R0 * NQKV, NQKV, WSP(u64, CTL_SS) + 2 * MTOK + R0, 1.f, WSP(unsigned, CTL_BND2), pm0};
        pg8::gemm_phase<pg8::EpiBf16Out<true, true>, GEMM_ALIGN, GEMM_SP2>(F.lds, 2 * DM, S, E, 0, PRB(1));
    }
    PROBE_E(8); SEAM(8); PROBE_S(8);
    PROBE_B(9); if (IN(9)) REP(9) { KAP ap = KARGS(); Frame F = FRH(); unsigned char* ws = ap->ws; attn_phase<false>((char*)lds, WSP(bf16_t, WS_QKV), WSP(bf16_t, WS_XR), nullptr, WSP(unsigned, CTL_BND2), WSP(unsigned, CTL_AQ) + 8 * 64, hb * nxh, nxh, F); }
    PROBE_E(9); SEAM(9); PROBE_S(9);
    PROBE_B(10); if (IN(10)) REP(10) { KAP ap = KARGS(); Frame F = FRH(); unsigned char* ws = ap->ws; p10_combine(ap, WSP(bf16_t, WS_XR), WSP(bf16_t, WS_AO), F, R0, Mh); }
    PROBE_E(10); SEAM(10); PROBE_S(10);
    PROBE_B(11); if (IN(11)) REP(11) {
        KAP ap = KARGS(); Frame F = FRH(); unsigned char* ws = ap->ws;
        pg8::Order S; S.init(nMh, DM / 256, 2 * DM, F.G, hidx, ws + WS_AO + (size_t)R0 * DM * 2, ws + WS_WOB, 0, nullptr, nxh);
        pg8::EpiResid<true, false> E{WSP(bf16_t, WS_XB) + (size_t)R0 * DM, nullptr, WSP(bf16_t, WS_XB) + (size_t)R0 * DM, WSP(u64, CTL_SS) + 3 * MTOK + R0};
        pg8::gemm_phase<pg8::EpiResid<true, false>, GEMM_ALIGN, GEMM_SP2>(F.lds, 2 * DM, S, E);
    }
    PROBE_E(11); if (IN(11) && IN(12)) xcd_barrier(barh); PROBE_S(11);
    PROBE_B(12); if (IN(12)) REP(12) { KAP ap = KARGS(); Frame F = FRH(); unsigned char* ws = ap->ws; p12_router(ap, WSP(bf16_t, WS_XB), WSP(u64, CTL_SS) + 3 * MTOK, WSP(unsigned, CTL_CNT), WSP(int, CTL_TOKINFO), WSP(unsigned char, WS_XSC), F, hb * (Mh / 64), Mh / 64); }
    if (IN(12)) { KAP ap = KARGS(); Frame F = FRH(); unsigned char* ws = ap->ws; WPool WP{shn, per, Gh, ngrp, 0}; for (int g = 0; g < ngrp; ++g) WP.total += shn - wpool_bef(WP, g);
        p0_weights_rp(ap, F, WSP(unsigned, CTL_CNT + 2048), WP); }
    PROBE_E(12); SEAM(12); PROBE_S(12);
    PROBE_B(14); if (IN(14)) REP(14) {
        KAP ap = KARGS(); Frame F = FRL(); unsigned char* ws = ap->ws;
        moe_tables(WSP(unsigned, CTL_CNT), (LAS int*)(F.lds + MOE_T_OFF), F);
        const int* tiles = (const int*)(LAS int*)(F.lds + MOE_T_OFF); const int nT = tiles[0];
        pg8::Order S; S.init(nT, 2 * FE / 256, DM, F.G, bx, ws + WS_XSC, ws + WS_WEGU, (size_t)2 * FE * DM, tiles + 1, pg8::NXCD, 1);
        pg8::EpiSwiGLU8 E{WSP(unsigned char, WS_ACTE), FE, 1.0f / (XS_SC * WEGU_SC), ACT_SC, (PROBE_SKIP_EPI && rep_ == 1) ? 1 : 0};
        pg8::gemm_phase<pg8::EpiSwiGLU8, GEMM_ALIGN, false, true>(F.lds, DM, S, E, 0, PRB(14));
    }
    PROBE_E(14); SEAM(14); PROBE_S(14);
    PROBE_B(15); if (IN(15)) REP(15) {
        KAP ap = KARGS(); Frame F = FRL(); unsigned char* ws = ap->ws;
        moe_tables(WSP(unsigned, CTL_CNT), (LAS int*)(F.lds + MOE_T_OFF), F);
        const int* tiles = (const int*)(LAS int*)(F.lds + MOE_T_OFF); const int nT = tiles[0];
        int rt = nT & 31; if (rt > 7) rt = 0;
        pg8::Order S; S.init(nT - rt, DM / 256, FE, F.G, bx, ws + WS_ACTE, ws + WS_WEDN, (size_t)DM * FE, tiles + 1);
        pg8::EpiBf16Out<false> E{WSP(bf16_t, WS_YS), DM, nullptr, 1.0f / (ACT_SC * WEDN_SC), nullptr, 0};
        pg8::gemm_phase<pg8::EpiBf16Out<false>, GEMM_ALIGN, false, true>(F.lds, FE, S, E);
        if (rt) { pg8::TailOrder S2{rt * 8 * TAIL_NS, F.G, bx, nT - rt, TAIL_NS, (const char*)(ws + WS_ACTE), (const char*)(ws + WS_WEDN), (size_t)256 * FE, (size_t)DM * FE, (size_t)(FE / TAIL_NS), tiles + 1};
            pg8::EpiPart E2{WSP(float, WS_SLAB), (nT - rt) * 256, (size_t)rt * 256 * DM};
            pg8::gemm_phase<pg8::EpiPart, GEMM_ALIGN, false, true, pg8::TailOrder>(F.lds, FE, S2, E2, FE / TAIL_NS / 128); }
    }
    PROBE_E(15); SEAM(15); PROBE_S(15);
    PROBE_B(16); if (IN(16)) REP(16) { KAP ap = KARGS(); Frame F = FRL(); unsigned char* ws = ap->ws; moe_tables(WSP(unsigned, CTL_CNT), (LAS int*)(F.lds + MOE_T_OFF), F);
        p16_final(WSP(bf16_t, WS_XB), WSP(bf16_t, WS_YS), WSP(float, WS_SLAB), (const int*)(LAS int*)(F.lds + MOE_T_OFF), WSP(int, CTL_TOKINFO), ap->in[22], ap->out, F); }
PROBE_E(16); PROBE_FIN();
#undef IN
#undef REP
#undef SEAM
#undef WSP
#undef FRL
#undef FRH
#undef KARGS
}

#ifndef MK_ONE_LAUNCH
#define MK_ONE_LAUNCH 1
#endif
extern "C" void kernel_launch(void* const* d_in, const int* in_sizes, int n_in, void* d_out, int out_size, void* d_ws, size_t ws_size, hipStream_t stream) {
    static int grid = 0;
    if (grid == 0) {
        if (n_in != 23 || out_size != MTOK * DM || ws_size < WS_END) { fprintf(stderr, "kernel_launch: unexpected shapes (n_in %d, out %d, ws %zu)\n", n_in, out_size, ws_size); grid = -1; return; }
        int dev = 0, cus = 0, per_cu = 0;
        if (hipGetDevice(&dev) != hipSuccess || hipDeviceGetAttribute(&cus, hipDeviceAttributeMultiprocessorCount, dev) != hipSuccess) { grid = -1; return; }
        if (hipFuncSetAttribute((const void*)mega_fwd, hipFuncAttributeMaxDynamicSharedMemorySize, LDS_BYTES) != hipSuccess) { fprintf(stderr, "kernel_launch: hipFuncSetAttribute failed\n"); grid = -1; return; }
        if (hipOccupancyMaxActiveBlocksPerMultiprocessor(&per_cu, (const void*)mega_fwd, NTHREADS, LDS_BYTES) != hipSuccess || per_cu < 1) { fprintf(stderr, "kernel_launch: occupancy query reports %d\n", per_cu); (void)hipGetLastError(); per_cu = 1; }
        grid = cus;
    }
    if (grid < 0) return;
    if (hipMemsetAsync((char*)d_ws + WS_CTL, 0, CTL_ZERO_BYTES, stream) != hipSuccess) return;
    Args a{};
    for (int i = 0; i < 23; ++i) a.in[i] = (const float*)d_in[i];
    a.out = (float*)d_out; a.ws = (unsigned char*)d_ws;
#if MK_ONE_LAUNCH
    a.ph_lo = 0; a.ph_hi = NPHASE;
    hipLaunchKernelGGL(mega_fwd, dim3(grid), dim3(NTHREADS), LDS_BYTES, stream, a);
#else
    for (int p = 0; p < NPHASE; ++p) { a.ph_lo = p; a.ph_hi = p + 1; hipLaunchKernelGGL(mega_fwd, dim3(grid), dim3(NTHREADS), LDS_BYTES, stream, a); }
#endif
}
```

```cpp
#include <hip/hip_runtime.h>
#include <cstdio>
#include <cstdint>

#define GAS __attribute__((address_space(1)))
#define LAS __attribute__((address_space(3)))
#ifndef PROBE_KIND
#define PROBE_KIND 0
#endif
typedef unsigned short bf16_t;
typedef short bf16x8 __attribute__((ext_vector_type(8)));
typedef short s16x4 __attribute__((ext_vector_type(4)));
typedef float f32x2 __attribute__((ext_vector_type(2)));
typedef float f32x4 __attribute__((ext_vector_type(4)));
typedef float f32x16 __attribute__((ext_vector_type(16)));
typedef unsigned u32x2 __attribute__((ext_vector_type(2)));
typedef unsigned u32x4 __attribute__((ext_vector_type(4)));

constexpr int NB = 8, SEQ = 2048, DM = 2048, MTOK = NB * SEQ;
constexpr int NQKV = 3 * DM, FF = 5632, FE = 7168, NE = 8;
constexpr int HA = 16, HB = 8;
constexpr float RMS_EPS = 1e-6f;
constexpr float LAM_INIT = 0.35550906759096996f;
constexpr int MAXTILES = 136;
constexpr int MOE_ROWS = 135 * 256;

constexpr size_t MiB = 1u << 20;
constexpr size_t WS_CTL = 0, CTL_ZERO_BYTES = 960 * 1024;
constexpr size_t CTL_BAR = 4096;
constexpr size_t CTL_BARH = 832 * 1024, CTL_BARH_STRIDE = 16384;
constexpr size_t CTL_SS = 64 * 1024;
constexpr size_t CTL_AQ = 580 * 1024;
constexpr size_t CTL_CNT = 576 * 1024;
constexpr size_t CTL_BND1 = 640 * 1024, CTL_BND2 = 704 * 1024;
constexpr size_t CTL_TILES = 768 * 1024;
constexpr size_t CTL_TOKINFO = 1 * MiB;
constexpr size_t WS_WQKV = 2 * MiB, WS_WOA = 26 * MiB, WS_WGU = 34 * MiB, WS_WDN = 78 * MiB, WS_WKVQ = 100 * MiB, WS_WOB = 124 * MiB;
constexpr size_t WS_XB = 132 * MiB, WS_XR = 196 * MiB, WS_WEGU = 324 * MiB, WS_WEDN = 548 * MiB, WS_BIG = 660 * MiB;
constexpr size_t WS_QKV = WS_BIG, WS_AO = WS_BIG + 192 * MiB, WS_ACT = WS_BIG + 256 * MiB, WS_KMEAN = WS_BIG + 432 * MiB, WS_SEL = WS_BIG + 433 * MiB;
constexpr size_t WS_ACTE = WS_BIG, WS_XS = WS_BIG + 237 * MiB, WS_YS = WS_BIG + 305 * MiB, WS_SLAB = WS_BIG + 440 * MiB, WS_XSC = WS_BIG + 500 * MiB, WS_END = WS_XSC + 256 * MiB;
static_assert(WS_END <= 1792 * MiB, "workspace map");
static_assert((size_t)MOE_ROWS * FE <= 237 * MiB && (size_t)MOE_ROWS * DM <= 68 * MiB && (size_t)MOE_ROWS * DM * 2 <= 135 * MiB && WS_SEL + MiB <= WS_END, "moe buffers");
constexpr float XS_SC = 16.f, WEGU_SC = 256.f, ACT_SC = 8.f, WEDN_SC = 512.f;
constexpr int TAIL_NS = 4, TAIL_MAXROWS = 31 * 256;
static_assert((size_t)TAIL_NS * 7 * 256 * DM * 4 <= 60 * MiB, "slab (nT in [128, 135] -> at most 7 tail row tiles)");

constexpr int RING_BYTES = 131072, LDS_BYTES = 147456, LDSCTL_OFF = LDS_BYTES - 512;

#define LDS_WAIT() asm volatile("s_waitcnt lgkmcnt(0)" ::: "memory")
#define VM_WAIT() asm volatile("s_waitcnt vmcnt(0)" ::: "memory")
__device__ __forceinline__ unsigned cvt_pk_bf16(float lo, float hi) { unsigned r; asm volatile("v_cvt_pk_bf16_f32 %0, %1, %2" : "=v"(r) : "v"(lo), "v"(hi)); return r; }
__device__ __forceinline__ float bf2f(unsigned short b) { return __uint_as_float(((unsigned)b) << 16); }
template <int CTRL> __device__ __forceinline__ float dppx(float v) { return __builtin_bit_cast(float, __builtin_amdgcn_update_dpp(0, __builtin_bit_cast(int, v), CTRL, 0xf, 0xf, true)); }
__device__ __forceinline__ float xor1_get(float v) { return dppx<0xB1>(v); }
__device__ __forceinline__ float sum_xor16(float v) { auto r = __builtin_amdgcn_permlane16_swap(__float_as_uint(v), __float_as_uint(v), false, false); return __uint_as_float(r[0]) + __uint_as_float(r[1]); }
__device__ __forceinline__ float sum_xor32(float v) { auto r = __builtin_amdgcn_permlane32_swap(__float_as_uint(v), __float_as_uint(v), false, false); return __uint_as_float(r[0]) + __uint_as_float(r[1]); }
__device__ __forceinline__ float row_sum16(float v) { v += dppx<0xB1>(v); v += dppx<0x4E>(v); v += dppx<0x141>(v); v += dppx<0x140>(v); return v; }
__device__ __forceinline__ float row_max16(float v) { v = __builtin_fmaxf(v, dppx<0xB1>(v)); v = __builtin_fmaxf(v, dppx<0x4E>(v)); v = __builtin_fmaxf(v, dppx<0x141>(v)); v = __builtin_fmaxf(v, dppx<0x140>(v)); return v; }
__device__ __forceinline__ float wave_sum(float v) { return sum_xor32(sum_xor16(row_sum16(v))); }
typedef unsigned long long u64;
__device__ __forceinline__ float rstd_of(float ss) { return __builtin_amdgcn_rsqf(ss * (1.0f / (float)DM) + RMS_EPS); }
__device__ __forceinline__ u64 ss_fix(float s) { return (u64)(s * 16777216.0f); }
__device__ __forceinline__ float rstd_q(u64 q) { return rstd_of((float)q * (1.0f / 16777216.0f)); }

#define XB_TMO      128
#define XB_XCNT(j)  (256  + 64 * (j))
#define XB_XSUB(j)  (1280 + 64 * (j))
#define XB_XGEN(j)  (2304 + 64 * (j))
#define XB_TOP      3328
#define XB_TOPGEN   3392
#define XCD_BAR_WORDS 3456
#define XB_SPIN_CAP (1u << 18)
__device__ __forceinline__ unsigned xb_ld(unsigned* p)              { return __hip_atomic_load(p, __ATOMIC_RELAXED, __HIP_MEMORY_SCOPE_AGENT); }
__device__ __forceinline__ unsigned xb_add(unsigned* p, unsigned v) { return __hip_atomic_fetch_add(p, v, __ATOMIC_RELAXED, __HIP_MEMORY_SCOPE_AGENT); }
__device__ __forceinline__ unsigned xb_xcc_id() { return (unsigned)__builtin_amdgcn_s_getreg((3 << 11) | 20) & 0xFu; }
#define XB_SPIN(cond, bar) do { unsigned _sp = 0; while (cond) { __builtin_amdgcn_s_sleep(1); \
    if ((++_sp & 255u) == 0u) { if (xb_ld(&(bar)[XB_TMO])) break; if (_sp > XB_SPIN_CAP) { atomicAdd(&(bar)[XB_TMO], 1u); break; } } } } while (0)
struct XcdBarrier { unsigned* bar; unsigned x; volatile LAS unsigned* st; unsigned members; };
__device__ __forceinline__ XcdBarrier xcd_barrier_post(unsigned* bar, volatile LAS unsigned* st, unsigned members) {
    XcdBarrier b; b.bar = bar; b.x = xb_xcc_id(); b.st = st; b.members = members;
    if (threadIdx.x == 0) (void)xb_add(&bar[XB_XCNT(b.x)], 1u);
    return b;
}
__device__ __forceinline__ void xcd_barrier_complete(unsigned* bar, unsigned x, unsigned& nloc, unsigned& nx, const unsigned G) {
    unsigned sum, cnt, mine, sp = 0u;
    for (;;) {
        sum = 0u; cnt = 0u; mine = 0u;
#pragma unroll
        for (unsigned j = 0; j < 16; ++j) { const unsigned c = xb_ld(&bar[XB_XCNT(j)]); sum += c; cnt += (c > 0u) ? 1u : 0u; mine = (j == x) ? c : mine; }
        if (sum == G) break;
        __builtin_amdgcn_s_sleep(1);
        if ((++sp & 255u) == 0u) { if (xb_ld(&bar[XB_TMO])) break; if (sp > XB_SPIN_CAP) { atomicAdd(&bar[XB_TMO], 1u); break; } }
    }
    nloc = mine > 0u ? mine : 1u; nx = cnt > 0u ? cnt : 1u;
}
__device__ __forceinline__ void xcd_barrier(const XcdBarrier& b) {
    asm volatile("s_waitcnt vmcnt(0)" ::: "memory");
    __syncthreads();
    if (threadIdx.x == 0) {
        unsigned* bar = b.bar;
        __builtin_amdgcn_s_waitcnt(0);
        unsigned nloc = b.st[0], nx = b.st[1];
        if (nloc == 0u) { xcd_barrier_complete(bar, b.x, nloc, nx, b.members); b.st[0] = nloc; b.st[1] = nx; }
        const unsigned old = xb_add(&bar[XB_XSUB(b.x)], 1u);
        const unsigned gen = old / nloc;
        if (old + 1u == (gen + 1u) * nloc) {
            __builtin_amdgcn_fence(__ATOMIC_RELEASE, "agent");
            asm volatile("s_waitcnt vmcnt(0)" ::: "memory");
            const unsigned og = xb_add(&bar[XB_TOP], 1u);
            const unsigned tg = og / nx;
            if (og + 1u == (tg + 1u) * nx) xb_add(&bar[XB_TOPGEN], 1u);
            else XB_SPIN(xb_ld(&bar[XB_TOPGEN]) == tg, bar);
            __builtin_amdgcn_fence(__ATOMIC_ACQUIRE, "agent");
            xb_add(&bar[XB_XGEN(b.x)], 1u);
            asm volatile("s_waitcnt vmcnt(0)" ::: "memory");
        } else {
            XB_SPIN(xb_ld(&bar[XB_XGEN(b.x)]) == gen, bar);
            __builtin_amdgcn_fence(__ATOMIC_ACQUIRE, "agent");
            asm volatile("s_waitcnt vmcnt(0)" ::: "memory");
        }
    }
    __syncthreads();
}

namespace pg8 {
constexpr int BM = 256, BK = 64, HALF = 128, HTB = HALF * BK * 2, STAGE_BYTES = 8 * HTB, NXCD = 8, WGM = 8;
__host__ __device__ __forceinline__ int lds_byte(int r, int c) { const int st = (r >> 4) * 2 + (c >> 5), rr = r & 15, cc = c & 31, ob = rr * 64 + cc * 2; return st * 1024 + (ob ^ (((ob >> 9) & 1) << 5)); }
__host__ __device__ __forceinline__ void stage_rc(int b, int& R, int& C) { const int st = b / 1024, sb = b % 1024, swz = sb ^ (((sb >> 9) & 1) << 5); R = (st >> 1) * 16 + swz / 64; C = (st & 1) * 32 + (swz % 64) / 2; }
__host__ __device__ __forceinline__ int perm32(int rho) { const int n = rho >> 4, i = rho & 15; return 8 * (i >> 2) + 4 * n + (i & 3); }

struct Unit { int pm, pn, e, ks, ar; };

struct Order {
    int nM, nN, nwg, G, c, nx, use_ar; const char* A; const char* B; size_t tstep, estride; const int* tile_e;
    __device__ __forceinline__ void init(int nM_, int nN_, int KB, int G_, int c_, const void* A_, const void* B_, size_t estride_, const int* tile_e_, int nx_ = NXCD, int use_ar_ = 0) {
        use_ar = use_ar_; nM = nM_; nN = nN_; nwg = nM * nN; G = G_; c = c_; nx = nx_; A = (const char*)A_; B = (const char*)B_; tstep = (size_t)BM * KB; estride = estride_; tile_e = tile_e_; }
    __device__ __forceinline__ bool next(int i, Unit& u) const {
        const long L = (long)i * G + c; if (L >= nwg) return false;
        int wgid = (int)L; { const int q = nwg / nx, r = nwg % nx, xcd = wgid % nx, off = wgid / nx; wgid = (xcd < r ? xcd * (q + 1) : r * (q + 1) + (xcd - r) * q) + off; }
        const int nig = WGM * nN, gid = wgid / nig, fm = gid * WGM, gsz = (nM - fm) < WGM ? (nM - fm) : WGM;
        u.pm = fm + ((wgid % nig) % gsz); u.pn = (wgid % nig) / gsz; const int v = tile_e ? tile_e[u.pm] : 0; u.e = v & 15; u.ar = use_ar ? (v >> 4) : u.pm; u.ks = 0; return true;
    }
    __device__ __forceinline__ const char* a_base(const Unit& u) const { return A + (size_t)u.ar * tstep; }
    __device__ __forceinline__ const char* b_base(const Unit& u) const { return B + (size_t)u.e * estride + (size_t)u.pn * tstep; }
};

struct TailOrder {
    int nsub, G, c, pm0, NS; const char* A; const char* B; size_t tstep, estride, kslice; const int* tile_e;
    __device__ __forceinline__ bool next(int i, Unit& u) const { const int L = i * G + c; if (L >= nsub) return false; const int per = 8 * NS; u.pm = pm0 + L / per; const int rem = L % per; u.pn = rem / NS; u.ks = rem % NS; u.e = tile_e[u.pm] & 15; u.ar = u.pm; return true; }
    __device__ __forceinline__ const char* a_base(const Unit& u) const { return A + (size_t)u.pm * tstep + (size_t)u.ks * kslice; }
    __device__ __forceinline__ const char* b_base(const Unit& u) const { return B + (size_t)u.e * estride + (size_t)u.pn * tstep + (size_t)u.ks * kslice; }
};

template <bool SCALE, bool BOUND = false> struct EpiBf16Out {
    static constexpr bool PERM = true;
    bf16_t* O; int ldc; const u64* ss; float csc; unsigned* bnd; int pm0;
    __device__ __forceinline__ void operator()(const f32x4 (&acc)[2][2][4][2], const Unit& u, int wr, int wc, int fr, int fq) const {
        const int row0 = u.pm * BM + wr * 64 + fr, col0 = u.pn * BM + wc * 32 + 8 * fq; float mx[2] = {0.f, 0.f};
        u64 ssv[2][4];
#pragma unroll
        for (int ai = 0; ai < 2; ++ai)
#pragma unroll
            for (int m = 0; m < 4; ++m) ssv[ai][m] = SCALE ? ss[row0 + ai * HALF + m * 16] : 0ull;
#pragma unroll
        for (int ai = 0; ai < 2; ++ai)
#pragma unroll
            for (int m = 0; m < 4; ++m) { const int row = row0 + ai * HALF + m * 16; float rs = csc; if (SCALE) rs = rstd_q(ssv[ai][m]);
                bf16_t* rowp = O + (size_t)row * ldc + col0;
#pragma unroll
                for (int bj = 0; bj < 2; ++bj) { const f32x4 v0 = acc[ai][bj][m][0] * rs, v1 = acc[ai][bj][m][1] * rs;
                    u32x4 w; w.x = cvt_pk_bf16(v0[0], v0[1]); w.y = cvt_pk_bf16(v0[2], v0[3]); w.z = cvt_pk_bf16(v1[0], v1[1]); w.w = cvt_pk_bf16(v1[2], v1[3]);
                    *(u32x4*)(rowp + bj * HALF) = w;
                    if (BOUND) { float sq = ((v0[0] * v0[0] + v0[1] * v0[1]) + (v0[2] * v0[2] + v0[3] * v0[3])) + ((v1[0] * v1[0] + v1[1] * v1[1]) + (v1[2] * v1[2] + v1[3] * v1[3]));
                        sq = sum_xor32(sum_xor16(sq)); mx[bj] = __builtin_fmaxf(mx[bj], sq); } } }
        if (BOUND) {
#pragma unroll
            for (int bj = 0; bj < 2; ++bj) { const float v = row_max16(mx[bj]);
                if (fr == 0 && fq == 0) __hip_atomic_fetch_max(bnd + ((size_t)(2 * u.pn + bj) * 64 + u.pm + pm0) * 4 + wc, __float_as_uint(v), __ATOMIC_RELAXED, __HIP_MEMORY_SCOPE_AGENT); } }
    }
};
__device__ __forceinline__ float clamp448(float x) { return __builtin_fminf(__builtin_fmaxf(x, -448.0f), 448.0f); }
__device__ __forceinline__ unsigned pk4_fp8(float a, float b, float c, float d) { int v = __builtin_amdgcn_cvt_pk_fp8_f32(clamp448(a), clamp448(b), 0, false); v = __builtin_amdgcn_cvt_pk_fp8_f32(clamp448(c), clamp448(d), v, true); return (unsigned)v; }
__device__ __forceinline__ float silu_mul(float g, float u) { return g * __builtin_amdgcn_rcpf(1.0f + __builtin_amdgcn_exp2f(-1.4426950408889634f * g)) * u; }
__device__ __forceinline__ float silu_mul_c(float g, float u, float c1, float c2) { return (g * u) * (c2 * __builtin_amdgcn_rcpf(1.0f + __builtin_amdgcn_exp2f(g * c1))); }
typedef float f32x2 __attribute__((ext_vector_type(2)));
__device__ __forceinline__ f32x2 silu_mul2(f32x2 g, f32x2 u, float c1, float k) {
    const f32x2 t = g * c1; f32x2 e; e.x = __builtin_amdgcn_exp2f(t.x); e.y = __builtin_amdgcn_exp2f(t.y);
    const f32x2 d = e * k + k; f32x2 r; r.x = __builtin_amdgcn_rcpf(d.x); r.y = __builtin_amdgcn_rcpf(d.y);
    return (g * u) * r;
}
__device__ __forceinline__ f32x4 silu_mul4(f32x4 g, f32x4 u, float c1, float k) { const f32x2 a = silu_mul2(g.xy, u.xy, c1, k), b = silu_mul2(g.zw, u.zw, c1, k); return (f32x4){a.x, a.y, b.x, b.y}; }
template <bool RAW> struct EpiSwiGLU {
    static constexpr bool PERM = true;
    bf16_t* O; int ldc; const void* rsrc;
    __device__ __forceinline__ void operator()(const f32x4 (&acc)[2][2][4][2], const Unit& u, int wr, int wc, int fr, int fq) const {
        const int row0 = u.pm * BM + wr * 64 + fr, col0 = u.pn * HALF + wc * 32 + 8 * fq;
        float rsv[2][4];
#pragma unroll
        for (int ai = 0; ai < 2; ++ai)
#pragma unroll
            for (int m = 0; m < 4; ++m) { const int row = row0 + ai * HALF + m * 16; if (RAW) rsv[ai][m] = ((const float*)rsrc)[row]; else rsv[ai][m] = rstd_q(((const u64*)rsrc)[row]); }
#pragma unroll
        for (int ai = 0; ai < 2; ++ai)
#pragma unroll
            for (int m = 0; m < 4; ++m) { const int row = row0 + ai * HALF + m * 16; const float rs = rsv[ai][m];
                const float c1 = -1.4426950408889634f * rs, kk = __builtin_amdgcn_rcpf(rs * rs);
                const f32x4 a0 = silu_mul4(acc[ai][0][m][0], acc[ai][1][m][0], c1, kk), a1 = silu_mul4(acc[ai][0][m][1], acc[ai][1][m][1], c1, kk);
                u32x4 w; w.x = cvt_pk_bf16(a0[0], a0[1]); w.y = cvt_pk_bf16(a0[2], a0[3]); w.z = cvt_pk_bf16(a1[0], a1[1]); w.w = cvt_pk_bf16(a1[2], a1[3]);
                *(u32x4*)(O + (size_t)row * ldc + col0) = w; }
    }
};
struct EpiSwiGLU8 {
    static constexpr bool PERM = true;
    unsigned char* O; int ldc; float isc, osc; int skip;
    __device__ __forceinline__ void operator()(const f32x4 (&acc)[2][2][4][2], const Unit& u, int wr, int wc, int fr, int fq) const {
        if (skip) return;
        const int row0 = u.pm * BM + wr * 64 + fr, col0 = u.pn * HALF + wc * 32 + 8 * fq; const float c1 = -1.4426950408889634f * isc, kk = 1.0f / (isc * isc * osc);
#pragma unroll
        for (int ai = 0; ai < 2; ++ai)
#pragma unroll
            for (int m = 0; m < 4; ++m) { const int row = row0 + ai * HALF + m * 16;
                const f32x4 a0 = silu_mul4(acc[ai][0][m][0], acc[ai][1][m][0], c1, kk), a1 = silu_mul4(acc[ai][0][m][1], acc[ai][1][m][1], c1, kk);
                u32x2 w; w.x = pk4_fp8(a0[0], a0[1], a0[2], a0[3]); w.y = pk4_fp8(a1[0], a1[1], a1[2], a1[3]);
                *(u32x2*)(O + (size_t)row * ldc + col0) = w; }
    }
};
struct EpiPart {
    static constexpr bool PERM = false;
    float* slab; int row_base; size_t ks_stride;
    __device__ __forceinline__ void operator()(const f32x4 (&acc)[2][2][4][2], const Unit& u, int wr, int wc, int fr, int fq) const {
        const int row0 = u.pm * BM + wr * 64 + fr - row_base, col0 = u.pn * BM + wc * 32 + 4 * fq; float* sp = slab + (size_t)u.ks * ks_stride;
#pragma unroll
        for (int ai = 0; ai < 2; ++ai)
#pragma unroll
            for (int m = 0; m < 4; ++m) { float* rowp = sp + (size_t)(row0 + ai * HALF + m * 16) * DM + col0;
#pragma unroll
                for (int bj = 0; bj < 2; ++bj)
#pragma unroll
                    for (int n = 0; n < 2; ++n) *(f32x4*)(rowp + bj * HALF + n * 16) = acc[ai][bj][m][n]; }
    }
};
template <bool BASE_BF16, bool WRITE_F32> struct EpiResid {
    static constexpr bool PERM = true;
    const void* base; float* xr; bf16_t* xb; u64* ssout;
    __device__ __forceinline__ void operator()(const f32x4 (&acc)[2][2][4][2], const Unit& u, int wr, int wc, int fr, int fq) const {
        const int row0 = u.pm * BM + wr * 64 + fr, col0 = u.pn * BM + wc * 32 + 8 * fq;
#pragma unroll
        for (int ai = 0; ai < 2; ++ai) { u32x4 qv[4][2];
            if (BASE_BF16) {
#pragma unroll
                for (int m = 0; m < 4; ++m)
#pragma unroll
                    for (int bj = 0; bj < 2; ++bj) qv[m][bj] = *(const u32x4*)((const bf16_t*)base + (size_t)(row0 + ai * HALF + m * 16) * DM + col0 + bj * HALF); }
#pragma unroll
            for (int m = 0; m < 4; ++m) { const int row = row0 + ai * HALF + m * 16; const size_t off = (size_t)row * DM + col0; float s = 0.f;
#pragma unroll
                for (int bj = 0; bj < 2; ++bj) { const int c = bj * HALF; f32x4 b0, b1;
                    if (BASE_BF16) { const u32x4 q = qv[m][bj];
                        b0 = (f32x4){__uint_as_float(q.x << 16), __uint_as_float(q.x & 0xffff0000u), __uint_as_float(q.y << 16), __uint_as_float(q.y & 0xffff0000u)};
                        b1 = (f32x4){__uint_as_float(q.z << 16), __uint_as_float(q.z & 0xffff0000u), __uint_as_float(q.w << 16), __uint_as_float(q.w & 0xffff0000u)}; }
                    else { b0 = *(const f32x4*)((const float*)base + off + c); b1 = *(const f32x4*)((const float*)base + off + c + 4); }
                    const f32x4 o0 = b0 + acc[ai][bj][m][0], o1 = b1 + acc[ai][bj][m][1];
                    if (WRITE_F32) { *(f32x4*)(xr + off + c) = o0; *(f32x4*)(xr + off + c + 4) = o1; }
                    u32x4 w; w.x = cvt_pk_bf16(o0[0], o0[1]); w.y = cvt_pk_bf16(o0[2], o0[3]); w.z = cvt_pk_bf16(o1[0], o1[1]); w.w = cvt_pk_bf16(o1[2], o1[3]); *(u32x4*)(xb + off + c) = w;
                    s += (o0[0] * o0[0] + o0[1] * o0[1]) + (o0[2] * o0[2] + o0[3] * o0[3]); s += (o1[0] * o1[0] + o1[1] * o1[1]) + (o1[2] * o1[2] + o1[3] * o1[3]); }
                s = sum_xor32(sum_xor16(s));
                if (fq == 0) __hip_atomic_fetch_add(ssout + row, ss_fix(s), __ATOMIC_RELAXED, __HIP_MEMORY_SCOPE_AGENT); } }
    }
};

typedef int i32x8 __attribute__((ext_vector_type(8)));
__device__ __forceinline__ i32x8 cat16(bf16x8 lo, bf16x8 hi) { typedef int i32x4 __attribute__((ext_vector_type(4))); const i32x4 a = __builtin_bit_cast(i32x4, lo), b = __builtin_bit_cast(i32x4, hi); return (i32x8){a[0], a[1], a[2], a[3], b[0], b[1], b[2], b[3]}; }
__device__ __forceinline__ void mfma_fp8(f32x4& acc, i32x8 a, i32x8 b) { asm volatile("v_mfma_f32_16x16x128_f8f6f4 %0, %1, %2, %0" : "+v"(acc) : "v"(a), "v"(b)); }
template <class Epi, bool ALIGN_EPI, bool SP2, bool FP8 = false, class Sched = Order>
__device__ __forceinline__ void gemm_phase(LAS unsigned char* lds, const int KB, const Sched& S, const Epi& E, const int nt_override = 0, volatile LAS unsigned* prb = nullptr) {
    unsigned long long pk_ = 0, pg_ = 0, pl_ = 0; unsigned pnk_ = 0, png_ = 0;
#define PG8_STAMP(x) do { if (prb) { asm volatile("s_memtime %0\n\ts_waitcnt lgkmcnt(0)" : "=s"(x) :: "memory"); } } while (0)
    int tid_ = threadIdx.x; asm volatile("" : "+v"(tid_));
    const int tid = tid_, wid = __builtin_amdgcn_readfirstlane(tid >> 6), lane = tid & 63, wr = wid >> 2, wc = wid & 3, fr = lane & 15, fq = lane >> 4;
    const int nt = nt_override ? nt_override : KB / 128;
    unsigned voffA[2], voffB[2];
#pragma unroll
    for (int i = 0; i < 2; ++i) { int R, C; stage_rc(tid * 16 + i * 8192, R, C); const int Rb = Epi::PERM ? ((R & ~31) + perm32(R & 31)) : R;
        voffA[i] = (unsigned)(R * KB + C * 2); voffB[i] = (unsigned)(Rb * KB + C * 2); }
    const size_t kstep = (size_t)(BK * 2);
    const size_t hstep = (size_t)HALF * KB;
    const unsigned ldsw = (unsigned)wid * 1024u;
    const int aoff = lds_byte(wr * 64 + fr, fq * 8), boff = lds_byte(wc * 32 + fr, fq * 8);
#define PG8_SA(b, h) (((b) * 2 + (h)) * HTB)
#define PG8_SB(b, h) ((4 + (b) * 2 + (h)) * HTB)
#define PG8_STAGE(bufoff, gbase, voff) do { _Pragma("unroll") for (int _i = 0; _i < 2; ++_i) \
        __builtin_amdgcn_global_load_lds((const unsigned*)((const char*)(gbase) + (voff)[_i]), (LAS unsigned*)(lds + (bufoff) + ldsw + _i * 8192), 16, 0, 0); } while (0)
#define PG8_LDA(dst, b, h) do { _Pragma("unroll") for (int m = 0; m < 4; ++m) _Pragma("unroll") for (int k = 0; k < 2; ++k) dst[m][k] = *(const LAS bf16x8*)(lds + PG8_SA(b, h) + aoff + m * 2048 + k * 1024); } while (0)
#define PG8_LDB(dst, b, h) do { _Pragma("unroll") for (int n = 0; n < 2; ++n) _Pragma("unroll") for (int k = 0; k < 2; ++k) dst[n][k] = *(const LAS bf16x8*)(lds + PG8_SB(b, h) + boff + n * 2048 + k * 1024); } while (0)
#define PG8_MMA(ai, bj, At, Bt) do { __builtin_amdgcn_s_setprio(1); _Pragma("unroll") for (int m = 0; m < 4; ++m) _Pragma("unroll") for (int n = 0; n < 2; ++n) { \
        if constexpr (FP8) mfma_fp8(acc[ai][bj][m][n], cat16(Bt[n][0], Bt[n][1]), cat16(At[m][0], At[m][1])); \
        else { _Pragma("unroll") for (int k = 0; k < 2; ++k) acc[ai][bj][m][n] = __builtin_amdgcn_mfma_f32_16x16x32_bf16(Bt[n][k], At[m][k], acc[ai][bj][m][n], 0, 0, 0); } } \
        __builtin_amdgcn_s_setprio(0); } while (0)
#define PG8_WAIT_V(n) asm volatile("s_waitcnt vmcnt(" #n ")" ::: "memory")
#define PG8_WAIT_L(n) asm volatile("s_waitcnt lgkmcnt(" #n ")" ::: "memory")
#define PG8_BAR __builtin_amdgcn_s_barrier()
#define PG8_SCHED __builtin_amdgcn_sched_barrier(0)
    Unit cur, nxt; int ui = 0;
    if (!S.next(0, cur)) return;
    f32x4 acc[2][2][4][2];
#pragma unroll
    for (int a = 0; a < 2; ++a)
#pragma unroll
        for (int b = 0; b < 2; ++b)
#pragma unroll
            for (int m = 0; m < 4; ++m)
#pragma unroll
                for (int n = 0; n < 2; ++n) acc[a][b][m][n] = (f32x4){0.f, 0.f, 0.f, 0.f};
    bf16x8 At[4][2], B0[2][2], B1[2][2];
    const char* cA = S.a_base(cur); const char* cB = S.b_base(cur);
    if constexpr (SP2) {
        PG8_STAGE(PG8_SB(0, 0), cB, voffB); PG8_STAGE(PG8_SB(0, 1), cB + hstep, voffB); PG8_STAGE(PG8_SA(0, 0), cA, voffA); PG8_STAGE(PG8_SA(0, 1), cA + hstep, voffA);
        if (wr == 1) PG8_BAR;
        PG8_WAIT_V(2); PG8_BAR;
        PG8_STAGE(PG8_SB(1, 0), cB + kstep, voffB); PG8_STAGE(PG8_SA(1, 0), cA + kstep, voffA); PG8_STAGE(PG8_SB(1, 1), cB + hstep + kstep, voffB);
        PG8_WAIT_V(6); PG8_BAR;
    } else {
        PG8_STAGE(PG8_SB(0, 0), cB, voffB); PG8_STAGE(PG8_SA(0, 0), cA, voffA); PG8_STAGE(PG8_SB(0, 1), cB + hstep, voffB); PG8_STAGE(PG8_SA(0, 1), cA + hstep, voffA);
        if (wr == 1) PG8_BAR;
        PG8_WAIT_V(4); PG8_BAR;
        PG8_STAGE(PG8_SB(1, 0), cB + kstep, voffB); PG8_STAGE(PG8_SA(1, 0), cA + kstep, voffA); PG8_STAGE(PG8_SB(1, 1), cB + hstep + kstep, voffB);
        PG8_WAIT_V(6); PG8_BAR;
    }
    for (;;) {
        const bool has_next = S.next(ui + 1, nxt);
        const char* nA = has_next ? S.a_base(nxt) : cA; const char* nB = has_next ? S.b_base(nxt) : cB;
        { unsigned long long ts_; PG8_STAMP(ts_); if (prb && pl_) { pg_ += ts_ - pl_; ++png_; } pl_ = ts_; }
        for (int t = 0; t < nt; t += 2) {
            const bool last = (t == nt - 2);
            const char* a1 = cA + (size_t)(t + 1) * kstep;
            const char* a2 = last ? nA : cA + (size_t)(t + 2) * kstep; const char* b2 = last ? nB : cB + (size_t)(t + 2) * kstep;
            const char* a3 = a2 + kstep; const char* b3 = b2 + kstep;
            if constexpr (SP2) {
            PG8_LDB(B0, 0, 0); PG8_LDB(B1, 0, 1); PG8_SCHED; PG8_LDA(At, 0, 0); PG8_STAGE(PG8_SA(1, 1), a1 + hstep, voffA);
            PG8_WAIT_V(8); PG8_WAIT_L(0); PG8_BAR; PG8_MMA(0, 0, At, B0); PG8_MMA(0, 1, At, B1); PG8_BAR; PG8_SCHED;
            PG8_LDA(At, 0, 1); PG8_STAGE(PG8_SB(0, 0), b2, voffB); PG8_STAGE(PG8_SB(0, 1), b2 + hstep, voffB); PG8_STAGE(PG8_SA(0, 0), a2, voffA);
            PG8_WAIT_V(8); PG8_WAIT_L(0); PG8_BAR; PG8_MMA(1, 0, At, B0); PG8_MMA(1, 1, At, B1); PG8_BAR; PG8_SCHED;
            PG8_LDB(B0, 1, 0); PG8_LDB(B1, 1, 1); PG8_SCHED; PG8_LDA(At, 1, 0); PG8_STAGE(PG8_SA(0, 1), a2 + hstep, voffA);
            PG8_WAIT_V(8); PG8_WAIT_L(0); PG8_BAR; PG8_MMA(0, 0, At, B0); PG8_MMA(0, 1, At, B1); PG8_BAR; PG8_SCHED;
            PG8_LDA(At, 1, 1); PG8_STAGE(PG8_SB(1, 0), b3, voffB); PG8_STAGE(PG8_SB(1, 1), b3 + hstep, voffB); PG8_STAGE(PG8_SA(1, 0), a3, voffA);
            PG8_WAIT_V(8); PG8_WAIT_L(0); PG8_BAR; PG8_MMA(1, 0, At, B0); PG8_MMA(1, 1, At, B1); PG8_BAR; PG8_SCHED;
            } else {
            PG8_LDB(B0, 0, 0); PG8_SCHED; PG8_LDA(At, 0, 0); PG8_STAGE(PG8_SA(1, 1), a1 + hstep, voffA);
            PG8_WAIT_L(8); PG8_BAR; PG8_WAIT_L(0); PG8_MMA(0, 0, At, B0); PG8_BAR; PG8_SCHED;
            PG8_LDB(B1, 0, 1); PG8_STAGE(PG8_SB(0, 0), b2, voffB);
            PG8_BAR; PG8_WAIT_L(0); PG8_MMA(0, 1, At, B1); PG8_BAR;
            PG8_LDA(At, 0, 1); PG8_STAGE(PG8_SA(0, 0), a2, voffA);
            PG8_BAR; PG8_WAIT_L(0); PG8_MMA(1, 0, At, B0); PG8_BAR; PG8_SCHED;
            PG8_STAGE(PG8_SB(0, 1), b2 + hstep, voffB);
            PG8_WAIT_V(6); PG8_BAR; PG8_MMA(1, 1, At, B1); PG8_BAR;
            PG8_LDB(B0, 1, 0); PG8_SCHED; PG8_LDA(At, 1, 0); PG8_STAGE(PG8_SA(0, 1), a2 + hstep, voffA);
            PG8_WAIT_L(8); PG8_BAR; PG8_WAIT_L(0); PG8_MMA(0, 0, At, B0); PG8_BAR; PG8_SCHED;
            PG8_LDB(B1, 1, 1); PG8_STAGE(PG8_SB(1, 0), b3, voffB);
            PG8_BAR; PG8_WAIT_L(0); PG8_MMA(0, 1, At, B1); PG8_BAR;
            PG8_LDA(At, 1, 1); PG8_STAGE(PG8_SA(1, 0), a3, voffA);
            PG8_BAR; PG8_WAIT_L(0); PG8_MMA(1, 0, At, B0); PG8_BAR; PG8_SCHED;
            PG8_STAGE(PG8_SB(1, 1), b3 + hstep, voffB);
            PG8_WAIT_V(6); PG8_BAR; PG8_MMA(1, 1, At, B1); PG8_BAR;
            }
        }
        { unsigned long long ts_; PG8_STAMP(ts_); if (prb) { pk_ += ts_ - pl_; pnk_ += (unsigned)nt; pl_ = ts_; } }
        if constexpr (FP8) asm volatile("s_nop 15\n\ts_nop 15" ::: "memory");
        if constexpr (ALIGN_EPI) { if (wr == 0) PG8_BAR; }
        E(acc, cur, wr, wc, fr, fq);
        if (!has_next) break;
#pragma unroll
        for (int a = 0; a < 2; ++a)
#pragma unroll
            for (int b = 0; b < 2; ++b)
#pragma unroll
                for (int m = 0; m < 4; ++m)
#pragma unroll
                    for (int n = 0; n < 2; ++n) acc[a][b][m][n] = (f32x4){0.f, 0.f, 0.f, 0.f};
        cur = nxt; cA = nA; cB = nB; ++ui;
        if constexpr (ALIGN_EPI) { if (wr == 1) PG8_BAR; }
    }
    PG8_WAIT_V(0);
    if constexpr (!ALIGN_EPI) { if (wr == 0) PG8_BAR; }
    PG8_BAR;
    if (prb && blockIdx.x == 0 && tid == 0) { if (PROBE_KIND == 4) prb[20] = (unsigned)((pk_ / (pnk_ ? pnk_ : 1u)) * 100ull); if (PROBE_KIND == 5) prb[20] = (unsigned)((pg_ / (png_ ? png_ : 1u)) * 10ull); }
#undef PG8_STAMP
#undef PG8_SA
#undef PG8_SB
#undef PG8_STAGE
#undef PG8_LDA
#undef PG8_LDB
#undef PG8_MMA
#undef PG8_WAIT_V
#undef PG8_WAIT_L
#undef PG8_BAR
#undef PG8_SCHED
}
}
constexpr bool GEMM_SP2 = true, GEMM_ALIGN = true;

namespace att {
constexpr int D = 128, LDQ = NQKV, LDO = DM;
constexpr float SCALE = 0.08838834764831845f, THR = 8.f;
constexpr int NW = 8, QBLK = 32, KVBLK = 64, QB = NW * QBLK;
constexpr int SHM_V = KVBLK * D * 2, SHM_K = KVBLK * D * 2;
constexpr int LDS_ATT = 2 * SHM_V + 2 * SHM_K + NW * 64 * 4;
constexpr unsigned BIGW = 0x40000000u;
#define KSWZ(row, colB) ((row) * 256 + ((colB) ^ (((row) & 7) << 4)))
#define SBAR() __builtin_amdgcn_sched_barrier(0)
__device__ __forceinline__ int v_st(int k, int c) { const int kk = (k & ~0xC) | ((k & 4) << 1) | ((k & 8) >> 1); return ((kk >> 3) * 4 + (c >> 5)) * 512 + ((kk & 7) * 32 + (c & 31)) * 2; }
__device__ __forceinline__ int v_rd_base(int lane) { return ((lane & 3) << 3) | (((lane >> 2) & 3) << 6) | (((lane >> 4) & 1) << 5) | (((lane >> 5) & 1) << 8); }
constexpr int v_rd_off(int d0, int ks, int half) { return d0 * 512 + ks * 4096 + half * 2048; }
__device__ __forceinline__ int crow(int r, int hi) { return (r & 3) + 8 * (r >> 2) + 4 * hi; }
__device__ __forceinline__ bf16x8 ld8(const bf16_t* p) { return *reinterpret_cast<const bf16x8*>(p); }
__device__ __forceinline__ void mask_tile(f32x16& p0, f32x16& p1, int dq) {
    const float NEG = -__builtin_inff();
#pragma unroll
    for (int r = 0; r < 16; ++r) {
        const int c = (r & 3) + 8 * (r >> 2);
        if ((unsigned)(dq - c) >= BIGW) p0[r] = NEG;
        if ((unsigned)(dq - c - 32) >= BIGW) p1[r] = NEG;
    }
}
__device__ __forceinline__ void mask_lane(f32x16& p0, f32x16& p1, bool keep) {
    const float NEG = -__builtin_inff();
#pragma unroll
    for (int r = 0; r < 16; ++r) { p0[r] = keep ? p0[r] : NEG; p1[r] = keep ? p1[r] : NEG; }
}
__device__ __forceinline__ void partialSM(f32x16& p0, f32x16& p1, float& m_reg, float& mn, float& alpha) {
    float pmax = p0[0]; for (int r = 1; r < 16; ++r) pmax = fmaxf(pmax, p0[r]); for (int r = 0; r < 16; ++r) pmax = fmaxf(pmax, p1[r]);
    { auto rr = __builtin_amdgcn_permlane32_swap(__float_as_uint(pmax), __float_as_uint(pmax), false, false);
      pmax = fmaxf(__uint_as_float(rr[0]), __uint_as_float(rr[1])); }
    constexpr float C2 = 1.4426950408889634f * SCALE;
    if (__builtin_expect(__all((pmax - m_reg) * SCALE <= THR), 1)) { mn = m_reg; alpha = 1.f; }
    else { mn = fmaxf(m_reg, pmax); alpha = __builtin_amdgcn_exp2f((m_reg - mn) * C2); m_reg = mn; }
    const float mnL = -mn * C2;
    for (int r = 0; r < 16; ++r) p0[r] = fmaf(p0[r], C2, mnL); for (int r = 0; r < 16; ++r) p1[r] = fmaf(p1[r], C2, mnL);
    for (int r = 0; r < 16; ++r) p0[r] = __builtin_amdgcn_exp2f(p0[r]);
}
__device__ __forceinline__ void finishSM(f32x16& p0, f32x16& p1, float alpha, float& l_reg, bf16x8& pa0, bf16x8& pa1, bf16x8& pa2, bf16x8& pa3) {
    for (int r = 0; r < 16; ++r) p1[r] = __builtin_amdgcn_exp2f(p1[r]);
    float ps = 0; for (int r = 0; r < 16; ++r) ps += p0[r]; for (int r = 0; r < 16; ++r) ps += p1[r];
    { auto rr = __builtin_amdgcn_permlane32_swap(__float_as_uint(ps), __float_as_uint(ps), false, false);
      ps = __uint_as_float(rr[0]) + __uint_as_float(rr[1]); }
    l_reg = l_reg * alpha + ps;
#define PK4(P, B_, OUT) do { unsigned a0 = cvt_pk_bf16(P[B_+0], P[B_+1]), a1 = cvt_pk_bf16(P[B_+2], P[B_+3]);                          \
        unsigned b0 = cvt_pk_bf16(P[B_+4], P[B_+5]), b1 = cvt_pk_bf16(P[B_+6], P[B_+7]);                                             \
        auto r0 = __builtin_amdgcn_permlane32_swap(a0, b0, false, false); auto r1 = __builtin_amdgcn_permlane32_swap(a1, b1, false, false); \
        u32x4 w = {r0[0], r1[0], r0[1], r1[1]}; OUT = *reinterpret_cast<bf16x8*>(&w); } while (0)
    PK4(p0, 0, pa0); PK4(p0, 8, pa1); PK4(p1, 0, pa2); PK4(p1, 8, pa3);
#undef PK4
}
template <int KB>
__device__ __forceinline__ void qkt(f32x16& p0, f32x16& p1, const char* K_lds, int r32, int hi, const bf16x8* qr, float a, float bias0) {
#pragma unroll
    for (int r = 0; r < 16; ++r) { const float c = (float)((r & 3) + 8 * (r >> 2)); p0[r] = fmaf(a, c, bias0); p1[r] = fmaf(a, c + 32.f, bias0); }
    const char* kb[4];
#pragma unroll
    for (int dd = 0; dd < 4; ++dd) kb[dd] = K_lds + KB * SHM_K + KSWZ(r32, (dd * 16 + hi * 8) * 2);
#pragma unroll
    for (int d0 = 0; d0 < 8; ++d0) { const char* ap = kb[d0 & 3] + (d0 >> 2) * 128;
        bf16x8 b0 = *reinterpret_cast<const bf16x8*>(ap);
        bf16x8 b1 = *reinterpret_cast<const bf16x8*>(ap + 32 * 256);
        p0 = __builtin_amdgcn_mfma_f32_32x32x16_bf16(b0, qr[d0], p0, 0, 0, 0);
        p1 = __builtin_amdgcn_mfma_f32_32x32x16_bf16(b1, qr[d0], p1, 0, 0, 0); }
}
template <int VB>
__device__ __forceinline__ void pv_tile(f32x16* o, int vb0, bf16x8 pa0, bf16x8 pa1, bf16x8 pa2, bf16x8 pa3) {
#define TRRD(dst, off) asm volatile("ds_read_b64_tr_b16 %0, %1 offset:%2" : "=&v"(dst) : "v"(vb0), "i"(off) : "memory")
#define PV_D0(d0) do { s16x4 l0, l1, l2, l3, h0, h1, h2, h3; constexpr int b_ = VB * SHM_V + v_rd_off(d0, 0, 0); \
        TRRD(l0, b_); TRRD(h0, b_ + 2048); TRRD(l1, b_ + 4096); TRRD(h1, b_ + 6144); TRRD(l2, b_ + 8192); TRRD(h2, b_ + 10240); TRRD(l3, b_ + 12288); TRRD(h3, b_ + 14336); \
        asm volatile("s_waitcnt lgkmcnt(0)" ::: "memory"); SBAR();   \
        o[d0] = __builtin_amdgcn_mfma_f32_32x32x16_bf16(pa0, (bf16x8){l0[0], l0[1], l0[2], l0[3], h0[0], h0[1], h0[2], h0[3]}, o[d0], 0, 0, 0);   \
        o[d0] = __builtin_amdgcn_mfma_f32_32x32x16_bf16(pa1, (bf16x8){l1[0], l1[1], l1[2], l1[3], h1[0], h1[1], h1[2], h1[3]}, o[d0], 0, 0, 0);   \
        o[d0] = __builtin_amdgcn_mfma_f32_32x32x16_bf16(pa2, (bf16x8){l2[0], l2[1], l2[2], l2[3], h2[0], h2[1], h2[2], h2[3]}, o[d0], 0, 0, 0);   \
        o[d0] = __builtin_amdgcn_mfma_f32_32x32x16_bf16(pa3, (bf16x8){l3[0], l3[1], l3[2], l3[3], h3[0], h3[1], h3[2], h3[3]}, o[d0], 0, 0, 0); } while (0)
    PV_D0(0); PV_D0(1); PV_D0(2); PV_D0(3);
#undef PV_D0
#undef TRRD
}
struct BlockRef { const bf16_t* Q; const bf16_t* K; const bf16_t* V; bf16_t* O; const unsigned char* sel; int P0; float a; int jlo; };
struct Seam { bf16x8 qr[8]; bf16x8 st_v0, st_v1, st_k0, st_k1; };
#define AROW(p, k0, rr) (((p) + (size_t)((k0) + (rr)) * LDQ) + toff)
#define VMW() asm volatile("s_waitcnt vmcnt(0)" ::: "memory")
#define VMWN(n) asm volatile("s_waitcnt vmcnt(%0)" :: "i"(n) : "memory")
#define SLOAD_H(Kp, Vp, k0) do { S.st_v0 = ld8(AROW(Vp, k0, 0)); S.st_v1 = ld8(AROW(Vp, k0, 32));              \
                         S.st_k0 = ld8(AROW(Kp, k0, 0)); S.st_k1 = ld8(AROW(Kp, k0, 32)); } while (0)
#define SWRITE_HK(bf) do { *(bf16x8*)(K_lds + (bf) * SHM_K + kws) = S.st_k0; *(bf16x8*)(K_lds + (bf) * SHM_K + kws + 32 * 256) = S.st_k1; } while (0)
#define SWRITE_HV(bf) do { *(bf16x8*)(V_lds + (bf) * SHM_V + vst0) = S.st_v0; *(bf16x8*)(V_lds + (bf) * SHM_V + vst1) = S.st_v1; } while (0)
#define SWRITE_H(bf) do { SWRITE_HV(bf); SWRITE_HK(bf); } while (0)
__device__ __forceinline__ int attn_jlo(const unsigned* bnd, int qseg, int kseg, int b, int qb, float slope) {
    float q2 = 0.f, k2 = 0.f;
#pragma unroll
    for (int w = 0; w < 4; ++w) q2 += __uint_as_float(bnd[((size_t)qseg * 64 + b * 8 + qb) * 4 + w]);
    for (int t = 0; t <= qb; ++t) { float s2 = 0.f;
#pragma unroll
        for (int w = 0; w < 4; ++w) s2 += __uint_as_float(bnd[((size_t)kseg * 64 + b * 8 + t) * 4 + w]);
        k2 = __builtin_fmaxf(k2, s2); }
    const float W = (2.0f * 1.02f * __builtin_sqrtf(q2 * k2) * SCALE + 30.0f) / slope, lo = (float)(qb * 256) - W;
    return lo > 0.f ? (int)(lo * (1.0f / 64.0f)) : 0;
}
struct DynCtx { const bf16_t* qkv; bf16_t* out; const unsigned char* sel; const unsigned* bnd; unsigned* qctr; volatile LAS int* nw; int q0, qb0, nq; };
template <bool MOBA> __device__ __forceinline__ BlockRef attn_ref_blk(int code, const DynCtx& C) {
    constexpr int NH = MOBA ? HA : HB * 4, NPB = NH * 8;
    const int b = code / NPB, idx = code % NPB, qb = 7 - idx / NH, hh = NH - 1 - idx % NH; BlockRef r; const size_t t0 = (size_t)b * SEQ;
    if (MOBA) { const int h = hh; const float slope = __builtin_amdgcn_exp2f(-0.5f * (float)(h + 1));
        r.Q = C.qkv + (t0 + qb * 256) * NQKV + h * 128; r.K = C.qkv + t0 * NQKV + DM + h * 128; r.V = C.qkv + t0 * NQKV + 2 * DM + h * 128;
        r.O = C.out + (t0 + qb * 256) * DM + h * 128; r.sel = C.sel + (size_t)(b * HA + h) * SEQ; r.P0 = qb * 256; r.a = slope * (1.0f / SCALE); r.jlo = attn_jlo(C.bnd, h, 16 + h, b, qb, slope); }
    else { const int h = hh >> 2, c = (hh >> 1) & 1, vh = hh & 1; const float slope = __builtin_amdgcn_exp2f(-(float)(h + 1));
        r.Q = C.qkv + (t0 + qb * 256) * NQKV + 2 * DM + h * 256 + c * 128; r.K = C.qkv + t0 * NQKV + h * 256 + c * 128; r.V = C.qkv + t0 * NQKV + DM + h * 256 + vh * 128;
        r.O = C.out + (size_t)c * MTOK * DM + (t0 + qb * 256) * DM + h * 256 + vh * 128; r.sel = nullptr; r.P0 = qb * 256; r.a = slope * (1.0f / SCALE); r.jlo = attn_jlo(C.bnd, 32 + 2 * h + c, 2 * h + c, b, qb, slope); }
    return r;
}
__device__ __forceinline__ int attn_pull_from(unsigned* qctr, int q0, int k0, int npb, int qb0, int nq) {
    for (int k = k0; k < nq; ++k) { const int q = qb0 + ((q0 - qb0 + k) & (nq - 1)); if (xb_ld(qctr + 64 * q) >= (unsigned)npb) continue;
        const unsigned i = xb_add(qctr + 64 * q, 1u); if (i < (unsigned)npb) return q * npb + (int)i; }
    return -1;
}
__device__ __forceinline__ void attn_prime(const BlockRef& cur, char* lds, Seam& S) {
    int tid_ = threadIdx.x; asm volatile("" : "+v"(tid_));
    const int tid = tid_, wid = __builtin_amdgcn_readfirstlane(tid >> 6), lane = tid & 63, r32 = lane & 31, hi = lane >> 5;
    const int sr = tid >> 4, sc = (tid & 15) * 8, kws = KSWZ(sr, sc * 2); char* K_lds = lds + 2 * SHM_V; const unsigned toff = (unsigned)(sr * LDQ + sc);
    { const unsigned qoff = (unsigned)(r32 * LDQ + hi * 8); const bf16_t* qb_ = cur.Q + (size_t)(wid * QBLK) * LDQ;
      for (int d0 = 0; d0 < 8; ++d0) S.qr[d0] = ld8(qb_ + qoff + d0 * 16); }
    SLOAD_H(cur.K, cur.V, cur.jlo * KVBLK); VMW(); SWRITE_HK(0);
    __syncthreads();
}
template <bool MOBA>
__device__ __forceinline__ int attn_block(const BlockRef& cur, const DynCtx& C, char* lds, Seam& S) {
    int tid_ = threadIdx.x; asm volatile("" : "+v"(tid_));
    const int tid = tid_, wid = __builtin_amdgcn_readfirstlane(tid >> 6), lane = tid & 63, r32 = lane & 31, hi = lane >> 5;
    const int NT = (cur.P0 + QB) / KVBLK - cur.jlo;
    const int qlo = cur.P0 + wid * QBLK, qm = qlo + r32 - 4 * hi;
    char* V_lds = lds; char* K_lds = lds + 2 * SHM_V;
    float* ws = (float*)(lds + 2 * SHM_V + 2 * SHM_K) + wid * 64; float* li_l = ws, * al_l = ws + 32;
    float m_reg = -1e30f, l_reg = 0; f32x16 o[4] = {};
    const int sr = tid >> 4, sc = (tid & 15) * 8, vst0 = v_st(sr, sc), vst1 = v_st(32 + sr, sc), kws = KSWZ(sr, sc * 2); const unsigned toff = (unsigned)(sr * LDQ + sc);
    const int vb0 = (int)(uintptr_t)V_lds + v_rd_base(lane);
    const bf16_t* Kh = cur.K; const bf16_t* Vh = cur.V;
    unsigned selm = 0xffu; if (MOBA) selm = cur.sel[cur.P0 + wid * QBLK + r32];
    const float aa = cur.a, abase = -aa * (float)qm;
#define RESC(a) do { if (__any((a) < 1.f)) { if (hi == 0) al_l[r32] = (a); asm volatile("s_waitcnt lgkmcnt(0)" ::: "memory");              \
                     for (int d_ = 0; d_ < 4; ++d_) for (int r = 0; r < 16; ++r) o[d_][r] *= al_l[crow(r, hi)]; } } while (0)
#define KBASE(t) ((cur.jlo + (t)) * KVBLK)
#define BIAS(t) fmaf(aa, (float)KBASE(t), abase)
#define MASKT(P0_, P1_, t) do { const int kb_ = KBASE(t); \
        if (!MOBA || kb_ >= cur.P0) { if (kb_ + KVBLK - 1 > qlo) mask_tile(P0_, P1_, qm - kb_); } \
        else { const bool keep_ = ((selm >> (kb_ >> 8)) & 1u) != 0u; if (!__all(keep_)) mask_lane(P0_, P1_, keep_); } } while (0)
#define SEAM_K0() do { VMWN(8); SWRITE_HK(0); SBAR(); } while (0)
    f32x16 pA0, pA1, pB0, pB1; float mnA, mnB, alA, alB; bf16x8 pa0, pa1, pa2, pa3;
    SWRITE_HV(0); SBAR();
    if (NT > 1) { SLOAD_H(Kh, Vh, KBASE(1)); }
    constexpr int NPB_ = (MOBA ? HA : HB * 4) * 8; unsigned pi_ = 0u; if (tid == 0) pi_ = xb_add(C.qctr + 64 * C.q0, 1u);
    SBAR(); qkt<0>(pA0, pA1, K_lds, r32, hi, S.qr, aa, BIAS(0));
    MASKT(pA0, pA1, 0); partialSM(pA0, pA1, m_reg, mnA, alA);
    if (NT > 1) { VMW(); SWRITE_H(1); }
    if (tid == 0) *C.nw = pi_ < (unsigned)NPB_ ? C.q0 * NPB_ + (int)pi_ : attn_pull_from(C.qctr, C.q0, 1, NPB_, C.qb0, C.nq);
    __syncthreads();
#define HALF_STEP(PX0, PX1, mnX, alX, PY0, PY1, alY, t, KB, VB, SB) do {                                                      \
        SBAR(); qkt<KB>(PX0, PX1, K_lds, r32, hi, S.qr, aa, BIAS(t));                                                         \
        finishSM(PY0, PY1, alY, l_reg, pa0, pa1, pa2, pa3); SBAR();                                                           \
        if ((t) + 1 < NT) { SLOAD_H(Kh, Vh, KBASE((t) + 1)); SBAR(); }                                                        \
        pv_tile<VB>(o, vb0, pa0, pa1, pa2, pa3); MASKT(PX0, PX1, (t)); partialSM(PX0, PX1, m_reg, mnX, alX);                  \
        __syncthreads();                                                                                                      \
        if ((t) + 1 < NT) { VMW(); SWRITE_H(SB); }                                                                            \
        RESC(alX); __syncthreads(); } while (0)
    for (int t = 1; t + 1 < NT; t += 2) {
        HALF_STEP(pB0, pB1, mnB, alB, pA0, pA1, alA, t, 1, 0, 0);
        HALF_STEP(pA0, pA1, mnA, alA, pB0, pB1, alB, t + 1, 0, 1, 1);
    }
    const bool even = (NT & 1) == 0;
    if (even) { SBAR(); qkt<1>(pB0, pB1, K_lds, r32, hi, S.qr, aa, BIAS(NT - 1)); SBAR(); }
    const int nc_ = __builtin_amdgcn_readfirstlane(*C.nw); const BlockRef nxt = nc_ >= 0 ? attn_ref_blk<MOBA>(nc_, C) : cur;
    SLOAD_H(nxt.K, nxt.V, nxt.jlo * KVBLK); SBAR();
    { const unsigned qoff = (unsigned)(r32 * LDQ + hi * 8); const bf16_t* qb_ = nxt.Q + (size_t)(wid * QBLK) * LDQ;
      _Pragma("unroll") for (int d0 = 0; d0 < 8; ++d0) S.qr[d0] = ld8(qb_ + qoff + d0 * 16); }
    SBAR();
    finishSM(pA0, pA1, alA, l_reg, pa0, pa1, pa2, pa3); SBAR();
    pv_tile<0>(o, vb0, pa0, pa1, pa2, pa3);
    if (even) { MASKT(pB0, pB1, NT - 1); partialSM(pB0, pB1, m_reg, mnB, alB); __syncthreads(); RESC(alB);
        finishSM(pB0, pB1, alB, l_reg, pa0, pa1, pa2, pa3); SBAR(); pv_tile<1>(o, vb0, pa0, pa1, pa2, pa3); }
    SBAR(); SEAM_K0();
    if (hi == 0) li_l[r32] = l_reg; asm volatile("s_waitcnt lgkmcnt(0)" ::: "memory");
    float rli[16];
#pragma unroll
    for (int r = 0; r < 16; ++r) rli[r] = __builtin_amdgcn_rcpf(li_l[crow(r, hi)]);
    bf16_t* Ow = cur.O + (size_t)(wid * QBLK) * LDO;
#pragma unroll
    for (int r = 0; r < 16; ++r) { const int orow = crow(r, hi);
#pragma unroll
        for (int d0 = 0; d0 < 4; ++d0) { const float v = o[d0][r] * rli[r];
            const float vn = xor1_get(v);
            if ((r32 & 1) == 0) *(unsigned*)(Ow + (size_t)orow * LDO + d0 * 32 + r32) = cvt_pk_bf16(v, vn); } }
    __syncthreads();
    return nc_;
#undef RESC
#undef KBASE
#undef BIAS
#undef MASKT
#undef SEAM_K0
#undef HALF_STEP
}
#undef AROW
#undef VMW
#undef VMWN
#undef SLOAD_H
#undef SWRITE_HK
#undef SWRITE_HV
#undef SWRITE_H
}

constexpr int NWAVES = 8, NTHREADS = NWAVES * 64, NPHASE = 17;
struct Args { const float* in[23]; float* out; unsigned char* ws; int ph_lo, ph_hi; };
struct Frame { LAS unsigned char* lds; int tid, lane, wave, G, vc, gw, NGW; };
typedef const __attribute__((address_space(4))) Args* KAP;

struct WJob { const float* src; void* dst; const float* gain; float sc; int K, N, mode, kb, nb, f8; };
__device__ __forceinline__ int wdrow(int n, int mode) { return mode == 0 ? n : ((n >> 7) * 256 + (mode == 2 ? 128 : 0) + (n & 127)); }
constexpr int I_QKV = 32 * 24, I_OA = 32 * 8, I_G = 32 * 22, I_DN = 88 * 8, I_KV = 32 * 16, I_QB = 32 * 8, I_OB = 32 * 8, I_E1 = 32 * 28, I_EG = 8 * I_E1, I_ED1 = 112 * 8, I_ED = 8 * I_ED1;
constexpr int W_NITEMS0 = I_QKV + I_OA + 2 * I_G + I_DN + I_KV + I_QB + I_OB;
constexpr int W_NEXP = 2 * I_EG + I_ED, W_NITEMS = W_NITEMS0 + W_NEXP;
__device__ __forceinline__ void wjob_decode(KAP ap, int item, WJob& j) {
    unsigned char* ws = ap->ws; int r = item; int nbn; j.f8 = 0; j.sc = 1.0f;
    if (r < I_QKV) { j.src = ap->in[2]; j.dst = (bf16_t*)(ws + WS_WQKV); j.gain = ap->in[1]; j.K = DM; j.N = NQKV; j.mode = 0; }
    else if ((r -= I_QKV) < I_OA) { j.src = ap->in[3]; j.dst = (bf16_t*)(ws + WS_WOA); j.gain = nullptr; j.K = DM; j.N = DM; j.mode = 0; }
    else if ((r -= I_OA) < I_G) { j.src = ap->in[15]; j.dst = (bf16_t*)(ws + WS_WGU); j.gain = ap->in[14]; j.K = DM; j.N = FF; j.mode = 1; }
    else if ((r -= I_G) < I_G) { j.src = ap->in[16]; j.dst = (bf16_t*)(ws + WS_WGU); j.gain = ap->in[14]; j.K = DM; j.N = FF; j.mode = 2; }
    else if ((r -= I_G) < I_DN) { j.src = ap->in[17]; j.dst = (bf16_t*)(ws + WS_WDN); j.gain = nullptr; j.K = FF; j.N = DM; j.mode = 0; }
    else if ((r -= I_DN) < I_KV) { j.src = ap->in[5]; j.dst = (bf16_t*)(ws + WS_WKVQ); j.gain = ap->in[4]; j.K = DM; j.N = 2 * DM; j.mode = 0; }
    else if ((r -= I_KV) < I_QB) { j.src = ap->in[7]; j.dst = (bf16_t*)(ws + WS_WKVQ) + (size_t)2 * DM * DM; j.gain = ap->in[6]; j.K = DM; j.N = DM; j.mode = 0; }
    else if ((r -= I_QB) < I_OB) { j.src = ap->in[13]; j.dst = (bf16_t*)(ws + WS_WOB); j.gain = nullptr; j.K = DM; j.N = DM; j.mode = 0; }
    else if ((r -= I_OB) < I_EG) { const int e = r / I_E1; r -= e * I_E1; j.src = ap->in[19] + (size_t)e * DM * FE; j.dst = ws + WS_WEGU + (size_t)e * 2 * FE * DM; j.gain = ap->in[14] + DM; j.K = DM; j.N = FE; j.mode = 1; j.f8 = 1; j.sc = WEGU_SC; }
    else if ((r -= I_EG) < I_EG) { const int e = r / I_E1; r -= e * I_E1; j.src = ap->in[20] + (size_t)e * DM * FE; j.dst = ws + WS_WEGU + (size_t)e * 2 * FE * DM; j.gain = ap->in[14] + DM; j.K = DM; j.N = FE; j.mode = 2; j.f8 = 1; j.sc = WEGU_SC; }
    else { r -= I_EG; const int e = r / I_ED1; r -= e * I_ED1; j.src = ap->in[21] + (size_t)e * FE * DM; j.dst = ws + WS_WEDN + (size_t)e * DM * FE; j.gain = nullptr; j.K = FE; j.N = DM; j.mode = 0; j.f8 = 1; j.sc = WEDN_SC; }
    nbn = j.N >> 8; j.kb = r / nbn; j.nb = r - j.kb * nbn;
}
__device__ __forceinline__ void p0_weights(KAP a, Frame& F, int first, const int end, const int stride) {
    LAS float* tile = (LAS float*)F.lds;
    const int w = F.wave, l = F.lane;
    float v[32];
    int item = first; bool have = item < end; WJob j;
#define W_LOAD() do { const float* sp = j.src + (size_t)(j.kb * 64 + w) * j.N + j.nb * 256 + l; \
        _Pragma("unroll") for (int i = 0; i < 8; ++i) _Pragma("unroll") for (int c = 0; c < 4; ++c) v[i * 4 + c] = __builtin_nontemporal_load(sp + (size_t)(8 * i) * j.N + 64 * c); } while (0)
    if (have) { wjob_decode(a, item, j); W_LOAD(); }
    while (have) {
        __syncthreads();
#pragma unroll
        for (int i = 0; i < 8; ++i) { const int k = w + 8 * i; const float g = (j.gain ? j.gain[j.kb * 64 + k] : 1.0f) * j.sc;
#pragma unroll
            for (int c = 0; c < 4; ++c) tile[k * 257 + l + 64 * c] = v[i * 4 + c] * g; }
        void* cdst = j.dst; const int cK = j.K, cmode = j.mode, ckb = j.kb, cnb = j.nb, cf8 = j.f8;
        item += stride; const bool have_next = item < end;
        if (have_next) { wjob_decode(a, item, j); W_LOAD(); }
        __syncthreads();
        if (cf8) {
            const int c4 = l >> 4, n16 = l & 15;
#pragma unroll
            for (int jj = 0; jj < 2; ++jj) { const int n = n16 + 16 * w + 128 * jj; const LAS float* s = tile + (16 * c4) * 257 + n;
                u32x4 o; o.x = pg8::pk4_fp8(s[0], s[257], s[2 * 257], s[3 * 257]); o.y = pg8::pk4_fp8(s[4 * 257], s[5 * 257], s[6 * 257], s[7 * 257]);
                o.z = pg8::pk4_fp8(s[8 * 257], s[9 * 257], s[10 * 257], s[11 * 257]); o.w = pg8::pk4_fp8(s[12 * 257], s[13 * 257], s[14 * 257], s[15 * 257]);
                *(u32x4*)((unsigned char*)cdst + (size_t)wdrow(cnb * 256 + n, cmode) * cK + ckb * 64 + 16 * c4) = o; }
        } else {
        const int c8 = l >> 3, nn = l & 7;
#pragma unroll
        for (int jj = 0; jj < 4; ++jj) { const int n = nn + 8 * w + 64 * jj; const LAS float* s = tile + (8 * c8) * 257 + n;
            u32x4 o; o.x = cvt_pk_bf16(s[0], s[257]); o.y = cvt_pk_bf16(s[2 * 257], s[3 * 257]); o.z = cvt_pk_bf16(s[4 * 257], s[5 * 257]); o.w = cvt_pk_bf16(s[6 * 257], s[7 * 257]);
            *(u32x4*)((bf16_t*)cdst + (size_t)wdrow(cnb * 256 + n, cmode) * cK + ckb * 64 + 8 * c8) = o; }
        }
        have = have_next;
    }
#undef W_LOAD
    __syncthreads();
}
#ifndef W_DEEP4
#define W_DEEP4 1
#endif
__device__ __forceinline__ void p0_weights2(KAP a, Frame& F, int first, const int end, const int stride) {
    const int w = F.wave, l = F.lane;
    float va[32], vb[32];
    WJob ja, jb;
#define W_LOAD2(J, V) do { const float* sp = (J).src + (size_t)((J).kb * 64 + w) * (J).N + (J).nb * 256 + l; \
        _Pragma("unroll") for (int i = 0; i < 8; ++i) _Pragma("unroll") for (int c = 0; c < 4; ++c) (V)[i * 4 + c] = __builtin_nontemporal_load(sp + (size_t)(8 * i) * (J).N + 64 * c); } while (0)
#define W_ITEM2(J, V, TILE, NEXT_ITEM) do { \
        LAS float* tile = (LAS float*)F.lds + (TILE) * (64 * 257); \
        _Pragma("unroll") for (int i = 0; i < 8; ++i) { const int k = w + 8 * i; const float g = ((J).gain ? (J).gain[(J).kb * 64 + k] : 1.0f) * (J).sc; \
            _Pragma("unroll") for (int c = 0; c < 4; ++c) tile[k * 257 + l + 64 * c] = (V)[i * 4 + c] * g; } \
        void* cdst = (J).dst; const int cK = (J).K, cmode = (J).mode, ckb = (J).kb, cnb = (J).nb, cf8 = (J).f8; \
        if ((NEXT_ITEM) < end) { wjob_decode(a, (NEXT_ITEM), (J)); W_LOAD2(J, V); } \
        __syncthreads(); \
        if (cf8) { const int c4 = l >> 4, n16 = l & 15; \
            _Pragma("unroll") for (int jj = 0; jj < 2; ++jj) { const int n = n16 + 16 * w + 128 * jj; const LAS float* s = tile + (16 * c4) * 257 + n; \
                u32x4 o; o.x = pg8::pk4_fp8(s[0], s[257], s[2 * 257], s[3 * 257]); o.y = pg8::pk4_fp8(s[4 * 257], s[5 * 257], s[6 * 257], s[7 * 257]); \
                o.z = pg8::pk4_fp8(s[8 * 257], s[9 * 257], s[10 * 257], s[11 * 257]); o.w = pg8::pk4_fp8(s[12 * 257], s[13 * 257], s[14 * 257], s[15 * 257]); \
                *(u32x4*)((unsigned char*)cdst + (size_t)wdrow(cnb * 256 + n, cmode) * cK + ckb * 64 + 16 * c4) = o; } \
        } else { const int c8 = l >> 3, nn = l & 7; \
            _Pragma("unroll") for (int jj = 0; jj < 4; ++jj) { const int n = nn + 8 * w + 64 * jj; const LAS float* s = tile + (8 * c8) * 257 + n; \
                u32x4 o; o.x = cvt_pk_bf16(s[0], s[257]); o.y = cvt_pk_bf16(s[2 * 257], s[3 * 257]); o.z = cvt_pk_bf16(s[4 * 257], s[5 * 257]); o.w = cvt_pk_bf16(s[6 * 257], s[7 * 257]); \
                *(u32x4*)((bf16_t*)cdst + (size_t)wdrow(cnb * 256 + n, cmode) * cK + ckb * 64 + 8 * c8) = o; } } \
    } while (0)
    int item = first;
    __syncthreads();
#if W_DEEP4
    float vc[32], vd[32]; WJob jc, jd;
    if (item < end) { wjob_decode(a, item, ja); W_LOAD2(ja, va); }
    if (item + stride < end) { wjob_decode(a, item + stride, jb); W_LOAD2(jb, vb); }
    if (item + 2 * stride < end) { wjob_decode(a, item + 2 * stride, jc); W_LOAD2(jc, vc); }
    if (item + 3 * stride < end) { wjob_decode(a, item + 3 * stride, jd); W_LOAD2(jd, vd); }
    for (; item < end; item += 4 * stride) {
        W_ITEM2(ja, va, 0, item + 4 * stride);
        if (item + stride < end) W_ITEM2(jb, vb, 1, item + 5 * stride);
        if (item + 2 * stride < end) W_ITEM2(jc, vc, 0, item + 6 * stride);
        if (item + 3 * stride < end) W_ITEM2(jd, vd, 1, item + 7 * stride);
    }
#else
    if (item < end) { wjob_decode(a, item, ja); W_LOAD2(ja, va); }
    if (item + stride < end) { wjob_decode(a, item + stride, jb); W_LOAD2(jb, vb); }
    for (; item < end; item += 2 * stride) {
        W_ITEM2(ja, va, 0, item + 2 * stride);
        if (item + stride < end) W_ITEM2(jb, vb, 1, item + 3 * stride);
    }
#endif
#undef W_LOAD2
#undef W_ITEM2
    __syncthreads();
}
__device__ __forceinline__ void p0_weights_r(KAP a, Frame& F, int first, const int end, const int wg, const int nwg) {
    const int t = F.tid & 255, half = __builtin_amdgcn_readfirstlane(F.tid >> 8), nq = t & 15, kq = (t >> 4) & 3, ng = t >> 6;
    const int n0 = ng * 64 + nq * 4, k0 = kq * 16, nworkers = 2 * nwg;
    f32x4 va[16], vb[16], ga[4], gb[4]; WJob ja, jb;
#define WR_LOAD(J, V, G) do { const char* ub = (const char*)((J).src + (size_t)(J).kb * 64 * (J).N + (J).nb * 256); const unsigned loff = (unsigned)(k0 * (J).N + n0) * 4u; \
        _Pragma("unroll") for (int i = 0; i < 16; ++i) (V)[i] = __builtin_nontemporal_load((const f32x4*)(ub + (size_t)i * (J).N * 4 + loff)); \
        _Pragma("unroll") for (int i = 0; i < 4; ++i) (G)[i] = (J).gain ? *(const f32x4*)((J).gain + (J).kb * 64 + k0 + 4 * i) : (f32x4){1.f, 1.f, 1.f, 1.f}; } while (0)
#define WR_ITEM(J, V, G, NEXT_ITEM) do { \
        _Pragma("unroll") for (int i = 0; i < 4; ++i) (G)[i] = (G)[i] * (J).sc; \
        unsigned char* cdst = (unsigned char*)(J).dst; const int cK = (J).K, cmode = (J).mode, ckb = (J).kb, cnb = (J).nb; \
        _Pragma("unroll") for (int j = 0; j < 4; ++j) { u32x4 o; \
            o.x = pg8::pk4_fp8((V)[0][j] * (G)[0][0], (V)[1][j] * (G)[0][1], (V)[2][j] * (G)[0][2], (V)[3][j] * (G)[0][3]); o.y = pg8::pk4_fp8((V)[4][j] * (G)[1][0], (V)[5][j] * (G)[1][1], (V)[6][j] * (G)[1][2], (V)[7][j] * (G)[1][3]); \
            o.z = pg8::pk4_fp8((V)[8][j] * (G)[2][0], (V)[9][j] * (G)[2][1], (V)[10][j] * (G)[2][2], (V)[11][j] * (G)[2][3]); o.w = pg8::pk4_fp8((V)[12][j] * (G)[3][0], (V)[13][j] * (G)[3][1], (V)[14][j] * (G)[3][2], (V)[15][j] * (G)[3][3]); \
            *(u32x4*)(cdst + (size_t)wdrow(cnb * 256 + n0 + j, cmode) * cK + ckb * 64 + k0) = o; } \
        if ((NEXT_ITEM) < end) { wjob_decode(a, (NEXT_ITEM), (J)); WR_LOAD(J, V, G); } \
    } while (0)
    int item = first + 2 * wg + half;
    if (item < end) { wjob_decode(a, item, ja); WR_LOAD(ja, va, ga); }
    if (item + nworkers < end) { wjob_decode(a, item + nworkers, jb); WR_LOAD(jb, vb, gb); }
    for (; item < end; item += 2 * nworkers) {
        WR_ITEM(ja, va, ga, item + 2 * nworkers);
        if (item + nworkers < end) WR_ITEM(jb, vb, gb, item + 3 * nworkers);
    }
#undef WR_LOAD
#undef WR_ITEM
}
__device__ __forceinline__ void p0_x(const float* x, bf16_t* xb, u64* ss0, Frame& F) {
    for (int row = F.gw; row < MTOK; row += F.NGW) {
        const f32x4* xr = (const f32x4*)(x + (size_t)row * DM) + F.lane; f32x4 v[8]; float s = 0.f;
#pragma unroll
        for (int j = 0; j < 8; ++j) { v[j] = __builtin_nontemporal_load(xr + 64 * j); s += (v[j].x * v[j].x + v[j].y * v[j].y) + (v[j].z * v[j].z + v[j].w * v[j].w); }
        s = wave_sum(s);
        u32x2* o8 = (u32x2*)(xb + (size_t)row * DM) + F.lane;
#pragma unroll
        for (int j = 0; j < 8; ++j) { u32x2 w; w.x = cvt_pk_bf16(v[j].x, v[j].y); w.y = cvt_pk_bf16(v[j].z, v[j].w); o8[64 * j] = w; }
        if (F.lane == 0) ss0[row] = ss_fix(s);
    }
}
__device__ __forceinline__ void p2_kmean(const bf16_t* qkv, float* kmean, Frame& F, int u0, int nu) {
    const int c16 = F.lane & 15, rg = F.lane >> 4;
    for (int u = u0 + F.gw; u < u0 + nu; u += F.NGW) {
        const int bh = u >> 3, jb = u & 7, b = bh / HA, h = bh % HA;
        const bf16_t* kp = qkv + (size_t)(b * SEQ + jb * 256 + rg) * NQKV + DM + h * 128 + 8 * c16;
        float s[8] = {0.f, 0.f, 0.f, 0.f, 0.f, 0.f, 0.f, 0.f};
#pragma unroll 8
        for (int i = 0; i < 64; ++i) { const u32x4 q = *(const u32x4*)(kp + (size_t)(4 * i) * NQKV);
            s[0] += __uint_as_float(q.x << 16); s[1] += __uint_as_float(q.x & 0xffff0000u); s[2] += __uint_as_float(q.y << 16); s[3] += __uint_as_float(q.y & 0xffff0000u);
            s[4] += __uint_as_float(q.z << 16); s[5] += __uint_as_float(q.z & 0xffff0000u); s[6] += __uint_as_float(q.w << 16); s[7] += __uint_as_float(q.w & 0xffff0000u); }
#pragma unroll
        for (int e = 0; e < 8; ++e) s[e] = sum_xor32(sum_xor16(s[e]));
        if (rg == 0) { float* kd = kmean + (size_t)u * 128 + 8 * c16;
            *(f32x4*)kd = (f32x4){s[0], s[1], s[2], s[3]} * (1.0f / 256.0f); *(f32x4*)(kd + 4) = (f32x4){s[4], s[5], s[6], s[7]} * (1.0f / 256.0f); }
    }
}
__device__ __forceinline__ void p3_select(const bf16_t* qkv, const float* kmean, unsigned char* sel, Frame& F, int u0, int nu) {
    LAS float* km = (LAS float*)F.lds;
    for (int u = u0 + F.vc; u < u0 + nu; u += F.G) {
        const int bh = u >> 2, ch = u & 3, b = bh / HA, h = bh % HA;
        __syncthreads();
        km[F.tid] = kmean[(size_t)bh * 1024 + F.tid]; km[F.tid + 512] = kmean[(size_t)bh * 1024 + 512 + F.tid];
        __syncthreads();
        const int s = ch * 512 + F.tid, own = s >> 8;
        const bf16_t* qp = qkv + (size_t)(b * SEQ + s) * NQKV + h * 128;
        float gate[8] = {0.f, 0.f, 0.f, 0.f, 0.f, 0.f, 0.f, 0.f};
        if (own > 0) {
#pragma unroll 4
            for (int c = 0; c < 16; ++c) { const u32x4 q = *(const u32x4*)(qp + 8 * c);
                const float q0 = __uint_as_float(q.x << 16), q1 = __uint_as_float(q.x & 0xffff0000u), q2 = __uint_as_float(q.y << 16), q3 = __uint_as_float(q.y & 0xffff0000u);
                const float q4 = __uint_as_float(q.z << 16), q5 = __uint_as_float(q.z & 0xffff0000u), q6 = __uint_as_float(q.w << 16), q7 = __uint_as_float(q.w & 0xffff0000u);
#pragma unroll
                for (int jb = 0; jb < 8; ++jb) { const f32x4 k0 = *(const LAS f32x4*)(km + jb * 128 + 8 * c), k1 = *(const LAS f32x4*)(km + jb * 128 + 8 * c + 4);
                    gate[jb] += (q0 * k0.x + q1 * k0.y) + (q2 * k0.z + q3 * k0.w) + (q4 * k1.x + q5 * k1.y) + (q6 * k1.z + q7 * k1.w); } }
        }
        unsigned mask = 0u; const int nsel = own < 3 ? own : 3;
#pragma unroll
        for (int it = 0; it < 3; ++it) { if (it < nsel) { int best = -1; float bv = -__builtin_inff();
#pragma unroll
                for (int jb = 0; jb < 8; ++jb) { const bool ok = (jb < own) && (((mask >> jb) & 1u) == 0u) && (best < 0 || gate[jb] > bv); if (ok) { bv = gate[jb]; best = jb; } }
                if (best >= 0) mask |= 1u << best; } }
        sel[(size_t)bh * SEQ + s] = (unsigned char)mask;
    }
    __syncthreads();
}
template <bool MOBA> __device__ __forceinline__ void attn_phase(char* lds, const bf16_t* qkv, bf16_t* out, const unsigned char* sel, const unsigned* bnd, unsigned* qctr, int qb0, int nq, Frame& F) {
    constexpr int NPB = (MOBA ? HA : HB * 4) * 8;
    att::DynCtx C{qkv, out, sel, bnd, qctr, (volatile LAS int*)(F.lds + 70000), qb0 + (int)(xb_xcc_id() & (unsigned)(nq - 1)), qb0, nq};
    __syncthreads();
    if (F.tid == 0) *C.nw = att::attn_pull_from(qctr, C.q0, 0, NPB, qb0, nq);
    __syncthreads();
    int code = __builtin_amdgcn_readfirstlane(*C.nw); if (code < 0) return;
    att::BlockRef cur = att::attn_ref_blk<MOBA>(code, C); att::Seam S;
    att::attn_prime(cur, lds, S);
    for (;;) {
        code = att::attn_block<MOBA>(cur, C, lds, S);
        if (code < 0) break;
        cur = att::attn_ref_blk<MOBA>(code, C);
    }
}
__device__ __forceinline__ void p10_combine(KAP a, const bf16_t* omap, bf16_t* ao, Frame& F, int t0, int nt) {
    const int l = F.lane;
    float d1 = a->in[8][l] * a->in[9][l] + a->in[8][l + 64] * a->in[9][l + 64], d2 = a->in[10][l] * a->in[11][l] + a->in[10][l + 64] * a->in[11][l + 64];
    d1 = wave_sum(d1); d2 = wave_sum(d2);
    const float lam = __expf(d1) - __expf(d2) + LAM_INIT;
    const f32x4 g = *(const f32x4*)(a->in[12] + 4 * l);
    for (int tok = t0 + F.gw; tok < t0 + nt; tok += F.NGW) {
        const bf16_t* p1 = omap + (size_t)tok * DM + 4 * l; const bf16_t* p2 = p1 + (size_t)MTOK * DM; bf16_t* po = ao + (size_t)tok * DM + 4 * l;
        u32x2 x1v[HB], x2v[HB];
#pragma unroll
        for (int h = 0; h < HB; ++h) { x1v[h] = *(const u32x2*)(p1 + h * 256); x2v[h] = *(const u32x2*)(p2 + h * 256); }
#pragma unroll
        for (int h = 0; h < HB; ++h) { const u32x2 x1 = x1v[h], x2 = x2v[h];
            f32x4 d; d.x = __uint_as_float(x1.x << 16) - lam * __uint_as_float(x2.x << 16); d.y = __uint_as_float(x1.x & 0xffff0000u) - lam * __uint_as_float(x2.x & 0xffff0000u);
            d.z = __uint_as_float(x1.y << 16) - lam * __uint_as_float(x2.y << 16); d.w = __uint_as_float(x1.y & 0xffff0000u) - lam * __uint_as_float(x2.y & 0xffff0000u);
            float ss = wave_sum((d.x * d.x + d.y * d.y) + (d.z * d.z + d.w * d.w));
            const float r = __builtin_amdgcn_rsqf(ss * (1.0f / 256.0f) + RMS_EPS) * (1.0f - LAM_INIT);
            u32x2 w; w.x = cvt_pk_bf16(d.x * r * g.x, d.y * r * g.y); w.y = cvt_pk_bf16(d.z * r * g.z, d.w * r * g.w); *(u32x2*)(po + h * 256) = w; }
    }
}
__device__ __forceinline__ void p12_router(KAP a, const bf16_t* xb, const u64* ss3, unsigned* gcnt, int* tokinfo, unsigned char* xs, Frame& F, int c0, int nc) {
    LAS float* gwt = (LAS float*)F.lds;
    LAS unsigned* cnt = (LAS unsigned*)(F.lds + 65536); LAS unsigned* base = cnt + 8;
    const float* wr = a->in[18]; const float* g1 = a->in[14] + DM;
    __syncthreads();
    for (int idx = F.tid; idx < DM * NE; idx += NTHREADS) gwt[idx] = wr[idx] * g1[idx >> 3];
    if (F.tid < 8) cnt[F.tid] = 0u;
    __syncthreads();
    const int l = F.lane;
    for (int chunk = c0 + F.vc; chunk < c0 + nc; chunk += F.G) {
        int e0v = 0, e1v = 0, i0v = 0, i1v = 0; float g0v = 0.f, g1v = 0.f;
        float lgs[8][8];
#pragma unroll
        for (int i = 0; i < 8; ++i)
#pragma unroll
            for (int e = 0; e < 8; ++e) lgs[i][e] = 0.f;
        { const bf16_t* xp0 = xb + (size_t)(chunk * 64 + F.wave * 8) * DM + l;
#pragma unroll 4
          for (int j = 0; j < 32; ++j) { const LAS f32x4* wp = (const LAS f32x4*)(gwt + (l + 64 * j) * 8); const f32x4 w0 = wp[0], w1 = wp[1];
#pragma unroll
              for (int i = 0; i < 8; ++i) { const float xv = bf2f(xp0[(size_t)i * DM + 64 * j]);
                  lgs[i][0] += xv * w0.x; lgs[i][1] += xv * w0.y; lgs[i][2] += xv * w0.z; lgs[i][3] += xv * w0.w; lgs[i][4] += xv * w1.x; lgs[i][5] += xv * w1.y; lgs[i][6] += xv * w1.z; lgs[i][7] += xv * w1.w; } } }
#pragma unroll
        for (int i = 0; i < 8; ++i) {
            const int tok = chunk * 64 + F.wave * 8 + i;
            float lg[8];
            const float rs = rstd_q(ss3[tok]);
#pragma unroll
            for (int e = 0; e < 8; ++e) lg[e] = wave_sum(lgs[i][e]) * rs;
            int b0 = 0; float v0 = lg[0];
#pragma unroll
            for (int e = 1; e < 8; ++e) if (lg[e] > v0) { v0 = lg[e]; b0 = e; }
            int b1 = -1; float v1 = -__builtin_inff();
#pragma unroll
            for (int e = 0; e < 8; ++e) if (e != b0 && (b1 < 0 || lg[e] > v1)) { v1 = lg[e]; b1 = e; }
            const float ga = 1.0f / (1.0f + __expf(v1 - v0));
            unsigned i0 = 0u, i1 = 0u;
            if (l == 0) { i0 = __hip_atomic_fetch_add(&cnt[b0], 1u, __ATOMIC_RELAXED, __HIP_MEMORY_SCOPE_WORKGROUP); i1 = __hip_atomic_fetch_add(&cnt[b1], 1u, __ATOMIC_RELAXED, __HIP_MEMORY_SCOPE_WORKGROUP); }
            i0 = __builtin_amdgcn_readfirstlane(i0); i1 = __builtin_amdgcn_readfirstlane(i1);
            if (l == i) { e0v = b0; e1v = b1; i0v = (int)i0; i1v = (int)i1; g0v = ga; g1v = 1.0f - ga; }
        }
        __syncthreads();
        if (F.tid < 8) base[F.tid] = __hip_atomic_fetch_add(gcnt + 64 * F.tid, cnt[F.tid], __ATOMIC_RELAXED, __HIP_MEMORY_SCOPE_AGENT);
        __syncthreads();
        if (l < 8) { const int tok = chunk * 64 + F.wave * 8 + l; int* ti = tokinfo + (size_t)tok * 8;
            ti[0] = e0v; ti[1] = e1v; ti[2] = (int)base[e0v] + i0v; ti[3] = (int)base[e1v] + i1v; ti[4] = __float_as_int(g0v); ti[5] = __float_as_int(g1v); }
#pragma unroll
        for (int h = 0; h < 2; ++h) { u32x2 xv[4][8];
#pragma unroll
            for (int i = 0; i < 4; ++i) { const u32x2* sp = (const u32x2*)(xb + (size_t)(chunk * 64 + F.wave * 8 + 4 * h + i) * DM) + l;
#pragma unroll
                for (int j = 0; j < 8; ++j) xv[i][j] = sp[64 * j]; }
#pragma unroll
            for (int i = 0; i < 4; ++i) { const int ii = 4 * h + i, tok = chunk * 64 + F.wave * 8 + ii;
                const int e0 = __builtin_amdgcn_readlane(e0v, ii), e1 = __builtin_amdgcn_readlane(e1v, ii), q0 = __builtin_amdgcn_readlane(i0v, ii), q1 = __builtin_amdgcn_readlane(i1v, ii);
                const size_t row0 = (size_t)e0 * MTOK + base[e0] + q0, row1 = (size_t)e1 * MTOK + base[e1] + q1;
                const float rs = rstd_q(ss3[tok]) * XS_SC;
                unsigned* d0 = (unsigned*)(xs + row0 * DM) + l; unsigned* d1 = (unsigned*)(xs + row1 * DM) + l;
#pragma unroll
                for (int j = 0; j < 8; ++j) { const u32x2 b = xv[i][j];
                    const unsigned q = pg8::pk4_fp8(__uint_as_float(b.x << 16) * rs, __uint_as_float(b.x & 0xffff0000u) * rs, __uint_as_float(b.y << 16) * rs, __uint_as_float(b.y & 0xffff0000u) * rs); d0[64 * j] = q; d1[64 * j] = q; } } }
        __syncthreads();
        if (F.tid < 8) cnt[F.tid] = 0u;
        __syncthreads();
    }
}
__device__ __forceinline__ void p13_gather(const bf16_t* xb, const u64* ss3, unsigned* gcnt, int* tiles, int* tokinfo, unsigned char* xs, Frame& F) {
    LAS int* pst = (LAS int*)F.lds;
    __syncthreads();
    if (F.tid == 0) { int acc = 0;
        for (int e = 0; e < NE; ++e) { const int c = (int)__hip_atomic_load(gcnt + 64 * e, __ATOMIC_RELAXED, __HIP_MEMORY_SCOPE_AGENT); const int p = (c + 255) & ~255;
            pst[e] = acc; pst[8 + e] = c; pst[16 + e] = p;
            if (blockIdx.x == 0) for (int t = acc >> 8; t < (acc + p) >> 8; ++t) tiles[1 + t] = e;
            acc += p; }
        if (blockIdx.x == 0) tiles[0] = acc >> 8; }
    __syncthreads();
    const int l = F.lane;
    for (int tok = F.gw; tok < MTOK; tok += F.NGW) {
        int* ti = tokinfo + (size_t)tok * 8;
        const int row0 = pst[ti[0]] + ti[2], row1 = pst[ti[1]] + ti[3];
        if (l == 0) { ti[6] = row0; ti[7] = row1; }
        const float rs = rstd_q(ss3[tok]) * XS_SC;
        const u32x2* sp = (const u32x2*)(xb + (size_t)tok * DM) + l; unsigned* d0 = (unsigned*)(xs + (size_t)row0 * DM) + l; unsigned* d1 = (unsigned*)(xs + (size_t)row1 * DM) + l;
#pragma unroll
        for (int j = 0; j < 8; ++j) { const u32x2 b = sp[64 * j];
            const unsigned q = pg8::pk4_fp8(__uint_as_float(b.x << 16) * rs, __uint_as_float(b.x & 0xffff0000u) * rs, __uint_as_float(b.y << 16) * rs, __uint_as_float(b.y & 0xffff0000u) * rs); d0[64 * j] = q; d1[64 * j] = q; }
    }
    for (int e = 0; e < NE; ++e) { const int lo = pst[e] + pst[8 + e], hi = pst[e] + pst[16 + e];
        for (int r = lo + F.gw; r < hi; r += F.NGW) { u32x4* d = (u32x4*)(xs + (size_t)r * DM) + l; d[0] = (u32x4){0u, 0u, 0u, 0u}; d[64] = (u32x4){0u, 0u, 0u, 0u}; } }
    __syncthreads();
}
__device__ __forceinline__ void ys_row(const bf16_t* ys, const float* slab, int split0, size_t ks_stride, int row, int l, f32x4 (&a)[8]) {
    if (row >= split0) { const float* p = slab + (size_t)(row - split0) * DM + 4 * l;
#pragma unroll
        for (int j = 0; j < 8; ++j) { f32x4 t = *(const f32x4*)(p + 256 * j);
#pragma unroll
            for (int ks = 1; ks < TAIL_NS; ++ks) t = t + *(const f32x4*)(p + 256 * j + (size_t)ks * ks_stride);
            a[j] = t * (1.0f / (ACT_SC * WEDN_SC)); } }
    else { const u32x2* p = (const u32x2*)(ys + (size_t)row * DM) + l;
#pragma unroll
        for (int j = 0; j < 8; ++j) { const u32x2 q = p[64 * j]; a[j] = (f32x4){__uint_as_float(q.x << 16), __uint_as_float(q.x & 0xffff0000u), __uint_as_float(q.y << 16), __uint_as_float(q.y & 0xffff0000u)}; } }
}
constexpr int MOE_T_OFF = 131072;
__device__ __forceinline__ void moe_tables(const unsigned* gcnt, LAS int* T, Frame& F) {
    __syncthreads();
    if (F.tid == 0) { int acc = 0;
        for (int e = 0; e < NE; ++e) { const int c = (int)__hip_atomic_load(gcnt + 64 * e, __ATOMIC_RELAXED, __HIP_MEMORY_SCOPE_AGENT); const int p = (c + 255) & ~255;
            T[256 + e] = acc;
            for (int j = 0; j < (p >> 8); ++j) T[1 + (acc >> 8) + j] = e + 16 * (e * (MTOK / 256) + j);
            acc += p; }
        T[0] = acc >> 8; }
    __syncthreads();
}
__device__ __forceinline__ void p16_final(const bf16_t* xb, const bf16_t* ys, const float* slab, const int* tiles, const int* tokinfo, const float* fg, float* out, Frame& F) {
    const int l = F.lane; const int nT = tiles[0]; int rt = nT & 31; if (rt > 7) rt = 0; const int split0 = (nT - rt) * 256; const size_t ks_stride = (size_t)rt * 256 * DM;
    for (int tok = F.gw; tok < MTOK; tok += F.NGW) {
        const int* ti = tokinfo + (size_t)tok * 8; const float g0 = __int_as_float(ti[4]), g1 = __int_as_float(ti[5]); const int row0 = tiles[256 + ti[0]] + ti[2], row1 = tiles[256 + ti[1]] + ti[3];
        const u32x2* xp = (const u32x2*)(xb + (size_t)tok * DM) + l;
        f32x4 v[8], a0[8], a1[8]; float s = 0.f;
#pragma unroll
        for (int j = 0; j < 8; ++j) { const u32x2 q = xp[64 * j]; v[j] = (f32x4){__uint_as_float(q.x << 16), __uint_as_float(q.x & 0xffff0000u), __uint_as_float(q.y << 16), __uint_as_float(q.y & 0xffff0000u)}; }
        ys_row(ys, slab, split0, ks_stride, row0, l, a0); ys_row(ys, slab, split0, ks_stride, row1, l, a1);
#pragma unroll
        for (int j = 0; j < 8; ++j) { v[j] = v[j] + g0 * a0[j] + g1 * a1[j]; s += (v[j].x * v[j].x + v[j].y * v[j].y) + (v[j].z * v[j].z + v[j].w * v[j].w); }
        const float r = rstd_of(wave_sum(s));
        f32x4* op = (f32x4*)(out + (size_t)tok * DM) + l; const f32x4* gp = (const f32x4*)fg + l;
#pragma unroll
        for (int j = 0; j < 8; ++j) op[64 * j] = v[j] * r * gp[64 * j];
    }
}

#ifndef SH_LO
#define SH_LO 60
#define SH_STEP 16
#endif
static_assert(2 * (4 * SH_LO + 6 * SH_STEP) == 8 * 84, "uneven expert-weight shares must cover every item");
#ifndef PH_MASK
#define PH_MASK 0x1ffff
#endif
__global__ void __launch_bounds__(NTHREADS, 2) mega_fwd(Args args_by_value) {
    extern __shared__ __attribute__((aligned(16))) unsigned char lds[];
    (void)args_by_value;
    const KAP kap0 = (KAP)__builtin_amdgcn_kernarg_segment_ptr();
#define KARGS() ({ KAP p_ = kap0; asm volatile("" : "+s"(p_)); p_; })
    Frame F0;
#define F F0
    F.lds = (LAS unsigned char*)lds;
    F.tid = threadIdx.x; F.lane = F.tid & 63; F.wave = __builtin_amdgcn_readfirstlane(F.tid >> 6);
    F.G = gridDim.x; { const int bx = blockIdx.x; F.vc = (F.G % 8 == 0) ? (bx % 8) * (F.G / 8) + bx / 8 : bx; }
    F.gw = F.vc * NWAVES + F.wave; F.NGW = F.G * NWAVES;
    volatile LAS unsigned* MISC = (volatile LAS unsigned*)(F.lds + LDSCTL_OFF);
    for (int u = F.tid; u < (LDS_BYTES - LDSCTL_OFF) / 4; u += NTHREADS) ((LAS unsigned*)(F.lds + LDSCTL_OFF))[u] = 0u;
    __syncthreads();
    const int lo = kap0->ph_lo, hi = kap0->ph_hi;
    const bool use_bar = (hi - lo) > 1;
    XcdBarrier bar; bar.bar = (unsigned*)(kap0->ws + CTL_BAR); bar.x = 0; bar.st = MISC + 8;
    if (use_bar) bar = xcd_barrier_post((unsigned*)(kap0->ws + CTL_BAR), MISC + 8, (unsigned)F.G);
#ifndef DUP_MASK
#define DUP_MASK 0
#endif
#ifndef PROBE_SKIP_EPI
#define PROBE_SKIP_EPI 0
#endif
#ifndef PROBE_KIND
#define PROBE_KIND 4
#endif
#ifndef PROBE_PH
#define PROBE_PH 6
#endif
#ifndef PROBE_AMP
#define PROBE_AMP 4
#endif
#ifndef PROBE_PHM
#define PROBE_PHM (1 << PROBE_PH)
#endif
#define PROBE_SEL(k) ((PROBE_KIND == 2 || PROBE_KIND == 3) ? ((PROBE_PHM >> (k)) & 1) : ((k) == PROBE_PH))
#if PROBE_KIND
#define PROBE_ME (blockIdx.x == 0 && F0.tid == 0)
#define PROBE_B(k) do { if (PROBE_SEL(k) && PROBE_ME) { const unsigned long long r_ = __builtin_amdgcn_s_memrealtime(), t_ = __builtin_amdgcn_s_memtime(); MISC[16] = (unsigned)r_; MISC[17] = (unsigned)(r_ >> 32); MISC[18] = (unsigned)t_; MISC[19] = (unsigned)(t_ >> 32); } } while (0)
#define PROBE_E(k) do { if (PROBE_SEL(k) && PROBE_ME) { const unsigned long long r_ = __builtin_amdgcn_s_memrealtime(), t_ = __builtin_amdgcn_s_memtime(); \
        const unsigned long long r0_ = ((unsigned long long)MISC[17] << 32) | MISC[16], t0_ = ((unsigned long long)MISC[19] << 32) | MISC[18]; const unsigned long long dr_ = r_ - r0_, dt_ = t_ - t0_; \
        if (PROBE_KIND == 1) MISC[20] = (unsigned)((dt_ * 10000ull) / (dr_ ? dr_ : 1ull));   \
        if (PROBE_KIND == 2) MISC[20] = MISC[20] + (unsigned)(dr_ * PROBE_AMP); \
        if (PROBE_KIND == 3) { MISC[16] = (unsigned)r_; MISC[17] = (unsigned)(r_ >> 32); } } } while (0)
#define PROBE_S(k) do { if (PROBE_KIND == 3 && PROBE_SEL(k) && PROBE_ME) { const unsigned long long r_ = __builtin_amdgcn_s_memrealtime(); const unsigned long long r0_ = ((unsigned long long)MISC[17] << 32) | MISC[16]; MISC[20] = MISC[20] + (unsigned)((r_ - r0_) * PROBE_AMP); } } while (0)
#define PROBE_FIN() do { if (PROBE_ME) { const unsigned long long r0_ = __builtin_amdgcn_s_memrealtime(); const unsigned long long d_ = MISC[20]; while (__builtin_amdgcn_s_memrealtime() - r0_ < d_) __builtin_amdgcn_s_sleep(8); } } while (0)
#else
#define PROBE_B(k) do { } while (0)
#define PROBE_E(k) do { } while (0)
#define PROBE_S(k) do { } while (0)
#define PROBE_FIN() do { } while (0)
#endif
#define PRB(k) (((PROBE_KIND == 4 || PROBE_KIND == 5) && (k) == PROBE_PH) ? MISC : (volatile LAS unsigned*)nullptr)
#define IN(k) (((PH_MASK >> (k)) & 1) && lo <= (k) && (k) < hi)
#define REP(k) for (int rep_ = 0; rep_ < (((DUP_MASK >> (k)) & 1) ? 2 : 1); ++rep_)
#define SEAM(k) do { if (IN(k) && IN((k) + 1)) { if ((k) >= 1 && (k) <= 10) xcd_barrier(barh); else xcd_barrier(bar); } } while (0)
#define WSP(T, off) ((T*)(ws + (off)))
#define FRL() ({ Frame f_ = F0; asm volatile("" : "+v"(f_.tid), "+v"(f_.lane)); f_; })
#undef F
    const int bx = blockIdx.x;
    const int ngrp = (F0.G % 8 == 0) ? 8 : 1, hb = (ngrp == 8) ? (bx & 7) : 0, nxh = 8 / ngrp, Gh = F0.G / ngrp;
    const int hidx = (ngrp == 8) ? (bx >> 3) : bx;
    const int Mh = MTOK / ngrp, R0 = hb * Mh, nMh = Mh / 256, pm0 = hb * nMh;
    Frame FH0 = F0; FH0.G = Gh; FH0.vc = (Gh % nxh == 0) ? (hidx % nxh) * (Gh / nxh) + hidx / nxh : hidx; FH0.gw = FH0.vc * NWAVES + F0.wave; FH0.NGW = Gh * NWAVES;
#define FRH() ({ Frame f_ = FH0; asm volatile("" : "+v"(f_.tid), "+v"(f_.lane)); f_; })
    int shn, sh0, nbef;
    if (ngrp == 8 && W_NEXP == 8 * 84 * 32 && Gh == 32) { int acc = 0, rg = 0; for (int g = 0; g <= hb; ++g) { acc += rg; const int d = g < 7 - g ? g : 7 - g; rg = SH_LO + SH_STEP * d; }
        shn = rg * Gh; sh0 = W_NITEMS0 + acc * Gh; nbef = (rg * hb) / 7; }
    else { shn = W_NEXP / ngrp; sh0 = W_NITEMS0 + hb * shn; const int per = (shn + Gh - 1) / Gh; nbef = (ngrp == 8) ? (per * hb) / 7 : per; }
    XcdBarrier barh = bar;
    if (use_bar) barh = xcd_barrier_post((unsigned*)(kap0->ws + CTL_BARH + (size_t)hb * CTL_BARH_STRIDE), MISC + 10, (unsigned)Gh);

    PROBE_B(0); if (IN(0)) REP(0) { KAP ap = KARGS(); Frame F = FRL(); unsigned char* ws = ap->ws; p0_weights(ap, F, F.vc, W_NITEMS0, F.G); p0_x(ap->in[0], WSP(bf16_t, WS_XB), WSP(u64, CTL_SS), F); }
    PROBE_E(0); SEAM(0); PROBE_S(0);
    if (IN(0)) { KAP ap = KARGS(); Frame F = FRH(); const int e_ = sh0 + nbef * Gh < sh0 + shn ? sh0 + nbef * Gh : sh0 + shn; p0_weights_r(ap, F, sh0, e_, hidx, Gh); }
    PROBE_B(1); if (IN(1)) REP(1) {
        KAP ap = KARGS(); Frame F = FRH(); unsigned char* ws = ap->ws;
        pg8::Order S; S.init(nMh, NQKV / 256, 2 * DM, F.G, hidx, ws + WS_XB + (size_t)R0 * DM * 2, ws + WS_WQKV, 0, nullptr, nxh);
        pg8::EpiBf16Out<true, true> E{WSP(bf16_t, WS_QKV) + (size_t)R0 * NQKV, NQKV, WSP(u64, CTL_SS) + R0, 1.f, WSP(unsigned, CTL_BND1), pm0};
        pg8::gemm_phase<pg8::EpiBf16Out<true, true>, GEMM_ALIGN, GEMM_SP2>(F.lds, 2 * DM, S, E, 0, PRB(1));
    }
    PROBE_E(1); SEAM(1); PROBE_S(1);
    PROBE_B(2); if (IN(2)) REP(2) { KAP ap = KARGS(); Frame F = FRH(); unsigned char* ws = ap->ws; p2_kmean(WSP(bf16_t, WS_QKV), WSP(float, WS_KMEAN), F, hb * nxh * HA * 8, nxh * HA * 8); }
    PROBE_E(2); SEAM(2); PROBE_S(2);
    PROBE_B(3); if (IN(3)) REP(3) { KAP ap = KARGS(); Frame F = FRH(); unsigned char* ws = ap->ws; p3_select(WSP(bf16_t, WS_QKV), WSP(float, WS_KMEAN), WSP(unsigned char, WS_SEL), F, hb * nxh * HA * 4, nxh * HA * 4); }
    PROBE_E(3); SEAM(3); PROBE_S(3);
    PROBE_B(4); if (IN(4)) REP(4) { KAP ap = KARGS(); Frame F = FRH(); unsigned char* ws = ap->ws; attn_phase<true>((char*)lds, WSP(bf16_t, WS_QKV), WSP(bf16_t, WS_AO), WSP(unsigned char, WS_SEL), WSP(unsigned, CTL_BND1), WSP(unsigned, CTL_AQ), hb * nxh, nxh, F); }
    PROBE_E(4); SEAM(4); PROBE_S(4);
    PROBE_B(5); if (IN(5)) REP(5) {
        KAP ap = KARGS(); Frame F = FRH(); unsigned char* ws = ap->ws;
        pg8::Order S; S.init(nMh, DM / 256, 2 * DM, F.G, hidx, ws + WS_AO + (size_t)R0 * DM * 2, ws + WS_WOA, 0, nullptr, nxh);
        pg8::EpiResid<true, false> E{WSP(bf16_t, WS_XB) + (size_t)R0 * DM, nullptr, WSP(bf16_t, WS_XB) + (size_t)R0 * DM, WSP(u64, CTL_SS) + MTOK + R0};
        pg8::gemm_phase<pg8::EpiResid<true, false>, GEMM_ALIGN, GEMM_SP2>(F.lds, 2 * DM, S, E);
    }
    PROBE_E(5); SEAM(5); PROBE_S(5);
    PROBE_B(6); if (IN(6)) REP(6) {
        KAP ap = KARGS(); Frame F = FRH(); unsigned char* ws = ap->ws;
        pg8::Order S; S.init(nMh, 2 * FF / 256, 2 * DM, F.G, hidx, ws + WS_XB + (size_t)R0 * DM * 2, ws + WS_WGU, 0, nullptr, nxh);
        pg8::EpiSwiGLU<false> E{WSP(bf16_t, WS_ACT) + (size_t)R0 * FF, FF, WSP(u64, CTL_SS) + MTOK + R0};
        pg8::gemm_phase<pg8::EpiSwiGLU<false>, GEMM_ALIGN, GEMM_SP2>(F.lds, 2 * DM, S, E, 0, PRB(6));
    }
    PROBE_E(6); SEAM(6); PROBE_S(6);
    PROBE_B(7); if (IN(7)) REP(7) {
        KAP ap = KARGS(); Frame F = FRH(); unsigned char* ws = ap->ws;
        pg8::Order S; S.init(nMh, DM / 256, 2 * FF, F.G, hidx, ws + WS_ACT + (size_t)R0 * FF * 2, ws + WS_WDN, 0, nullptr, nxh);
        pg8::EpiResid<true, false> E{WSP(bf16_t, WS_XB) + (size_t)R0 * DM, nullptr, WSP(bf16_t, WS_XB) + (size_t)R0 * DM, WSP(u64, CTL_SS) + 2 * MTOK + R0};
        pg8::gemm_phase<pg8::EpiResid<true, false>, GEMM_ALIGN, GEMM_SP2>(F.lds, 2 * FF, S, E);
    }
    PROBE_E(7); SEAM(7); PROBE_S(7);
    PROBE_B(8); if (IN(8)) REP(8) {
        KAP ap = KARGS(); Frame F = FRH(); unsigned char* ws = ap->ws;
        pg8::Order S; S.init(nMh, NQKV / 256, 2 * DM, F.G, hidx, ws + WS_XB + (size_t)R0 * DM * 2, ws + WS_WKVQ, 0, nullptr, nxh);
        pg8::EpiBf16Out<true, true> E{WSP(bf16_t, WS_QKV) + (size_t)R0 * NQKV, NQKV, WSP(u64, CTL_SS) + 2 * MTOK + R0, 1.f, WSP(unsigned, CTL_BND2), pm0};
        pg8::gemm_phase<pg8::EpiBf16Out<true, true>, GEMM_ALIGN, GEMM_SP2>(F.lds, 2 * DM, S, E, 0, PRB(1));
    }
    PROBE_E(8); SEAM(8); PROBE_S(8);
    PROBE_B(9); if (IN(9)) REP(9) { KAP ap = KARGS(); Frame F = FRH(); unsigned char* ws = ap->ws; attn_phase<false>((char*)lds, WSP(bf16_t, WS_QKV), WSP(bf16_t, WS_XR), nullptr, WSP(unsigned, CTL_BND2), WSP(unsigned, CTL_AQ) + 8 * 64, hb * nxh, nxh, F); }
    PROBE_E(9); SEAM(9); PROBE_S(9);
    PROBE_B(10); if (IN(10)) REP(10) { KAP ap = KARGS(); Frame F = FRH(); unsigned char* ws = ap->ws; p10_combine(ap, WSP(bf16_t, WS_XR), WSP(bf16_t, WS_AO), F, R0, Mh); }
    PROBE_E(10); SEAM(10); PROBE_S(10);
    PROBE_B(11); if (IN(11)) REP(11) {
        KAP ap = KARGS(); Frame F = FRH(); unsigned char* ws = ap->ws;
        pg8::Order S; S.init(nMh, DM / 256, 2 * DM, F.G, hidx, ws + WS_AO + (size_t)R0 * DM * 2, ws + WS_WOB, 0, nullptr, nxh);
        pg8::EpiResid<true, false> E{WSP(bf16_t, WS_XB) + (size_t)R0 * DM, nullptr, WSP(bf16_t, WS_XB) + (size_t)R0 * DM, WSP(u64, CTL_SS) + 3 * MTOK + R0};
        pg8::gemm_phase<pg8::EpiResid<true, false>, GEMM_ALIGN, GEMM_SP2>(F.lds, 2 * DM, S, E);
    }
    PROBE_E(11); if (IN(11) && IN(12)) xcd_barrier(barh); PROBE_S(11);
    PROBE_B(12); if (IN(12)) REP(12) { KAP ap = KARGS(); Frame F = FRH(); unsigned char* ws = ap->ws; p12_router(ap, WSP(bf16_t, WS_XB), WSP(u64, CTL_SS) + 3 * MTOK, WSP(unsigned, CTL_CNT), WSP(int, CTL_TOKINFO), WSP(unsigned char, WS_XSC), F, hb * (Mh / 64), Mh / 64); }
    if (IN(12)) { KAP ap = KARGS(); Frame F = FRH(); p0_weights_r(ap, F, sh0 + nbef * Gh, sh0 + shn, hidx, Gh); }
    PROBE_E(12); SEAM(12); PROBE_S(12);
    PROBE_B(14); if (IN(14)) REP(14) {
        KAP ap = KARGS(); Frame F = FRL(); unsigned char* ws = ap->ws;
        moe_tables(WSP(unsigned, CTL_CNT), (LAS int*)(F.lds + MOE_T_OFF), F);
        const int* tiles = (const int*)(LAS int*)(F.lds + MOE_T_OFF); const int nT = tiles[0];
        pg8::Order S; S.init(nT, 2 * FE / 256, DM, F.G, bx, ws + WS_XSC, ws + WS_WEGU, (size_t)2 * FE * DM, tiles + 1, pg8::NXCD, 1);
        pg8::EpiSwiGLU8 E{WSP(unsigned char, WS_ACTE), FE, 1.0f / (XS_SC * WEGU_SC), ACT_SC, (PROBE_SKIP_EPI && rep_ == 1) ? 1 : 0};
        pg8::gemm_phase<pg8::EpiSwiGLU8, GEMM_ALIGN, false, true>(F.lds, DM, S, E, 0, PRB(14));
    }
    PROBE_E(14); SEAM(14); PROBE_S(14);
    PROBE_B(15); if (IN(15)) REP(15) {
        KAP ap = KARGS(); Frame F = FRL(); unsigned char* ws = ap->ws;
        moe_tables(WSP(unsigned, CTL_CNT), (LAS int*)(F.lds + MOE_T_OFF), F);
        const int* tiles = (const int*)(LAS int*)(F.lds + MOE_T_OFF); const int nT = tiles[0];
        int rt = nT & 31; if (rt > 7) rt = 0;
        pg8::Order S; S.init(nT - rt, DM / 256, FE, F.G, bx, ws + WS_ACTE, ws + WS_WEDN, (size_t)DM * FE, tiles + 1);
        pg8::EpiBf16Out<false> E{WSP(bf16_t, WS_YS), DM, nullptr, 1.0f / (ACT_SC * WEDN_SC), nullptr, 0};
        pg8::gemm_phase<pg8::EpiBf16Out<false>, GEMM_ALIGN, false, true>(F.lds, FE, S, E);
        if (rt) { pg8::TailOrder S2{rt * 8 * TAIL_NS, F.G, bx, nT - rt, TAIL_NS, (const char*)(ws + WS_ACTE), (const char*)(ws + WS_WEDN), (size_t)256 * FE, (size_t)DM * FE, (size_t)(FE / TAIL_NS), tiles + 1};
            pg8::EpiPart E2{WSP(float, WS_SLAB), (nT - rt) * 256, (size_t)rt * 256 * DM};
            pg8::gemm_phase<pg8::EpiPart, GEMM_ALIGN, false, true, pg8::TailOrder>(F.lds, FE, S2, E2, FE / TAIL_NS / 128); }
    }
    PROBE_E(15); SEAM(15); PROBE_S(15);
    PROBE_B(16); if (IN(16)) REP(16) { KAP ap = KARGS(); Frame F = FRL(); unsigned char* ws = ap->ws; moe_tables(WSP(unsigned, CTL_CNT), (LAS int*)(F.lds + MOE_T_OFF), F);
        p16_final(WSP(bf16_t, WS_XB), WSP(bf16_t, WS_YS), WSP(float, WS_SLAB), (const int*)(LAS int*)(F.lds + MOE_T_OFF), WSP(int, CTL_TOKINFO), ap->in[22], ap->out, F); }
PROBE_E(16); PROBE_FIN();
#undef IN
#undef REP
#undef SEAM
#undef WSP
#undef FRL
#undef FRH
#undef KARGS
}

#ifndef MK_ONE_LAUNCH
#define MK_ONE_LAUNCH 1
#endif
extern "C" void kernel_launch(void* const* d_in, const int* in_sizes, int n_in, void* d_out, int out_size, void* d_ws, size_t ws_size, hipStream_t stream) {
    static int grid = 0;
    if (grid == 0) {
        if (n_in != 23 || out_size != MTOK * DM || ws_size < WS_END) { fprintf(stderr, "kernel_launch: unexpected shapes (n_in %d, out %d, ws %zu)\n", n_in, out_size, ws_size); grid = -1; return; }
        int dev = 0, cus = 0, per_cu = 0;
        if (hipGetDevice(&dev) != hipSuccess || hipDeviceGetAttribute(&cus, hipDeviceAttributeMultiprocessorCount, dev) != hipSuccess) { grid = -1; return; }
        if (hipFuncSetAttribute((const void*)mega_fwd, hipFuncAttributeMaxDynamicSharedMemorySize, LDS_BYTES) != hipSuccess) { fprintf(stderr, "kernel_launch: hipFuncSetAttribute failed\n"); grid = -1; return; }
        if (hipOccupancyMaxActiveBlocksPerMultiprocessor(&per_cu, (const void*)mega_fwd, NTHREADS, LDS_BYTES) != hipSuccess || per_cu < 1) { fprintf(stderr, "kernel_launch: occupancy query reports %d\n", per_cu); (void)hipGetLastError(); per_cu = 1; }
        grid = cus;
    }
    if (grid < 0) return;
    if (hipMemsetAsync((char*)d_ws + WS_CTL, 0, CTL_ZERO_BYTES, stream) != hipSuccess) return;
    Args a{};
    for (int i = 0; i < 23; ++i) a.in[i] = (const float*)d_in[i];
    a.out = (float*)d_out; a.ws = (unsigned char*)d_ws;
#if MK_ONE_LAUNCH
    a.ph_lo = 0; a.ph_hi = NPHASE;
    hipLaunchKernelGGL(mega_fwd, dim3(grid), dim3(NTHREADS), LDS_BYTES, stream, a);
#else
    for (int p = 0; p < NPHASE; ++p) { a.ph_lo = p; a.ph_hi = p + 1; hipLaunchKernelGGL(mega_fwd, dim3(grid), dim3(NTHREADS), LDS_BYTES, stream, a); }
#endif
}
```

```cpp
#include <hip/hip_runtime.h>
#include <cstdio>
#include <cstdint>

#define GAS __attribute__((address_space(1)))
#define LAS __attribute__((address_space(3)))
#ifndef PROBE_KIND
#define PROBE_KIND 0
#endif
typedef unsigned short bf16_t;
typedef short bf16x8 __attribute__((ext_vector_type(8)));
typedef short s16x4 __attribute__((ext_vector_type(4)));
typedef float f32x2 __attribute__((ext_vector_type(2)));
typedef float f32x4 __attribute__((ext_vector_type(4)));
typedef float f32x16 __attribute__((ext_vector_type(16)));
typedef unsigned u32x2 __attribute__((ext_vector_type(2)));
typedef unsigned u32x4 __attribute__((ext_vector_type(4)));

constexpr int NB = 8, SEQ = 2048, DM = 2048, MTOK = NB * SEQ;
constexpr int NQKV = 3 * DM, FF = 5632, FE = 7168, NE = 8;
constexpr int HA = 16, HB = 8;
constexpr float RMS_EPS = 1e-6f;
constexpr float LAM_INIT = 0.35550906759096996f;
constexpr int MAXTILES = 136;
constexpr int MOE_ROWS = 135 * 256;

constexpr size_t MiB = 1u << 20;
constexpr size_t WS_CTL = 0, CTL_ZERO_BYTES = 960 * 1024;
constexpr size_t CTL_BAR = 4096;
constexpr size_t CTL_BARH = 832 * 1024, CTL_BARH_STRIDE = 16384;
constexpr size_t CTL_SS = 64 * 1024;
constexpr size_t CTL_AQ = 580 * 1024;
constexpr size_t CTL_CNT = 576 * 1024;
constexpr size_t CTL_BND1 = 640 * 1024, CTL_BND2 = 704 * 1024;
constexpr size_t CTL_TILES = 768 * 1024;
constexpr size_t CTL_TOKINFO = 1 * MiB;
constexpr size_t WS_WQKV = 2 * MiB, WS_WOA = 26 * MiB, WS_WGU = 34 * MiB, WS_WDN = 78 * MiB, WS_WKVQ = 100 * MiB, WS_WOB = 124 * MiB;
constexpr size_t WS_XB = 132 * MiB, WS_XR = 196 * MiB, WS_WEGU = 324 * MiB, WS_WEDN = 548 * MiB, WS_BIG = 660 * MiB;
constexpr size_t WS_QKV = WS_BIG, WS_AO = WS_BIG + 192 * MiB, WS_ACT = WS_BIG + 256 * MiB, WS_KMEAN = WS_BIG + 432 * MiB, WS_SEL = WS_BIG + 433 * MiB;
constexpr size_t WS_ACTE = WS_BIG, WS_XS = WS_BIG + 237 * MiB, WS_YS = WS_BIG + 305 * MiB, WS_SLAB = WS_BIG + 440 * MiB, WS_XSC = WS_BIG + 500 * MiB, WS_END = WS_XSC + 256 * MiB;
static_assert(WS_END <= 1792 * MiB, "workspace map");
static_assert((size_t)MOE_ROWS * FE <= 237 * MiB && (size_t)MOE_ROWS * DM <= 68 * MiB && (size_t)MOE_ROWS * DM * 2 <= 135 * MiB && WS_SEL + MiB <= WS_END, "moe buffers");
constexpr float XS_SC = 16.f, WEGU_SC = 256.f, ACT_SC = 8.f, WEDN_SC = 512.f;
constexpr int TAIL_NS = 4, TAIL_MAXROWS = 31 * 256;
static_assert((size_t)TAIL_NS * 7 * 256 * DM * 4 <= 60 * MiB, "slab (nT in [128, 135] -> at most 7 tail row tiles)");

constexpr int RING_BYTES = 131072, LDS_BYTES = 147456, LDSCTL_OFF = LDS_BYTES - 512;

#define LDS_WAIT() asm volatile("s_waitcnt lgkmcnt(0)" ::: "memory")
#define VM_WAIT() asm volatile("s_waitcnt vmcnt(0)" ::: "memory")
__device__ __forceinline__ unsigned cvt_pk_bf16(float lo, float hi) { unsigned r; asm volatile("v_cvt_pk_bf16_f32 %0, %1, %2" : "=v"(r) : "v"(lo), "v"(hi)); return r; }
__device__ __forceinline__ float bf2f(unsigned short b) { return __uint_as_float(((unsigned)b) << 16); }
template <int CTRL> __device__ __forceinline__ float dppx(float v) { return __builtin_bit_cast(float, __builtin_amdgcn_update_dpp(0, __builtin_bit_cast(int, v), CTRL, 0xf, 0xf, true)); }
__device__ __forceinline__ float xor1_get(float v) { return dppx<0xB1>(v); }
__device__ __forceinline__ float sum_xor16(float v) { auto r = __builtin_amdgcn_permlane16_swap(__float_as_uint(v), __float_as_uint(v), false, false); return __uint_as_float(r[0]) + __uint_as_float(r[1]); }
__device__ __forceinline__ float sum_xor32(float v) { auto r = __builtin_amdgcn_permlane32_swap(__float_as_uint(v), __float_as_uint(v), false, false); return __uint_as_float(r[0]) + __uint_as_float(r[1]); }
__device__ __forceinline__ float row_sum16(float v) { v += dppx<0xB1>(v); v += dppx<0x4E>(v); v += dppx<0x141>(v); v += dppx<0x140>(v); return v; }
__device__ __forceinline__ float row_max16(float v) { v = __builtin_fmaxf(v, dppx<0xB1>(v)); v = __builtin_fmaxf(v, dppx<0x4E>(v)); v = __builtin_fmaxf(v, dppx<0x141>(v)); v = __builtin_fmaxf(v, dppx<0x140>(v)); return v; }
__device__ __forceinline__ float wave_sum(float v) { return sum_xor32(sum_xor16(row_sum16(v))); }
typedef unsigned long long u64;
__device__ __forceinline__ float rstd_of(float ss) { return __builtin_amdgcn_rsqf(ss * (1.0f / (float)DM) + RMS_EPS); }
__device__ __forceinline__ u64 ss_fix(float s) { return (u64)(s * 16777216.0f); }
__device__ __forceinline__ float rstd_q(u64 q) { return rstd_of((float)q * (1.0f / 16777216.0f)); }

#define XB_TMO      128
#define XB_XCNT(j)  (256  + 64 * (j))
#define XB_XSUB(j)  (1280 + 64 * (j))
#define XB_XGEN(j)  (2304 + 64 * (j))
#define XB_TOP      3328
#define XB_TOPGEN   3392
#define XCD_BAR_WORDS 3456
#define XB_SPIN_CAP (1u << 18)
__device__ __forceinline__ unsigned xb_ld(unsigned* p)              { return __hip_atomic_load(p, __ATOMIC_RELAXED, __HIP_MEMORY_SCOPE_AGENT); }
__device__ __forceinline__ unsigned xb_add(unsigned* p, unsigned v) { return __hip_atomic_fetch_add(p, v, __ATOMIC_RELAXED, __HIP_MEMORY_SCOPE_AGENT); }
__device__ __forceinline__ unsigned xb_xcc_id() { return (unsigned)__builtin_amdgcn_s_getreg((3 << 11) | 20) & 0xFu; }
#define XB_SPIN(cond, bar) do { unsigned _sp = 0; while (cond) { __builtin_amdgcn_s_sleep(1); \
    if ((++_sp & 255u) == 0u) { if (xb_ld(&(bar)[XB_TMO])) break; if (_sp > XB_SPIN_CAP) { atomicAdd(&(bar)[XB_TMO], 1u); break; } } } } while (0)
struct XcdBarrier { unsigned* bar; unsigned x; volatile LAS unsigned* st; unsigned members; };
__device__ __forceinline__ XcdBarrier xcd_barrier_post(unsigned* bar, volatile LAS unsigned* st, unsigned members) {
    XcdBarrier b; b.bar = bar; b.x = xb_xcc_id(); b.st = st; b.members = members;
    if (threadIdx.x == 0) (void)xb_add(&bar[XB_XCNT(b.x)], 1u);
    return b;
}
__device__ __forceinline__ void xcd_barrier_complete(unsigned* bar, unsigned x, unsigned& nloc, unsigned& nx, const unsigned G) {
    unsigned sum, cnt, mine, sp = 0u;
    for (;;) {
        sum = 0u; cnt = 0u; mine = 0u;
#pragma unroll
        for (unsigned j = 0; j < 16; ++j) { const unsigned c = xb_ld(&bar[XB_XCNT(j)]); sum += c; cnt += (c > 0u) ? 1u : 0u; mine = (j == x) ? c : mine; }
        if (sum == G) break;
        __builtin_amdgcn_s_sleep(1);
        if ((++sp & 255u) == 0u) { if (xb_ld(&bar[XB_TMO])) break; if (sp > XB_SPIN_CAP) { atomicAdd(&bar[XB_TMO], 1u); break; } }
    }
    nloc = mine > 0u ? mine : 1u; nx = cnt > 0u ? cnt : 1u;
}
__device__ __forceinline__ void xcd_barrier(const XcdBarrier& b) {
    asm volatile("s_waitcnt vmcnt(0)" ::: "memory");
    __syncthreads();
    if (threadIdx.x == 0) {
        unsigned* bar = b.bar;
        __builtin_amdgcn_s_waitcnt(0);
        unsigned nloc = b.st[0], nx = b.st[1];
        if (nloc == 0u) { xcd_barrier_complete(bar, b.x, nloc, nx, b.members); b.st[0] = nloc; b.st[1] = nx; }
        const unsigned old = xb_add(&bar[XB_XSUB(b.x)], 1u);
        const unsigned gen = old / nloc;
        if (old + 1u == (gen + 1u) * nloc) {
            __builtin_amdgcn_fence(__ATOMIC_RELEASE, "agent");
            asm volatile("s_waitcnt vmcnt(0)" ::: "memory");
            const unsigned og = xb_add(&bar[XB_TOP], 1u);
            const unsigned tg = og / nx;
            if (og + 1u == (tg + 1u) * nx) xb_add(&bar[XB_TOPGEN], 1u);
            else XB_SPIN(xb_ld(&bar[XB_TOPGEN]) == tg, bar);
            __builtin_amdgcn_fence(__ATOMIC_ACQUIRE, "agent");
            xb_add(&bar[XB_XGEN(b.x)], 1u);
            asm volatile("s_waitcnt vmcnt(0)" ::: "memory");
        } else {
            XB_SPIN(xb_ld(&bar[XB_XGEN(b.x)]) == gen, bar);
            __builtin_amdgcn_fence(__ATOMIC_ACQUIRE, "agent");
            asm volatile("s_waitcnt vmcnt(0)" ::: "memory");
        }
    }
    __syncthreads();
}

namespace pg8 {
constexpr int BM = 256, BK = 64, HALF = 128, HTB = HALF * BK * 2, STAGE_BYTES = 8 * HTB, NXCD = 8, WGM = 8;
__host__ __device__ __forceinline__ int lds_byte(int r, int c) { const int st = (r >> 4) * 2 + (c >> 5), rr = r & 15, cc = c & 31, ob = rr * 64 + cc * 2; return st * 1024 + (ob ^ (((ob >> 9) & 1) << 5)); }
__host__ __device__ __forceinline__ void stage_rc(int b, int& R, int& C) { const int st = b / 1024, sb = b % 1024, swz = sb ^ (((sb >> 9) & 1) << 5); R = (st >> 1) * 16 + swz / 64; C = (st & 1) * 32 + (swz % 64) / 2; }
__host__ __device__ __forceinline__ int perm32(int rho) { const int n = rho >> 4, i = rho & 15; return 8 * (i >> 2) + 4 * n + (i & 3); }

struct Unit { int pm, pn, e, ks, ar; };

struct Order {
    int nM, nN, nwg, G, c, nx, use_ar; const char* A; const char* B; size_t tstep, estride; const int* tile_e;
    __device__ __forceinline__ void init(int nM_, int nN_, int KB, int G_, int c_, const void* A_, const void* B_, size_t estride_, const int* tile_e_, int nx_ = NXCD, int use_ar_ = 0) {
        use_ar = use_ar_; nM = nM_; nN = nN_; nwg = nM * nN; G = G_; c = c_; nx = nx_; A = (const char*)A_; B = (const char*)B_; tstep = (size_t)BM * KB; estride = estride_; tile_e = tile_e_; }
    __device__ __forceinline__ bool next(int i, Unit& u) const {
        const long L = (long)i * G + c; if (L >= nwg) return false;
        int wgid = (int)L; { const int q = nwg / nx, r = nwg % nx, xcd = wgid % nx, off = wgid / nx; wgid = (xcd < r ? xcd * (q + 1) : r * (q + 1) + (xcd - r) * q) + off; }
        const int nig = WGM * nN, gid = wgid / nig, fm = gid * WGM, gsz = (nM - fm) < WGM ? (nM - fm) : WGM;
        u.pm = fm + ((wgid % nig) % gsz); u.pn = (wgid % nig) / gsz; const int v = tile_e ? tile_e[u.pm] : 0; u.e = v & 15; u.ar = use_ar ? (v >> 4) : u.pm; u.ks = 0; return true;
    }
    __device__ __forceinline__ const char* a_base(const Unit& u) const { return A + (size_t)u.ar * tstep; }
    __device__ __forceinline__ const char* b_base(const Unit& u) const { return B + (size_t)u.e * estride + (size_t)u.pn * tstep; }
};

struct TailOrder {
    int nsub, G, c, pm0, NS; const char* A; const char* B; size_t tstep, estride, kslice; const int* tile_e;
    __device__ __forceinline__ bool next(int i, Unit& u) const { const int L = i * G + c; if (L >= nsub) return false; const int per = 8 * NS; u.pm = pm0 + L / per; const int rem = L % per; u.pn = rem / NS; u.ks = rem % NS; u.e = tile_e[u.pm] & 15; u.ar = u.pm; return true; }
    __device__ __forceinline__ const char* a_base(const Unit& u) const { return A + (size_t)u.pm * tstep + (size_t)u.ks * kslice; }
    __device__ __forceinline__ const char* b_base(const Unit& u) const { return B + (size_t)u.e * estride + (size_t)u.pn * tstep + (size_t)u.ks * kslice; }
};

template <bool SCALE, bool BOUND = false> struct EpiBf16Out {
    static constexpr bool PERM = true;
    bf16_t* O; int ldc; const u64* ss; float csc; unsigned* bnd; int pm0;
    __device__ __forceinline__ void operator()(const f32x4 (&acc)[2][2][4][2], const Unit& u, int wr, int wc, int fr, int fq) const {
        const int row0 = u.pm * BM + wr * 64 + fr, col0 = u.pn * BM + wc * 32 + 8 * fq; float mx[2] = {0.f, 0.f};
        u64 ssv[2][4];
#pragma unroll
        for (int ai = 0; ai < 2; ++ai)
#pragma unroll
            for (int m = 0; m < 4; ++m) ssv[ai][m] = SCALE ? ss[row0 + ai * HALF + m * 16] : 0ull;
#pragma unroll
        for (int ai = 0; ai < 2; ++ai)
#pragma unroll
            for (int m = 0; m < 4; ++m) { const int row = row0 + ai * HALF + m * 16; float rs = csc; if (SCALE) rs = rstd_q(ssv[ai][m]);
                bf16_t* rowp = O + (size_t)row * ldc + col0;
#pragma unroll
                for (int bj = 0; bj < 2; ++bj) { const f32x4 v0 = acc[ai][bj][m][0] * rs, v1 = acc[ai][bj][m][1] * rs;
                    u32x4 w; w.x = cvt_pk_bf16(v0[0], v0[1]); w.y = cvt_pk_bf16(v0[2], v0[3]); w.z = cvt_pk_bf16(v1[0], v1[1]); w.w = cvt_pk_bf16(v1[2], v1[3]);
                    *(u32x4*)(rowp + bj * HALF) = w;
                    if (BOUND) { float sq = ((v0[0] * v0[0] + v0[1] * v0[1]) + (v0[2] * v0[2] + v0[3] * v0[3])) + ((v1[0] * v1[0] + v1[1] * v1[1]) + (v1[2] * v1[2] + v1[3] * v1[3]));
                        sq = sum_xor32(sum_xor16(sq)); mx[bj] = __builtin_fmaxf(mx[bj], sq); } } }
        if (BOUND) {
#pragma unroll
            for (int bj = 0; bj < 2; ++bj) { const float v = row_max16(mx[bj]);
                if (fr == 0 && fq == 0) __hip_atomic_fetch_max(bnd + ((size_t)(2 * u.pn + bj) * 64 + u.pm + pm0) * 4 + wc, __float_as_uint(v), __ATOMIC_RELAXED, __HIP_MEMORY_SCOPE_AGENT); } }
    }
};
__device__ __forceinline__ float clamp448(float x) { return __builtin_fminf(__builtin_fmaxf(x, -448.0f), 448.0f); }
__device__ __forceinline__ unsigned pk4_fp8(float a, float b, float c, float d) { int v = __builtin_amdgcn_cvt_pk_fp8_f32(clamp448(a), clamp448(b), 0, false); v = __builtin_amdgcn_cvt_pk_fp8_f32(clamp448(c), clamp448(d), v, true); return (unsigned)v; }
__device__ __forceinline__ float silu_mul(float g, float u) { return g * __builtin_amdgcn_rcpf(1.0f + __builtin_amdgcn_exp2f(-1.4426950408889634f * g)) * u; }
__device__ __forceinline__ float silu_mul_c(float g, float u, float c1, float c2) { return (g * u) * (c2 * __builtin_amdgcn_rcpf(1.0f + __builtin_amdgcn_exp2f(g * c1))); }
typedef float f32x2 __attribute__((ext_vector_type(2)));
__device__ __forceinline__ f32x2 silu_mul2(f32x2 g, f32x2 u, float c1, float k) {
    const f32x2 t = g * c1; f32x2 e; e.x = __builtin_amdgcn_exp2f(t.x); e.y = __builtin_amdgcn_exp2f(t.y);
    const f32x2 d = e * k + k; f32x2 r; r.x = __builtin_amdgcn_rcpf(d.x); r.y = __builtin_amdgcn_rcpf(d.y);
    return (g * u) * r;
}
__device__ __forceinline__ f32x4 silu_mul4(f32x4 g, f32x4 u, float c1, float k) { const f32x2 a = silu_mul2(g.xy, u.xy, c1, k), b = silu_mul2(g.zw, u.zw, c1, k); return (f32x4){a.x, a.y, b.x, b.y}; }
template <bool RAW> struct EpiSwiGLU {
    static constexpr bool PERM = true;
    bf16_t* O; int ldc; const void* rsrc;
    __device__ __forceinline__ void operator()(const f32x4 (&acc)[2][2][4][2], const Unit& u, int wr, int wc, int fr, int fq) const {
        const int row0 = u.pm * BM + wr * 64 + fr, col0 = u.pn * HALF + wc * 32 + 8 * fq;
        float rsv[2][4];
#pragma unroll
        for (int ai = 0; ai < 2; ++ai)
#pragma unroll
            for (int m = 0; m < 4; ++m) { const int row = row0 + ai * HALF + m * 16; if (RAW) rsv[ai][m] = ((const float*)rsrc)[row]; else rsv[ai][m] = rstd_q(((const u64*)rsrc)[row]); }
#pragma unroll
        for (int ai = 0; ai < 2; ++ai)
#pragma unroll
            for (int m = 0; m < 4; ++m) { const int row = row0 + ai * HALF + m * 16; const float rs = rsv[ai][m];
                const float c1 = -1.4426950408889634f * rs, kk = __builtin_amdgcn_rcpf(rs * rs);
                const f32x4 a0 = silu_mul4(acc[ai][0][m][0], acc[ai][1][m][0], c1, kk), a1 = silu_mul4(acc[ai][0][m][1], acc[ai][1][m][1], c1, kk);
                u32x4 w; w.x = cvt_pk_bf16(a0[0], a0[1]); w.y = cvt_pk_bf16(a0[2], a0[3]); w.z = cvt_pk_bf16(a1[0], a1[1]); w.w = cvt_pk_bf16(a1[2], a1[3]);
                *(u32x4*)(O + (size_t)row * ldc + col0) = w; }
    }
};
struct EpiSwiGLU8 {
    static constexpr bool PERM = true;
    unsigned char* O; int ldc; float isc, osc; int skip;
    __device__ __forceinline__ void operator()(const f32x4 (&acc)[2][2][4][2], const Unit& u, int wr, int wc, int fr, int fq) const {
        if (skip) return;
        const int row0 = u.pm * BM + wr * 64 + fr, col0 = u.pn * HALF + wc * 32 + 8 * fq; const float c1 = -1.4426950408889634f * isc, kk = 1.0f / (isc * isc * osc);
#pragma unroll
        for (int ai = 0; ai < 2; ++ai)
#pragma unroll
            for (int m = 0; m < 4; ++m) { const int row = row0 + ai * HALF + m * 16;
                const f32x4 a0 = silu_mul4(acc[ai][0][m][0], acc[ai][1][m][0], c1, kk), a1 = silu_mul4(acc[ai][0][m][1], acc[ai][1][m][1], c1, kk);
                u32x2 w; w.x = pk4_fp8(a0[0], a0[1], a0[2], a0[3]); w.y = pk4_fp8(a1[0], a1[1], a1[2], a1[3]);
                *(u32x2*)(O + (size_t)row * ldc + col0) = w; }
    }
};
struct EpiPart {
    static constexpr bool PERM = false;
    float* slab; int row_base; size_t ks_stride;
    __device__ __forceinline__ void operator()(const f32x4 (&acc)[2][2][4][2], const Unit& u, int wr, int wc, int fr, int fq) const {
        const int row0 = u.pm * BM + wr * 64 + fr - row_base, col0 = u.pn * BM + wc * 32 + 4 * fq; float* sp = slab + (size_t)u.ks * ks_stride;
#pragma unroll
        for (int ai = 0; ai < 2; ++ai)
#pragma unroll
            for (int m = 0; m < 4; ++m) { float* rowp = sp + (size_t)(row0 + ai * HALF + m * 16) * DM + col0;
#pragma unroll
                for (int bj = 0; bj < 2; ++bj)
#pragma unroll
                    for (int n = 0; n < 2; ++n) *(f32x4*)(rowp + bj * HALF + n * 16) = acc[ai][bj][m][n]; }
    }
};
template <bool BASE_BF16, bool WRITE_F32> struct EpiResid {
    static constexpr bool PERM = true;
    const void* base; float* xr; bf16_t* xb; u64* ssout;
    __device__ __forceinline__ void operator()(const f32x4 (&acc)[2][2][4][2], const Unit& u, int wr, int wc, int fr, int fq) const {
        const int row0 = u.pm * BM + wr * 64 + fr, col0 = u.pn * BM + wc * 32 + 8 * fq;
#pragma unroll
        for (int ai = 0; ai < 2; ++ai) { u32x4 qv[4][2];
            if (BASE_BF16) {
#pragma unroll
                for (int m = 0; m < 4; ++m)
#pragma unroll
                    for (int bj = 0; bj < 2; ++bj) qv[m][bj] = *(const u32x4*)((const bf16_t*)base + (size_t)(row0 + ai * HALF + m * 16) * DM + col0 + bj * HALF); }
#pragma unroll
            for (int m = 0; m < 4; ++m) { const int row = row0 + ai * HALF + m * 16; const size_t off = (size_t)row * DM + col0; float s = 0.f;
#pragma unroll
                for (int bj = 0; bj < 2; ++bj) { const int c = bj * HALF; f32x4 b0, b1;
                    if (BASE_BF16) { const u32x4 q = qv[m][bj];
                        b0 = (f32x4){__uint_as_float(q.x << 16), __uint_as_float(q.x & 0xffff0000u), __uint_as_float(q.y << 16), __uint_as_float(q.y & 0xffff0000u)};
                        b1 = (f32x4){__uint_as_float(q.z << 16), __uint_as_float(q.z & 0xffff0000u), __uint_as_float(q.w << 16), __uint_as_float(q.w & 0xffff0000u)}; }
                    else { b0 = *(const f32x4*)((const float*)base + off + c); b1 = *(const f32x4*)((const float*)base + off + c + 4); }
                    const f32x4 o0 = b0 + acc[ai][bj][m][0], o1 = b1 + acc[ai][bj][m][1];
                    if (WRITE_F32) { *(f32x4*)(xr + off + c) = o0; *(f32x4*)(xr + off + c + 4) = o1; }
                    u32x4 w; w.x = cvt_pk_bf16(o0[0], o0[1]); w.y = cvt_pk_bf16(o0[2], o0[3]); w.z = cvt_pk_bf16(o1[0], o1[1]); w.w = cvt_pk_bf16(o1[2], o1[3]); *(u32x4*)(xb + off + c) = w;
                    s += (o0[0] * o0[0] + o0[1] * o0[1]) + (o0[2] * o0[2] + o0[3] * o0[3]); s += (o1[0] * o1[0] + o1[1] * o1[1]) + (o1[2] * o1[2] + o1[3] * o1[3]); }
                s = sum_xor32(sum_xor16(s));
                if (fq == 0) __hip_atomic_fetch_add(ssout + row, ss_fix(s), __ATOMIC_RELAXED, __HIP_MEMORY_SCOPE_AGENT); } }
    }
};

typedef int i32x8 __attribute__((ext_vector_type(8)));
__device__ __forceinline__ i32x8 cat16(bf16x8 lo, bf16x8 hi) { typedef int i32x4 __attribute__((ext_vector_type(4))); const i32x4 a = __builtin_bit_cast(i32x4, lo), b = __builtin_bit_cast(i32x4, hi); return (i32x8){a[0], a[1], a[2], a[3], b[0], b[1], b[2], b[3]}; }
__device__ __forceinline__ void mfma_fp8(f32x4& acc, i32x8 a, i32x8 b) { asm volatile("v_mfma_f32_16x16x128_f8f6f4 %0, %1, %2, %0" : "+v"(acc) : "v"(a), "v"(b)); }
template <class Epi, bool ALIGN_EPI, bool SP2, bool FP8 = false, class Sched = Order>
__device__ __forceinline__ void gemm_phase(LAS unsigned char* lds, const int KB, const Sched& S, const Epi& E, const int nt_override = 0, volatile LAS unsigned* prb = nullptr) {
    unsigned long long pk_ = 0, pg_ = 0, pl_ = 0; unsigned pnk_ = 0, png_ = 0;
#define PG8_STAMP(x) do { if (prb) { asm volatile("s_memtime %0\n\ts_waitcnt lgkmcnt(0)" : "=s"(x) :: "memory"); } } while (0)
    int tid_ = threadIdx.x; asm volatile("" : "+v"(tid_));
    const int tid = tid_, wid = __builtin_amdgcn_readfirstlane(tid >> 6), lane = tid & 63, wr = wid >> 2, wc = wid & 3, fr = lane & 15, fq = lane >> 4;
    const int nt = nt_override ? nt_override : KB / 128;
    unsigned voffA[2], voffB[2];
#pragma unroll
    for (int i = 0; i < 2; ++i) { int R, C; stage_rc(tid * 16 + i * 8192, R, C); const int Rb = Epi::PERM ? ((R & ~31) + perm32(R & 31)) : R;
        voffA[i] = (unsigned)(R * KB + C * 2); voffB[i] = (unsigned)(Rb * KB + C * 2); }
    const size_t kstep = (size_t)(BK * 2);
    const size_t hstep = (size_t)HALF * KB;
    const unsigned ldsw = (unsigned)wid * 1024u;
    const int aoff = lds_byte(wr * 64 + fr, fq * 8), boff = lds_byte(wc * 32 + fr, fq * 8);
#define PG8_SA(b, h) (((b) * 2 + (h)) * HTB)
#define PG8_SB(b, h) ((4 + (b) * 2 + (h)) * HTB)
#define PG8_STAGE(bufoff, gbase, voff) do { _Pragma("unroll") for (int _i = 0; _i < 2; ++_i) \
        __builtin_amdgcn_global_load_lds((const unsigned*)((const char*)(gbase) + (voff)[_i]), (LAS unsigned*)(lds + (bufoff) + ldsw + _i * 8192), 16, 0, 0); } while (0)
#define PG8_LDA(dst, b, h) do { _Pragma("unroll") for (int m = 0; m < 4; ++m) _Pragma("unroll") for (int k = 0; k < 2; ++k) dst[m][k] = *(const LAS bf16x8*)(lds + PG8_SA(b, h) + aoff + m * 2048 + k * 1024); } while (0)
#define PG8_LDB(dst, b, h) do { _Pragma("unroll") for (int n = 0; n < 2; ++n) _Pragma("unroll") for (int k = 0; k < 2; ++k) dst[n][k] = *(const LAS bf16x8*)(lds + PG8_SB(b, h) + boff + n * 2048 + k * 1024); } while (0)
#define PG8_MMA(ai, bj, At, Bt) do { __builtin_amdgcn_s_setprio(1); _Pragma("unroll") for (int m = 0; m < 4; ++m) _Pragma("unroll") for (int n = 0; n < 2; ++n) { \
        if constexpr (FP8) mfma_fp8(acc[ai][bj][m][n], cat16(Bt[n][0], Bt[n][1]), cat16(At[m][0], At[m][1])); \
        else { _Pragma("unroll") for (int k = 0; k < 2; ++k) acc[ai][bj][m][n] = __builtin_amdgcn_mfma_f32_16x16x32_bf16(Bt[n][k], At[m][k], acc[ai][bj][m][n], 0, 0, 0); } } \
        __builtin_amdgcn_s_setprio(0); } while (0)
#define PG8_WAIT_V(n) asm volatile("s_waitcnt vmcnt(" #n ")" ::: "memory")
#define PG8_WAIT_L(n) asm volatile("s_waitcnt lgkmcnt(" #n ")" ::: "memory")
#define PG8_BAR __builtin_amdgcn_s_barrier()
#define PG8_SCHED __builtin_amdgcn_sched_barrier(0)
    Unit cur, nxt; int ui = 0;
    if (!S.next(0, cur)) return;
    f32x4 acc[2][2][4][2];
#pragma unroll
    for (int a = 0; a < 2; ++a)
#pragma unroll
        for (int b = 0; b < 2; ++b)
#pragma unroll
            for (int m = 0; m < 4; ++m)
#pragma unroll
                for (int n = 0; n < 2; ++n) acc[a][b][m][n] = (f32x4){0.f, 0.f, 0.f, 0.f};
    bf16x8 At[4][2], B0[2][2], B1[2][2];
    const char* cA = S.a_base(cur); const char* cB = S.b_base(cur);
    if constexpr (SP2) {
        PG8_STAGE(PG8_SB(0, 0), cB, voffB); PG8_STAGE(PG8_SB(0, 1), cB + hstep, voffB); PG8_STAGE(PG8_SA(0, 0), cA, voffA); PG8_STAGE(PG8_SA(0, 1), cA + hstep, voffA);
        if (wr == 1) PG8_BAR;
        PG8_WAIT_V(2); PG8_BAR;
        PG8_STAGE(PG8_SB(1, 0), cB + kstep, voffB); PG8_STAGE(PG8_SA(1, 0), cA + kstep, voffA); PG8_STAGE(PG8_SB(1, 1), cB + hstep + kstep, voffB);
        PG8_WAIT_V(6); PG8_BAR;
    } else {
        PG8_STAGE(PG8_SB(0, 0), cB, voffB); PG8_STAGE(PG8_SA(0, 0), cA, voffA); PG8_STAGE(PG8_SB(0, 1), cB + hstep, voffB); PG8_STAGE(PG8_SA(0, 1), cA + hstep, voffA);
        if (wr == 1) PG8_BAR;
        PG8_WAIT_V(4); PG8_BAR;
        PG8_STAGE(PG8_SB(1, 0), cB + kstep, voffB); PG8_STAGE(PG8_SA(1, 0), cA + kstep, voffA); PG8_STAGE(PG8_SB(1, 1), cB + hstep + kstep, voffB);
        PG8_WAIT_V(6); PG8_BAR;
    }
    for (;;) {
        const bool has_next = S.next(ui + 1, nxt);
        const char* nA = has_next ? S.a_base(nxt) : cA; const char* nB = has_next ? S.b_base(nxt) : cB;
        { unsigned long long ts_; PG8_STAMP(ts_); if (prb && pl_) { pg_ += ts_ - pl_; ++png_; } pl_ = ts_; }
        for (int t = 0; t < nt; t += 2) {
            const bool last = (t == nt - 2);
            const char* a1 = cA + (size_t)(t + 1) * kstep;
            const char* a2 = last ? nA : cA + (size_t)(t + 2) * kstep; const char* b2 = last ? nB : cB + (size_t)(t + 2) * kstep;
            const char* a3 = a2 + kstep; const char* b3 = b2 + kstep;
            if constexpr (SP2) {
            PG8_LDB(B0, 0, 0); PG8_LDB(B1, 0, 1); PG8_SCHED; PG8_LDA(At, 0, 0); PG8_STAGE(PG8_SA(1, 1), a1 + hstep, voffA);
            PG8_WAIT_V(8); PG8_WAIT_L(0); PG8_BAR; PG8_MMA(0, 0, At, B0); PG8_MMA(0, 1, At, B1); PG8_BAR; PG8_SCHED;
            PG8_LDA(At, 0, 1); PG8_STAGE(PG8_SB(0, 0), b2, voffB); PG8_STAGE(PG8_SB(0, 1), b2 + hstep, voffB); PG8_STAGE(PG8_SA(0, 0), a2, voffA);
            PG8_WAIT_V(8); PG8_WAIT_L(0); PG8_BAR; PG8_MMA(1, 0, At, B0); PG8_MMA(1, 1, At, B1); PG8_BAR; PG8_SCHED;
            PG8_LDB(B0, 1, 0); PG8_LDB(B1, 1, 1); PG8_SCHED; PG8_LDA(At, 1, 0); PG8_STAGE(PG8_SA(0, 1), a2 + hstep, voffA);
            PG8_WAIT_V(8); PG8_WAIT_L(0); PG8_BAR; PG8_MMA(0, 0, At, B0); PG8_MMA(0, 1, At, B1); PG8_BAR; PG8_SCHED;
            PG8_LDA(At, 1, 1); PG8_STAGE(PG8_SB(1, 0), b3, voffB); PG8_STAGE(PG8_SB(1, 1), b3 + hstep, voffB); PG8_STAGE(PG8_SA(1, 0), a3, voffA);
            PG8_WAIT_V(8); PG8_WAIT_L(0); PG8_BAR; PG8_MMA(1, 0, At, B0); PG8_MMA(1, 1, At, B1); PG8_BAR; PG8_SCHED;
            } else {
            PG8_LDB(B0, 0, 0); PG8_SCHED; PG8_LDA(At, 0, 0); PG8_STAGE(PG8_SA(1, 1), a1 + hstep, voffA);
            PG8_WAIT_L(8); PG8_BAR; PG8_WAIT_L(0); PG8_MMA(0, 0, At, B0); PG8_BAR; PG8_SCHED;
            PG8_LDB(B1, 0, 1); PG8_STAGE(PG8_SB(0, 0), b2, voffB);
            PG8_BAR; PG8_WAIT_L(0); PG8_MMA(0, 1, At, B1); PG8_BAR;
            PG8_LDA(At, 0, 1); PG8_STAGE(PG8_SA(0, 0), a2, voffA);
            PG8_BAR; PG8_WAIT_L(0); PG8_MMA(1, 0, At, B0); PG8_BAR; PG8_SCHED;
            PG8_STAGE(PG8_SB(0, 1), b2 + hstep, voffB);
            PG8_WAIT_V(6); PG8_BAR; PG8_MMA(1, 1, At, B1); PG8_BAR;
            PG8_LDB(B0, 1, 0); PG8_SCHED; PG8_LDA(At, 1, 0); PG8_STAGE(PG8_SA(0, 1), a2 + hstep, voffA);
            PG8_WAIT_L(8); PG8_BAR; PG8_WAIT_L(0); PG8_MMA(0, 0, At, B0); PG8_BAR; PG8_SCHED;
            PG8_LDB(B1, 1, 1); PG8_STAGE(PG8_SB(1, 0), b3, voffB);
            PG8_BAR; PG8_WAIT_L(0); PG8_MMA(0, 1, At, B1); PG8_BAR;
            PG8_LDA(At, 1, 1); PG8_STAGE(PG8_SA(1, 0), a3, voffA);
            PG8_BAR; PG8_WAIT_L(0); PG8_MMA(1, 0, At, B0); PG8_BAR; PG8_SCHED;
            PG8_STAGE(PG8_SB(1, 1), b3 + hstep, voffB);
            PG8_WAIT_V(6); PG8_BAR; PG8_MMA(1, 1, At, B1); PG8_BAR;
            }
        }
        { unsigned long long ts_; PG8_STAMP(ts_); if (prb) { pk_ += ts_ - pl_; pnk_ += (unsigned)nt; pl_ = ts_; } }
        if constexpr (FP8) asm volatile("s_nop 15\n\ts_nop 15" ::: "memory");
        if constexpr (ALIGN_EPI) { if (wr == 0) PG8_BAR; }
        E(acc, cur, wr, wc, fr, fq);
        if (!has_next) break;
#pragma unroll
        for (int a = 0; a < 2; ++a)
#pragma unroll
            for (int b = 0; b < 2; ++b)
#pragma unroll
                for (int m = 0; m < 4; ++m)
#pragma unroll
                    for (int n = 0; n < 2; ++n) acc[a][b][m][n] = (f32x4){0.f, 0.f, 0.f, 0.f};
        cur = nxt; cA = nA; cB = nB; ++ui;
        if constexpr (ALIGN_EPI) { if (wr == 1) PG8_BAR; }
    }
    PG8_WAIT_V(0);
    if constexpr (!ALIGN_EPI) { if (wr == 0) PG8_BAR; }
    PG8_BAR;
    if (prb && blockIdx.x == 0 && tid == 0) { if (PROBE_KIND == 4) prb[20] = (unsigned)((pk_ / (pnk_ ? pnk_ : 1u)) * 100ull); if (PROBE_KIND == 5) prb[20] = (unsigned)((pg_ / (png_ ? png_ : 1u)) * 10ull); }
#undef PG8_STAMP
#undef PG8_SA
#undef PG8_SB
#undef PG8_STAGE
#undef PG8_LDA
#undef PG8_LDB
#undef PG8_MMA
#undef PG8_WAIT_V
#undef PG8_WAIT_L
#undef PG8_BAR
#undef PG8_SCHED
}
}
constexpr bool GEMM_SP2 = true, GEMM_ALIGN = true;

namespace att {
constexpr int D = 128, LDQ = NQKV, LDO = DM;
constexpr float SCALE = 0.08838834764831845f, THR = 8.f;
constexpr int NW = 8, QBLK = 32, KVBLK = 64, QB = NW * QBLK;
constexpr int SHM_V = KVBLK * D * 2, SHM_K = KVBLK * D * 2;
constexpr int LDS_ATT = 2 * SHM_V + 2 * SHM_K + NW * 64 * 4;
constexpr unsigned BIGW = 0x40000000u;
#define KSWZ(row, colB) ((row) * 256 + ((colB) ^ (((row) & 7) << 4)))
#define SBAR() __builtin_amdgcn_sched_barrier(0)
__device__ __forceinline__ int v_st(int k, int c) { const int kk = (k & ~0xC) | ((k & 4) << 1) | ((k & 8) >> 1); return ((kk >> 3) * 4 + (c >> 5)) * 512 + ((kk & 7) * 32 + (c & 31)) * 2; }
__device__ __forceinline__ int v_rd_base(int lane) { return ((lane & 3) << 3) | (((lane >> 2) & 3) << 6) | (((lane >> 4) & 1) << 5) | (((lane >> 5) & 1) << 8); }
constexpr int v_rd_off(int d0, int ks, int half) { return d0 * 512 + ks * 4096 + half * 2048; }
__device__ __forceinline__ int crow(int r, int hi) { return (r & 3) + 8 * (r >> 2) + 4 * hi; }
__device__ __forceinline__ bf16x8 ld8(const bf16_t* p) { return *reinterpret_cast<const bf16x8*>(p); }
__device__ __forceinline__ void mask_tile(f32x16& p0, f32x16& p1, int dq) {
    const float NEG = -__builtin_inff();
#pragma unroll
    for (int r = 0; r < 16; ++r) {
        const int c = (r & 3) + 8 * (r >> 2);
        if ((unsigned)(dq - c) >= BIGW) p0[r] = NEG;
        if ((unsigned)(dq - c - 32) >= BIGW) p1[r] = NEG;
    }
}
__device__ __forceinline__ void mask_lane(f32x16& p0, f32x16& p1, bool keep) {
    const float NEG = -__builtin_inff();
#pragma unroll
    for (int r = 0; r < 16; ++r) { p0[r] = keep ? p0[r] : NEG; p1[r] = keep ? p1[r] : NEG; }
}
__device__ __forceinline__ void partialSM(f32x16& p0, f32x16& p1, float& m_reg, float& mn, float& alpha) {
    float pmax = p0[0]; for (int r = 1; r < 16; ++r) pmax = fmaxf(pmax, p0[r]); for (int r = 0; r < 16; ++r) pmax = fmaxf(pmax, p1[r]);
    { auto rr = __builtin_amdgcn_permlane32_swap(__float_as_uint(pmax), __float_as_uint(pmax), false, false);
      pmax = fmaxf(__uint_as_float(rr[0]), __uint_as_float(rr[1])); }
    constexpr float C2 = 1.4426950408889634f * SCALE;
    if (__builtin_expect(__all((pmax - m_reg) * SCALE <= THR), 1)) { mn = m_reg; alpha = 1.f; }
    else { mn = fmaxf(m_reg, pmax); alpha = __builtin_amdgcn_exp2f((m_reg - mn) * C2); m_reg = mn; }
    const float mnL = -mn * C2;
    for (int r = 0; r < 16; ++r) p0[r] = fmaf(p0[r], C2, mnL); for (int r = 0; r < 16; ++r) p1[r] = fmaf(p1[r], C2, mnL);
    for (int r = 0; r < 16; ++r) p0[r] = __builtin_amdgcn_exp2f(p0[r]);
}
__device__ __forceinline__ void finishSM(f32x16& p0, f32x16& p1, float alpha, float& l_reg, bf16x8& pa0, bf16x8& pa1, bf16x8& pa2, bf16x8& pa3) {
    for (int r = 0; r < 16; ++r) p1[r] = __builtin_amdgcn_exp2f(p1[r]);
    float ps = 0; for (int r = 0; r < 16; ++r) ps += p0[r]; for (int r = 0; r < 16; ++r) ps += p1[r];
    { auto rr = __builtin_amdgcn_permlane32_swap(__float_as_uint(ps), __float_as_uint(ps), false, false);
      ps = __uint_as_float(rr[0]) + __uint_as_float(rr[1]); }
    l_reg = l_reg * alpha + ps;
#define PK4(P, B_, OUT) do { unsigned a0 = cvt_pk_bf16(P[B_+0], P[B_+1]), a1 = cvt_pk_bf16(P[B_+2], P[B_+3]);                          \
        unsigned b0 = cvt_pk_bf16(P[B_+4], P[B_+5]), b1 = cvt_pk_bf16(P[B_+6], P[B_+7]);                                             \
        auto r0 = __builtin_amdgcn_permlane32_swap(a0, b0, false, false); auto r1 = __builtin_amdgcn_permlane32_swap(a1, b1, false, false); \
        u32x4 w = {r0[0], r1[0], r0[1], r1[1]}; OUT = *reinterpret_cast<bf16x8*>(&w); } while (0)
    PK4(p0, 0, pa0); PK4(p0, 8, pa1); PK4(p1, 0, pa2); PK4(p1, 8, pa3);
#undef PK4
}
template <int KB>
__device__ __forceinline__ void qkt(f32x16& p0, f32x16& p1, const char* K_lds, int r32, int hi, const bf16x8* qr, float a, float bias0) {
#pragma unroll
    for (int r = 0; r < 16; ++r) { const float c = (float)((r & 3) + 8 * (r >> 2)); p0[r] = fmaf(a, c, bias0); p1[r] = fmaf(a, c + 32.f, bias0); }
    const char* kb[4];
#pragma unroll
    for (int dd = 0; dd < 4; ++dd) kb[dd] = K_lds + KB * SHM_K + KSWZ(r32, (dd * 16 + hi * 8) * 2);
#pragma unroll
    for (int d0 = 0; d0 < 8; ++d0) { const char* ap = kb[d0 & 3] + (d0 >> 2) * 128;
        bf16x8 b0 = *reinterpret_cast<const bf16x8*>(ap);
        bf16x8 b1 = *reinterpret_cast<const bf16x8*>(ap + 32 * 256);
        p0 = __builtin_amdgcn_mfma_f32_32x32x16_bf16(b0, qr[d0], p0, 0, 0, 0);
        p1 = __builtin_amdgcn_mfma_f32_32x32x16_bf16(b1, qr[d0], p1, 0, 0, 0); }
}
template <int VB>
__device__ __forceinline__ void pv_tile(f32x16* o, int vb0, bf16x8 pa0, bf16x8 pa1, bf16x8 pa2, bf16x8 pa3) {
#define TRRD(dst, off) asm volatile("ds_read_b64_tr_b16 %0, %1 offset:%2" : "=&v"(dst) : "v"(vb0), "i"(off) : "memory")
#define PV_D0(d0) do { s16x4 l0, l1, l2, l3, h0, h1, h2, h3; constexpr int b_ = VB * SHM_V + v_rd_off(d0, 0, 0); \
        TRRD(l0, b_); TRRD(h0, b_ + 2048); TRRD(l1, b_ + 4096); TRRD(h1, b_ + 6144); TRRD(l2, b_ + 8192); TRRD(h2, b_ + 10240); TRRD(l3, b_ + 12288); TRRD(h3, b_ + 14336); \
        asm volatile("s_waitcnt lgkmcnt(0)" ::: "memory"); SBAR();   \
        o[d0] = __builtin_amdgcn_mfma_f32_32x32x16_bf16(pa0, (bf16x8){l0[0], l0[1], l0[2], l0[3], h0[0], h0[1], h0[2], h0[3]}, o[d0], 0, 0, 0);   \
        o[d0] = __builtin_amdgcn_mfma_f32_32x32x16_bf16(pa1, (bf16x8){l1[0], l1[1], l1[2], l1[3], h1[0], h1[1], h1[2], h1[3]}, o[d0], 0, 0, 0);   \
        o[d0] = __builtin_amdgcn_mfma_f32_32x32x16_bf16(pa2, (bf16x8){l2[0], l2[1], l2[2], l2[3], h2[0], h2[1], h2[2], h2[3]}, o[d0], 0, 0, 0);   \
        o[d0] = __builtin_amdgcn_mfma_f32_32x32x16_bf16(pa3, (bf16x8){l3[0], l3[1], l3[2], l3[3], h3[0], h3[1], h3[2], h3[3]}, o[d0], 0, 0, 0); } while (0)
    PV_D0(0); PV_D0(1); PV_D0(2); PV_D0(3);
#undef PV_D0
#undef TRRD
}
struct BlockRef { const bf16_t* Q; const bf16_t* K; const bf16_t* V; bf16_t* O; const unsigned char* sel; int P0; float a; int jlo; };
struct Seam { bf16x8 qr[8]; bf16x8 st_v0, st_v1, st_k0, st_k1; };
#define AROW(p, k0, rr) (((p) + (size_t)((k0) + (rr)) * LDQ) + toff)
#define VMW() asm volatile("s_waitcnt vmcnt(0)" ::: "memory")
#define VMWN(n) asm volatile("s_waitcnt vmcnt(%0)" :: "i"(n) : "memory")
#define SLOAD_H(Kp, Vp, k0) do { S.st_v0 = ld8(AROW(Vp, k0, 0)); S.st_v1 = ld8(AROW(Vp, k0, 32));              \
                         S.st_k0 = ld8(AROW(Kp, k0, 0)); S.st_k1 = ld8(AROW(Kp, k0, 32)); } while (0)
#define SWRITE_HK(bf) do { *(bf16x8*)(K_lds + (bf) * SHM_K + kws) = S.st_k0; *(bf16x8*)(K_lds + (bf) * SHM_K + kws + 32 * 256) = S.st_k1; } while (0)
#define SWRITE_HV(bf) do { *(bf16x8*)(V_lds + (bf) * SHM_V + vst0) = S.st_v0; *(bf16x8*)(V_lds + (bf) * SHM_V + vst1) = S.st_v1; } while (0)
#define SWRITE_H(bf) do { SWRITE_HV(bf); SWRITE_HK(bf); } while (0)
__device__ __forceinline__ int attn_jlo(const unsigned* bnd, int qseg, int kseg, int b, int qb, float slope) {
    float q2 = 0.f, k2 = 0.f;
#pragma unroll
    for (int w = 0; w < 4; ++w) q2 += __uint_as_float(bnd[((size_t)qseg * 64 + b * 8 + qb) * 4 + w]);
    for (int t = 0; t <= qb; ++t) { float s2 = 0.f;
#pragma unroll
        for (int w = 0; w < 4; ++w) s2 += __uint_as_float(bnd[((size_t)kseg * 64 + b * 8 + t) * 4 + w]);
        k2 = __builtin_fmaxf(k2, s2); }
    const float W = (2.0f * 1.02f * __builtin_sqrtf(q2 * k2) * SCALE + 30.0f) / slope, lo = (float)(qb * 256) - W;
    return lo > 0.f ? (int)(lo * (1.0f / 64.0f)) : 0;
}
struct DynCtx { const bf16_t* qkv; bf16_t* out; const unsigned char* sel; const unsigned* bnd; unsigned* qctr; volatile LAS int* nw; int q0, qb0, nq; const LAS int* jt; };
template <bool MOBA> __device__ __forceinline__ BlockRef attn_ref_blk(int code, const DynCtx& C) {
    constexpr int NH = MOBA ? HA : HB * 4, NPB = NH * 8;
    const int b = code / NPB, idx = code % NPB, qb = 7 - idx / NH, hh = NH - 1 - idx % NH; BlockRef r; const size_t t0 = (size_t)b * SEQ;
    if (MOBA) { const int h = hh; const float slope = __builtin_amdgcn_exp2f(-0.5f * (float)(h + 1));
        r.Q = C.qkv + (t0 + qb * 256) * NQKV + h * 128; r.K = C.qkv + t0 * NQKV + DM + h * 128; r.V = C.qkv + t0 * NQKV + 2 * DM + h * 128;
        r.O = C.out + (t0 + qb * 256) * DM + h * 128; r.sel = C.sel + (size_t)(b * HA + h) * SEQ; r.P0 = qb * 256; r.a = slope * (1.0f / SCALE); r.jlo = C.jt[(b - C.qb0) * 128 + h * 8 + qb]; }
    else { const int h = hh >> 2, c = (hh >> 1) & 1, vh = hh & 1; const float slope = __builtin_amdgcn_exp2f(-(float)(h + 1));
        r.Q = C.qkv + (t0 + qb * 256) * NQKV + 2 * DM + h * 256 + c * 128; r.K = C.qkv + t0 * NQKV + h * 256 + c * 128; r.V = C.qkv + t0 * NQKV + DM + h * 256 + vh * 128;
        r.O = C.out + (size_t)c * MTOK * DM + (t0 + qb * 256) * DM + h * 256 + vh * 128; r.sel = nullptr; r.P0 = qb * 256; r.a = slope * (1.0f / SCALE); r.jlo = C.jt[(b - C.qb0) * 128 + (2 * h + c) * 8 + qb]; }
    return r;
}
__device__ __forceinline__ int attn_pull_from(unsigned* qctr, int q0, int k0, int npb, int qb0, int nq) {
    for (int k = k0; k < nq; ++k) { const int q = qb0 + ((q0 - qb0 + k) & (nq - 1)); if (xb_ld(qctr + 64 * q) >= (unsigned)npb) continue;
        const unsigned i = xb_add(qctr + 64 * q, 1u); if (i < (unsigned)npb) return q * npb + (int)i; }
    return -1;
}
__device__ __forceinline__ void attn_prime(const BlockRef& cur, char* lds, Seam& S) {
    int tid_ = threadIdx.x; asm volatile("" : "+v"(tid_));
    const int tid = tid_, wid = __builtin_amdgcn_readfirstlane(tid >> 6), lane = tid & 63, r32 = lane & 31, hi = lane >> 5;
    const int sr = tid >> 4, sc = (tid & 15) * 8, kws = KSWZ(sr, sc * 2); char* K_lds = lds + 2 * SHM_V; const unsigned toff = (unsigned)(sr * LDQ + sc);
    { const unsigned qoff = (unsigned)(r32 * LDQ + hi * 8); const bf16_t* qb_ = cur.Q + (size_t)(wid * QBLK) * LDQ;
      for (int d0 = 0; d0 < 8; ++d0) S.qr[d0] = ld8(qb_ + qoff + d0 * 16); }
    SLOAD_H(cur.K, cur.V, cur.jlo * KVBLK); VMW(); SWRITE_HK(0);
    __syncthreads();
}
template <bool MOBA>
__device__ __forceinline__ int attn_block(const BlockRef& cur, const DynCtx& C, char* lds, Seam& S) {
    int tid_ = threadIdx.x; asm volatile("" : "+v"(tid_));
    const int tid = tid_, wid = __builtin_amdgcn_readfirstlane(tid >> 6), lane = tid & 63, r32 = lane & 31, hi = lane >> 5;
    const int NT = (cur.P0 + QB) / KVBLK - cur.jlo;
    const int qlo = cur.P0 + wid * QBLK, qm = qlo + r32 - 4 * hi;
    char* V_lds = lds; char* K_lds = lds + 2 * SHM_V;
    float* ws = (float*)(lds + 2 * SHM_V + 2 * SHM_K) + wid * 64; float* li_l = ws, * al_l = ws + 32;
    float m_reg = -1e30f, l_reg = 0; f32x16 o[4] = {};
    const int sr = tid >> 4, sc = (tid & 15) * 8, vst0 = v_st(sr, sc), vst1 = v_st(32 + sr, sc), kws = KSWZ(sr, sc * 2); const unsigned toff = (unsigned)(sr * LDQ + sc);
    const int vb0 = (int)(uintptr_t)V_lds + v_rd_base(lane);
    const bf16_t* Kh = cur.K; const bf16_t* Vh = cur.V;
    unsigned selm = 0xffu; if (MOBA) selm = cur.sel[cur.P0 + wid * QBLK + r32];
    const float aa = cur.a, abase = -aa * (float)qm;
#define RESC(a) do { if (__any((a) < 1.f)) { if (hi == 0) al_l[r32] = (a); asm volatile("s_waitcnt lgkmcnt(0)" ::: "memory");              \
                     for (int d_ = 0; d_ < 4; ++d_) for (int r = 0; r < 16; ++r) o[d_][r] *= al_l[crow(r, hi)]; } } while (0)
#define KBASE(t) ((cur.jlo + (t)) * KVBLK)
#define BIAS(t) fmaf(aa, (float)KBASE(t), abase)
#define MASKT(P0_, P1_, t) do { const int kb_ = KBASE(t); \
        if (!MOBA || kb_ >= cur.P0) { if (kb_ + KVBLK - 1 > qlo) mask_tile(P0_, P1_, qm - kb_); } \
        else { const bool keep_ = ((selm >> (kb_ >> 8)) & 1u) != 0u; if (!__all(keep_)) mask_lane(P0_, P1_, keep_); } } while (0)
#define SEAM_K0() do { VMWN(8); SWRITE_HK(0); SBAR(); } while (0)
    f32x16 pA0, pA1, pB0, pB1; float mnA, mnB, alA, alB; bf16x8 pa0, pa1, pa2, pa3;
    SWRITE_HV(0); SBAR();
    if (NT > 1) { SLOAD_H(Kh, Vh, KBASE(1)); }
    constexpr int NPB_ = (MOBA ? HA : HB * 4) * 8; unsigned pi_ = 0u; if (tid == 0) pi_ = xb_add(C.qctr + 64 * C.q0, 1u);
    SBAR(); qkt<0>(pA0, pA1, K_lds, r32, hi, S.qr, aa, BIAS(0));
    MASKT(pA0, pA1, 0); partialSM(pA0, pA1, m_reg, mnA, alA);
    if (NT > 1) { VMW(); SWRITE_H(1); }
    if (tid == 0) *C.nw = pi_ < (unsigned)NPB_ ? C.q0 * NPB_ + (int)pi_ : attn_pull_from(C.qctr, C.q0, 1, NPB_, C.qb0, C.nq);
    __syncthreads();
#define HALF_STEP(PX0, PX1, mnX, alX, PY0, PY1, alY, t, KB, VB, SB) do {                                                      \
        SBAR(); qkt<KB>(PX0, PX1, K_lds, r32, hi, S.qr, aa, BIAS(t));                                                         \
        finishSM(PY0, PY1, alY, l_reg, pa0, pa1, pa2, pa3); SBAR();                                                           \
        if ((t) + 1 < NT) { SLOAD_H(Kh, Vh, KBASE((t) + 1)); SBAR(); }                                                        \
        pv_tile<VB>(o, vb0, pa0, pa1, pa2, pa3); MASKT(PX0, PX1, (t)); partialSM(PX0, PX1, m_reg, mnX, alX);                  \
        __syncthreads();                                                                                                      \
        if ((t) + 1 < NT) { VMW(); SWRITE_H(SB); }                                                                            \
        RESC(alX); __syncthreads(); } while (0)
    for (int t = 1; t + 1 < NT; t += 2) {
        HALF_STEP(pB0, pB1, mnB, alB, pA0, pA1, alA, t, 1, 0, 0);
        HALF_STEP(pA0, pA1, mnA, alA, pB0, pB1, alB, t + 1, 0, 1, 1);
    }
    const bool even = (NT & 1) == 0;
    if (even) { SBAR(); qkt<1>(pB0, pB1, K_lds, r32, hi, S.qr, aa, BIAS(NT - 1)); SBAR(); }
    const int nc_ = __builtin_amdgcn_readfirstlane(*C.nw); const BlockRef nxt = nc_ >= 0 ? attn_ref_blk<MOBA>(nc_, C) : cur;
    SLOAD_H(nxt.K, nxt.V, nxt.jlo * KVBLK); SBAR();
    { const unsigned qoff = (unsigned)(r32 * LDQ + hi * 8); const bf16_t* qb_ = nxt.Q + (size_t)(wid * QBLK) * LDQ;
      _Pragma("unroll") for (int d0 = 0; d0 < 8; ++d0) S.qr[d0] = ld8(qb_ + qoff + d0 * 16); }
    SBAR();
    finishSM(pA0, pA1, alA, l_reg, pa0, pa1, pa2, pa3); SBAR();
    pv_tile<0>(o, vb0, pa0, pa1, pa2, pa3);
    if (even) { MASKT(pB0, pB1, NT - 1); partialSM(pB0, pB1, m_reg, mnB, alB); __syncthreads(); RESC(alB);
        finishSM(pB0, pB1, alB, l_reg, pa0, pa1, pa2, pa3); SBAR(); pv_tile<1>(o, vb0, pa0, pa1, pa2, pa3); }
    SBAR(); SEAM_K0();
    if (hi == 0) li_l[r32] = l_reg; asm volatile("s_waitcnt lgkmcnt(0)" ::: "memory");
    float rli[16];
#pragma unroll
    for (int r = 0; r < 16; ++r) rli[r] = __builtin_amdgcn_rcpf(li_l[crow(r, hi)]);
    bf16_t* Ow = cur.O + (size_t)(wid * QBLK) * LDO;
#pragma unroll
    for (int r = 0; r < 16; ++r) { const int orow = crow(r, hi);
#pragma unroll
        for (int d0 = 0; d0 < 4; ++d0) { const float v = o[d0][r] * rli[r];
            const float vn = xor1_get(v);
            if ((r32 & 1) == 0) *(unsigned*)(Ow + (size_t)orow * LDO + d0 * 32 + r32) = cvt_pk_bf16(v, vn); } }
    __syncthreads();
    return nc_;
#undef RESC
#undef KBASE
#undef BIAS
#undef MASKT
#undef SEAM_K0
#undef HALF_STEP
}
#undef AROW
#undef VMW
#undef VMWN
#undef SLOAD_H
#undef SWRITE_HK
#undef SWRITE_HV
#undef SWRITE_H
}

constexpr int NWAVES = 8, NTHREADS = NWAVES * 64, NPHASE = 17;
struct Args { const float* in[23]; float* out; unsigned char* ws; int ph_lo, ph_hi; };
struct Frame { LAS unsigned char* lds; int tid, lane, wave, G, vc, gw, NGW; };
typedef const __attribute__((address_space(4))) Args* KAP;

struct WJob { const float* src; void* dst; const float* gain; float sc; int K, N, mode, kb, nb, f8; };
__device__ __forceinline__ int wdrow(int n, int mode) { return mode == 0 ? n : ((n >> 7) * 256 + (mode == 2 ? 128 : 0) + (n & 127)); }
constexpr int I_QKV = 32 * 24, I_OA = 32 * 8, I_G = 32 * 22, I_DN = 88 * 8, I_KV = 32 * 16, I_QB = 32 * 8, I_OB = 32 * 8, I_E1 = 32 * 28, I_EG = 8 * I_E1, I_ED1 = 112 * 8, I_ED = 8 * I_ED1;
constexpr int W_NITEMS0 = I_QKV + I_OA + 2 * I_G + I_DN + I_KV + I_QB + I_OB;
constexpr int W_NEXP = 2 * I_EG + I_ED, W_NITEMS = W_NITEMS0 + W_NEXP;
__device__ __forceinline__ void wjob_decode(KAP ap, int item, WJob& j) {
    unsigned char* ws = ap->ws; int r = item; int nbn; j.f8 = 0; j.sc = 1.0f;
    if (r < I_QKV) { j.src = ap->in[2]; j.dst = (bf16_t*)(ws + WS_WQKV); j.gain = ap->in[1]; j.K = DM; j.N = NQKV; j.mode = 0; }
    else if ((r -= I_QKV) < I_OA) { j.src = ap->in[3]; j.dst = (bf16_t*)(ws + WS_WOA); j.gain = nullptr; j.K = DM; j.N = DM; j.mode = 0; }
    else if ((r -= I_OA) < I_G) { j.src = ap->in[15]; j.dst = (bf16_t*)(ws + WS_WGU); j.gain = ap->in[14]; j.K = DM; j.N = FF; j.mode = 1; }
    else if ((r -= I_G) < I_G) { j.src = ap->in[16]; j.dst = (bf16_t*)(ws + WS_WGU); j.gain = ap->in[14]; j.K = DM; j.N = FF; j.mode = 2; }
    else if ((r -= I_G) < I_DN) { j.src = ap->in[17]; j.dst = (bf16_t*)(ws + WS_WDN); j.gain = nullptr; j.K = FF; j.N = DM; j.mode = 0; }
    else if ((r -= I_DN) < I_KV) { j.src = ap->in[5]; j.dst = (bf16_t*)(ws + WS_WKVQ); j.gain = ap->in[4]; j.K = DM; j.N = 2 * DM; j.mode = 0; }
    else if ((r -= I_KV) < I_QB) { j.src = ap->in[7]; j.dst = (bf16_t*)(ws + WS_WKVQ) + (size_t)2 * DM * DM; j.gain = ap->in[6]; j.K = DM; j.N = DM; j.mode = 0; }
    else if ((r -= I_QB) < I_OB) { j.src = ap->in[13]; j.dst = (bf16_t*)(ws + WS_WOB); j.gain = nullptr; j.K = DM; j.N = DM; j.mode = 0; }
    else if ((r -= I_OB) < I_EG) { const int e = r / I_E1; r -= e * I_E1; j.src = ap->in[19] + (size_t)e * DM * FE; j.dst = ws + WS_WEGU + (size_t)e * 2 * FE * DM; j.gain = ap->in[14] + DM; j.K = DM; j.N = FE; j.mode = 1; j.f8 = 1; j.sc = WEGU_SC; }
    else if ((r -= I_EG) < I_EG) { const int e = r / I_E1; r -= e * I_E1; j.src = ap->in[20] + (size_t)e * DM * FE; j.dst = ws + WS_WEGU + (size_t)e * 2 * FE * DM; j.gain = ap->in[14] + DM; j.K = DM; j.N = FE; j.mode = 2; j.f8 = 1; j.sc = WEGU_SC; }
    else { r -= I_EG; const int e = r / I_ED1; r -= e * I_ED1; j.src = ap->in[21] + (size_t)e * FE * DM; j.dst = ws + WS_WEDN + (size_t)e * DM * FE; j.gain = nullptr; j.K = FE; j.N = DM; j.mode = 0; j.f8 = 1; j.sc = WEDN_SC; }
    nbn = j.N >> 8; j.kb = r / nbn; j.nb = r - j.kb * nbn;
}
__device__ __forceinline__ void p0_weights(KAP a, Frame& F, int first, const int end, const int stride) {
    LAS float* tile = (LAS float*)F.lds;
    const int w = F.wave, l = F.lane;
    float v[32];
    int item = first; bool have = item < end; WJob j;
#define W_LOAD() do { const float* sp = j.src + (size_t)(j.kb * 64 + w) * j.N + j.nb * 256 + l; \
        _Pragma("unroll") for (int i = 0; i < 8; ++i) _Pragma("unroll") for (int c = 0; c < 4; ++c) v[i * 4 + c] = __builtin_nontemporal_load(sp + (size_t)(8 * i) * j.N + 64 * c); } while (0)
    if (have) { wjob_decode(a, item, j); W_LOAD(); }
    while (have) {
        __syncthreads();
#pragma unroll
        for (int i = 0; i < 8; ++i) { const int k = w + 8 * i; const float g = (j.gain ? j.gain[j.kb * 64 + k] : 1.0f) * j.sc;
#pragma unroll
            for (int c = 0; c < 4; ++c) tile[k * 257 + l + 64 * c] = v[i * 4 + c] * g; }
        void* cdst = j.dst; const int cK = j.K, cmode = j.mode, ckb = j.kb, cnb = j.nb, cf8 = j.f8;
        item += stride; const bool have_next = item < end;
        if (have_next) { wjob_decode(a, item, j); W_LOAD(); }
        __syncthreads();
        if (cf8) {
            const int c4 = l >> 4, n16 = l & 15;
#pragma unroll
            for (int jj = 0; jj < 2; ++jj) { const int n = n16 + 16 * w + 128 * jj; const LAS float* s = tile + (16 * c4) * 257 + n;
                u32x4 o; o.x = pg8::pk4_fp8(s[0], s[257], s[2 * 257], s[3 * 257]); o.y = pg8::pk4_fp8(s[4 * 257], s[5 * 257], s[6 * 257], s[7 * 257]);
                o.z = pg8::pk4_fp8(s[8 * 257], s[9 * 257], s[10 * 257], s[11 * 257]); o.w = pg8::pk4_fp8(s[12 * 257], s[13 * 257], s[14 * 257], s[15 * 257]);
                *(u32x4*)((unsigned char*)cdst + (size_t)wdrow(cnb * 256 + n, cmode) * cK + ckb * 64 + 16 * c4) = o; }
        } else {
        const int c8 = l >> 3, nn = l & 7;
#pragma unroll
        for (int jj = 0; jj < 4; ++jj) { const int n = nn + 8 * w + 64 * jj; const LAS float* s = tile + (8 * c8) * 257 + n;
            u32x4 o; o.x = cvt_pk_bf16(s[0], s[257]); o.y = cvt_pk_bf16(s[2 * 257], s[3 * 257]); o.z = cvt_pk_bf16(s[4 * 257], s[5 * 257]); o.w = cvt_pk_bf16(s[6 * 257], s[7 * 257]);
            *(u32x4*)((bf16_t*)cdst + (size_t)wdrow(cnb * 256 + n, cmode) * cK + ckb * 64 + 8 * c8) = o; }
        }
        have = have_next;
    }
#undef W_LOAD
    __syncthreads();
}
#ifndef W_DEEP4
#define W_DEEP4 1
#endif
__device__ __forceinline__ void p0_weights2(KAP a, Frame& F, int first, const int end, const int stride) {
    const int w = F.wave, l = F.lane;
    float va[32], vb[32];
    WJob ja, jb;
#define W_LOAD2(J, V) do { const float* sp = (J).src + (size_t)((J).kb * 64 + w) * (J).N + (J).nb * 256 + l; \
        _Pragma("unroll") for (int i = 0; i < 8; ++i) _Pragma("unroll") for (int c = 0; c < 4; ++c) (V)[i * 4 + c] = __builtin_nontemporal_load(sp + (size_t)(8 * i) * (J).N + 64 * c); } while (0)
#define W_ITEM2(J, V, TILE, NEXT_ITEM) do { \
        LAS float* tile = (LAS float*)F.lds + (TILE) * (64 * 257); \
        _Pragma("unroll") for (int i = 0; i < 8; ++i) { const int k = w + 8 * i; const float g = ((J).gain ? (J).gain[(J).kb * 64 + k] : 1.0f) * (J).sc; \
            _Pragma("unroll") for (int c = 0; c < 4; ++c) tile[k * 257 + l + 64 * c] = (V)[i * 4 + c] * g; } \
        void* cdst = (J).dst; const int cK = (J).K, cmode = (J).mode, ckb = (J).kb, cnb = (J).nb, cf8 = (J).f8; \
        if ((NEXT_ITEM) < end) { wjob_decode(a, (NEXT_ITEM), (J)); W_LOAD2(J, V); } \
        __syncthreads(); \
        if (cf8) { const int c4 = l >> 4, n16 = l & 15; \
            _Pragma("unroll") for (int jj = 0; jj < 2; ++jj) { const int n = n16 + 16 * w + 128 * jj; const LAS float* s = tile + (16 * c4) * 257 + n; \
                u32x4 o; o.x = pg8::pk4_fp8(s[0], s[257], s[2 * 257], s[3 * 257]); o.y = pg8::pk4_fp8(s[4 * 257], s[5 * 257], s[6 * 257], s[7 * 257]); \
                o.z = pg8::pk4_fp8(s[8 * 257], s[9 * 257], s[10 * 257], s[11 * 257]); o.w = pg8::pk4_fp8(s[12 * 257], s[13 * 257], s[14 * 257], s[15 * 257]); \
                *(u32x4*)((unsigned char*)cdst + (size_t)wdrow(cnb * 256 + n, cmode) * cK + ckb * 64 + 16 * c4) = o; } \
        } else { const int c8 = l >> 3, nn = l & 7; \
            _Pragma("unroll") for (int jj = 0; jj < 4; ++jj) { const int n = nn + 8 * w + 64 * jj; const LAS float* s = tile + (8 * c8) * 257 + n; \
                u32x4 o; o.x = cvt_pk_bf16(s[0], s[257]); o.y = cvt_pk_bf16(s[2 * 257], s[3 * 257]); o.z = cvt_pk_bf16(s[4 * 257], s[5 * 257]); o.w = cvt_pk_bf16(s[6 * 257], s[7 * 257]); \
                *(u32x4*)((bf16_t*)cdst + (size_t)wdrow(cnb * 256 + n, cmode) * cK + ckb * 64 + 8 * c8) = o; } } \
    } while (0)
    int item = first;
    __syncthreads();
#if W_DEEP4
    float vc[32], vd[32]; WJob jc, jd;
    if (item < end) { wjob_decode(a, item, ja); W_LOAD2(ja, va); }
    if (item + stride < end) { wjob_decode(a, item + stride, jb); W_LOAD2(jb, vb); }
    if (item + 2 * stride < end) { wjob_decode(a, item + 2 * stride, jc); W_LOAD2(jc, vc); }
    if (item + 3 * stride < end) { wjob_decode(a, item + 3 * stride, jd); W_LOAD2(jd, vd); }
    for (; item < end; item += 4 * stride) {
        W_ITEM2(ja, va, 0, item + 4 * stride);
        if (item + stride < end) W_ITEM2(jb, vb, 1, item + 5 * stride);
        if (item + 2 * stride < end) W_ITEM2(jc, vc, 0, item + 6 * stride);
        if (item + 3 * stride < end) W_ITEM2(jd, vd, 1, item + 7 * stride);
    }
#else
    if (item < end) { wjob_decode(a, item, ja); W_LOAD2(ja, va); }
    if (item + stride < end) { wjob_decode(a, item + stride, jb); W_LOAD2(jb, vb); }
    for (; item < end; item += 2 * stride) {
        W_ITEM2(ja, va, 0, item + 2 * stride);
        if (item + stride < end) W_ITEM2(jb, vb, 1, item + 3 * stride);
    }
#endif
#undef W_LOAD2
#undef W_ITEM2
    __syncthreads();
}
__device__ __forceinline__ void p0_weights_r(KAP a, Frame& F, int first, const int end, const int wg, const int nwg) {
    const int t = F.tid & 255, half = __builtin_amdgcn_readfirstlane(F.tid >> 8), nq = t & 15, kq = (t >> 4) & 3, ng = t >> 6;
    const int n0 = ng * 64 + nq * 4, k0 = kq * 16, nworkers = 2 * nwg;
    f32x4 va[16], vb[16], ga[4], gb[4]; WJob ja, jb;
#define WR_LOAD(J, V, G) do { const char* ub = (const char*)((J).src + (size_t)(J).kb * 64 * (J).N + (J).nb * 256); const unsigned loff = (unsigned)(k0 * (J).N + n0) * 4u; \
        _Pragma("unroll") for (int i = 0; i < 16; ++i) (V)[i] = __builtin_nontemporal_load((const f32x4*)(ub + (size_t)i * (J).N * 4 + loff)); \
        _Pragma("unroll") for (int i = 0; i < 4; ++i) (G)[i] = (J).gain ? *(const f32x4*)((J).gain + (J).kb * 64 + k0 + 4 * i) : (f32x4){1.f, 1.f, 1.f, 1.f}; } while (0)
#define WR_ITEM(J, V, G, NEXT_ITEM) do { \
        _Pragma("unroll") for (int i = 0; i < 4; ++i) (G)[i] = (G)[i] * (J).sc; \
        unsigned char* cdst = (unsigned char*)(J).dst; const int cK = (J).K, cmode = (J).mode, ckb = (J).kb, cnb = (J).nb; \
        _Pragma("unroll") for (int j = 0; j < 4; ++j) { u32x4 o; \
            o.x = pg8::pk4_fp8((V)[0][j] * (G)[0][0], (V)[1][j] * (G)[0][1], (V)[2][j] * (G)[0][2], (V)[3][j] * (G)[0][3]); o.y = pg8::pk4_fp8((V)[4][j] * (G)[1][0], (V)[5][j] * (G)[1][1], (V)[6][j] * (G)[1][2], (V)[7][j] * (G)[1][3]); \
            o.z = pg8::pk4_fp8((V)[8][j] * (G)[2][0], (V)[9][j] * (G)[2][1], (V)[10][j] * (G)[2][2], (V)[11][j] * (G)[2][3]); o.w = pg8::pk4_fp8((V)[12][j] * (G)[3][0], (V)[13][j] * (G)[3][1], (V)[14][j] * (G)[3][2], (V)[15][j] * (G)[3][3]); \
            *(u32x4*)(cdst + (size_t)wdrow(cnb * 256 + n0 + j, cmode) * cK + ckb * 64 + k0) = o; } \
        if ((NEXT_ITEM) < end) { wjob_decode(a, (NEXT_ITEM), (J)); WR_LOAD(J, V, G); } \
    } while (0)
    int item = first + 2 * wg + half;
    if (item < end) { wjob_decode(a, item, ja); WR_LOAD(ja, va, ga); }
    if (item + nworkers < end) { wjob_decode(a, item + nworkers, jb); WR_LOAD(jb, vb, gb); }
    for (; item < end; item += 2 * nworkers) {
        WR_ITEM(ja, va, ga, item + 2 * nworkers);
        if (item + nworkers < end) WR_ITEM(jb, vb, gb, item + 3 * nworkers);
    }
#undef WR_LOAD
#undef WR_ITEM
}
__device__ __forceinline__ void p0_x(const float* x, bf16_t* xb, u64* ss0, Frame& F) {
    for (int row = F.gw; row < MTOK; row += F.NGW) {
        const f32x4* xr = (const f32x4*)(x + (size_t)row * DM) + F.lane; f32x4 v[8]; float s = 0.f;
#pragma unroll
        for (int j = 0; j < 8; ++j) { v[j] = __builtin_nontemporal_load(xr + 64 * j); s += (v[j].x * v[j].x + v[j].y * v[j].y) + (v[j].z * v[j].z + v[j].w * v[j].w); }
        s = wave_sum(s);
        u32x2* o8 = (u32x2*)(xb + (size_t)row * DM) + F.lane;
#pragma unroll
        for (int j = 0; j < 8; ++j) { u32x2 w; w.x = cvt_pk_bf16(v[j].x, v[j].y); w.y = cvt_pk_bf16(v[j].z, v[j].w); o8[64 * j] = w; }
        if (F.lane == 0) ss0[row] = ss_fix(s);
    }
}
__device__ __forceinline__ void p2_kmean(const bf16_t* qkv, float* kmean, Frame& F, int u0, int nu) {
    const int c16 = F.lane & 15, rg = F.lane >> 4;
    for (int u = u0 + F.gw; u < u0 + nu; u += F.NGW) {
        const int bh = u >> 3, jb = u & 7, b = bh / HA, h = bh % HA;
        const bf16_t* kp = qkv + (size_t)(b * SEQ + jb * 256 + rg) * NQKV + DM + h * 128 + 8 * c16;
        float s[8] = {0.f, 0.f, 0.f, 0.f, 0.f, 0.f, 0.f, 0.f};
#pragma unroll 8
        for (int i = 0; i < 64; ++i) { const u32x4 q = *(const u32x4*)(kp + (size_t)(4 * i) * NQKV);
            s[0] += __uint_as_float(q.x << 16); s[1] += __uint_as_float(q.x & 0xffff0000u); s[2] += __uint_as_float(q.y << 16); s[3] += __uint_as_float(q.y & 0xffff0000u);
            s[4] += __uint_as_float(q.z << 16); s[5] += __uint_as_float(q.z & 0xffff0000u); s[6] += __uint_as_float(q.w << 16); s[7] += __uint_as_float(q.w & 0xffff0000u); }
#pragma unroll
        for (int e = 0; e < 8; ++e) s[e] = sum_xor32(sum_xor16(s[e]));
        if (rg == 0) { float* kd = kmean + (size_t)u * 128 + 8 * c16;
            *(f32x4*)kd = (f32x4){s[0], s[1], s[2], s[3]} * (1.0f / 256.0f); *(f32x4*)(kd + 4) = (f32x4){s[4], s[5], s[6], s[7]} * (1.0f / 256.0f); }
    }
}
__device__ __forceinline__ void p3_select(const bf16_t* qkv, const float* kmean, unsigned char* sel, Frame& F, int u0, int nu) {
    LAS float* km = (LAS float*)F.lds;
    for (int u = u0 + F.vc; u < u0 + nu; u += F.G) {
        const int bh = u >> 2, ch = u & 3, b = bh / HA, h = bh % HA;
        __syncthreads();
        km[F.tid] = kmean[(size_t)bh * 1024 + F.tid]; km[F.tid + 512] = kmean[(size_t)bh * 1024 + 512 + F.tid];
        __syncthreads();
        const int s = ch * 512 + F.tid, own = s >> 8;
        const bf16_t* qp = qkv + (size_t)(b * SEQ + s) * NQKV + h * 128;
        float gate[8] = {0.f, 0.f, 0.f, 0.f, 0.f, 0.f, 0.f, 0.f};
        if (own > 0) {
#pragma unroll 4
            for (int c = 0; c < 16; ++c) { const u32x4 q = *(const u32x4*)(qp + 8 * c);
                const float q0 = __uint_as_float(q.x << 16), q1 = __uint_as_float(q.x & 0xffff0000u), q2 = __uint_as_float(q.y << 16), q3 = __uint_as_float(q.y & 0xffff0000u);
                const float q4 = __uint_as_float(q.z << 16), q5 = __uint_as_float(q.z & 0xffff0000u), q6 = __uint_as_float(q.w << 16), q7 = __uint_as_float(q.w & 0xffff0000u);
#pragma unroll
                for (int jb = 0; jb < 8; ++jb) { const f32x4 k0 = *(const LAS f32x4*)(km + jb * 128 + 8 * c), k1 = *(const LAS f32x4*)(km + jb * 128 + 8 * c + 4);
                    gate[jb] += (q0 * k0.x + q1 * k0.y) + (q2 * k0.z + q3 * k0.w) + (q4 * k1.x + q5 * k1.y) + (q6 * k1.z + q7 * k1.w); } }
        }
        unsigned mask = 0u; const int nsel = own < 3 ? own : 3;
#pragma unroll
        for (int it = 0; it < 3; ++it) { if (it < nsel) { int best = -1; float bv = -__builtin_inff();
#pragma unroll
                for (int jb = 0; jb < 8; ++jb) { const bool ok = (jb < own) && (((mask >> jb) & 1u) == 0u) && (best < 0 || gate[jb] > bv); if (ok) { bv = gate[jb]; best = jb; } }
                if (best >= 0) mask |= 1u << best; } }
        sel[(size_t)bh * SEQ + s] = (unsigned char)mask;
    }
    __syncthreads();
}
template <bool MOBA> __device__ __forceinline__ void attn_phase(char* lds, const bf16_t* qkv, bf16_t* out, const unsigned char* sel, const unsigned* bnd, unsigned* qctr, int qb0, int nq, Frame& F) {
    constexpr int NPB = (MOBA ? HA : HB * 4) * 8;
    LAS int* jt = (LAS int*)(F.lds + 70016);
    att::DynCtx C{qkv, out, sel, bnd, qctr, (volatile LAS int*)(F.lds + 70000), qb0 + (int)(xb_xcc_id() & (unsigned)(nq - 1)), qb0, nq, jt};
    __syncthreads();
    for (int i = F.tid; i < nq * 128; i += NTHREADS) { const int b = qb0 + (i >> 7), seg = (i >> 3) & 15, qb = i & 7;
        if (MOBA) jt[i] = att::attn_jlo(bnd, seg, 16 + seg, b, qb, __builtin_amdgcn_exp2f(-0.5f * (float)(seg + 1)));
        else jt[i] = att::attn_jlo(bnd, 32 + seg, seg, b, qb, __builtin_amdgcn_exp2f(-(float)((seg >> 1) + 1))); }
    if (F.tid == 0) *C.nw = att::attn_pull_from(qctr, C.q0, 0, NPB, qb0, nq);
    __syncthreads();
    int code = __builtin_amdgcn_readfirstlane(*C.nw); if (code < 0) return;
    att::BlockRef cur = att::attn_ref_blk<MOBA>(code, C); att::Seam S;
    att::attn_prime(cur, lds, S);
    for (;;) {
        code = att::attn_block<MOBA>(cur, C, lds, S);
        if (code < 0) break;
        cur = att::attn_ref_blk<MOBA>(code, C);
    }
}
__device__ __forceinline__ void p10_combine(KAP a, const bf16_t* omap, bf16_t* ao, Frame& F, int t0, int nt) {
    const int l = F.lane;
    float d1 = a->in[8][l] * a->in[9][l] + a->in[8][l + 64] * a->in[9][l + 64], d2 = a->in[10][l] * a->in[11][l] + a->in[10][l + 64] * a->in[11][l + 64];
    d1 = wave_sum(d1); d2 = wave_sum(d2);
    const float lam = __expf(d1) - __expf(d2) + LAM_INIT;
    const f32x4 g = *(const f32x4*)(a->in[12] + 4 * l);
    for (int tok = t0 + F.gw; tok < t0 + nt; tok += F.NGW) {
        const bf16_t* p1 = omap + (size_t)tok * DM + 4 * l; const bf16_t* p2 = p1 + (size_t)MTOK * DM; bf16_t* po = ao + (size_t)tok * DM + 4 * l;
        u32x2 x1v[HB], x2v[HB];
#pragma unroll
        for (int h = 0; h < HB; ++h) { x1v[h] = *(const u32x2*)(p1 + h * 256); x2v[h] = *(const u32x2*)(p2 + h * 256); }
#pragma unroll
        for (int h = 0; h < HB; ++h) { const u32x2 x1 = x1v[h], x2 = x2v[h];
            f32x4 d; d.x = __uint_as_float(x1.x << 16) - lam * __uint_as_float(x2.x << 16); d.y = __uint_as_float(x1.x & 0xffff0000u) - lam * __uint_as_float(x2.x & 0xffff0000u);
            d.z = __uint_as_float(x1.y << 16) - lam * __uint_as_float(x2.y << 16); d.w = __uint_as_float(x1.y & 0xffff0000u) - lam * __uint_as_float(x2.y & 0xffff0000u);
            float ss = wave_sum((d.x * d.x + d.y * d.y) + (d.z * d.z + d.w * d.w));
            const float r = __builtin_amdgcn_rsqf(ss * (1.0f / 256.0f) + RMS_EPS) * (1.0f - LAM_INIT);
            u32x2 w; w.x = cvt_pk_bf16(d.x * r * g.x, d.y * r * g.y); w.y = cvt_pk_bf16(d.z * r * g.z, d.w * r * g.w); *(u32x2*)(po + h * 256) = w; }
    }
}
__device__ __forceinline__ void p12_router(KAP a, const bf16_t* xb, const u64* ss3, unsigned* gcnt, int* tokinfo, unsigned char* xs, Frame& F, int c0, int nc) {
    LAS float* gwt = (LAS float*)F.lds;
    LAS unsigned* cnt = (LAS unsigned*)(F.lds + 65536); LAS unsigned* base = cnt + 8;
    const float* wr = a->in[18]; const float* g1 = a->in[14] + DM;
    __syncthreads();
    for (int idx = F.tid; idx < DM * NE; idx += NTHREADS) gwt[idx] = wr[idx] * g1[idx >> 3];
    if (F.tid < 8) cnt[F.tid] = 0u;
    __syncthreads();
    const int l = F.lane;
    for (int chunk = c0 + F.vc; chunk < c0 + nc; chunk += F.G) {
        int e0v = 0, e1v = 0, i0v = 0, i1v = 0; float g0v = 0.f, g1v = 0.f;
        float lgs[8][8];
#pragma unroll
        for (int i = 0; i < 8; ++i)
#pragma unroll
            for (int e = 0; e < 8; ++e) lgs[i][e] = 0.f;
        { const bf16_t* xp0 = xb + (size_t)(chunk * 64 + F.wave * 8) * DM + l;
#pragma unroll 4
          for (int j = 0; j < 32; ++j) { const LAS f32x4* wp = (const LAS f32x4*)(gwt + (l + 64 * j) * 8); const f32x4 w0 = wp[0], w1 = wp[1];
#pragma unroll
              for (int i = 0; i < 8; ++i) { const float xv = bf2f(xp0[(size_t)i * DM + 64 * j]);
                  lgs[i][0] += xv * w0.x; lgs[i][1] += xv * w0.y; lgs[i][2] += xv * w0.z; lgs[i][3] += xv * w0.w; lgs[i][4] += xv * w1.x; lgs[i][5] += xv * w1.y; lgs[i][6] += xv * w1.z; lgs[i][7] += xv * w1.w; } } }
#pragma unroll
        for (int i = 0; i < 8; ++i) {
            const int tok = chunk * 64 + F.wave * 8 + i;
            float lg[8];
            const float rs = rstd_q(ss3[tok]);
#pragma unroll
            for (int e = 0; e < 8; ++e) lg[e] = wave_sum(lgs[i][e]) * rs;
            int b0 = 0; float v0 = lg[0];
#pragma unroll
            for (int e = 1; e < 8; ++e) if (lg[e] > v0) { v0 = lg[e]; b0 = e; }
            int b1 = -1; float v1 = -__builtin_inff();
#pragma unroll
            for (int e = 0; e < 8; ++e) if (e != b0 && (b1 < 0 || lg[e] > v1)) { v1 = lg[e]; b1 = e; }
            const float ga = 1.0f / (1.0f + __expf(v1 - v0));
            unsigned i0 = 0u, i1 = 0u;
            if (l == 0) { i0 = __hip_atomic_fetch_add(&cnt[b0], 1u, __ATOMIC_RELAXED, __HIP_MEMORY_SCOPE_WORKGROUP); i1 = __hip_atomic_fetch_add(&cnt[b1], 1u, __ATOMIC_RELAXED, __HIP_MEMORY_SCOPE_WORKGROUP); }
            i0 = __builtin_amdgcn_readfirstlane(i0); i1 = __builtin_amdgcn_readfirstlane(i1);
            if (l == i) { e0v = b0; e1v = b1; i0v = (int)i0; i1v = (int)i1; g0v = ga; g1v = 1.0f - ga; }
        }
        __syncthreads();
        if (F.tid < 8) base[F.tid] = __hip_atomic_fetch_add(gcnt + 64 * F.tid, cnt[F.tid], __ATOMIC_RELAXED, __HIP_MEMORY_SCOPE_AGENT);
        __syncthreads();
        if (l < 8) { const int tok = chunk * 64 + F.wave * 8 + l; int* ti = tokinfo + (size_t)tok * 8;
            ti[0] = e0v; ti[1] = e1v; ti[2] = (int)base[e0v] + i0v; ti[3] = (int)base[e1v] + i1v; ti[4] = __float_as_int(g0v); ti[5] = __float_as_int(g1v); }
#pragma unroll
        for (int h = 0; h < 2; ++h) { u32x2 xv[4][8];
#pragma unroll
            for (int i = 0; i < 4; ++i) { const u32x2* sp = (const u32x2*)(xb + (size_t)(chunk * 64 + F.wave * 8 + 4 * h + i) * DM) + l;
#pragma unroll
                for (int j = 0; j < 8; ++j) xv[i][j] = sp[64 * j]; }
#pragma unroll
            for (int i = 0; i < 4; ++i) { const int ii = 4 * h + i, tok = chunk * 64 + F.wave * 8 + ii;
                const int e0 = __builtin_amdgcn_readlane(e0v, ii), e1 = __builtin_amdgcn_readlane(e1v, ii), q0 = __builtin_amdgcn_readlane(i0v, ii), q1 = __builtin_amdgcn_readlane(i1v, ii);
                const size_t row0 = (size_t)e0 * MTOK + base[e0] + q0, row1 = (size_t)e1 * MTOK + base[e1] + q1;
                const float rs = rstd_q(ss3[tok]) * XS_SC;
                unsigned* d0 = (unsigned*)(xs + row0 * DM) + l; unsigned* d1 = (unsigned*)(xs + row1 * DM) + l;
#pragma unroll
                for (int j = 0; j < 8; ++j) { const u32x2 b = xv[i][j];
                    const unsigned q = pg8::pk4_fp8(__uint_as_float(b.x << 16) * rs, __uint_as_float(b.x & 0xffff0000u) * rs, __uint_as_float(b.y << 16) * rs, __uint_as_float(b.y & 0xffff0000u) * rs); d0[64 * j] = q; d1[64 * j] = q; } } }
        __syncthreads();
        if (F.tid < 8) cnt[F.tid] = 0u;
        __syncthreads();
    }
}
__device__ __forceinline__ void p13_gather(const bf16_t* xb, const u64* ss3, unsigned* gcnt, int* tiles, int* tokinfo, unsigned char* xs, Frame& F) {
    LAS int* pst = (LAS int*)F.lds;
    __syncthreads();
    if (F.tid == 0) { int acc = 0;
        for (int e = 0; e < NE; ++e) { const int c = (int)__hip_atomic_load(gcnt + 64 * e, __ATOMIC_RELAXED, __HIP_MEMORY_SCOPE_AGENT); const int p = (c + 255) & ~255;
            pst[e] = acc; pst[8 + e] = c; pst[16 + e] = p;
            if (blockIdx.x == 0) for (int t = acc >> 8; t < (acc + p) >> 8; ++t) tiles[1 + t] = e;
            acc += p; }
        if (blockIdx.x == 0) tiles[0] = acc >> 8; }
    __syncthreads();
    const int l = F.lane;
    for (int tok = F.gw; tok < MTOK; tok += F.NGW) {
        int* ti = tokinfo + (size_t)tok * 8;
        const int row0 = pst[ti[0]] + ti[2], row1 = pst[ti[1]] + ti[3];
        if (l == 0) { ti[6] = row0; ti[7] = row1; }
        const float rs = rstd_q(ss3[tok]) * XS_SC;
        const u32x2* sp = (const u32x2*)(xb + (size_t)tok * DM) + l; unsigned* d0 = (unsigned*)(xs + (size_t)row0 * DM) + l; unsigned* d1 = (unsigned*)(xs + (size_t)row1 * DM) + l;
#pragma unroll
        for (int j = 0; j < 8; ++j) { const u32x2 b = sp[64 * j];
            const unsigned q = pg8::pk4_fp8(__uint_as_float(b.x << 16) * rs, __uint_as_float(b.x & 0xffff0000u) * rs, __uint_as_float(b.y << 16) * rs, __uint_as_float(b.y & 0xffff0000u) * rs); d0[64 * j] = q; d1[64 * j] = q; }
    }
    for (int e = 0; e < NE; ++e) { const int lo = pst[e] + pst[8 + e], hi = pst[e] + pst[16 + e];
        for (int r = lo + F.gw; r < hi; r += F.NGW) { u32x4* d = (u32x4*)(xs + (size_t)r * DM) + l; d[0] = (u32x4){0u, 0u, 0u, 0u}; d[64] = (u32x4){0u, 0u, 0u, 0u}; } }
    __syncthreads();
}
__device__ __forceinline__ void ys_row(const bf16_t* ys, const float* slab, int split0, size_t ks_stride, int row, int l, f32x4 (&a)[8]) {
    if (row >= split0) { const float* p = slab + (size_t)(row - split0) * DM + 4 * l;
#pragma unroll
        for (int j = 0; j < 8; ++j) { f32x4 t = *(const f32x4*)(p + 256 * j);
#pragma unroll
            for (int ks = 1; ks < TAIL_NS; ++ks) t = t + *(const f32x4*)(p + 256 * j + (size_t)ks * ks_stride);
            a[j] = t * (1.0f / (ACT_SC * WEDN_SC)); } }
    else { const u32x2* p = (const u32x2*)(ys + (size_t)row * DM) + l;
#pragma unroll
        for (int j = 0; j < 8; ++j) { const u32x2 q = p[64 * j]; a[j] = (f32x4){__uint_as_float(q.x << 16), __uint_as_float(q.x & 0xffff0000u), __uint_as_float(q.y << 16), __uint_as_float(q.y & 0xffff0000u)}; } }
}
constexpr int MOE_T_OFF = 131072;
__device__ __forceinline__ void moe_tables(const unsigned* gcnt, LAS int* T, Frame& F) {
    __syncthreads();
    if (F.tid == 0) { int acc = 0;
        for (int e = 0; e < NE; ++e) { const int c = (int)__hip_atomic_load(gcnt + 64 * e, __ATOMIC_RELAXED, __HIP_MEMORY_SCOPE_AGENT); const int p = (c + 255) & ~255;
            T[256 + e] = acc;
            for (int j = 0; j < (p >> 8); ++j) T[1 + (acc >> 8) + j] = e + 16 * (e * (MTOK / 256) + j);
            acc += p; }
        T[0] = acc >> 8; }
    __syncthreads();
}
__device__ __forceinline__ void p16_final(const bf16_t* xb, const bf16_t* ys, const float* slab, const int* tiles, const int* tokinfo, const float* fg, float* out, Frame& F) {
    const int l = F.lane; const int nT = tiles[0]; int rt = nT & 31; if (rt > 7) rt = 0; const int split0 = (nT - rt) * 256; const size_t ks_stride = (size_t)rt * 256 * DM;
    for (int tok = F.gw; tok < MTOK; tok += F.NGW) {
        const int* ti = tokinfo + (size_t)tok * 8; const float g0 = __int_as_float(ti[4]), g1 = __int_as_float(ti[5]); const int row0 = tiles[256 + ti[0]] + ti[2], row1 = tiles[256 + ti[1]] + ti[3];
        const u32x2* xp = (const u32x2*)(xb + (size_t)tok * DM) + l;
        f32x4 v[8], a0[8], a1[8]; float s = 0.f;
#pragma unroll
        for (int j = 0; j < 8; ++j) { const u32x2 q = xp[64 * j]; v[j] = (f32x4){__uint_as_float(q.x << 16), __uint_as_float(q.x & 0xffff0000u), __uint_as_float(q.y << 16), __uint_as_float(q.y & 0xffff0000u)}; }
        ys_row(ys, slab, split0, ks_stride, row0, l, a0); ys_row(ys, slab, split0, ks_stride, row1, l, a1);
#pragma unroll
        for (int j = 0; j < 8; ++j) { v[j] = v[j] + g0 * a0[j] + g1 * a1[j]; s += (v[j].x * v[j].x + v[j].y * v[j].y) + (v[j].z * v[j].z + v[j].w * v[j].w); }
        const float r = rstd_of(wave_sum(s));
        f32x4* op = (f32x4*)(out + (size_t)tok * DM) + l; const f32x4* gp = (const f32x4*)fg + l;
#pragma unroll
        for (int j = 0; j < 8; ++j) op[64 * j] = v[j] * r * gp[64 * j];
    }
}

#ifndef PH_MASK
#define PH_MASK 0x1ffff
#endif
__global__ void __launch_bounds__(NTHREADS, 2) mega_fwd(Args args_by_value) {
    extern __shared__ __attribute__((aligned(16))) unsigned char lds[];
    (void)args_by_value;
    const KAP kap0 = (KAP)__builtin_amdgcn_kernarg_segment_ptr();
#define KARGS() ({ KAP p_ = kap0; asm volatile("" : "+s"(p_)); p_; })
    Frame F0;
#define F F0
    F.lds = (LAS unsigned char*)lds;
    F.tid = threadIdx.x; F.lane = F.tid & 63; F.wave = __builtin_amdgcn_readfirstlane(F.tid >> 6);
    F.G = gridDim.x; { const int bx = blockIdx.x; F.vc = (F.G % 8 == 0) ? (bx % 8) * (F.G / 8) + bx / 8 : bx; }
    F.gw = F.vc * NWAVES + F.wave; F.NGW = F.G * NWAVES;
    volatile LAS unsigned* MISC = (volatile LAS unsigned*)(F.lds + LDSCTL_OFF);
    for (int u = F.tid; u < (LDS_BYTES - LDSCTL_OFF) / 4; u += NTHREADS) ((LAS unsigned*)(F.lds + LDSCTL_OFF))[u] = 0u;
    __syncthreads();
    const int lo = kap0->ph_lo, hi = kap0->ph_hi;
    const bool use_bar = (hi - lo) > 1;
    XcdBarrier bar; bar.bar = (unsigned*)(kap0->ws + CTL_BAR); bar.x = 0; bar.st = MISC + 8;
    if (use_bar) bar = xcd_barrier_post((unsigned*)(kap0->ws + CTL_BAR), MISC + 8, (unsigned)F.G);
#ifndef DUP_MASK
#define DUP_MASK 0
#endif
#ifndef PROBE_SKIP_EPI
#define PROBE_SKIP_EPI 0
#endif
#ifndef PROBE_KIND
#define PROBE_KIND 4
#endif
#ifndef PROBE_PH
#define PROBE_PH 6
#endif
#ifndef PROBE_AMP
#define PROBE_AMP 4
#endif
#ifndef PROBE_PHM
#define PROBE_PHM (1 << PROBE_PH)
#endif
#define PROBE_SEL(k) ((PROBE_KIND == 2 || PROBE_KIND == 3) ? ((PROBE_PHM >> (k)) & 1) : ((k) == PROBE_PH))
#if PROBE_KIND
#define PROBE_ME (blockIdx.x == 0 && F0.tid == 0)
#define PROBE_B(k) do { if (PROBE_SEL(k) && PROBE_ME) { const unsigned long long r_ = __builtin_amdgcn_s_memrealtime(), t_ = __builtin_amdgcn_s_memtime(); MISC[16] = (unsigned)r_; MISC[17] = (unsigned)(r_ >> 32); MISC[18] = (unsigned)t_; MISC[19] = (unsigned)(t_ >> 32); } } while (0)
#define PROBE_E(k) do { if (PROBE_SEL(k) && PROBE_ME) { const unsigned long long r_ = __builtin_amdgcn_s_memrealtime(), t_ = __builtin_amdgcn_s_memtime(); \
        const unsigned long long r0_ = ((unsigned long long)MISC[17] << 32) | MISC[16], t0_ = ((unsigned long long)MISC[19] << 32) | MISC[18]; const unsigned long long dr_ = r_ - r0_, dt_ = t_ - t0_; \
        if (PROBE_KIND == 1) MISC[20] = (unsigned)((dt_ * 10000ull) / (dr_ ? dr_ : 1ull));   \
        if (PROBE_KIND == 2) MISC[20] = MISC[20] + (unsigned)(dr_ * PROBE_AMP); \
        if (PROBE_KIND == 3) { MISC[16] = (unsigned)r_; MISC[17] = (unsigned)(r_ >> 32); } } } while (0)
#define PROBE_S(k) do { if (PROBE_KIND == 3 && PROBE_SEL(k) && PROBE_ME) { const unsigned long long r_ = __builtin_amdgcn_s_memrealtime(); const unsigned long long r0_ = ((unsigned long long)MISC[17] << 32) | MISC[16]; MISC[20] = MISC[20] + (unsigned)((r_ - r0_) * PROBE_AMP); } } while (0)
#define PROBE_FIN() do { if (PROBE_ME) { const unsigned long long r0_ = __builtin_amdgcn_s_memrealtime(); const unsigned long long d_ = MISC[20]; while (__builtin_amdgcn_s_memrealtime() - r0_ < d_) __builtin_amdgcn_s_sleep(8); } } while (0)
#else
#define PROBE_B(k) do { } while (0)
#define PROBE_E(k) do { } while (0)
#define PROBE_S(k) do { } while (0)
#define PROBE_FIN() do { } while (0)
#endif
#define PRB(k) (((PROBE_KIND == 4 || PROBE_KIND == 5) && (k) == PROBE_PH) ? MISC : (volatile LAS unsigned*)nullptr)
#define IN(k) (((PH_MASK >> (k)) & 1) && lo <= (k) && (k) < hi)
#define REP(k) for (int rep_ = 0; rep_ < (((DUP_MASK >> (k)) & 1) ? 2 : 1); ++rep_)
#define SEAM(k) do { if (IN(k) && IN((k) + 1)) { if ((k) >= 1 && (k) <= 10) xcd_barrier(barh); else xcd_barrier(bar); } } while (0)
#define WSP(T, off) ((T*)(ws + (off)))
#define FRL() ({ Frame f_ = F0; asm volatile("" : "+v"(f_.tid), "+v"(f_.lane)); f_; })
#undef F
    const int bx = blockIdx.x;
    const int ngrp = (F0.G % 8 == 0) ? 8 : 1, hb = (ngrp == 8) ? (bx & 7) : 0, nxh = 8 / ngrp, Gh = F0.G / ngrp;
    const int hidx = (ngrp == 8) ? (bx >> 3) : bx;
    const int Mh = MTOK / ngrp, R0 = hb * Mh, nMh = Mh / 256, pm0 = hb * nMh;
    Frame FH0 = F0; FH0.G = Gh; FH0.vc = (Gh % nxh == 0) ? (hidx % nxh) * (Gh / nxh) + hidx / nxh : hidx; FH0.gw = FH0.vc * NWAVES + F0.wave; FH0.NGW = Gh * NWAVES;
#define FRH() ({ Frame f_ = FH0; asm volatile("" : "+v"(f_.tid), "+v"(f_.lane)); f_; })
    const int shn = W_NEXP / ngrp, sh0 = W_NITEMS0 + hb * shn;
    const int per = (shn + Gh - 1) / Gh, nbef = (ngrp == 8) ? (per * hb) / 7 : per;
    XcdBarrier barh = bar;
    if (use_bar) barh = xcd_barrier_post((unsigned*)(kap0->ws + CTL_BARH + (size_t)hb * CTL_BARH_STRIDE), MISC + 10, (unsigned)Gh);

    PROBE_B(0); if (IN(0)) REP(0) { KAP ap = KARGS(); Frame F = FRL(); unsigned char* ws = ap->ws; p0_weights(ap, F, F.vc, W_NITEMS0, F.G); p0_x(ap->in[0], WSP(bf16_t, WS_XB), WSP(u64, CTL_SS), F); }
    PROBE_E(0); SEAM(0); PROBE_S(0);
    if (IN(0)) { KAP ap = KARGS(); Frame F = FRH(); const int e_ = sh0 + nbef * Gh < sh0 + shn ? sh0 + nbef * Gh : sh0 + shn; p0_weights_r(ap, F, sh0, e_, hidx, Gh); }
    PROBE_B(1); if (IN(1)) REP(1) {
        KAP ap = KARGS(); Frame F = FRH(); unsigned char* ws = ap->ws;
        pg8::Order S; S.init(nMh, NQKV / 256, 2 * DM, F.G, hidx, ws + WS_XB + (size_t)R0 * DM * 2, ws + WS_WQKV, 0, nullptr, nxh);
        pg8::EpiBf16Out<true, true> E{WSP(bf16_t, WS_QKV) + (size_t)R0 * NQKV, NQKV, WSP(u64, CTL_SS) + R0, 1.f, WSP(unsigned, CTL_BND1), pm0};
        pg8::gemm_phase<pg8::EpiBf16Out<true, true>, GEMM_ALIGN, GEMM_SP2>(F.lds, 2 * DM, S, E, 0, PRB(1));
    }
    PROBE_E(1); SEAM(1); PROBE_S(1);
    PROBE_B(2); if (IN(2)) REP(2) { KAP ap = KARGS(); Frame F = FRH(); unsigned char* ws = ap->ws; p2_kmean(WSP(bf16_t, WS_QKV), WSP(float, WS_KMEAN), F, hb * nxh * HA * 8, nxh * HA * 8); }
    PROBE_E(2); SEAM(2); PROBE_S(2);
    PROBE_B(3); if (IN(3)) REP(3) { KAP ap = KARGS(); Frame F = FRH(); unsigned char* ws = ap->ws; p3_select(WSP(bf16_t, WS_QKV), WSP(float, WS_KMEAN), WSP(unsigned char, WS_SEL), F, hb * nxh * HA * 4, nxh * HA * 4); }
    PROBE_E(3); SEAM(3); PROBE_S(3);
    PROBE_B(4); if (IN(4)) REP(4) { KAP ap = KARGS(); Frame F = FRH(); unsigned char* ws = ap->ws; attn_phase<true>((char*)lds, WSP(bf16_t, WS_QKV), WSP(bf16_t, WS_AO), WSP(unsigned char, WS_SEL), WSP(unsigned, CTL_BND1), WSP(unsigned, CTL_AQ), hb * nxh, nxh, F); }
    PROBE_E(4); SEAM(4); PROBE_S(4);
    PROBE_B(5); if (IN(5)) REP(5) {
        KAP ap = KARGS(); Frame F = FRH(); unsigned char* ws = ap->ws;
        pg8::Order S; S.init(nMh, DM / 256, 2 * DM, F.G, hidx, ws + WS_AO + (size_t)R0 * DM * 2, ws + WS_WOA, 0, nullptr, nxh);
        pg8::EpiResid<true, false> E{WSP(bf16_t, WS_XB) + (size_t)R0 * DM, nullptr, WSP(bf16_t, WS_XB) + (size_t)R0 * DM, WSP(u64, CTL_SS) + MTOK + R0};
        pg8::gemm_phase<pg8::EpiResid<true, false>, GEMM_ALIGN, GEMM_SP2>(F.lds, 2 * DM, S, E);
    }
    PROBE_E(5); SEAM(5); PROBE_S(5);
    PROBE_B(6); if (IN(6)) REP(6) {
        KAP ap = KARGS(); Frame F = FRH(); unsigned char* ws = ap->ws;
        pg8::Order S; S.init(nMh, 2 * FF / 256, 2 * DM, F.G, hidx, ws + WS_XB + (size_t)R0 * DM * 2, ws + WS_WGU, 0, nullptr, nxh);
        pg8::EpiSwiGLU<false> E{WSP(bf16_t, WS_ACT) + (size_t)R0 * FF, FF, WSP(u64, CTL_SS) + MTOK + R0};
        pg8::gemm_phase<pg8::EpiSwiGLU<false>, GEMM_ALIGN, GEMM_SP2>(F.lds, 2 * DM, S, E, 0, PRB(6));
    }
    PROBE_E(6); SEAM(6); PROBE_S(6);
    PROBE_B(7); if (IN(7)) REP(7) {
        KAP ap = KARGS(); Frame F = FRH(); unsigned char* ws = ap->ws;
        pg8::Order S; S.init(nMh, DM / 256, 2 * FF, F.G, hidx, ws + WS_ACT + (size_t)R0 * FF * 2, ws + WS_WDN, 0, nullptr, nxh);
        pg8::EpiResid<true, false> E{WSP(bf16_t, WS_XB) + (size_t)R0 * DM, nullptr, WSP(bf16_t, WS_XB) + (size_t)R0 * DM, WSP(u64, CTL_SS) + 2 * MTOK + R0};
        pg8::gemm_phase<pg8::EpiResid<true, false>, GEMM_ALIGN, GEMM_SP2>(F.lds, 2 * FF, S, E);
    }
    PROBE_E(7); SEAM(7); PROBE_S(7);
    PROBE_B(8); if (IN(8)) REP(8) {
        KAP ap = KARGS(); Frame F = FRH(); unsigned char* ws = ap->ws;
        pg8::Order S; S.init(nMh, NQKV / 256, 2 * DM, F.G, hidx, ws + WS_XB + (size_t)R0 * DM * 2, ws + WS_WKVQ, 0, nullptr, nxh);
        pg8::EpiBf16Out<true, true> E{WSP(bf16_t, WS_QKV) + (size_t)R0 * NQKV, NQKV, WSP(u64, CTL_SS) + 2 * MTOK + R0, 1.f, WSP(unsigned, CTL_BND2), pm0};
        pg8::gemm_phase<pg8::EpiBf16Out<true, true>, GEMM_ALIGN, GEMM_SP2>(F.lds, 2 * DM, S, E, 0, PRB(1));
    }
    PROBE_E(8); SEAM(8); PROBE_S(8);
    PROBE_B(9); if (IN(9)) REP(9) { KAP ap = KARGS(); Frame F = FRH(); unsigned char* ws = ap->ws; attn_phase<false>((char*)lds, WSP(bf16_t, WS_QKV), WSP(bf16_t, WS_XR), nullptr, WSP(unsigned, CTL_BND2), WSP(unsigned, CTL_AQ) + 8 * 64, hb * nxh, nxh, F); }
    PROBE_E(9); SEAM(9); PROBE_S(9);
    PROBE_B(10); if (IN(10)) REP(10) { KAP ap = KARGS(); Frame F = FRH(); unsigned char* ws = ap->ws; p10_combine(ap, WSP(bf16_t, WS_XR), WSP(bf16_t, WS_AO), F, R0, Mh); }
    PROBE_E(10); SEAM(10); PROBE_S(10);
    PROBE_B(11); if (IN(11)) REP(11) {
        KAP ap = KARGS(); Frame F = FRH(); unsigned char* ws = ap->ws;
        pg8::Order S; S.init(nMh, DM / 256, 2 * DM, F.G, hidx, ws + WS_AO + (size_t)R0 * DM * 2, ws + WS_WOB, 0, nullptr, nxh);
        pg8::EpiResid<true, false> E{WSP(bf16_t, WS_XB) + (size_t)R0 * DM, nullptr, WSP(bf16_t, WS_XB) + (size_t)R0 * DM, WSP(u64, CTL_SS) + 3 * MTOK + R0};
        pg8::gemm_phase<pg8::EpiResid<true, false>, GEMM_ALIGN, GEMM_SP2>(F.lds, 2 * DM, S, E);
    }
    PROBE_E(11); if (IN(11) && IN(12)) xcd_barrier(barh); PROBE_S(11);
    PROBE_B(12); if (IN(12)) REP(12) { KAP ap = KARGS(); Frame F = FRH(); unsigned char* ws = ap->ws; p12_router(ap, WSP(bf16_t, WS_XB), WSP(u64, CTL_SS) + 3 * MTOK, WSP(unsigned, CTL_CNT), WSP(int, CTL_TOKINFO), WSP(unsigned char, WS_XSC), F, hb * (Mh / 64), Mh / 64); }
    if (IN(12)) { KAP ap = KARGS(); Frame F = FRH(); p0_weights_r(ap, F, sh0 + nbef * Gh, sh0 + shn, hidx, Gh); }
    PROBE_E(12); SEAM(12); PROBE_S(12);
    PROBE_B(14); if (IN(14)) REP(14) {
        KAP ap = KARGS(); Frame F = FRL(); unsigned char* ws = ap->ws;
        moe_tables(WSP(unsigned, CTL_CNT), (LAS int*)(F.lds + MOE_T_OFF), F);
        const int* tiles = (const int*)(LAS int*)(F.lds + MOE_T_OFF); const int nT = tiles[0];
        pg8::Order S; S.init(nT, 2 * FE / 256, DM, F.G, bx, ws + WS_XSC, ws + WS_WEGU, (size_t)2 * FE * DM, tiles + 1, pg8::NXCD, 1);
        pg8::EpiSwiGLU8 E{WSP(unsigned char, WS_ACTE), FE, 1.0f / (XS_SC * WEGU_SC), ACT_SC, (PROBE_SKIP_EPI && rep_ == 1) ? 1 : 0};
        pg8::gemm_phase<pg8::EpiSwiGLU8, GEMM_ALIGN, false, true>(F.lds, DM, S, E, 0, PRB(14));
    }
    PROBE_E(14); SEAM(14); PROBE_S(14);
    PROBE_B(15); if (IN(15)) REP(15) {
        KAP ap = KARGS(); Frame F = FRL(); unsigned char* ws = ap->ws;
        moe_tables(WSP(unsigned, CTL_CNT), (LAS int*)(F.lds + MOE_T_OFF), F);
        const int* tiles = (const int*)(LAS int*)(F.lds + MOE_T_OFF); const int nT = tiles[0];
        int rt = nT & 31; if (rt > 7) rt = 0;
        pg8::Order S; S.init(nT - rt, DM / 256, FE, F.G, bx, ws + WS_ACTE, ws + WS_WEDN, (size_t)DM * FE, tiles + 1);
        pg8::EpiBf16Out<false> E{WSP(bf16_t, WS_YS), DM, nullptr, 1.0f / (ACT_SC * WEDN_SC), nullptr, 0};
        pg8::gemm_phase<pg8::EpiBf16Out<false>, GEMM_ALIGN, false, true>(F.lds, FE, S, E);
        if (rt) { pg8::TailOrder S2{rt * 8 * TAIL_NS, F.G, bx, nT - rt, TAIL_NS, (const char*)(ws + WS_ACTE), (const char*)(ws + WS_WEDN), (size_t)256 * FE, (size_t)DM * FE, (size_t)(FE / TAIL_NS), tiles + 1};
            pg8::EpiPart E2{WSP(float, WS_SLAB), (nT - rt) * 256, (size_t)rt * 256 * DM};
            pg8::gemm_phase<pg8::EpiPart, GEMM_ALIGN, false, true, pg8::TailOrder>(F.lds, FE, S2, E2, FE / TAIL_NS / 128); }
    }
    PROBE_E(15); SEAM(15); PROBE_S(15);
    PROBE_B(16); if (IN(16)) REP(16) { KAP ap = KARGS(); Frame F = FRL(); unsigned char* ws = ap->ws; moe_tables(WSP(unsigned, CTL_CNT), (LAS int*)(F.lds + MOE_T_OFF), F);
        p16_final(WSP(bf16_t, WS_XB), WSP(bf16_t, WS_YS), WSP(float, WS_SLAB), (const int*)(LAS int*)(F.lds + MOE_T_OFF), WSP(int, CTL_TOKINFO), ap->in[22], ap->out, F); }
PROBE_E(16); PROBE_FIN();
#undef IN
#undef REP
#undef SEAM
#undef WSP
#undef FRL
#undef FRH
#undef KARGS
}

#ifndef MK_ONE_LAUNCH
#define MK_ONE_LAUNCH 1
#endif
extern "C" void kernel_launch(void* const* d_in, const int* in_sizes, int n_in, void* d_out, int out_size, void* d_ws, size_t ws_size, hipStream_t stream) {
    static int grid = 0;
    if (grid == 0) {
        if (n_in != 23 || out_size != MTOK * DM || ws_size < WS_END) { fprintf(stderr, "kernel_launch: unexpected shapes (n_in %d, out %d, ws %zu)\n", n_in, out_size, ws_size); grid = -1; return; }
        int dev = 0, cus = 0, per_cu = 0;
        if (hipGetDevice(&dev) != hipSuccess || hipDeviceGetAttribute(&cus, hipDeviceAttributeMultiprocessorCount, dev) != hipSuccess) { grid = -1; return; }
        if (hipFuncSetAttribute((const void*)mega_fwd, hipFuncAttributeMaxDynamicSharedMemorySize, LDS_BYTES) != hipSuccess) { fprintf(stderr, "kernel_launch: hipFuncSetAttribute failed\n"); grid = -1; return; }
        if (hipOccupancyMaxActiveBlocksPerMultiprocessor(&per_cu, (const void*)mega_fwd, NTHREADS, LDS_BYTES) != hipSuccess || per_cu < 1) { fprintf(stderr, "kernel_launch: occupancy query reports %d\n", per_cu); (void)hipGetLastError(); per_cu = 1; }
        grid = cus;
    }
    if (grid < 0) return;
    if (hipMemsetAsync((char*)d_ws + WS_CTL, 0, CTL_ZERO_BYTES, stream) != hipSuccess) return;
    Args a{};
    for (int i = 0; i < 23; ++i) a.in[i] = (const float*)d_in[i];
    a.out = (float*)d_out; a.ws = (unsigned char*)d_ws;
#if MK_ONE_LAUNCH
    a.ph_lo = 0; a.ph_hi = NPHASE;
    hipLaunchKernelGGL(mega_fwd, dim3(grid), dim3(NTHREADS), LDS_BYTES, stream, a);
#else
    for (int p = 0; p < NPHASE; ++p) { a.ph_lo = p; a.ph_hi = p + 1; hipLaunchKernelGGL(mega_fwd, dim3(grid), dim3(NTHREADS), LDS_BYTES, stream, a); }
#endif
}
```

```cpp
#include <hip/hip_runtime.h>
#include <cstdio>
#include <cstdint>

#define GAS __attribute__((address_space(1)))
#define LAS __attribute__((address_space(3)))
#ifndef PROBE_KIND
#define PROBE_KIND 0
#endif
typedef unsigned short bf16_t;
typedef short bf16x8 __attribute__((ext_vector_type(8)));
typedef short s16x4 __attribute__((ext_vector_type(4)));
typedef float f32x2 __attribute__((ext_vector_type(2)));
typedef float f32x4 __attribute__((ext_vector_type(4)));
typedef float f32x16 __attribute__((ext_vector_type(16)));
typedef unsigned u32x2 __attribute__((ext_vector_type(2)));
typedef unsigned u32x4 __attribute__((ext_vector_type(4)));

constexpr int NB = 8, SEQ = 2048, DM = 2048, MTOK = NB * SEQ;
constexpr int NQKV = 3 * DM, FF = 5632, FE = 7168, NE = 8;
constexpr int HA = 16, HB = 8;
constexpr float RMS_EPS = 1e-6f;
constexpr float LAM_INIT = 0.35550906759096996f;
constexpr int MAXTILES = 136;
constexpr int MOE_ROWS = 135 * 256;

constexpr size_t MiB = 1u << 20;
constexpr size_t WS_CTL = 0, CTL_ZERO_BYTES = 960 * 1024;
constexpr size_t CTL_BAR = 4096;
constexpr size_t CTL_BARH = 832 * 1024, CTL_BARH_STRIDE = 16384;
constexpr size_t CTL_SS = 64 * 1024;
constexpr size_t CTL_AQ = 580 * 1024;
constexpr size_t CTL_CNT = 576 * 1024;
constexpr size_t CTL_BND1 = 640 * 1024, CTL_BND2 = 704 * 1024;
constexpr size_t CTL_TILES = 768 * 1024;
constexpr size_t CTL_TOKINFO = 1 * MiB;
constexpr size_t WS_WQKV = 2 * MiB, WS_WOA = 26 * MiB, WS_WGU = 34 * MiB, WS_WDN = 78 * MiB, WS_WKVQ = 100 * MiB, WS_WOB = 124 * MiB;
constexpr size_t WS_XB = 132 * MiB, WS_XR = 196 * MiB, WS_WEGU = 324 * MiB, WS_WEDN = 548 * MiB, WS_BIG = 660 * MiB;
constexpr size_t WS_QKV = WS_BIG, WS_AO = WS_BIG + 192 * MiB, WS_ACT = WS_BIG + 256 * MiB, WS_KMEAN = WS_BIG + 432 * MiB, WS_SEL = WS_BIG + 433 * MiB;
constexpr size_t WS_ACTE = WS_BIG, WS_XS = WS_BIG + 237 * MiB, WS_YS = WS_BIG + 305 * MiB, WS_SLAB = WS_BIG + 440 * MiB, WS_XSC = WS_BIG + 500 * MiB, WS_END = WS_XSC + 256 * MiB;
static_assert(WS_END <= 1792 * MiB, "workspace map");
static_assert((size_t)MOE_ROWS * FE <= 237 * MiB && (size_t)MOE_ROWS * DM <= 68 * MiB && (size_t)MOE_ROWS * DM * 2 <= 135 * MiB && WS_SEL + MiB <= WS_END, "moe buffers");
constexpr float XS_SC = 16.f, WEGU_SC = 256.f, ACT_SC = 8.f, WEDN_SC = 512.f;
constexpr int TAIL_NS = 4, TAIL_MAXROWS = 31 * 256;
static_assert((size_t)TAIL_NS * 7 * 256 * DM * 4 <= 60 * MiB, "slab (nT in [128, 135] -> at most 7 tail row tiles)");

constexpr int RING_BYTES = 131072, LDS_BYTES = 147456, LDSCTL_OFF = LDS_BYTES - 512;

#define LDS_WAIT() asm volatile("s_waitcnt lgkmcnt(0)" ::: "memory")
#define VM_WAIT() asm volatile("s_waitcnt vmcnt(0)" ::: "memory")
__device__ __forceinline__ unsigned cvt_pk_bf16(float lo, float hi) { unsigned r; asm volatile("v_cvt_pk_bf16_f32 %0, %1, %2" : "=v"(r) : "v"(lo), "v"(hi)); return r; }
__device__ __forceinline__ float bf2f(unsigned short b) { return __uint_as_float(((unsigned)b) << 16); }
template <int CTRL> __device__ __forceinline__ float dppx(float v) { return __builtin_bit_cast(float, __builtin_amdgcn_update_dpp(0, __builtin_bit_cast(int, v), CTRL, 0xf, 0xf, true)); }
__device__ __forceinline__ float xor1_get(float v) { return dppx<0xB1>(v); }
__device__ __forceinline__ float sum_xor16(float v) { auto r = __builtin_amdgcn_permlane16_swap(__float_as_uint(v), __float_as_uint(v), false, false); return __uint_as_float(r[0]) + __uint_as_float(r[1]); }
__device__ __forceinline__ float sum_xor32(float v) { auto r = __builtin_amdgcn_permlane32_swap(__float_as_uint(v), __float_as_uint(v), false, false); return __uint_as_float(r[0]) + __uint_as_float(r[1]); }
__device__ __forceinline__ float row_sum16(float v) { v += dppx<0xB1>(v); v += dppx<0x4E>(v); v += dppx<0x141>(v); v += dppx<0x140>(v); return v; }
__device__ __forceinline__ float row_max16(float v) { v = __builtin_fmaxf(v, dppx<0xB1>(v)); v = __builtin_fmaxf(v, dppx<0x4E>(v)); v = __builtin_fmaxf(v, dppx<0x141>(v)); v = __builtin_fmaxf(v, dppx<0x140>(v)); return v; }
__device__ __forceinline__ float wave_sum(float v) { return sum_xor32(sum_xor16(row_sum16(v))); }
typedef unsigned long long u64;
__device__ __forceinline__ float rstd_of(float ss) { return __builtin_amdgcn_rsqf(ss * (1.0f / (float)DM) + RMS_EPS); }
__device__ __forceinline__ u64 ss_fix(float s) { return (u64)(s * 16777216.0f); }
__device__ __forceinline__ float rstd_q(u64 q) { return rstd_of((float)q * (1.0f / 16777216.0f)); }

#define XB_TMO      128
#define XB_XCNT(j)  (256  + 64 * (j))
#define XB_XSUB(j)  (1280 + 64 * (j))
#define XB_XGEN(j)  (2304 + 64 * (j))
#define XB_TOP      3328
#define XB_TOPGEN   3392
#define XCD_BAR_WORDS 3456
#define XB_SPIN_CAP (1u << 18)
__device__ __forceinline__ unsigned xb_ld(unsigned* p)              { return __hip_atomic_load(p, __ATOMIC_RELAXED, __HIP_MEMORY_SCOPE_AGENT); }
__device__ __forceinline__ unsigned xb_add(unsigned* p, unsigned v) { return __hip_atomic_fetch_add(p, v, __ATOMIC_RELAXED, __HIP_MEMORY_SCOPE_AGENT); }
__device__ __forceinline__ unsigned xb_xcc_id() { return (unsigned)__builtin_amdgcn_s_getreg((3 << 11) | 20) & 0xFu; }
#define XB_SPIN(cond, bar) do { unsigned _sp = 0; while (cond) { __builtin_amdgcn_s_sleep(1); \
    if ((++_sp & 255u) == 0u) { if (xb_ld(&(bar)[XB_TMO])) break; if (_sp > XB_SPIN_CAP) { atomicAdd(&(bar)[XB_TMO], 1u); break; } } } } while (0)
struct XcdBarrier { unsigned* bar; unsigned x; volatile LAS unsigned* st; unsigned members; };
__device__ __forceinline__ XcdBarrier xcd_barrier_post(unsigned* bar, volatile LAS unsigned* st, unsigned members) {
    XcdBarrier b; b.bar = bar; b.x = xb_xcc_id(); b.st = st; b.members = members;
    if (threadIdx.x == 0) (void)xb_add(&bar[XB_XCNT(b.x)], 1u);
    return b;
}
__device__ __forceinline__ void xcd_barrier_complete(unsigned* bar, unsigned x, unsigned& nloc, unsigned& nx, const unsigned G) {
    unsigned sum, cnt, mine, sp = 0u;
    for (;;) {
        sum = 0u; cnt = 0u; mine = 0u;
#pragma unroll
        for (unsigned j = 0; j < 16; ++j) { const unsigned c = xb_ld(&bar[XB_XCNT(j)]); sum += c; cnt += (c > 0u) ? 1u : 0u; mine = (j == x) ? c : mine; }
        if (sum == G) break;
        __builtin_amdgcn_s_sleep(1);
        if ((++sp & 255u) == 0u) { if (xb_ld(&bar[XB_TMO])) break; if (sp > XB_SPIN_CAP) { atomicAdd(&bar[XB_TMO], 1u); break; } }
    }
    nloc = mine > 0u ? mine : 1u; nx = cnt > 0u ? cnt : 1u;
}
__device__ __forceinline__ void xcd_barrier(const XcdBarrier& b) {
    asm volatile("s_waitcnt vmcnt(0)" ::: "memory");
    __syncthreads();
    if (threadIdx.x == 0) {
        unsigned* bar = b.bar;
        __builtin_amdgcn_s_waitcnt(0);
        unsigned nloc = b.st[0], nx = b.st[1];
        if (nloc == 0u) { xcd_barrier_complete(bar, b.x, nloc, nx, b.members); b.st[0] = nloc; b.st[1] = nx; }
        const unsigned old = xb_add(&bar[XB_XSUB(b.x)], 1u);
        const unsigned gen = old / nloc;
        if (old + 1u == (gen + 1u) * nloc) {
            __builtin_amdgcn_fence(__ATOMIC_RELEASE, "agent");
            asm volatile("s_waitcnt vmcnt(0)" ::: "memory");
            const unsigned og = xb_add(&bar[XB_TOP], 1u);
            const unsigned tg = og / nx;
            if (og + 1u == (tg + 1u) * nx) xb_add(&bar[XB_TOPGEN], 1u);
            else XB_SPIN(xb_ld(&bar[XB_TOPGEN]) == tg, bar);
            __builtin_amdgcn_fence(__ATOMIC_ACQUIRE, "agent");
            xb_add(&bar[XB_XGEN(b.x)], 1u);
            asm volatile("s_waitcnt vmcnt(0)" ::: "memory");
        } else {
            XB_SPIN(xb_ld(&bar[XB_XGEN(b.x)]) == gen, bar);
            __builtin_amdgcn_fence(__ATOMIC_ACQUIRE, "agent");
            asm volatile("s_waitcnt vmcnt(0)" ::: "memory");
        }
    }
    __syncthreads();
}

namespace pg8 {
constexpr int BM = 256, BK = 64, HALF = 128, HTB = HALF * BK * 2, STAGE_BYTES = 8 * HTB, NXCD = 8, WGM = 8;
__host__ __device__ __forceinline__ int lds_byte(int r, int c) { const int st = (r >> 4) * 2 + (c >> 5), rr = r & 15, cc = c & 31, ob = rr * 64 + cc * 2; return st * 1024 + (ob ^ (((ob >> 9) & 1) << 5)); }
__host__ __device__ __forceinline__ void stage_rc(int b, int& R, int& C) { const int st = b / 1024, sb = b % 1024, swz = sb ^ (((sb >> 9) & 1) << 5); R = (st >> 1) * 16 + swz / 64; C = (st & 1) * 32 + (swz % 64) / 2; }
__host__ __device__ __forceinline__ int perm32(int rho) { const int n = rho >> 4, i = rho & 15; return 8 * (i >> 2) + 4 * n + (i & 3); }

struct Unit { int pm, pn, e, ks, ar; };

struct Order {
    int nM, nN, nwg, G, c, nx, use_ar; const char* A; const char* B; size_t tstep, estride; const int* tile_e;
    __device__ __forceinline__ void init(int nM_, int nN_, int KB, int G_, int c_, const void* A_, const void* B_, size_t estride_, const int* tile_e_, int nx_ = NXCD, int use_ar_ = 0) {
        use_ar = use_ar_; nM = nM_; nN = nN_; nwg = nM * nN; G = G_; c = c_; nx = nx_; A = (const char*)A_; B = (const char*)B_; tstep = (size_t)BM * KB; estride = estride_; tile_e = tile_e_; }
    __device__ __forceinline__ bool next(int i, Unit& u) const {
        const long L = (long)i * G + c; if (L >= nwg) return false;
        int wgid = (int)L; { const int q = nwg / nx, r = nwg % nx, xcd = wgid % nx, off = wgid / nx; wgid = (xcd < r ? xcd * (q + 1) : r * (q + 1) + (xcd - r) * q) + off; }
        const int nig = WGM * nN, gid = wgid / nig, fm = gid * WGM, gsz = (nM - fm) < WGM ? (nM - fm) : WGM;
        u.pm = fm + ((wgid % nig) % gsz); u.pn = (wgid % nig) / gsz; const int v = tile_e ? tile_e[u.pm] : 0; u.e = v & 15; u.ar = use_ar ? (v >> 4) : u.pm; u.ks = 0; return true;
    }
    __device__ __forceinline__ const char* a_base(const Unit& u) const { return A + (size_t)u.ar * tstep; }
    __device__ __forceinline__ const char* b_base(const Unit& u) const { return B + (size_t)u.e * estride + (size_t)u.pn * tstep; }
};

struct TailOrder {
    int nsub, G, c, pm0, NS; const char* A; const char* B; size_t tstep, estride, kslice; const int* tile_e;
    __device__ __forceinline__ bool next(int i, Unit& u) const { const int L = i * G + c; if (L >= nsub) return false; const int per = 8 * NS; u.pm = pm0 + L / per; const int rem = L % per; u.pn = rem / NS; u.ks = rem % NS; u.e = tile_e[u.pm] & 15; u.ar = u.pm; return true; }
    __device__ __forceinline__ const char* a_base(const Unit& u) const { return A + (size_t)u.pm * tstep + (size_t)u.ks * kslice; }
    __device__ __forceinline__ const char* b_base(const Unit& u) const { return B + (size_t)u.e * estride + (size_t)u.pn * tstep + (size_t)u.ks * kslice; }
};

template <bool SCALE, bool BOUND = false> struct EpiBf16Out {
    static constexpr bool PERM = true;
    bf16_t* O; int ldc; const u64* ss; float csc; unsigned* bnd; int pm0;
    __device__ __forceinline__ void operator()(const f32x4 (&acc)[2][2][4][2], const Unit& u, int wr, int wc, int fr, int fq) const {
        const int row0 = u.pm * BM + wr * 64 + fr, col0 = u.pn * BM + wc * 32 + 8 * fq; float mx[2] = {0.f, 0.f};
        u64 ssv[2][4];
#pragma unroll
        for (int ai = 0; ai < 2; ++ai)
#pragma unroll
            for (int m = 0; m < 4; ++m) ssv[ai][m] = SCALE ? ss[row0 + ai * HALF + m * 16] : 0ull;
#pragma unroll
        for (int ai = 0; ai < 2; ++ai)
#pragma unroll
            for (int m = 0; m < 4; ++m) { const int row = row0 + ai * HALF + m * 16; float rs = csc; if (SCALE) rs = rstd_q(ssv[ai][m]);
                bf16_t* rowp = O + (size_t)row * ldc + col0;
#pragma unroll
                for (int bj = 0; bj < 2; ++bj) { const f32x4 v0 = acc[ai][bj][m][0] * rs, v1 = acc[ai][bj][m][1] * rs;
                    u32x4 w; w.x = cvt_pk_bf16(v0[0], v0[1]); w.y = cvt_pk_bf16(v0[2], v0[3]); w.z = cvt_pk_bf16(v1[0], v1[1]); w.w = cvt_pk_bf16(v1[2], v1[3]);
                    *(u32x4*)(rowp + bj * HALF) = w;
                    if (BOUND) { float sq = ((v0[0] * v0[0] + v0[1] * v0[1]) + (v0[2] * v0[2] + v0[3] * v0[3])) + ((v1[0] * v1[0] + v1[1] * v1[1]) + (v1[2] * v1[2] + v1[3] * v1[3]));
                        sq = sum_xor32(sum_xor16(sq)); mx[bj] = __builtin_fmaxf(mx[bj], sq); } } }
        if (BOUND) {
#pragma unroll
            for (int bj = 0; bj < 2; ++bj) { const float v = row_max16(mx[bj]);
                if (fr == 0 && fq == 0) __hip_atomic_fetch_max(bnd + ((size_t)(2 * u.pn + bj) * 64 + u.pm + pm0) * 4 + wc, __float_as_uint(v), __ATOMIC_RELAXED, __HIP_MEMORY_SCOPE_AGENT); } }
    }
};
__device__ __forceinline__ float clamp448(float x) { return __builtin_fminf(__builtin_fmaxf(x, -448.0f), 448.0f); }
__device__ __forceinline__ unsigned pk4_fp8(float a, float b, float c, float d) { int v = __builtin_amdgcn_cvt_pk_fp8_f32(clamp448(a), clamp448(b), 0, false); v = __builtin_amdgcn_cvt_pk_fp8_f32(clamp448(c), clamp448(d), v, true); return (unsigned)v; }
__device__ __forceinline__ float silu_mul(float g, float u) { return g * __builtin_amdgcn_rcpf(1.0f + __builtin_amdgcn_exp2f(-1.4426950408889634f * g)) * u; }
__device__ __forceinline__ float silu_mul_c(float g, float u, float c1, float c2) { return (g * u) * (c2 * __builtin_amdgcn_rcpf(1.0f + __builtin_amdgcn_exp2f(g * c1))); }
typedef float f32x2 __attribute__((ext_vector_type(2)));
__device__ __forceinline__ f32x2 silu_mul2(f32x2 g, f32x2 u, float c1, float k) {
    const f32x2 t = g * c1; f32x2 e; e.x = __builtin_amdgcn_exp2f(t.x); e.y = __builtin_amdgcn_exp2f(t.y);
    const f32x2 d = e * k + k; f32x2 r; r.x = __builtin_amdgcn_rcpf(d.x); r.y = __builtin_amdgcn_rcpf(d.y);
    return (g * u) * r;
}
__device__ __forceinline__ f32x4 silu_mul4(f32x4 g, f32x4 u, float c1, float k) { const f32x2 a = silu_mul2(g.xy, u.xy, c1, k), b = silu_mul2(g.zw, u.zw, c1, k); return (f32x4){a.x, a.y, b.x, b.y}; }
template <bool RAW> struct EpiSwiGLU {
    static constexpr bool PERM = true;
    bf16_t* O; int ldc; const void* rsrc;
    __device__ __forceinline__ void operator()(const f32x4 (&acc)[2][2][4][2], const Unit& u, int wr, int wc, int fr, int fq) const {
        const int row0 = u.pm * BM + wr * 64 + fr, col0 = u.pn * HALF + wc * 32 + 8 * fq;
        float rsv[2][4];
#pragma unroll
        for (int ai = 0; ai < 2; ++ai)
#pragma unroll
            for (int m = 0; m < 4; ++m) { const int row = row0 + ai * HALF + m * 16; if (RAW) rsv[ai][m] = ((const float*)rsrc)[row]; else rsv[ai][m] = rstd_q(((const u64*)rsrc)[row]); }
#pragma unroll
        for (int ai = 0; ai < 2; ++ai)
#pragma unroll
            for (int m = 0; m < 4; ++m) { const int row = row0 + ai * HALF + m * 16; const float rs = rsv[ai][m];
                const float c1 = -1.4426950408889634f * rs, kk = __builtin_amdgcn_rcpf(rs * rs);
                const f32x4 a0 = silu_mul4(acc[ai][0][m][0], acc[ai][1][m][0], c1, kk), a1 = silu_mul4(acc[ai][0][m][1], acc[ai][1][m][1], c1, kk);
                u32x4 w; w.x = cvt_pk_bf16(a0[0], a0[1]); w.y = cvt_pk_bf16(a0[2], a0[3]); w.z = cvt_pk_bf16(a1[0], a1[1]); w.w = cvt_pk_bf16(a1[2], a1[3]);
                *(u32x4*)(O + (size_t)row * ldc + col0) = w; }
    }
};
struct EpiSwiGLU8 {
    static constexpr bool PERM = true;
    unsigned char* O; int ldc; float isc, osc; int skip;
    __device__ __forceinline__ void operator()(const f32x4 (&acc)[2][2][4][2], const Unit& u, int wr, int wc, int fr, int fq) const {
        if (skip) return;
        const int row0 = u.pm * BM + wr * 64 + fr, col0 = u.pn * HALF + wc * 32 + 8 * fq; const float c1 = -1.4426950408889634f * isc, kk = 1.0f / (isc * isc * osc);
#pragma unroll
        for (int ai = 0; ai < 2; ++ai)
#pragma unroll
            for (int m = 0; m < 4; ++m) { const int row = row0 + ai * HALF + m * 16;
                const f32x4 a0 = silu_mul4(acc[ai][0][m][0], acc[ai][1][m][0], c1, kk), a1 = silu_mul4(acc[ai][0][m][1], acc[ai][1][m][1], c1, kk);
                u32x2 w; w.x = pk4_fp8(a0[0], a0[1], a0[2], a0[3]); w.y = pk4_fp8(a1[0], a1[1], a1[2], a1[3]);
                *(u32x2*)(O + (size_t)row * ldc + col0) = w; }
    }
};
struct EpiPart {
    static constexpr bool PERM = false;
    float* slab; int row_base; size_t ks_stride;
    __device__ __forceinline__ void operator()(const f32x4 (&acc)[2][2][4][2], const Unit& u, int wr, int wc, int fr, int fq) const {
        const int row0 = u.pm * BM + wr * 64 + fr - row_base, col0 = u.pn * BM + wc * 32 + 4 * fq; float* sp = slab + (size_t)u.ks * ks_stride;
#pragma unroll
        for (int ai = 0; ai < 2; ++ai)
#pragma unroll
            for (int m = 0; m < 4; ++m) { float* rowp = sp + (size_t)(row0 + ai * HALF + m * 16) * DM + col0;
#pragma unroll
                for (int bj = 0; bj < 2; ++bj)
#pragma unroll
                    for (int n = 0; n < 2; ++n) *(f32x4*)(rowp + bj * HALF + n * 16) = acc[ai][bj][m][n]; }
    }
};
template <bool BASE_BF16, bool WRITE_F32> struct EpiResid {
    static constexpr bool PERM = true;
    const void* base; float* xr; bf16_t* xb; u64* ssout;
    __device__ __forceinline__ void operator()(const f32x4 (&acc)[2][2][4][2], const Unit& u, int wr, int wc, int fr, int fq) const {
        const int row0 = u.pm * BM + wr * 64 + fr, col0 = u.pn * BM + wc * 32 + 8 * fq;
#pragma unroll
        for (int ai = 0; ai < 2; ++ai) { u32x4 qv[4][2];
            if (BASE_BF16) {
#pragma unroll
                for (int m = 0; m < 4; ++m)
#pragma unroll
                    for (int bj = 0; bj < 2; ++bj) qv[m][bj] = *(const u32x4*)((const bf16_t*)base + (size_t)(row0 + ai * HALF + m * 16) * DM + col0 + bj * HALF); }
#pragma unroll
            for (int m = 0; m < 4; ++m) { const int row = row0 + ai * HALF + m * 16; const size_t off = (size_t)row * DM + col0; float s = 0.f;
#pragma unroll
                for (int bj = 0; bj < 2; ++bj) { const int c = bj * HALF; f32x4 b0, b1;
                    if (BASE_BF16) { const u32x4 q = qv[m][bj];
                        b0 = (f32x4){__uint_as_float(q.x << 16), __uint_as_float(q.x & 0xffff0000u), __uint_as_float(q.y << 16), __uint_as_float(q.y & 0xffff0000u)};
                        b1 = (f32x4){__uint_as_float(q.z << 16), __uint_as_float(q.z & 0xffff0000u), __uint_as_float(q.w << 16), __uint_as_float(q.w & 0xffff0000u)}; }
                    else { b0 = *(const f32x4*)((const float*)base + off + c); b1 = *(const f32x4*)((const float*)base + off + c + 4); }
                    const f32x4 o0 = b0 + acc[ai][bj][m][0], o1 = b1 + acc[ai][bj][m][1];
                    if (WRITE_F32) { *(f32x4*)(xr + off + c) = o0; *(f32x4*)(xr + off + c + 4) = o1; }
                    u32x4 w; w.x = cvt_pk_bf16(o0[0], o0[1]); w.y = cvt_pk_bf16(o0[2], o0[3]); w.z = cvt_pk_bf16(o1[0], o1[1]); w.w = cvt_pk_bf16(o1[2], o1[3]); *(u32x4*)(xb + off + c) = w;
                    s += (o0[0] * o0[0] + o0[1] * o0[1]) + (o0[2] * o0[2] + o0[3] * o0[3]); s += (o1[0] * o1[0] + o1[1] * o1[1]) + (o1[2] * o1[2] + o1[3] * o1[3]); }
                s = sum_xor32(sum_xor16(s));
                if (fq == 0) __hip_atomic_fetch_add(ssout + row, ss_fix(s), __ATOMIC_RELAXED, __HIP_MEMORY_SCOPE_AGENT); } }
    }
};

typedef int i32x8 __attribute__((ext_vector_type(8)));
__device__ __forceinline__ i32x8 cat16(bf16x8 lo, bf16x8 hi) { typedef int i32x4 __attribute__((ext_vector_type(4))); const i32x4 a = __builtin_bit_cast(i32x4, lo), b = __builtin_bit_cast(i32x4, hi); return (i32x8){a[0], a[1], a[2], a[3], b[0], b[1], b[2], b[3]}; }
__device__ __forceinline__ void mfma_fp8(f32x4& acc, i32x8 a, i32x8 b) { asm volatile("v_mfma_f32_16x16x128_f8f6f4 %0, %1, %2, %0" : "+v"(acc) : "v"(a), "v"(b)); }
template <class Epi, bool ALIGN_EPI, bool SP2, bool FP8 = false, class Sched = Order>
__device__ __forceinline__ void gemm_phase(LAS unsigned char* lds, const int KB, const Sched& S, const Epi& E, const int nt_override = 0, volatile LAS unsigned* prb = nullptr) {
    unsigned long long pk_ = 0, pg_ = 0, pl_ = 0; unsigned pnk_ = 0, png_ = 0;
#define PG8_STAMP(x) do { if (prb) { asm volatile("s_memtime %0\n\ts_waitcnt lgkmcnt(0)" : "=s"(x) :: "memory"); } } while (0)
    int tid_ = threadIdx.x; asm volatile("" : "+v"(tid_));
    const int tid = tid_, wid = __builtin_amdgcn_readfirstlane(tid >> 6), lane = tid & 63, wr = wid >> 2, wc = wid & 3, fr = lane & 15, fq = lane >> 4;
    const int nt = nt_override ? nt_override : KB / 128;
    unsigned voffA[2], voffB[2];
#pragma unroll
    for (int i = 0; i < 2; ++i) { int R, C; stage_rc(tid * 16 + i * 8192, R, C); const int Rb = Epi::PERM ? ((R & ~31) + perm32(R & 31)) : R;
        voffA[i] = (unsigned)(R * KB + C * 2); voffB[i] = (unsigned)(Rb * KB + C * 2); }
    const size_t kstep = (size_t)(BK * 2);
    const size_t hstep = (size_t)HALF * KB;
    const unsigned ldsw = (unsigned)wid * 1024u;
    const int aoff = lds_byte(wr * 64 + fr, fq * 8), boff = lds_byte(wc * 32 + fr, fq * 8);
#define PG8_SA(b, h) (((b) * 2 + (h)) * HTB)
#define PG8_SB(b, h) ((4 + (b) * 2 + (h)) * HTB)
#define PG8_STAGE(bufoff, gbase, voff) do { _Pragma("unroll") for (int _i = 0; _i < 2; ++_i) \
        __builtin_amdgcn_global_load_lds((const unsigned*)((const char*)(gbase) + (voff)[_i]), (LAS unsigned*)(lds + (bufoff) + ldsw + _i * 8192), 16, 0, 0); } while (0)
#define PG8_LDA(dst, b, h) do { _Pragma("unroll") for (int m = 0; m < 4; ++m) _Pragma("unroll") for (int k = 0; k < 2; ++k) dst[m][k] = *(const LAS bf16x8*)(lds + PG8_SA(b, h) + aoff + m * 2048 + k * 1024); } while (0)
#define PG8_LDB(dst, b, h) do { _Pragma("unroll") for (int n = 0; n < 2; ++n) _Pragma("unroll") for (int k = 0; k < 2; ++k) dst[n][k] = *(const LAS bf16x8*)(lds + PG8_SB(b, h) + boff + n * 2048 + k * 1024); } while (0)
#define PG8_MMA(ai, bj, At, Bt) do { __builtin_amdgcn_s_setprio(1); _Pragma("unroll") for (int m = 0; m < 4; ++m) _Pragma("unroll") for (int n = 0; n < 2; ++n) { \
        if constexpr (FP8) mfma_fp8(acc[ai][bj][m][n], cat16(Bt[n][0], Bt[n][1]), cat16(At[m][0], At[m][1])); \
        else { _Pragma("unroll") for (int k = 0; k < 2; ++k) acc[ai][bj][m][n] = __builtin_amdgcn_mfma_f32_16x16x32_bf16(Bt[n][k], At[m][k], acc[ai][bj][m][n], 0, 0, 0); } } \
        __builtin_amdgcn_s_setprio(0); } while (0)
#define PG8_WAIT_V(n) asm volatile("s_waitcnt vmcnt(" #n ")" ::: "memory")
#define PG8_WAIT_L(n) asm volatile("s_waitcnt lgkmcnt(" #n ")" ::: "memory")
#define PG8_BAR __builtin_amdgcn_s_barrier()
#define PG8_SCHED __builtin_amdgcn_sched_barrier(0)
    Unit cur, nxt; int ui = 0;
    if (!S.next(0, cur)) return;
    f32x4 acc[2][2][4][2];
#pragma unroll
    for (int a = 0; a < 2; ++a)
#pragma unroll
        for (int b = 0; b < 2; ++b)
#pragma unroll
            for (int m = 0; m < 4; ++m)
#pragma unroll
                for (int n = 0; n < 2; ++n) acc[a][b][m][n] = (f32x4){0.f, 0.f, 0.f, 0.f};
    bf16x8 At[4][2], B0[2][2], B1[2][2];
    const char* cA = S.a_base(cur); const char* cB = S.b_base(cur);
    if constexpr (SP2) {
        PG8_STAGE(PG8_SB(0, 0), cB, voffB); PG8_STAGE(PG8_SB(0, 1), cB + hstep, voffB); PG8_STAGE(PG8_SA(0, 0), cA, voffA); PG8_STAGE(PG8_SA(0, 1), cA + hstep, voffA);
        if (wr == 1) PG8_BAR;
        PG8_WAIT_V(2); PG8_BAR;
        PG8_STAGE(PG8_SB(1, 0), cB + kstep, voffB); PG8_STAGE(PG8_SA(1, 0), cA + kstep, voffA); PG8_STAGE(PG8_SB(1, 1), cB + hstep + kstep, voffB);
        PG8_WAIT_V(6); PG8_BAR;
    } else {
        PG8_STAGE(PG8_SB(0, 0), cB, voffB); PG8_STAGE(PG8_SA(0, 0), cA, voffA); PG8_STAGE(PG8_SB(0, 1), cB + hstep, voffB); PG8_STAGE(PG8_SA(0, 1), cA + hstep, voffA);
        if (wr == 1) PG8_BAR;
        PG8_WAIT_V(4); PG8_BAR;
        PG8_STAGE(PG8_SB(1, 0), cB + kstep, voffB); PG8_STAGE(PG8_SA(1, 0), cA + kstep, voffA); PG8_STAGE(PG8_SB(1, 1), cB + hstep + kstep, voffB);
        PG8_WAIT_V(6); PG8_BAR;
    }
    for (;;) {
        const bool has_next = S.next(ui + 1, nxt);
        const char* nA = has_next ? S.a_base(nxt) : cA; const char* nB = has_next ? S.b_base(nxt) : cB;
        { unsigned long long ts_; PG8_STAMP(ts_); if (prb && pl_) { pg_ += ts_ - pl_; ++png_; } pl_ = ts_; }
        for (int t = 0; t < nt; t += 2) {
            const bool last = (t == nt - 2);
            const char* a1 = cA + (size_t)(t + 1) * kstep;
            const char* a2 = last ? nA : cA + (size_t)(t + 2) * kstep; const char* b2 = last ? nB : cB + (size_t)(t + 2) * kstep;
            const char* a3 = a2 + kstep; const char* b3 = b2 + kstep;
            if constexpr (SP2) {
            PG8_LDB(B0, 0, 0); PG8_LDB(B1, 0, 1); PG8_SCHED; PG8_LDA(At, 0, 0); PG8_STAGE(PG8_SA(1, 1), a1 + hstep, voffA);
            PG8_WAIT_V(8); PG8_WAIT_L(0); PG8_BAR; PG8_MMA(0, 0, At, B0); PG8_MMA(0, 1, At, B1); PG8_BAR; PG8_SCHED;
            PG8_LDA(At, 0, 1); PG8_STAGE(PG8_SB(0, 0), b2, voffB); PG8_STAGE(PG8_SB(0, 1), b2 + hstep, voffB); PG8_STAGE(PG8_SA(0, 0), a2, voffA);
            PG8_WAIT_V(8); PG8_WAIT_L(0); PG8_BAR; PG8_MMA(1, 0, At, B0); PG8_MMA(1, 1, At, B1); PG8_BAR; PG8_SCHED;
            PG8_LDB(B0, 1, 0); PG8_LDB(B1, 1, 1); PG8_SCHED; PG8_LDA(At, 1, 0); PG8_STAGE(PG8_SA(0, 1), a2 + hstep, voffA);
            PG8_WAIT_V(8); PG8_WAIT_L(0); PG8_BAR; PG8_MMA(0, 0, At, B0); PG8_MMA(0, 1, At, B1); PG8_BAR; PG8_SCHED;
            PG8_LDA(At, 1, 1); PG8_STAGE(PG8_SB(1, 0), b3, voffB); PG8_STAGE(PG8_SB(1, 1), b3 + hstep, voffB); PG8_STAGE(PG8_SA(1, 0), a3, voffA);
            PG8_WAIT_V(8); PG8_WAIT_L(0); PG8_BAR; PG8_MMA(1, 0, At, B0); PG8_MMA(1, 1, At, B1); PG8_BAR; PG8_SCHED;
            } else {
            PG8_LDB(B0, 0, 0); PG8_SCHED; PG8_LDA(At, 0, 0); PG8_STAGE(PG8_SA(1, 1), a1 + hstep, voffA);
            PG8_WAIT_L(8); PG8_BAR; PG8_WAIT_L(0); PG8_MMA(0, 0, At, B0); PG8_BAR; PG8_SCHED;
            PG8_LDB(B1, 0, 1); PG8_STAGE(PG8_SB(0, 0), b2, voffB);
            PG8_BAR; PG8_WAIT_L(0); PG8_MMA(0, 1, At, B1); PG8_BAR;
            PG8_LDA(At, 0, 1); PG8_STAGE(PG8_SA(0, 0), a2, voffA);
            PG8_BAR; PG8_WAIT_L(0); PG8_MMA(1, 0, At, B0); PG8_BAR; PG8_SCHED;
            PG8_STAGE(PG8_SB(0, 1), b2 + hstep, voffB);
            PG8_WAIT_V(6); PG8_BAR; PG8_MMA(1, 1, At, B1); PG8_BAR;
            PG8_LDB(B0, 1, 0); PG8_SCHED; PG8_LDA(At, 1, 0); PG8_STAGE(PG8_SA(0, 1), a2 + hstep, voffA);
            PG8_WAIT_L(8); PG8_BAR; PG8_WAIT_L(0); PG8_MMA(0, 0, At, B0); PG8_BAR; PG8_SCHED;
            PG8_LDB(B1, 1, 1); PG8_STAGE(PG8_SB(1, 0), b3, voffB);
            PG8_BAR; PG8_WAIT_L(0); PG8_MMA(0, 1, At, B1); PG8_BAR;
            PG8_LDA(At, 1, 1); PG8_STAGE(PG8_SA(1, 0), a3, voffA);
            PG8_BAR; PG8_WAIT_L(0); PG8_MMA(1, 0, At, B0); PG8_BAR; PG8_SCHED;
            PG8_STAGE(PG8_SB(1, 1), b3 + hstep, voffB);
            PG8_WAIT_V(6); PG8_BAR; PG8_MMA(1, 1, At, B1); PG8_BAR;
            }
        }
        { unsigned long long ts_; PG8_STAMP(ts_); if (prb) { pk_ += ts_ - pl_; pnk_ += (unsigned)nt; pl_ = ts_; } }
        if constexpr (FP8) asm volatile("s_nop 15\n\ts_nop 15" ::: "memory");
        if constexpr (ALIGN_EPI) { if (wr == 0) PG8_BAR; }
        E(acc, cur, wr, wc, fr, fq);
        if (!has_next) break;
#pragma unroll
        for (int a = 0; a < 2; ++a)
#pragma unroll
            for (int b = 0; b < 2; ++b)
#pragma unroll
                for (int m = 0; m < 4; ++m)
#pragma unroll
                    for (int n = 0; n < 2; ++n) acc[a][b][m][n] = (f32x4){0.f, 0.f, 0.f, 0.f};
        cur = nxt; cA = nA; cB = nB; ++ui;
        if constexpr (ALIGN_EPI) { if (wr == 1) PG8_BAR; }
    }
    PG8_WAIT_V(0);
    if constexpr (!ALIGN_EPI) { if (wr == 0) PG8_BAR; }
    PG8_BAR;
    if (prb && blockIdx.x == 0 && tid == 0) { if (PROBE_KIND == 4) prb[20] = (unsigned)((pk_ / (pnk_ ? pnk_ : 1u)) * 100ull); if (PROBE_KIND == 5) prb[20] = (unsigned)((pg_ / (png_ ? png_ : 1u)) * 10ull); }
#undef PG8_STAMP
#undef PG8_SA
#undef PG8_SB
#undef PG8_STAGE
#undef PG8_LDA
#undef PG8_LDB
#undef PG8_MMA
#undef PG8_WAIT_V
#undef PG8_WAIT_L
#undef PG8_BAR
#undef PG8_SCHED
}
}
constexpr bool GEMM_SP2 = true, GEMM_ALIGN = true;

namespace att {
constexpr int D = 128, LDQ = NQKV, LDO = DM;
constexpr float SCALE = 0.08838834764831845f, THR = 8.f;
constexpr int NW = 8, QBLK = 32, KVBLK = 64, QB = NW * QBLK;
constexpr int SHM_V = KVBLK * D * 2, SHM_K = KVBLK * D * 2;
constexpr int LDS_ATT = 2 * SHM_V + 2 * SHM_K + NW * 64 * 4;
constexpr unsigned BIGW = 0x40000000u;
#define KSWZ(row, colB) ((row) * 256 + ((colB) ^ (((row) & 7) << 4)))
#define SBAR() __builtin_amdgcn_sched_barrier(0)
__device__ __forceinline__ int v_st(int k, int c) { const int kk = (k & ~0xC) | ((k & 4) << 1) | ((k & 8) >> 1); return ((kk >> 3) * 4 + (c >> 5)) * 512 + ((kk & 7) * 32 + (c & 31)) * 2; }
__device__ __forceinline__ int v_rd_base(int lane) { return ((lane & 3) << 3) | (((lane >> 2) & 3) << 6) | (((lane >> 4) & 1) << 5) | (((lane >> 5) & 1) << 8); }
constexpr int v_rd_off(int d0, int ks, int half) { return d0 * 512 + ks * 4096 + half * 2048; }
__device__ __forceinline__ int crow(int r, int hi) { return (r & 3) + 8 * (r >> 2) + 4 * hi; }
__device__ __forceinline__ bf16x8 ld8(const bf16_t* p) { return *reinterpret_cast<const bf16x8*>(p); }
__device__ __forceinline__ void mask_tile(f32x16& p0, f32x16& p1, int dq) {
    const float NEG = -__builtin_inff();
#pragma unroll
    for (int r = 0; r < 16; ++r) {
        const int c = (r & 3) + 8 * (r >> 2);
        if ((unsigned)(dq - c) >= BIGW) p0[r] = NEG;
        if ((unsigned)(dq - c - 32) >= BIGW) p1[r] = NEG;
    }
}
__device__ __forceinline__ void mask_lane(f32x16& p0, f32x16& p1, bool keep) {
    const float NEG = -__builtin_inff();
#pragma unroll
    for (int r = 0; r < 16; ++r) { p0[r] = keep ? p0[r] : NEG; p1[r] = keep ? p1[r] : NEG; }
}
__device__ __forceinline__ void partialSM(f32x16& p0, f32x16& p1, float& m_reg, float& mn, float& alpha) {
    float pmax = p0[0]; for (int r = 1; r < 16; ++r) pmax = fmaxf(pmax, p0[r]); for (int r = 0; r < 16; ++r) pmax = fmaxf(pmax, p1[r]);
    { auto rr = __builtin_amdgcn_permlane32_swap(__float_as_uint(pmax), __float_as_uint(pmax), false, false);
      pmax = fmaxf(__uint_as_float(rr[0]), __uint_as_float(rr[1])); }
    constexpr float C2 = 1.4426950408889634f * SCALE;
    if (__builtin_expect(__all((pmax - m_reg) * SCALE <= THR), 1)) { mn = m_reg; alpha = 1.f; }
    else { mn = fmaxf(m_reg, pmax); alpha = __builtin_amdgcn_exp2f((m_reg - mn) * C2); m_reg = mn; }
    const float mnL = -mn * C2;
    for (int r = 0; r < 16; ++r) p0[r] = fmaf(p0[r], C2, mnL); for (int r = 0; r < 16; ++r) p1[r] = fmaf(p1[r], C2, mnL);
    for (int r = 0; r < 16; ++r) p0[r] = __builtin_amdgcn_exp2f(p0[r]);
}
__device__ __forceinline__ void finishSM(f32x16& p0, f32x16& p1, float alpha, float& l_reg, bf16x8& pa0, bf16x8& pa1, bf16x8& pa2, bf16x8& pa3) {
    for (int r = 0; r < 16; ++r) p1[r] = __builtin_amdgcn_exp2f(p1[r]);
    float ps = 0; for (int r = 0; r < 16; ++r) ps += p0[r]; for (int r = 0; r < 16; ++r) ps += p1[r];
    { auto rr = __builtin_amdgcn_permlane32_swap(__float_as_uint(ps), __float_as_uint(ps), false, false);
      ps = __uint_as_float(rr[0]) + __uint_as_float(rr[1]); }
    l_reg = l_reg * alpha + ps;
#define PK4(P, B_, OUT) do { unsigned a0 = cvt_pk_bf16(P[B_+0], P[B_+1]), a1 = cvt_pk_bf16(P[B_+2], P[B_+3]);                          \
        unsigned b0 = cvt_pk_bf16(P[B_+4], P[B_+5]), b1 = cvt_pk_bf16(P[B_+6], P[B_+7]);                                             \
        auto r0 = __builtin_amdgcn_permlane32_swap(a0, b0, false, false); auto r1 = __builtin_amdgcn_permlane32_swap(a1, b1, false, false); \
        u32x4 w = {r0[0], r1[0], r0[1], r1[1]}; OUT = *reinterpret_cast<bf16x8*>(&w); } while (0)
    PK4(p0, 0, pa0); PK4(p0, 8, pa1); PK4(p1, 0, pa2); PK4(p1, 8, pa3);
#undef PK4
}
template <int KB>
__device__ __forceinline__ void qkt(f32x16& p0, f32x16& p1, const char* K_lds, int r32, int hi, const bf16x8* qr, float a, float bias0) {
#pragma unroll
    for (int r = 0; r < 16; ++r) { const float c = (float)((r & 3) + 8 * (r >> 2)); p0[r] = fmaf(a, c, bias0); p1[r] = fmaf(a, c + 32.f, bias0); }
    const char* kb[4];
#pragma unroll
    for (int dd = 0; dd < 4; ++dd) kb[dd] = K_lds + KB * SHM_K + KSWZ(r32, (dd * 16 + hi * 8) * 2);
#pragma unroll
    for (int d0 = 0; d0 < 8; ++d0) { const char* ap = kb[d0 & 3] + (d0 >> 2) * 128;
        bf16x8 b0 = *reinterpret_cast<const bf16x8*>(ap);
        bf16x8 b1 = *reinterpret_cast<const bf16x8*>(ap + 32 * 256);
        p0 = __builtin_amdgcn_mfma_f32_32x32x16_bf16(b0, qr[d0], p0, 0, 0, 0);
        p1 = __builtin_amdgcn_mfma_f32_32x32x16_bf16(b1, qr[d0], p1, 0, 0, 0); }
}
template <int VB>
__device__ __forceinline__ void pv_tile(f32x16* o, int vb0, bf16x8 pa0, bf16x8 pa1, bf16x8 pa2, bf16x8 pa3) {
#define TRRD(dst, off) asm volatile("ds_read_b64_tr_b16 %0, %1 offset:%2" : "=&v"(dst) : "v"(vb0), "i"(off) : "memory")
#define PV_D0(d0) do { s16x4 l0, l1, l2, l3, h0, h1, h2, h3; constexpr int b_ = VB * SHM_V + v_rd_off(d0, 0, 0); \
        TRRD(l0, b_); TRRD(h0, b_ + 2048); TRRD(l1, b_ + 4096); TRRD(h1, b_ + 6144); TRRD(l2, b_ + 8192); TRRD(h2, b_ + 10240); TRRD(l3, b_ + 12288); TRRD(h3, b_ + 14336); \
        asm volatile("s_waitcnt lgkmcnt(0)" ::: "memory"); SBAR();   \
        o[d0] = __builtin_amdgcn_mfma_f32_32x32x16_bf16(pa0, (bf16x8){l0[0], l0[1], l0[2], l0[3], h0[0], h0[1], h0[2], h0[3]}, o[d0], 0, 0, 0);   \
        o[d0] = __builtin_amdgcn_mfma_f32_32x32x16_bf16(pa1, (bf16x8){l1[0], l1[1], l1[2], l1[3], h1[0], h1[1], h1[2], h1[3]}, o[d0], 0, 0, 0);   \
        o[d0] = __builtin_amdgcn_mfma_f32_32x32x16_bf16(pa2, (bf16x8){l2[0], l2[1], l2[2], l2[3], h2[0], h2[1], h2[2], h2[3]}, o[d0], 0, 0, 0);   \
        o[d0] = __builtin_amdgcn_mfma_f32_32x32x16_bf16(pa3, (bf16x8){l3[0], l3[1], l3[2], l3[3], h3[0], h3[1], h3[2], h3[3]}, o[d0], 0, 0, 0); } while (0)
    PV_D0(0); PV_D0(1); PV_D0(2); PV_D0(3);
#undef PV_D0
#undef TRRD
}
struct BlockRef { const bf16_t* Q; const bf16_t* K; const bf16_t* V; bf16_t* O; const unsigned char* sel; int P0; float a; int jlo; };
struct Seam { bf16x8 qr[8]; bf16x8 st_v0, st_v1, st_k0, st_k1; };
#define AROW(p, k0, rr) (((p) + (size_t)((k0) + (rr)) * LDQ) + toff)
#define VMW() asm volatile("s_waitcnt vmcnt(0)" ::: "memory")
#define VMWN(n) asm volatile("s_waitcnt vmcnt(%0)" :: "i"(n) : "memory")
#define SLOAD_H(Kp, Vp, k0) do { S.st_v0 = ld8(AROW(Vp, k0, 0)); S.st_v1 = ld8(AROW(Vp, k0, 32));              \
                         S.st_k0 = ld8(AROW(Kp, k0, 0)); S.st_k1 = ld8(AROW(Kp, k0, 32)); } while (0)
#define SWRITE_HK(bf) do { *(bf16x8*)(K_lds + (bf) * SHM_K + kws) = S.st_k0; *(bf16x8*)(K_lds + (bf) * SHM_K + kws + 32 * 256) = S.st_k1; } while (0)
#define SWRITE_HV(bf) do { *(bf16x8*)(V_lds + (bf) * SHM_V + vst0) = S.st_v0; *(bf16x8*)(V_lds + (bf) * SHM_V + vst1) = S.st_v1; } while (0)
#define SWRITE_H(bf) do { SWRITE_HV(bf); SWRITE_HK(bf); } while (0)
__device__ __forceinline__ int attn_jlo(const unsigned* bnd, int qseg, int kseg, int b, int qb, float slope) {
    float q2 = 0.f, k2 = 0.f;
#pragma unroll
    for (int w = 0; w < 4; ++w) q2 += __uint_as_float(bnd[((size_t)qseg * 64 + b * 8 + qb) * 4 + w]);
    for (int t = 0; t <= qb; ++t) { float s2 = 0.f;
#pragma unroll
        for (int w = 0; w < 4; ++w) s2 += __uint_as_float(bnd[((size_t)kseg * 64 + b * 8 + t) * 4 + w]);
        k2 = __builtin_fmaxf(k2, s2); }
    const float W = (2.0f * 1.02f * __builtin_sqrtf(q2 * k2) * SCALE + 30.0f) / slope, lo = (float)(qb * 256) - W;
    return lo > 0.f ? (int)(lo * (1.0f / 64.0f)) : 0;
}
struct DynCtx { const bf16_t* qkv; bf16_t* out; const unsigned char* sel; const unsigned* bnd; unsigned* qctr; volatile LAS int* nw; int q0, qb0, nq; const LAS int* jt; };
template <bool MOBA> __device__ __forceinline__ BlockRef attn_ref_blk(int code, const DynCtx& C) {
    constexpr int NH = MOBA ? HA : HB * 4, NPB = NH * 8;
    const int b = code / NPB, idx = code % NPB, qb = 7 - idx / NH, hh = NH - 1 - idx % NH; BlockRef r; const size_t t0 = (size_t)b * SEQ;
    if (MOBA) { const int h = hh; const float slope = __builtin_amdgcn_exp2f(-0.5f * (float)(h + 1));
        r.Q = C.qkv + (t0 + qb * 256) * NQKV + h * 128; r.K = C.qkv + t0 * NQKV + DM + h * 128; r.V = C.qkv + t0 * NQKV + 2 * DM + h * 128;
        r.O = C.out + (t0 + qb * 256) * DM + h * 128; r.sel = C.sel + (size_t)(b * HA + h) * SEQ; r.P0 = qb * 256; r.a = slope * (1.0f / SCALE); r.jlo = C.jt[(b - C.qb0) * 128 + h * 8 + qb]; }
    else { const int h = hh >> 2, c = (hh >> 1) & 1, vh = hh & 1; const float slope = __builtin_amdgcn_exp2f(-(float)(h + 1));
        r.Q = C.qkv + (t0 + qb * 256) * NQKV + 2 * DM + h * 256 + c * 128; r.K = C.qkv + t0 * NQKV + h * 256 + c * 128; r.V = C.qkv + t0 * NQKV + DM + h * 256 + vh * 128;
        r.O = C.out + (size_t)c * MTOK * DM + (t0 + qb * 256) * DM + h * 256 + vh * 128; r.sel = nullptr; r.P0 = qb * 256; r.a = slope * (1.0f / SCALE); r.jlo = C.jt[(b - C.qb0) * 128 + (2 * h + c) * 8 + qb]; }
    return r;
}
__device__ __forceinline__ int attn_pull_from(unsigned* qctr, int q0, int k0, int npb, int qb0, int nq) {
    for (int k = k0; k < nq; ++k) { const int q = qb0 + ((q0 - qb0 + k) & (nq - 1)); if (xb_ld(qctr + 64 * q) >= (unsigned)npb) continue;
        const unsigned i = xb_add(qctr + 64 * q, 1u); if (i < (unsigned)npb) return q * npb + (int)i; }
    return -1;
}
__device__ __forceinline__ void attn_prime(const BlockRef& cur, char* lds, Seam& S) {
    int tid_ = threadIdx.x; asm volatile("" : "+v"(tid_));
    const int tid = tid_, wid = __builtin_amdgcn_readfirstlane(tid >> 6), lane = tid & 63, r32 = lane & 31, hi = lane >> 5;
    const int sr = tid >> 4, sc = (tid & 15) * 8, kws = KSWZ(sr, sc * 2); char* K_lds = lds + 2 * SHM_V; const unsigned toff = (unsigned)(sr * LDQ + sc);
    { const unsigned qoff = (unsigned)(r32 * LDQ + hi * 8); const bf16_t* qb_ = cur.Q + (size_t)(wid * QBLK) * LDQ;
      for (int d0 = 0; d0 < 8; ++d0) S.qr[d0] = ld8(qb_ + qoff + d0 * 16); }
    SLOAD_H(cur.K, cur.V, cur.jlo * KVBLK); VMW(); SWRITE_HK(0);
    __syncthreads();
}
template <bool MOBA>
__device__ __forceinline__ int attn_block(const BlockRef& cur, const DynCtx& C, char* lds, Seam& S) {
    int tid_ = threadIdx.x; asm volatile("" : "+v"(tid_));
    const int tid = tid_, wid = __builtin_amdgcn_readfirstlane(tid >> 6), lane = tid & 63, r32 = lane & 31, hi = lane >> 5;
    const int NT = (cur.P0 + QB) / KVBLK - cur.jlo;
    const int qlo = cur.P0 + wid * QBLK, qm = qlo + r32 - 4 * hi;
    char* V_lds = lds; char* K_lds = lds + 2 * SHM_V;
    float* ws = (float*)(lds + 2 * SHM_V + 2 * SHM_K) + wid * 64; float* li_l = ws, * al_l = ws + 32;
    float m_reg = -1e30f, l_reg = 0; f32x16 o[4] = {};
    const int sr = tid >> 4, sc = (tid & 15) * 8, vst0 = v_st(sr, sc), vst1 = v_st(32 + sr, sc), kws = KSWZ(sr, sc * 2); const unsigned toff = (unsigned)(sr * LDQ + sc);
    const int vb0 = (int)(uintptr_t)V_lds + v_rd_base(lane);
    const bf16_t* Kh = cur.K; const bf16_t* Vh = cur.V;
    unsigned selm = 0xffu; if (MOBA) selm = cur.sel[cur.P0 + wid * QBLK + r32];
    const float aa = cur.a, abase = -aa * (float)qm;
#define RESC(a) do { if (__any((a) < 1.f)) { if (hi == 0) al_l[r32] = (a); asm volatile("s_waitcnt lgkmcnt(0)" ::: "memory");              \
                     for (int d_ = 0; d_ < 4; ++d_) for (int r = 0; r < 16; ++r) o[d_][r] *= al_l[crow(r, hi)]; } } while (0)
#define KBASE(t) ((cur.jlo + (t)) * KVBLK)
#define BIAS(t) fmaf(aa, (float)KBASE(t), abase)
#define MASKT(P0_, P1_, t) do { const int kb_ = KBASE(t); \
        if (!MOBA || kb_ >= cur.P0) { if (kb_ + KVBLK - 1 > qlo) mask_tile(P0_, P1_, qm - kb_); } \
        else { const bool keep_ = ((selm >> (kb_ >> 8)) & 1u) != 0u; if (!__all(keep_)) mask_lane(P0_, P1_, keep_); } } while (0)
#define SEAM_K0() do { VMWN(8); SWRITE_HK(0); SBAR(); } while (0)
    f32x16 pA0, pA1, pB0, pB1; float mnA, mnB, alA, alB; bf16x8 pa0, pa1, pa2, pa3;
    SWRITE_HV(0); SBAR();
    if (NT > 1) { SLOAD_H(Kh, Vh, KBASE(1)); }
    constexpr int NPB_ = (MOBA ? HA : HB * 4) * 8; unsigned pi_ = 0u; if (tid == 0) pi_ = xb_add(C.qctr + 64 * C.q0, 1u);
    SBAR(); qkt<0>(pA0, pA1, K_lds, r32, hi, S.qr, aa, BIAS(0));
    MASKT(pA0, pA1, 0); partialSM(pA0, pA1, m_reg, mnA, alA);
    if (NT > 1) { VMW(); SWRITE_H(1); }
    if (tid == 0) *C.nw = pi_ < (unsigned)NPB_ ? C.q0 * NPB_ + (int)pi_ : attn_pull_from(C.qctr, C.q0, 1, NPB_, C.qb0, C.nq);
    __syncthreads();
#define HALF_STEP(PX0, PX1, mnX, alX, PY0, PY1, alY, t, KB, VB, SB) do {                                                      \
        SBAR(); qkt<KB>(PX0, PX1, K_lds, r32, hi, S.qr, aa, BIAS(t));                                                         \
        finishSM(PY0, PY1, alY, l_reg, pa0, pa1, pa2, pa3); SBAR();                                                           \
        if ((t) + 1 < NT) { SLOAD_H(Kh, Vh, KBASE((t) + 1)); SBAR(); }                                                        \
        pv_tile<VB>(o, vb0, pa0, pa1, pa2, pa3); MASKT(PX0, PX1, (t)); partialSM(PX0, PX1, m_reg, mnX, alX);                  \
        __syncthreads();                                                                                                      \
        if ((t) + 1 < NT) { VMW(); SWRITE_H(SB); }                                                                            \
        RESC(alX); __syncthreads(); } while (0)
    for (int t = 1; t + 1 < NT; t += 2) {
        HALF_STEP(pB0, pB1, mnB, alB, pA0, pA1, alA, t, 1, 0, 0);
        HALF_STEP(pA0, pA1, mnA, alA, pB0, pB1, alB, t + 1, 0, 1, 1);
    }
    const bool even = (NT & 1) == 0;
    if (even) { SBAR(); qkt<1>(pB0, pB1, K_lds, r32, hi, S.qr, aa, BIAS(NT - 1)); SBAR(); }
    const int nc_ = __builtin_amdgcn_readfirstlane(*C.nw); const BlockRef nxt = nc_ >= 0 ? attn_ref_blk<MOBA>(nc_, C) : cur;
    SLOAD_H(nxt.K, nxt.V, nxt.jlo * KVBLK); SBAR();
    { const unsigned qoff = (unsigned)(r32 * LDQ + hi * 8); const bf16_t* qb_ = nxt.Q + (size_t)(wid * QBLK) * LDQ;
      _Pragma("unroll") for (int d0 = 0; d0 < 8; ++d0) S.qr[d0] = ld8(qb_ + qoff + d0 * 16); }
    SBAR();
    finishSM(pA0, pA1, alA, l_reg, pa0, pa1, pa2, pa3); SBAR();
    pv_tile<0>(o, vb0, pa0, pa1, pa2, pa3);
    if (even) { MASKT(pB0, pB1, NT - 1); partialSM(pB0, pB1, m_reg, mnB, alB); __syncthreads(); RESC(alB);
        finishSM(pB0, pB1, alB, l_reg, pa0, pa1, pa2, pa3); SBAR(); pv_tile<1>(o, vb0, pa0, pa1, pa2, pa3); }
    SBAR(); SEAM_K0();
    if (hi == 0) li_l[r32] = l_reg; asm volatile("s_waitcnt lgkmcnt(0)" ::: "memory");
    float rli[16];
#pragma unroll
    for (int r = 0; r < 16; ++r) rli[r] = __builtin_amdgcn_rcpf(li_l[crow(r, hi)]);
    bf16_t* Ow = cur.O + (size_t)(wid * QBLK) * LDO;
#pragma unroll
    for (int r = 0; r < 16; ++r) { const int orow = crow(r, hi);
#pragma unroll
        for (int d0 = 0; d0 < 4; ++d0) { const float v = o[d0][r] * rli[r];
            const float vn = xor1_get(v);
            if ((r32 & 1) == 0) *(unsigned*)(Ow + (size_t)orow * LDO + d0 * 32 + r32) = cvt_pk_bf16(v, vn); } }
    __syncthreads();
    return nc_;
#undef RESC
#undef KBASE
#undef BIAS
#undef MASKT
#undef SEAM_K0
#undef HALF_STEP
}
#undef AROW
#undef VMW
#undef VMWN
#undef SLOAD_H
#undef SWRITE_HK
#undef SWRITE_HV
#undef SWRITE_H
}

constexpr int NWAVES = 8, NTHREADS = NWAVES * 64, NPHASE = 17;
struct Args { const float* in[23]; float* out; unsigned char* ws; int ph_lo, ph_hi; };
struct Frame { LAS unsigned char* lds; int tid, lane, wave, G, vc, gw, NGW; };
typedef const __attribute__((address_space(4))) Args* KAP;

struct WJob { const float* src; void* dst; const float* gain; float sc; int K, N, mode, kb, nb, f8; };
__device__ __forceinline__ int wdrow(int n, int mode) { return mode == 0 ? n : ((n >> 7) * 256 + (mode == 2 ? 128 : 0) + (n & 127)); }
constexpr int I_QKV = 32 * 24, I_OA = 32 * 8, I_G = 32 * 22, I_DN = 88 * 8, I_KV = 32 * 16, I_QB = 32 * 8, I_OB = 32 * 8, I_E1 = 32 * 28, I_EG = 8 * I_E1, I_ED1 = 112 * 8, I_ED = 8 * I_ED1;
constexpr int W_NITEMS0 = I_QKV + I_OA + 2 * I_G + I_DN + I_KV + I_QB + I_OB;
constexpr int W_NEXP = 2 * I_EG + I_ED, W_NITEMS = W_NITEMS0 + W_NEXP;
__device__ __forceinline__ void wjob_decode(KAP ap, int item, WJob& j) {
    unsigned char* ws = ap->ws; int r = item; int nbn; j.f8 = 0; j.sc = 1.0f;
    if (r < I_QKV) { j.src = ap->in[2]; j.dst = (bf16_t*)(ws + WS_WQKV); j.gain = ap->in[1]; j.K = DM; j.N = NQKV; j.mode = 0; }
    else if ((r -= I_QKV) < I_OA) { j.src = ap->in[3]; j.dst = (bf16_t*)(ws + WS_WOA); j.gain = nullptr; j.K = DM; j.N = DM; j.mode = 0; }
    else if ((r -= I_OA) < I_G) { j.src = ap->in[15]; j.dst = (bf16_t*)(ws + WS_WGU); j.gain = ap->in[14]; j.K = DM; j.N = FF; j.mode = 1; }
    else if ((r -= I_G) < I_G) { j.src = ap->in[16]; j.dst = (bf16_t*)(ws + WS_WGU); j.gain = ap->in[14]; j.K = DM; j.N = FF; j.mode = 2; }
    else if ((r -= I_G) < I_DN) { j.src = ap->in[17]; j.dst = (bf16_t*)(ws + WS_WDN); j.gain = nullptr; j.K = FF; j.N = DM; j.mode = 0; }
    else if ((r -= I_DN) < I_KV) { j.src = ap->in[5]; j.dst = (bf16_t*)(ws + WS_WKVQ); j.gain = ap->in[4]; j.K = DM; j.N = 2 * DM; j.mode = 0; }
    else if ((r -= I_KV) < I_QB) { j.src = ap->in[7]; j.dst = (bf16_t*)(ws + WS_WKVQ) + (size_t)2 * DM * DM; j.gain = ap->in[6]; j.K = DM; j.N = DM; j.mode = 0; }
    else if ((r -= I_QB) < I_OB) { j.src = ap->in[13]; j.dst = (bf16_t*)(ws + WS_WOB); j.gain = nullptr; j.K = DM; j.N = DM; j.mode = 0; }
    else if ((r -= I_OB) < I_EG) { const int e = r / I_E1; r -= e * I_E1; j.src = ap->in[19] + (size_t)e * DM * FE; j.dst = ws + WS_WEGU + (size_t)e * 2 * FE * DM; j.gain = ap->in[14] + DM; j.K = DM; j.N = FE; j.mode = 1; j.f8 = 1; j.sc = WEGU_SC; }
    else if ((r -= I_EG) < I_EG) { const int e = r / I_E1; r -= e * I_E1; j.src = ap->in[20] + (size_t)e * DM * FE; j.dst = ws + WS_WEGU + (size_t)e * 2 * FE * DM; j.gain = ap->in[14] + DM; j.K = DM; j.N = FE; j.mode = 2; j.f8 = 1; j.sc = WEGU_SC; }
    else { r -= I_EG; const int e = r / I_ED1; r -= e * I_ED1; j.src = ap->in[21] + (size_t)e * FE * DM; j.dst = ws + WS_WEDN + (size_t)e * DM * FE; j.gain = nullptr; j.K = FE; j.N = DM; j.mode = 0; j.f8 = 1; j.sc = WEDN_SC; }
    nbn = j.N >> 8; j.kb = r / nbn; j.nb = r - j.kb * nbn;
}
__device__ __forceinline__ void p0_weights(KAP a, Frame& F, int first, const int end, const int stride) {
    LAS float* tile = (LAS float*)F.lds;
    const int w = F.wave, l = F.lane;
    float v[32];
    int item = first; bool have = item < end; WJob j;
#define W_LOAD() do { const float* sp = j.src + (size_t)(j.kb * 64 + w) * j.N + j.nb * 256 + l; \
        _Pragma("unroll") for (int i = 0; i < 8; ++i) _Pragma("unroll") for (int c = 0; c < 4; ++c) v[i * 4 + c] = __builtin_nontemporal_load(sp + (size_t)(8 * i) * j.N + 64 * c); } while (0)
    if (have) { wjob_decode(a, item, j); W_LOAD(); }
    while (have) {
        __syncthreads();
#pragma unroll
        for (int i = 0; i < 8; ++i) { const int k = w + 8 * i; const float g = (j.gain ? j.gain[j.kb * 64 + k] : 1.0f) * j.sc;
#pragma unroll
            for (int c = 0; c < 4; ++c) tile[k * 257 + l + 64 * c] = v[i * 4 + c] * g; }
        void* cdst = j.dst; const int cK = j.K, cmode = j.mode, ckb = j.kb, cnb = j.nb, cf8 = j.f8;
        item += stride; const bool have_next = item < end;
        if (have_next) { wjob_decode(a, item, j); W_LOAD(); }
        __syncthreads();
        if (cf8) {
            const int c4 = l >> 4, n16 = l & 15;
#pragma unroll
            for (int jj = 0; jj < 2; ++jj) { const int n = n16 + 16 * w + 128 * jj; const LAS float* s = tile + (16 * c4) * 257 + n;
                u32x4 o; o.x = pg8::pk4_fp8(s[0], s[257], s[2 * 257], s[3 * 257]); o.y = pg8::pk4_fp8(s[4 * 257], s[5 * 257], s[6 * 257], s[7 * 257]);
                o.z = pg8::pk4_fp8(s[8 * 257], s[9 * 257], s[10 * 257], s[11 * 257]); o.w = pg8::pk4_fp8(s[12 * 257], s[13 * 257], s[14 * 257], s[15 * 257]);
                *(u32x4*)((unsigned char*)cdst + (size_t)wdrow(cnb * 256 + n, cmode) * cK + ckb * 64 + 16 * c4) = o; }
        } else {
        const int c8 = l >> 3, nn = l & 7;
#pragma unroll
        for (int jj = 0; jj < 4; ++jj) { const int n = nn + 8 * w + 64 * jj; const LAS float* s = tile + (8 * c8) * 257 + n;
            u32x4 o; o.x = cvt_pk_bf16(s[0], s[257]); o.y = cvt_pk_bf16(s[2 * 257], s[3 * 257]); o.z = cvt_pk_bf16(s[4 * 257], s[5 * 257]); o.w = cvt_pk_bf16(s[6 * 257], s[7 * 257]);
            *(u32x4*)((bf16_t*)cdst + (size_t)wdrow(cnb * 256 + n, cmode) * cK + ckb * 64 + 8 * c8) = o; }
        }
        have = have_next;
    }
#undef W_LOAD
    __syncthreads();
}
#ifndef W_DEEP4
#define W_DEEP4 1
#endif
__device__ __forceinline__ void p0_weights2(KAP a, Frame& F, int first, const int end, const int stride) {
    const int w = F.wave, l = F.lane;
    float va[32], vb[32];
    WJob ja, jb;
#define W_LOAD2(J, V) do { const float* sp = (J).src + (size_t)((J).kb * 64 + w) * (J).N + (J).nb * 256 + l; \
        _Pragma("unroll") for (int i = 0; i < 8; ++i) _Pragma("unroll") for (int c = 0; c < 4; ++c) (V)[i * 4 + c] = __builtin_nontemporal_load(sp + (size_t)(8 * i) * (J).N + 64 * c); } while (0)
#define W_ITEM2(J, V, TILE, NEXT_ITEM) do { \
        LAS float* tile = (LAS float*)F.lds + (TILE) * (64 * 257); \
        _Pragma("unroll") for (int i = 0; i < 8; ++i) { const int k = w + 8 * i; const float g = ((J).gain ? (J).gain[(J).kb * 64 + k] : 1.0f) * (J).sc; \
            _Pragma("unroll") for (int c = 0; c < 4; ++c) tile[k * 257 + l + 64 * c] = (V)[i * 4 + c] * g; } \
        void* cdst = (J).dst; const int cK = (J).K, cmode = (J).mode, ckb = (J).kb, cnb = (J).nb, cf8 = (J).f8; \
        if ((NEXT_ITEM) < end) { wjob_decode(a, (NEXT_ITEM), (J)); W_LOAD2(J, V); } \
        __syncthreads(); \
        if (cf8) { const int c4 = l >> 4, n16 = l & 15; \
            _Pragma("unroll") for (int jj = 0; jj < 2; ++jj) { const int n = n16 + 16 * w + 128 * jj; const LAS float* s = tile + (16 * c4) * 257 + n; \
                u32x4 o; o.x = pg8::pk4_fp8(s[0], s[257], s[2 * 257], s[3 * 257]); o.y = pg8::pk4_fp8(s[4 * 257], s[5 * 257], s[6 * 257], s[7 * 257]); \
                o.z = pg8::pk4_fp8(s[8 * 257], s[9 * 257], s[10 * 257], s[11 * 257]); o.w = pg8::pk4_fp8(s[12 * 257], s[13 * 257], s[14 * 257], s[15 * 257]); \
                *(u32x4*)((unsigned char*)cdst + (size_t)wdrow(cnb * 256 + n, cmode) * cK + ckb * 64 + 16 * c4) = o; } \
        } else { const int c8 = l >> 3, nn = l & 7; \
            _Pragma("unroll") for (int jj = 0; jj < 4; ++jj) { const int n = nn + 8 * w + 64 * jj; const LAS float* s = tile + (8 * c8) * 257 + n; \
                u32x4 o; o.x = cvt_pk_bf16(s[0], s[257]); o.y = cvt_pk_bf16(s[2 * 257], s[3 * 257]); o.z = cvt_pk_bf16(s[4 * 257], s[5 * 257]); o.w = cvt_pk_bf16(s[6 * 257], s[7 * 257]); \
                *(u32x4*)((bf16_t*)cdst + (size_t)wdrow(cnb * 256 + n, cmode) * cK + ckb * 64 + 8 * c8) = o; } } \
    } while (0)
    int item = first;
    __syncthreads();
#if W_DEEP4
    float vc[32], vd[32]; WJob jc, jd;
    if (item < end) { wjob_decode(a, item, ja); W_LOAD2(ja, va); }
    if (item + stride < end) { wjob_decode(a, item + stride, jb); W_LOAD2(jb, vb); }
    if (item + 2 * stride < end) { wjob_decode(a, item + 2 * stride, jc); W_LOAD2(jc, vc); }
    if (item + 3 * stride < end) { wjob_decode(a, item + 3 * stride, jd); W_LOAD2(jd, vd); }
    for (; item < end; item += 4 * stride) {
        W_ITEM2(ja, va, 0, item + 4 * stride);
        if (item + stride < end) W_ITEM2(jb, vb, 1, item + 5 * stride);
        if (item + 2 * stride < end) W_ITEM2(jc, vc, 0, item + 6 * stride);
        if (item + 3 * stride < end) W_ITEM2(jd, vd, 1, item + 7 * stride);
    }
#else
    if (item < end) { wjob_decode(a, item, ja); W_LOAD2(ja, va); }
    if (item + stride < end) { wjob_decode(a, item + stride, jb); W_LOAD2(jb, vb); }
    for (; item < end; item += 2 * stride) {
        W_ITEM2(ja, va, 0, item + 2 * stride);
        if (item + stride < end) W_ITEM2(jb, vb, 1, item + 3 * stride);
    }
#endif
#undef W_LOAD2
#undef W_ITEM2
    __syncthreads();
}
__device__ __forceinline__ void p0_weights_r(KAP a, Frame& F, int first, const int end, const int wg, const int nwg) {
    const int t = F.tid & 255, half = __builtin_amdgcn_readfirstlane(F.tid >> 8), nq = t & 15, kq = (t >> 4) & 3, ng = t >> 6;
    const int n0 = ng * 64 + nq * 4, k0 = kq * 16, nworkers = 2 * nwg;
    f32x4 va[16], vb[16], ga[4], gb[4]; WJob ja, jb;
#define WR_LOAD(J, V, G) do { const char* ub = (const char*)((J).src + (size_t)(J).kb * 64 * (J).N + (J).nb * 256); const unsigned loff = (unsigned)(k0 * (J).N + n0) * 4u; \
        _Pragma("unroll") for (int i = 0; i < 16; ++i) (V)[i] = __builtin_nontemporal_load((const f32x4*)(ub + (size_t)i * (J).N * 4 + loff)); \
        _Pragma("unroll") for (int i = 0; i < 4; ++i) (G)[i] = (J).gain ? *(const f32x4*)((J).gain + (J).kb * 64 + k0 + 4 * i) : (f32x4){1.f, 1.f, 1.f, 1.f}; } while (0)
#define WR_ITEM(J, V, G, NEXT_ITEM) do { \
        _Pragma("unroll") for (int i = 0; i < 4; ++i) (G)[i] = (G)[i] * (J).sc; \
        unsigned char* cdst = (unsigned char*)(J).dst; const int cK = (J).K, cmode = (J).mode, ckb = (J).kb, cnb = (J).nb; \
        _Pragma("unroll") for (int j = 0; j < 4; ++j) { u32x4 o; \
            o.x = pg8::pk4_fp8((V)[0][j] * (G)[0][0], (V)[1][j] * (G)[0][1], (V)[2][j] * (G)[0][2], (V)[3][j] * (G)[0][3]); o.y = pg8::pk4_fp8((V)[4][j] * (G)[1][0], (V)[5][j] * (G)[1][1], (V)[6][j] * (G)[1][2], (V)[7][j] * (G)[1][3]); \
            o.z = pg8::pk4_fp8((V)[8][j] * (G)[2][0], (V)[9][j] * (G)[2][1], (V)[10][j] * (G)[2][2], (V)[11][j] * (G)[2][3]); o.w = pg8::pk4_fp8((V)[12][j] * (G)[3][0], (V)[13][j] * (G)[3][1], (V)[14][j] * (G)[3][2], (V)[15][j] * (G)[3][3]); \
            *(u32x4*)(cdst + (size_t)wdrow(cnb * 256 + n0 + j, cmode) * cK + ckb * 64 + k0) = o; } \
        if ((NEXT_ITEM) < end) { wjob_decode(a, (NEXT_ITEM), (J)); WR_LOAD(J, V, G); } \
    } while (0)
    int item = first + 2 * wg + half;
    if (item < end) { wjob_decode(a, item, ja); WR_LOAD(ja, va, ga); }
    if (item + nworkers < end) { wjob_decode(a, item + nworkers, jb); WR_LOAD(jb, vb, gb); }
    for (; item < end; item += 2 * nworkers) {
        WR_ITEM(ja, va, ga, item + 2 * nworkers);
        if (item + nworkers < end) WR_ITEM(jb, vb, gb, item + 3 * nworkers);
    }
#undef WR_LOAD
#undef WR_ITEM
}
__device__ __forceinline__ void p0_x(const float* x, bf16_t* xb, u64* ss0, Frame& F) {
    for (int row = F.gw; row < MTOK; row += F.NGW) {
        const f32x4* xr = (const f32x4*)(x + (size_t)row * DM) + F.lane; f32x4 v[8]; float s = 0.f;
#pragma unroll
        for (int j = 0; j < 8; ++j) { v[j] = __builtin_nontemporal_load(xr + 64 * j); s += (v[j].x * v[j].x + v[j].y * v[j].y) + (v[j].z * v[j].z + v[j].w * v[j].w); }
        s = wave_sum(s);
        u32x2* o8 = (u32x2*)(xb + (size_t)row * DM) + F.lane;
#pragma unroll
        for (int j = 0; j < 8; ++j) { u32x2 w; w.x = cvt_pk_bf16(v[j].x, v[j].y); w.y = cvt_pk_bf16(v[j].z, v[j].w); o8[64 * j] = w; }
        if (F.lane == 0) ss0[row] = ss_fix(s);
    }
}
__device__ __forceinline__ void p2_kmean(const bf16_t* qkv, float* kmean, Frame& F, int u0, int nu) {
    const int c16 = F.lane & 15, rg = F.lane >> 4;
    for (int u = u0 + F.gw; u < u0 + nu; u += F.NGW) {
        const int bh = u >> 3, jb = u & 7, b = bh / HA, h = bh % HA;
        const bf16_t* kp = qkv + (size_t)(b * SEQ + jb * 256 + rg) * NQKV + DM + h * 128 + 8 * c16;
        float s[8] = {0.f, 0.f, 0.f, 0.f, 0.f, 0.f, 0.f, 0.f};
#pragma unroll 8
        for (int i = 0; i < 64; ++i) { const u32x4 q = *(const u32x4*)(kp + (size_t)(4 * i) * NQKV);
            s[0] += __uint_as_float(q.x << 16); s[1] += __uint_as_float(q.x & 0xffff0000u); s[2] += __uint_as_float(q.y << 16); s[3] += __uint_as_float(q.y & 0xffff0000u);
            s[4] += __uint_as_float(q.z << 16); s[5] += __uint_as_float(q.z & 0xffff0000u); s[6] += __uint_as_float(q.w << 16); s[7] += __uint_as_float(q.w & 0xffff0000u); }
#pragma unroll
        for (int e = 0; e < 8; ++e) s[e] = sum_xor32(sum_xor16(s[e]));
        if (rg == 0) { float* kd = kmean + (size_t)u * 128 + 8 * c16;
            *(f32x4*)kd = (f32x4){s[0], s[1], s[2], s[3]} * (1.0f / 256.0f); *(f32x4*)(kd + 4) = (f32x4){s[4], s[5], s[6], s[7]} * (1.0f / 256.0f); }
    }
}
__device__ __forceinline__ void p3_select(const bf16_t* qkv, const float* kmean, unsigned char* sel, Frame& F, int u0, int nu) {
    LAS float* km = (LAS float*)F.lds;
    for (int u = u0 + F.vc; u < u0 + nu; u += F.G) {
        const int bh = u >> 2, ch = u & 3, b = bh / HA, h = bh % HA;
        __syncthreads();
        km[F.tid] = kmean[(size_t)bh * 1024 + F.tid]; km[F.tid + 512] = kmean[(size_t)bh * 1024 + 512 + F.tid];
        __syncthreads();
        const int s = ch * 512 + F.tid, own = s >> 8;
        const bf16_t* qp = qkv + (size_t)(b * SEQ + s) * NQKV + h * 128;
        float gate[8] = {0.f, 0.f, 0.f, 0.f, 0.f, 0.f, 0.f, 0.f};
        if (own > 0) {
#pragma unroll 4
            for (int c = 0; c < 16; ++c) { const u32x4 q = *(const u32x4*)(qp + 8 * c);
                const float q0 = __uint_as_float(q.x << 16), q1 = __uint_as_float(q.x & 0xffff0000u), q2 = __uint_as_float(q.y << 16), q3 = __uint_as_float(q.y & 0xffff0000u);
                const float q4 = __uint_as_float(q.z << 16), q5 = __uint_as_float(q.z & 0xffff0000u), q6 = __uint_as_float(q.w << 16), q7 = __uint_as_float(q.w & 0xffff0000u);
#pragma unroll
                for (int jb = 0; jb < 8; ++jb) { const f32x4 k0 = *(const LAS f32x4*)(km + jb * 128 + 8 * c), k1 = *(const LAS f32x4*)(km + jb * 128 + 8 * c + 4);
                    gate[jb] += (q0 * k0.x + q1 * k0.y) + (q2 * k0.z + q3 * k0.w) + (q4 * k1.x + q5 * k1.y) + (q6 * k1.z + q7 * k1.w); } }
        }
        unsigned mask = 0u; const int nsel = own < 3 ? own : 3;
#pragma unroll
        for (int it = 0; it < 3; ++it) { if (it < nsel) { int best = -1; float bv = -__builtin_inff();
#pragma unroll
                for (int jb = 0; jb < 8; ++jb) { const bool ok = (jb < own) && (((mask >> jb) & 1u) == 0u) && (best < 0 || gate[jb] > bv); if (ok) { bv = gate[jb]; best = jb; } }
                if (best >= 0) mask |= 1u << best; } }
        sel[(size_t)bh * SEQ + s] = (unsigned char)mask;
    }
    __syncthreads();
}
template <bool MOBA> __device__ __forceinline__ void attn_phase(char* lds, const bf16_t* qkv, bf16_t* out, const unsigned char* sel, const unsigned* bnd, unsigned* qctr, int qb0, int nq, Frame& F) {
    constexpr int NPB = (MOBA ? HA : HB * 4) * 8;
    LAS int* jt = (LAS int*)(F.lds + 70016);
    att::DynCtx C{qkv, out, sel, bnd, qctr, (volatile LAS int*)(F.lds + 70000), qb0 + (int)(xb_xcc_id() & (unsigned)(nq - 1)), qb0, nq, jt};
    __syncthreads();
    for (int i = F.tid; i < nq * 128; i += NTHREADS) { const int b = qb0 + (i >> 7), seg = (i >> 3) & 15, qb = i & 7;
        if (MOBA) jt[i] = att::attn_jlo(bnd, seg, 16 + seg, b, qb, __builtin_amdgcn_exp2f(-0.5f * (float)(seg + 1)));
        else jt[i] = att::attn_jlo(bnd, 32 + seg, seg, b, qb, __builtin_amdgcn_exp2f(-(float)((seg >> 1) + 1))); }
    if (F.tid == 0) *C.nw = att::attn_pull_from(qctr, C.q0, 0, NPB, qb0, nq);
    __syncthreads();
    int code = __builtin_amdgcn_readfirstlane(*C.nw); if (code < 0) return;
    att::BlockRef cur = att::attn_ref_blk<MOBA>(code, C); att::Seam S;
    att::attn_prime(cur, lds, S);
    for (;;) {
        code = att::attn_block<MOBA>(cur, C, lds, S);
        if (code < 0) break;
        cur = att::attn_ref_blk<MOBA>(code, C);
    }
}
__device__ __forceinline__ void p10_combine(KAP a, const bf16_t* omap, bf16_t* ao, Frame& F, int t0, int nt) {
    const int l = F.lane;
    float d1 = a->in[8][l] * a->in[9][l] + a->in[8][l + 64] * a->in[9][l + 64], d2 = a->in[10][l] * a->in[11][l] + a->in[10][l + 64] * a->in[11][l + 64];
    d1 = wave_sum(d1); d2 = wave_sum(d2);
    const float lam = __expf(d1) - __expf(d2) + LAM_INIT;
    const f32x4 g = *(const f32x4*)(a->in[12] + 4 * l);
    for (int tok = t0 + F.gw; tok < t0 + nt; tok += F.NGW) {
        const bf16_t* p1 = omap + (size_t)tok * DM + 4 * l; const bf16_t* p2 = p1 + (size_t)MTOK * DM; bf16_t* po = ao + (size_t)tok * DM + 4 * l;
        u32x2 x1v[HB], x2v[HB];
#pragma unroll
        for (int h = 0; h < HB; ++h) { x1v[h] = *(const u32x2*)(p1 + h * 256); x2v[h] = *(const u32x2*)(p2 + h * 256); }
#pragma unroll
        for (int h = 0; h < HB; ++h) { const u32x2 x1 = x1v[h], x2 = x2v[h];
            f32x4 d; d.x = __uint_as_float(x1.x << 16) - lam * __uint_as_float(x2.x << 16); d.y = __uint_as_float(x1.x & 0xffff0000u) - lam * __uint_as_float(x2.x & 0xffff0000u);
            d.z = __uint_as_float(x1.y << 16) - lam * __uint_as_float(x2.y << 16); d.w = __uint_as_float(x1.y & 0xffff0000u) - lam * __uint_as_float(x2.y & 0xffff0000u);
            float ss = wave_sum((d.x * d.x + d.y * d.y) + (d.z * d.z + d.w * d.w));
            const float r = __builtin_amdgcn_rsqf(ss * (1.0f / 256.0f) + RMS_EPS) * (1.0f - LAM_INIT);
            u32x2 w; w.x = cvt_pk_bf16(d.x * r * g.x, d.y * r * g.y); w.y = cvt_pk_bf16(d.z * r * g.z, d.w * r * g.w); *(u32x2*)(po + h * 256) = w; }
    }
}
__device__ __forceinline__ void p12_router(KAP a, const bf16_t* xb, const u64* ss3, unsigned* gcnt, int* tokinfo, unsigned char* xs, Frame& F, int c0, int nc) {
    LAS float* gwt = (LAS float*)F.lds;
    LAS unsigned* cnt = (LAS unsigned*)(F.lds + 65536); LAS unsigned* base = cnt + 8;
    const float* wr = a->in[18]; const float* g1 = a->in[14] + DM;
    __syncthreads();
    for (int idx = F.tid; idx < DM * NE; idx += NTHREADS) gwt[idx] = wr[idx] * g1[idx >> 3];
    if (F.tid < 8) cnt[F.tid] = 0u;
    __syncthreads();
    const int l = F.lane;
    for (int chunk = c0 + F.vc; chunk < c0 + nc; chunk += F.G) {
        int e0v = 0, e1v = 0, i0v = 0, i1v = 0; float g0v = 0.f, g1v = 0.f;
        float lgs[8][8];
#pragma unroll
        for (int i = 0; i < 8; ++i)
#pragma unroll
            for (int e = 0; e < 8; ++e) lgs[i][e] = 0.f;
        { const bf16_t* xp0 = xb + (size_t)(chunk * 64 + F.wave * 8) * DM + l;
#pragma unroll 4
          for (int j = 0; j < 32; ++j) { const LAS f32x4* wp = (const LAS f32x4*)(gwt + (l + 64 * j) * 8); const f32x4 w0 = wp[0], w1 = wp[1];
#pragma unroll
              for (int i = 0; i < 8; ++i) { const float xv = bf2f(xp0[(size_t)i * DM + 64 * j]);
                  lgs[i][0] += xv * w0.x; lgs[i][1] += xv * w0.y; lgs[i][2] += xv * w0.z; lgs[i][3] += xv * w0.w; lgs[i][4] += xv * w1.x; lgs[i][5] += xv * w1.y; lgs[i][6] += xv * w1.z; lgs[i][7] += xv * w1.w; } } }
#pragma unroll
        for (int i = 0; i < 8; ++i) {
            const int tok = chunk * 64 + F.wave * 8 + i;
            float lg[8];
            const float rs = rstd_q(ss3[tok]);
#pragma unroll
            for (int e = 0; e < 8; ++e) lg[e] = wave_sum(lgs[i][e]) * rs;
            int b0 = 0; float v0 = lg[0];
#pragma unroll
            for (int e = 1; e < 8; ++e) if (lg[e] > v0) { v0 = lg[e]; b0 = e; }
            int b1 = -1; float v1 = -__builtin_inff();
#pragma unroll
            for (int e = 0; e < 8; ++e) if (e != b0 && (b1 < 0 || lg[e] > v1)) { v1 = lg[e]; b1 = e; }
            const float ga = 1.0f / (1.0f + __expf(v1 - v0));
            unsigned i0 = 0u, i1 = 0u;
            if (l == 0) { i0 = __hip_atomic_fetch_add(&cnt[b0], 1u, __ATOMIC_RELAXED, __HIP_MEMORY_SCOPE_WORKGROUP); i1 = __hip_atomic_fetch_add(&cnt[b1], 1u, __ATOMIC_RELAXED, __HIP_MEMORY_SCOPE_WORKGROUP); }
            i0 = __builtin_amdgcn_readfirstlane(i0); i1 = __builtin_amdgcn_readfirstlane(i1);
            if (l == i) { e0v = b0; e1v = b1; i0v = (int)i0; i1v = (int)i1; g0v = ga; g1v = 1.0f - ga; }
        }
        __syncthreads();
        if (F.tid < 8) base[F.tid] = __hip_atomic_fetch_add(gcnt + 64 * F.tid, cnt[F.tid], __ATOMIC_RELAXED, __HIP_MEMORY_SCOPE_AGENT);
        __syncthreads();
        if (l < 8) { const int tok = chunk * 64 + F.wave * 8 + l; int* ti = tokinfo + (size_t)tok * 8;
            ti[0] = e0v; ti[1] = e1v; ti[2] = (int)base[e0v] + i0v; ti[3] = (int)base[e1v] + i1v; ti[4] = __float_as_int(g0v); ti[5] = __float_as_int(g1v); }
#pragma unroll
        for (int h = 0; h < 2; ++h) { u32x2 xv[4][8];
#pragma unroll
            for (int i = 0; i < 4; ++i) { const u32x2* sp = (const u32x2*)(xb + (size_t)(chunk * 64 + F.wave * 8 + 4 * h + i) * DM) + l;
#pragma unroll
                for (int j = 0; j < 8; ++j) xv[i][j] = sp[64 * j]; }
#pragma unroll
            for (int i = 0; i < 4; ++i) { const int ii = 4 * h + i, tok = chunk * 64 + F.wave * 8 + ii;
                const int e0 = __builtin_amdgcn_readlane(e0v, ii), e1 = __builtin_amdgcn_readlane(e1v, ii), q0 = __builtin_amdgcn_readlane(i0v, ii), q1 = __builtin_amdgcn_readlane(i1v, ii);
                const size_t row0 = (size_t)e0 * MTOK + base[e0] + q0, row1 = (size_t)e1 * MTOK + base[e1] + q1;
                const float rs = rstd_q(ss3[tok]) * XS_SC;
                unsigned* d0 = (unsigned*)(xs + row0 * DM) + l; unsigned* d1 = (unsigned*)(xs + row1 * DM) + l;
#pragma unroll
                for (int j = 0; j < 8; ++j) { const u32x2 b = xv[i][j];
                    const unsigned q = pg8::pk4_fp8(__uint_as_float(b.x << 16) * rs, __uint_as_float(b.x & 0xffff0000u) * rs, __uint_as_float(b.y << 16) * rs, __uint_as_float(b.y & 0xffff0000u) * rs); d0[64 * j] = q; d1[64 * j] = q; } } }
        __syncthreads();
        if (F.tid < 8) cnt[F.tid] = 0u;
        __syncthreads();
    }
}
__device__ __forceinline__ void p13_gather(const bf16_t* xb, const u64* ss3, unsigned* gcnt, int* tiles, int* tokinfo, unsigned char* xs, Frame& F) {
    LAS int* pst = (LAS int*)F.lds;
    __syncthreads();
    if (F.tid == 0) { int acc = 0;
        for (int e = 0; e < NE; ++e) { const int c = (int)__hip_atomic_load(gcnt + 64 * e, __ATOMIC_RELAXED, __HIP_MEMORY_SCOPE_AGENT); const int p = (c + 255) & ~255;
            pst[e] = acc; pst[8 + e] = c; pst[16 + e] = p;
            if (blockIdx.x == 0) for (int t = acc >> 8; t < (acc + p) >> 8; ++t) tiles[1 + t] = e;
            acc += p; }
        if (blockIdx.x == 0) tiles[0] = acc >> 8; }
    __syncthreads();
    const int l = F.lane;
    for (int tok = F.gw; tok < MTOK; tok += F.NGW) {
        int* ti = tokinfo + (size_t)tok * 8;
        const int row0 = pst[ti[0]] + ti[2], row1 = pst[ti[1]] + ti[3];
        if (l == 0) { ti[6] = row0; ti[7] = row1; }
        const float rs = rstd_q(ss3[tok]) * XS_SC;
        const u32x2* sp = (const u32x2*)(xb + (size_t)tok * DM) + l; unsigned* d0 = (unsigned*)(xs + (size_t)row0 * DM) + l; unsigned* d1 = (unsigned*)(xs + (size_t)row1 * DM) + l;
#pragma unroll
        for (int j = 0; j < 8; ++j) { const u32x2 b = sp[64 * j];
            const unsigned q = pg8::pk4_fp8(__uint_as_float(b.x << 16) * rs, __uint_as_float(b.x & 0xffff0000u) * rs, __uint_as_float(b.y << 16) * rs, __uint_as_float(b.y & 0xffff0000u) * rs); d0[64 * j] = q; d1[64 * j] = q; }
    }
    for (int e = 0; e < NE; ++e) { const int lo = pst[e] + pst[8 + e], hi = pst[e] + pst[16 + e];
        for (int r = lo + F.gw; r < hi; r += F.NGW) { u32x4* d = (u32x4*)(xs + (size_t)r * DM) + l; d[0] = (u32x4){0u, 0u, 0u, 0u}; d[64] = (u32x4){0u, 0u, 0u, 0u}; } }
    __syncthreads();
}
__device__ __forceinline__ void ys_row(const bf16_t* ys, const float* slab, int split0, size_t ks_stride, int row, int l, f32x4 (&a)[8]) {
    if (row >= split0) { const float* p = slab + (size_t)(row - split0) * DM + 4 * l;
#pragma unroll
        for (int j = 0; j < 8; ++j) { f32x4 t = *(const f32x4*)(p + 256 * j);
#pragma unroll
            for (int ks = 1; ks < TAIL_NS; ++ks) t = t + *(const f32x4*)(p + 256 * j + (size_t)ks * ks_stride);
            a[j] = t * (1.0f / (ACT_SC * WEDN_SC)); } }
    else { const u32x2* p = (const u32x2*)(ys + (size_t)row * DM) + l;
#pragma unroll
        for (int j = 0; j < 8; ++j) { const u32x2 q = p[64 * j]; a[j] = (f32x4){__uint_as_float(q.x << 16), __uint_as_float(q.x & 0xffff0000u), __uint_as_float(q.y << 16), __uint_as_float(q.y & 0xffff0000u)}; } }
}
constexpr int MOE_T_OFF = 131072;
__device__ __forceinline__ void moe_tables(const unsigned* gcnt, LAS int* T, Frame& F) {
    __syncthreads();
    if (F.tid == 0) { int acc = 0;
        for (int e = 0; e < NE; ++e) { const int c = (int)__hip_atomic_load(gcnt + 64 * e, __ATOMIC_RELAXED, __HIP_MEMORY_SCOPE_AGENT); const int p = (c + 255) & ~255;
            T[256 + e] = acc;
            for (int j = 0; j < (p >> 8); ++j) T[1 + (acc >> 8) + j] = e + 16 * (e * (MTOK / 256) + j);
            acc += p; }
        T[0] = acc >> 8; }
    __syncthreads();
}
__device__ __forceinline__ void p16_final(const bf16_t* xb, const bf16_t* ys, const float* slab, const int* tiles, const int* tokinfo, const float* fg, float* out, Frame& F) {
    const int l = F.lane; const int nT = tiles[0]; int rt = nT & 31; if (rt > 7) rt = 0; const int split0 = (nT - rt) * 256; const size_t ks_stride = (size_t)rt * 256 * DM;
    for (int tok = F.gw; tok < MTOK; tok += F.NGW) {
        const int* ti = tokinfo + (size_t)tok * 8; const float g0 = __int_as_float(ti[4]), g1 = __int_as_float(ti[5]); const int row0 = tiles[256 + ti[0]] + ti[2], row1 = tiles[256 + ti[1]] + ti[3];
        const u32x2* xp = (const u32x2*)(xb + (size_t)tok * DM) + l;
        f32x4 v[8], a0[8], a1[8]; float s = 0.f;
#pragma unroll
        for (int j = 0; j < 8; ++j) { const u32x2 q = xp[64 * j]; v[j] = (f32x4){__uint_as_float(q.x << 16), __uint_as_float(q.x & 0xffff0000u), __uint_as_float(q.y << 16), __uint_as_float(q.y & 0xffff0000u)}; }
        ys_row(ys, slab, split0, ks_stride, row0, l, a0); ys_row(ys, slab, split0, ks_stride, row1, l, a1);
#pragma unroll
        for (int j = 0; j < 8; ++j) { v[j] = v[j] + g0 * a0[j] + g1 * a1[j]; s += (v[j].x * v[j].x + v[j].y * v[j].y) + (v[j].z * v[j].z + v[j].w * v[j].w); }
        const float r = rstd_of(wave_sum(s));
        f32x4* op = (f32x4*)(out + (size_t)tok * DM) + l; const f32x4* gp = (const f32x4*)fg + l;
#pragma unroll
        for (int j = 0; j < 8; ++j) op[64 * j] = v[j] * r * gp[64 * j];
    }
}

#ifndef PH_MASK
#define PH_MASK 0x1ffff
#endif
__global__ void __launch_bounds__(NTHREADS, 2) mega_fwd(Args args_by_value) {
    extern __shared__ __attribute__((aligned(16))) unsigned char lds[];
    (void)args_by_value;
    const KAP kap0 = (KAP)__builtin_amdgcn_kernarg_segment_ptr();
#define KARGS() ({ KAP p_ = kap0; asm volatile("" : "+s"(p_)); p_; })
    Frame F0;
#define F F0
    F.lds = (LAS unsigned char*)lds;
    F.tid = threadIdx.x; F.lane = F.tid & 63; F.wave = __builtin_amdgcn_readfirstlane(F.tid >> 6);
    F.G = gridDim.x; { const int bx = blockIdx.x; F.vc = (F.G % 8 == 0) ? (bx % 8) * (F.G / 8) + bx / 8 : bx; }
    F.gw = F.vc * NWAVES + F.wave; F.NGW = F.G * NWAVES;
    volatile LAS unsigned* MISC = (volatile LAS unsigned*)(F.lds + LDSCTL_OFF);
    for (int u = F.tid; u < (LDS_BYTES - LDSCTL_OFF) / 4; u += NTHREADS) ((LAS unsigned*)(F.lds + LDSCTL_OFF))[u] = 0u;
    __syncthreads();
    const int lo = kap0->ph_lo, hi = kap0->ph_hi;
    const bool use_bar = (hi - lo) > 1;
    XcdBarrier bar; bar.bar = (unsigned*)(kap0->ws + CTL_BAR); bar.x = 0; bar.st = MISC + 8;
    if (use_bar) bar = xcd_barrier_post((unsigned*)(kap0->ws + CTL_BAR), MISC + 8, (unsigned)F.G);
#ifndef DUP_MASK
#define DUP_MASK 0
#endif
#ifndef PROBE_SKIP_EPI
#define PROBE_SKIP_EPI 0
#endif
#ifndef PROBE_KIND
#define PROBE_KIND 4
#endif
#ifndef PROBE_PH
#define PROBE_PH 6
#endif
#ifndef PROBE_AMP
#define PROBE_AMP 4
#endif
#ifndef PROBE_PHM
#define PROBE_PHM (1 << PROBE_PH)
#endif
#define PROBE_SEL(k) ((PROBE_KIND == 2 || PROBE_KIND == 3) ? ((PROBE_PHM >> (k)) & 1) : ((k) == PROBE_PH))
#if PROBE_KIND
#define PROBE_ME (blockIdx.x == 0 && F0.tid == 0)
#define PROBE_B(k) do { if (PROBE_SEL(k) && PROBE_ME) { const unsigned long long r_ = __builtin_amdgcn_s_memrealtime(), t_ = __builtin_amdgcn_s_memtime(); MISC[16] = (unsigned)r_; MISC[17] = (unsigned)(r_ >> 32); MISC[18] = (unsigned)t_; MISC[19] = (unsigned)(t_ >> 32); } } while (0)
#define PROBE_E(k) do { if (PROBE_SEL(k) && PROBE_ME) { const unsigned long long r_ = __builtin_amdgcn_s_memrealtime(), t_ = __builtin_amdgcn_s_memtime(); \
        const unsigned long long r0_ = ((unsigned long long)MISC[17] << 32) | MISC[16], t0_ = ((unsigned long long)MISC[19] << 32) | MISC[18]; const unsigned long long dr_ = r_ - r0_, dt_ = t_ - t0_; \
        if (PROBE_KIND == 1) MISC[20] = (unsigned)((dt_ * 10000ull) / (dr_ ? dr_ : 1ull));   \
        if (PROBE_KIND == 2) MISC[20] = MISC[20] + (unsigned)(dr_ * PROBE_AMP); \
        if (PROBE_KIND == 3) { MISC[16] = (unsigned)r_; MISC[17] = (unsigned)(r_ >> 32); } } } while (0)
#define PROBE_S(k) do { if (PROBE_KIND == 3 && PROBE_SEL(k) && PROBE_ME) { const unsigned long long r_ = __builtin_amdgcn_s_memrealtime(); const unsigned long long r0_ = ((unsigned long long)MISC[17] << 32) | MISC[16]; MISC[20] = MISC[20] + (unsigned)((r_ - r0_) * PROBE_AMP); } } while (0)
#define PROBE_FIN() do { if (PROBE_ME) { const unsigned long long r0_ = __builtin_amdgcn_s_memrealtime(); const unsigned long long d_ = MISC[20]; while (__builtin_amdgcn_s_memrealtime() - r0_ < d_) __builtin_amdgcn_s_sleep(8); } } while (0)
#else
#define PROBE_B(k) do { } while (0)
#define PROBE_E(k) do { } while (0)
#define PROBE_S(k) do { } while (0)
#define PROBE_FIN() do { } while (0)
#endif
#define PRB(k) (((PROBE_KIND == 4 || PROBE_KIND == 5) && (k) == PROBE_PH) ? MISC : (volatile LAS unsigned*)nullptr)
#define IN(k) (((PH_MASK >> (k)) & 1) && lo <= (k) && (k) < hi)
#define REP(k) for (int rep_ = 0; rep_ < (((DUP_MASK >> (k)) & 1) ? 2 : 1); ++rep_)
#define SEAM(k) do { if (IN(k) && IN((k) + 1)) { if ((k) >= 1 && (k) <= 10) xcd_barrier(barh); else xcd_barrier(bar); } } while (0)
#define WSP(T, off) ((T*)(ws + (off)))
#define FRL() ({ Frame f_ = F0; asm volatile("" : "+v"(f_.tid), "+v"(f_.lane)); f_; })
#undef F
    const int bx = blockIdx.x;
    const int ngrp = (F0.G % 8 == 0) ? 8 : 1, hb = (ngrp == 8) ? (bx & 7) : 0, nxh = 8 / ngrp, Gh = F0.G / ngrp;
    const int hidx = (ngrp == 8) ? (bx >> 3) : bx;
    const int Mh = MTOK / ngrp, R0 = hb * Mh, nMh = Mh / 256, pm0 = hb * nMh;
    Frame FH0 = F0; FH0.G = Gh; FH0.vc = (Gh % nxh == 0) ? (hidx % nxh) * (Gh / nxh) + hidx / nxh : hidx; FH0.gw = FH0.vc * NWAVES + F0.wave; FH0.NGW = Gh * NWAVES;
#define FRH() ({ Frame f_ = FH0; asm volatile("" : "+v"(f_.tid), "+v"(f_.lane)); f_; })
    const int shn = W_NEXP / ngrp, sh0 = W_NITEMS0 + hb * shn;
    const int per = (shn + Gh - 1) / Gh, nbef = (ngrp == 8) ? (per * hb) / 7 : per;
    XcdBarrier barh = bar;
    if (use_bar) barh = xcd_barrier_post((unsigned*)(kap0->ws + CTL_BARH + (size_t)hb * CTL_BARH_STRIDE), MISC + 10, (unsigned)Gh);

    PROBE_B(0); if (IN(0)) REP(0) { KAP ap = KARGS(); Frame F = FRL(); unsigned char* ws = ap->ws; p0_weights(ap, F, F.vc, W_NITEMS0, F.G); p0_x(ap->in[0], WSP(bf16_t, WS_XB), WSP(u64, CTL_SS), F); }
    PROBE_E(0); SEAM(0); PROBE_S(0);
    if (IN(0)) { KAP ap = KARGS(); Frame F = FRH(); const int e_ = sh0 + nbef * Gh < sh0 + shn ? sh0 + nbef * Gh : sh0 + shn; p0_weights_r(ap, F, sh0, e_, hidx, Gh); }
    PROBE_B(1); if (IN(1)) REP(1) {
        KAP ap = KARGS(); Frame F = FRH(); unsigned char* ws = ap->ws;
        pg8::Order S; S.init(nMh, NQKV / 256, 2 * DM, F.G, hidx, ws + WS_XB + (size_t)R0 * DM * 2, ws + WS_WQKV, 0, nullptr, nxh);
        pg8::EpiBf16Out<true, true> E{WSP(bf16_t, WS_QKV) + (size_t)R0 * NQKV, NQKV, WSP(u64, CTL_SS) + R0, 1.f, WSP(unsigned, CTL_BND1), pm0};
        pg8::gemm_phase<pg8::EpiBf16Out<true, true>, GEMM_ALIGN, GEMM_SP2>(F.lds, 2 * DM, S, E, 0, PRB(1));
    }
    PROBE_E(1); SEAM(1); PROBE_S(1);
    PROBE_B(2); if (IN(2)) REP(2) { KAP ap = KARGS(); Frame F = FRH(); unsigned char* ws = ap->ws; p2_kmean(WSP(bf16_t, WS_QKV), WSP(float, WS_KMEAN), F, hb * nxh * HA * 8, nxh * HA * 8); }
    PROBE_E(2); SEAM(2); PROBE_S(2);
    PROBE_B(3); if (IN(3)) REP(3) { KAP ap = KARGS(); Frame F = FRH(); unsigned char* ws = ap->ws; p3_select(WSP(bf16_t, WS_QKV), WSP(float, WS_KMEAN), WSP(unsigned char, WS_SEL), F, hb * nxh * HA * 4, nxh * HA * 4); }
    PROBE_E(3); SEAM(3); PROBE_S(3);
    PROBE_B(4); if (IN(4)) REP(4) { KAP ap = KARGS(); Frame F = FRH(); unsigned char* ws = ap->ws; attn_phase<true>((char*)lds, WSP(bf16_t, WS_QKV), WSP(bf16_t, WS_AO), WSP(unsigned char, WS_SEL), WSP(unsigned, CTL_BND1), WSP(unsigned, CTL_AQ), hb * nxh, nxh, F); }
    PROBE_E(4); SEAM(4); PROBE_S(4);
    PROBE_B(5); if (IN(5)) REP(5) {
        KAP ap = KARGS(); Frame F = FRH(); unsigned char* ws = ap->ws;
        pg8::Order S; S.init(nMh, DM / 256, 2 * DM, F.G, hidx, ws + WS_AO + (size_t)R0 * DM * 2, ws + WS_WOA, 0, nullptr, nxh);
        pg8::EpiResid<true, false> E{WSP(bf16_t, WS_XB) + (size_t)R0 * DM, nullptr, WSP(bf16_t, WS_XB) + (size_t)R0 * DM, WSP(u64, CTL_SS) + MTOK + R0};
        pg8::gemm_phase<pg8::EpiResid<true, false>, GEMM_ALIGN, GEMM_SP2>(F.lds, 2 * DM, S, E);
    }
    PROBE_E(5); SEAM(5); PROBE_S(5);
    PROBE_B(6); if (IN(6)) REP(6) {
        KAP ap = KARGS(); Frame F = FRH(); unsigned char* ws = ap->ws;
        pg8::Order S; S.init(nMh, 2 * FF / 256, 2 * DM, F.G, hidx, ws + WS_XB + (size_t)R0 * DM * 2, ws + WS_WGU, 0, nullptr, nxh);
        pg8::EpiSwiGLU<false> E{WSP(bf16_t, WS_ACT) + (size_t)R0 * FF, FF, WSP(u64, CTL_SS) + MTOK + R0};
        pg8::gemm_phase<pg8::EpiSwiGLU<false>, GEMM_ALIGN, GEMM_SP2>(F.lds, 2 * DM, S, E, 0, PRB(6));
    }
    PROBE_E(6); SEAM(6); PROBE_S(6);
    PROBE_B(7); if (IN(7)) REP(7) {
        KAP ap = KARGS(); Frame F = FRH(); unsigned char* ws = ap->ws;
        pg8::Order S; S.init(nMh, DM / 256, 2 * FF, F.G, hidx, ws + WS_ACT + (size_t)R0 * FF * 2, ws + WS_WDN, 0, nullptr, nxh);
        pg8::EpiResid<true, false> E{WSP(bf16_t, WS_XB) + (size_t)R0 * DM, nullptr, WSP(bf16_t, WS_XB) + (size_t)R0 * DM, WSP(u64, CTL_SS) + 2 * MTOK + R0};
        pg8::gemm_phase<pg8::EpiResid<true, false>, GEMM_ALIGN, GEMM_SP2>(F.lds, 2 * FF, S, E);
    }
    PROBE_E(7); SEAM(7); PROBE_S(7);
    PROBE_B(8); if (IN(8)) REP(8) {
        KAP ap = KARGS(); Frame F = FRH(); unsigned char* ws = ap->ws;
        pg8::Order S; S.init(nMh, NQKV / 256, 2 * DM, F.G, hidx, ws + WS_XB + (size_t)R0 * DM * 2, ws + WS_WKVQ, 0, nullptr, nxh);
        pg8::EpiBf16Out<true, true> E{WSP(bf16_t, WS_QKV) + (size_t)R0 * NQKV, NQKV, WSP(u64, CTL_SS) + 2 * MTOK + R0, 1.f, WSP(unsigned, CTL_BND2), pm0};
        pg8::gemm_phase<pg8::EpiBf16Out<true, true>, GEMM_ALIGN, GEMM_SP2>(F.lds, 2 * DM, S, E, 0, PRB(1));
    }
    PROBE_E(8); SEAM(8); PROBE_S(8);
    PROBE_B(9); if (IN(9)) REP(9) { KAP ap = KARGS(); Frame F = FRH(); unsigned char* ws = ap->ws; attn_phase<false>((char*)lds, WSP(bf16_t, WS_QKV), WSP(bf16_t, WS_XR), nullptr, WSP(unsigned, CTL_BND2), WSP(unsigned, CTL_AQ) + 8 * 64, hb * nxh, nxh, F); }
    PROBE_E(9); SEAM(9); PROBE_S(9);
    PROBE_B(10); if (IN(10)) REP(10) { KAP ap = KARGS(); Frame F = FRH(); unsigned char* ws = ap->ws; p10_combine(ap, WSP(bf16_t, WS_XR), WSP(bf16_t, WS_AO), F, R0, Mh); }
    PROBE_E(10); SEAM(10); PROBE_S(10);
    PROBE_B(11); if (IN(11)) REP(11) {
        KAP ap = KARGS(); Frame F = FRH(); unsigned char* ws = ap->ws;
        pg8::Order S; S.init(nMh, DM / 256, 2 * DM, F.G, hidx, ws + WS_AO + (size_t)R0 * DM * 2, ws + WS_WOB, 0, nullptr, nxh);
        pg8::EpiResid<true, false> E{WSP(bf16_t, WS_XB) + (size_t)R0 * DM, nullptr, WSP(bf16_t, WS_XB) + (size_t)R0 * DM, WSP(u64, CTL_SS) + 3 * MTOK + R0};
        pg8::gemm_phase<pg8::EpiResid<true, false>, GEMM_ALIGN, GEMM_SP2>(F.lds, 2 * DM, S, E);
    }
    PROBE_E(11); if (IN(11) && IN(12)) xcd_barrier(barh); PROBE_S(11);
    PROBE_B(12); if (IN(12)) REP(12) { KAP ap = KARGS(); Frame F = FRH(); unsigned char* ws = ap->ws; p12_router(ap, WSP(bf16_t, WS_XB), WSP(u64, CTL_SS) + 3 * MTOK, WSP(unsigned, CTL_CNT), WSP(int, CTL_TOKINFO), WSP(unsigned char, WS_XSC), F, hb * (Mh / 64), Mh / 64); }
    if (IN(12)) { KAP ap = KARGS(); Frame F = FRH(); p0_weights_r(ap, F, sh0 + nbef * Gh, sh0 + shn, hidx, Gh); }
    PROBE_E(12); SEAM(12); PROBE_S(12);
    PROBE_B(14); if (IN(14)) REP(14) {
        KAP ap = KARGS(); Frame F = FRL(); unsigned char* ws = ap->ws;
        moe_tables(WSP(unsigned, CTL_CNT), (LAS int*)(F.lds + MOE_T_OFF), F);
        const int* tiles = (const int*)(LAS int*)(F.lds + MOE_T_OFF); const int nT = tiles[0];
        pg8::Order S; S.init(nT, 2 * FE / 256, DM, F.G, bx, ws + WS_XSC, ws + WS_WEGU, (size_t)2 * FE * DM, tiles + 1, pg8::NXCD, 1);
        pg8::EpiSwiGLU8 E{WSP(unsigned char, WS_ACTE), FE, 1.0f / (XS_SC * WEGU_SC), ACT_SC, (PROBE_SKIP_EPI && rep_ == 1) ? 1 : 0};
        pg8::gemm_phase<pg8::EpiSwiGLU8, GEMM_ALIGN, false, true>(F.lds, DM, S, E, 0, PRB(14));
    }
    PROBE_E(14); SEAM(14); PROBE_S(14);
    PROBE_B(15); if (IN(15)) REP(15) {
        KAP ap = KARGS(); Frame F = FRL(); unsigned char* ws = ap->ws;
        if (!IN(14)) moe_tables(WSP(unsigned, CTL_CNT), (LAS int*)(F.lds + MOE_T_OFF), F);
        const int* tiles = (const int*)(LAS int*)(F.lds + MOE_T_OFF); const int nT = tiles[0];
        int rt = nT & 31; if (rt > 7) rt = 0;
        pg8::Order S; S.init(nT - rt, DM / 256, FE, F.G, bx, ws + WS_ACTE, ws + WS_WEDN, (size_t)DM * FE, tiles + 1);
        pg8::EpiBf16Out<false> E{WSP(bf16_t, WS_YS), DM, nullptr, 1.0f / (ACT_SC * WEDN_SC), nullptr, 0};
        pg8::gemm_phase<pg8::EpiBf16Out<false>, GEMM_ALIGN, false, true>(F.lds, FE, S, E);
        if (rt) { pg8::TailOrder S2{rt * 8 * TAIL_NS, F.G, bx, nT - rt, TAIL_NS, (const char*)(ws + WS_ACTE), (const char*)(ws + WS_WEDN), (size_t)256 * FE, (size_t)DM * FE, (size_t)(FE / TAIL_NS), tiles + 1};
            pg8::EpiPart E2{WSP(float, WS_SLAB), (nT - rt) * 256, (size_t)rt * 256 * DM};
            pg8::gemm_phase<pg8::EpiPart, GEMM_ALIGN, false, true, pg8::TailOrder>(F.lds, FE, S2, E2, FE / TAIL_NS / 128); }
    }
    PROBE_E(15); SEAM(15); PROBE_S(15);
    PROBE_B(16); if (IN(16)) REP(16) { KAP ap = KARGS(); Frame F = FRL(); unsigned char* ws = ap->ws; if (!IN(14)) moe_tables(WSP(unsigned, CTL_CNT), (LAS int*)(F.lds + MOE_T_OFF), F);
        p16_final(WSP(bf16_t, WS_XB), WSP(bf16_t, WS_YS), WSP(float, WS_SLAB), (const int*)(LAS int*)(F.lds + MOE_T_OFF), WSP(int, CTL_TOKINFO), ap->in[22], ap->out, F); }
PROBE_E(16); PROBE_FIN();
#undef IN
#undef REP
#undef SEAM
#undef WSP
#undef FRL
#undef FRH
#undef KARGS
}

#ifndef MK_ONE_LAUNCH
#define MK_ONE_LAUNCH 1
#endif
extern "C" void kernel_launch(void* const* d_in, const int* in_sizes, int n_in, void* d_out, int out_size, void* d_ws, size_t ws_size, hipStream_t stream) {
    static int grid = 0;
    if (grid == 0) {
        if (n_in != 23 || out_size != MTOK * DM || ws_size < WS_END) { fprintf(stderr, "kernel_launch: unexpected shapes (n_in %d, out %d, ws %zu)\n", n_in, out_size, ws_size); grid = -1; return; }
        int dev = 0, cus = 0, per_cu = 0;
        if (hipGetDevice(&dev) != hipSuccess || hipDeviceGetAttribute(&cus, hipDeviceAttributeMultiprocessorCount, dev) != hipSuccess) { grid = -1; return; }
        if (hipFuncSetAttribute((const void*)mega_fwd, hipFuncAttributeMaxDynamicSharedMemorySize, LDS_BYTES) != hipSuccess) { fprintf(stderr, "kernel_launch: hipFuncSetAttribute failed\n"); grid = -1; return; }
        if (hipOccupancyMaxActiveBlocksPerMultiprocessor(&per_cu, (const void*)mega_fwd, NTHREADS, LDS_BYTES) != hipSuccess || per_cu < 1) { fprintf(stderr, "kernel_launch: occupancy query reports %d\n", per_cu); (void)hipGetLastError(); per_cu = 1; }
        grid = cus;
    }
    if (grid < 0) return;
    if (hipMemsetAsync((char*)d_ws + WS_CTL, 0, CTL_ZERO_BYTES, stream) != hipSuccess) return;
    Args a{};
    for (int i = 0; i < 23; ++i) a.in[i] = (const float*)d_in[i];
    a.out = (float*)d_out; a.ws = (unsigned char*)d_ws;
#if MK_ONE_LAUNCH
    a.ph_lo = 0; a.ph_hi = NPHASE;
    hipLaunchKernelGGL(mega_fwd, dim3(grid), dim3(NTHREADS), LDS_BYTES, stream, a);
#else
    for (int p = 0; p < NPHASE; ++p) { a.ph_lo = p; a.ph_hi = p + 1; hipLaunchKernelGGL(mega_fwd, dim3(grid), dim3(NTHREADS), LDS_BYTES, stream, a); }
#endif
}
```

```cpp
#include <hip/hip_runtime.h>
#include <cstdio>
#include <cstdint>

#define GAS __attribute__((address_space(1)))
#define LAS __attribute__((address_space(3)))
#ifndef PROBE_KIND
#define PROBE_KIND 0
#endif
typedef unsigned short bf16_t;
typedef short bf16x8 __attribute__((ext_vector_type(8)));
typedef short s16x4 __attribute__((ext_vector_type(4)));
typedef float f32x2 __attribute__((ext_vector_type(2)));
typedef float f32x4 __attribute__((ext_vector_type(4)));
typedef float f32x16 __attribute__((ext_vector_type(16)));
typedef unsigned u32x2 __attribute__((ext_vector_type(2)));
typedef unsigned u32x4 __attribute__((ext_vector_type(4)));

constexpr int NB = 8, SEQ = 2048, DM = 2048, MTOK = NB * SEQ;
constexpr int NQKV = 3 * DM, FF = 5632, FE = 7168, NE = 8;
constexpr int HA = 16, HB = 8;
constexpr float RMS_EPS = 1e-6f;
constexpr float LAM_INIT = 0.35550906759096996f;
constexpr int MAXTILES = 136;
constexpr int MOE_ROWS = 135 * 256;

constexpr size_t MiB = 1u << 20;
constexpr size_t WS_CTL = 0, CTL_ZERO_BYTES = 960 * 1024;
constexpr size_t CTL_BAR = 4096;
constexpr size_t CTL_BARH = 832 * 1024, CTL_BARH_STRIDE = 16384;
constexpr size_t CTL_SS = 64 * 1024;
constexpr size_t CTL_AQ = 580 * 1024;
constexpr size_t CTL_CNT = 576 * 1024;
constexpr size_t CTL_BND1 = 640 * 1024, CTL_BND2 = 704 * 1024;
constexpr size_t CTL_TILES = 768 * 1024;
constexpr size_t CTL_TOKINFO = 1 * MiB;
constexpr size_t WS_WQKV = 2 * MiB, WS_WOA = 26 * MiB, WS_WGU = 34 * MiB, WS_WDN = 78 * MiB, WS_WKVQ = 100 * MiB, WS_WOB = 124 * MiB;
constexpr size_t WS_XB = 132 * MiB, WS_XR = 196 * MiB, WS_WEGU = 324 * MiB, WS_WEDN = 548 * MiB, WS_BIG = 660 * MiB;
constexpr size_t WS_QKV = WS_BIG, WS_AO = WS_BIG + 192 * MiB, WS_ACT = WS_BIG + 256 * MiB, WS_KMEAN = WS_BIG + 432 * MiB, WS_SEL = WS_BIG + 433 * MiB;
constexpr size_t WS_ACTE = WS_BIG, WS_XS = WS_BIG + 237 * MiB, WS_YS = WS_BIG + 305 * MiB, WS_SLAB = WS_BIG + 440 * MiB, WS_XSC = WS_BIG + 500 * MiB, WS_END = WS_XSC + 256 * MiB;
static_assert(WS_END <= 1792 * MiB, "workspace map");
static_assert((size_t)MOE_ROWS * FE <= 237 * MiB && (size_t)MOE_ROWS * DM <= 68 * MiB && (size_t)MOE_ROWS * DM * 2 <= 135 * MiB && WS_SEL + MiB <= WS_END, "moe buffers");
constexpr float XS_SC = 16.f, WEGU_SC = 256.f, ACT_SC = 8.f, WEDN_SC = 512.f;
constexpr int TAIL_NS = 4, TAIL_MAXROWS = 31 * 256;
static_assert((size_t)TAIL_NS * 7 * 256 * DM * 4 <= 60 * MiB, "slab (nT in [128, 135] -> at most 7 tail row tiles)");

constexpr int RING_BYTES = 131072, LDS_BYTES = 147456, LDSCTL_OFF = LDS_BYTES - 512;

#define LDS_WAIT() asm volatile("s_waitcnt lgkmcnt(0)" ::: "memory")
#define VM_WAIT() asm volatile("s_waitcnt vmcnt(0)" ::: "memory")
__device__ __forceinline__ unsigned cvt_pk_bf16(float lo, float hi) { unsigned r; asm volatile("v_cvt_pk_bf16_f32 %0, %1, %2" : "=v"(r) : "v"(lo), "v"(hi)); return r; }
__device__ __forceinline__ float bf2f(unsigned short b) { return __uint_as_float(((unsigned)b) << 16); }
template <int CTRL> __device__ __forceinline__ float dppx(float v) { return __builtin_bit_cast(float, __builtin_amdgcn_update_dpp(0, __builtin_bit_cast(int, v), CTRL, 0xf, 0xf, true)); }
__device__ __forceinline__ float xor1_get(float v) { return dppx<0xB1>(v); }
__device__ __forceinline__ float sum_xor16(float v) { auto r = __builtin_amdgcn_permlane16_swap(__float_as_uint(v), __float_as_uint(v), false, false); return __uint_as_float(r[0]) + __uint_as_float(r[1]); }
__device__ __forceinline__ float sum_xor32(float v) { auto r = __builtin_amdgcn_permlane32_swap(__float_as_uint(v), __float_as_uint(v), false, false); return __uint_as_float(r[0]) + __uint_as_float(r[1]); }
__device__ __forceinline__ float row_sum16(float v) { v += dppx<0xB1>(v); v += dppx<0x4E>(v); v += dppx<0x141>(v); v += dppx<0x140>(v); return v; }
__device__ __forceinline__ float row_max16(float v) { v = __builtin_fmaxf(v, dppx<0xB1>(v)); v = __builtin_fmaxf(v, dppx<0x4E>(v)); v = __builtin_fmaxf(v, dppx<0x141>(v)); v = __builtin_fmaxf(v, dppx<0x140>(v)); return v; }
__device__ __forceinline__ float wave_sum(float v) { return sum_xor32(sum_xor16(row_sum16(v))); }
typedef unsigned long long u64;
__device__ __forceinline__ float rstd_of(float ss) { return __builtin_amdgcn_rsqf(ss * (1.0f / (float)DM) + RMS_EPS); }
__device__ __forceinline__ u64 ss_fix(float s) { return (u64)(s * 16777216.0f); }
__device__ __forceinline__ float rstd_q(u64 q) { return rstd_of((float)q * (1.0f / 16777216.0f)); }

#define XB_TMO      128
#define XB_XCNT(j)  (256  + 64 * (j))
#define XB_XSUB(j)  (1280 + 64 * (j))
#define XB_XGEN(j)  (2304 + 64 * (j))
#define XB_TOP      3328
#define XB_TOPGEN   3392
#define XCD_BAR_WORDS 3456
#define XB_SPIN_CAP (1u << 18)
__device__ __forceinline__ unsigned xb_ld(unsigned* p)              { return __hip_atomic_load(p, __ATOMIC_RELAXED, __HIP_MEMORY_SCOPE_AGENT); }
__device__ __forceinline__ unsigned xb_add(unsigned* p, unsigned v) { return __hip_atomic_fetch_add(p, v, __ATOMIC_RELAXED, __HIP_MEMORY_SCOPE_AGENT); }
__device__ __forceinline__ unsigned xb_xcc_id() { return (unsigned)__builtin_amdgcn_s_getreg((3 << 11) | 20) & 0xFu; }
#define XB_SPIN(cond, bar) do { unsigned _sp = 0; while (cond) { __builtin_amdgcn_s_sleep(1); \
    if ((++_sp & 255u) == 0u) { if (xb_ld(&(bar)[XB_TMO])) break; if (_sp > XB_SPIN_CAP) { atomicAdd(&(bar)[XB_TMO], 1u); break; } } } } while (0)
struct XcdBarrier { unsigned* bar; unsigned x; volatile LAS unsigned* st; unsigned members; };
__device__ __forceinline__ XcdBarrier xcd_barrier_post(unsigned* bar, volatile LAS unsigned* st, unsigned members) {
    XcdBarrier b; b.bar = bar; b.x = xb_xcc_id(); b.st = st; b.members = members;
    if (threadIdx.x == 0) (void)xb_add(&bar[XB_XCNT(b.x)], 1u);
    return b;
}
__device__ __forceinline__ void xcd_barrier_complete(unsigned* bar, unsigned x, unsigned& nloc, unsigned& nx, const unsigned G) {
    unsigned sum, cnt, mine, sp = 0u;
    for (;;) {
        sum = 0u; cnt = 0u; mine = 0u;
#pragma unroll
        for (unsigned j = 0; j < 16; ++j) { const unsigned c = xb_ld(&bar[XB_XCNT(j)]); sum += c; cnt += (c > 0u) ? 1u : 0u; mine = (j == x) ? c : mine; }
        if (sum == G) break;
        __builtin_amdgcn_s_sleep(1);
        if ((++sp & 255u) == 0u) { if (xb_ld(&bar[XB_TMO])) break; if (sp > XB_SPIN_CAP) { atomicAdd(&bar[XB_TMO], 1u); break; } }
    }
    nloc = mine > 0u ? mine : 1u; nx = cnt > 0u ? cnt : 1u;
}
__device__ __forceinline__ void xcd_barrier(const XcdBarrier& b) {
    asm volatile("s_waitcnt vmcnt(0)" ::: "memory");
    __syncthreads();
    if (threadIdx.x == 0) {
        unsigned* bar = b.bar;
        __builtin_amdgcn_s_waitcnt(0);
        unsigned nloc = b.st[0], nx = b.st[1];
        if (nloc == 0u) { xcd_barrier_complete(bar, b.x, nloc, nx, b.members); b.st[0] = nloc; b.st[1] = nx; }
        const unsigned old = xb_add(&bar[XB_XSUB(b.x)], 1u);
        const unsigned gen = old / nloc;
        if (old + 1u == (gen + 1u) * nloc) {
            __builtin_amdgcn_fence(__ATOMIC_RELEASE, "agent");
            asm volatile("s_waitcnt vmcnt(0)" ::: "memory");
            const unsigned og = xb_add(&bar[XB_TOP], 1u);
            const unsigned tg = og / nx;
            if (og + 1u == (tg + 1u) * nx) xb_add(&bar[XB_TOPGEN], 1u);
            else XB_SPIN(xb_ld(&bar[XB_TOPGEN]) == tg, bar);
            __builtin_amdgcn_fence(__ATOMIC_ACQUIRE, "agent");
            xb_add(&bar[XB_XGEN(b.x)], 1u);
            asm volatile("s_waitcnt vmcnt(0)" ::: "memory");
        } else {
            XB_SPIN(xb_ld(&bar[XB_XGEN(b.x)]) == gen, bar);
            __builtin_amdgcn_fence(__ATOMIC_ACQUIRE, "agent");
            asm volatile("s_waitcnt vmcnt(0)" ::: "memory");
        }
    }
    __syncthreads();
}

namespace pg8 {
constexpr int BM = 256, BK = 64, HALF = 128, HTB = HALF * BK * 2, STAGE_BYTES = 8 * HTB, NXCD = 8, WGM = 8;
__host__ __device__ __forceinline__ int lds_byte(int r, int c) { const int st = (r >> 4) * 2 + (c >> 5), rr = r & 15, cc = c & 31, ob = rr * 64 + cc * 2; return st * 1024 + (ob ^ (((ob >> 9) & 1) << 5)); }
__host__ __device__ __forceinline__ void stage_rc(int b, int& R, int& C) { const int st = b / 1024, sb = b % 1024, swz = sb ^ (((sb >> 9) & 1) << 5); R = (st >> 1) * 16 + swz / 64; C = (st & 1) * 32 + (swz % 64) / 2; }
__host__ __device__ __forceinline__ int perm32(int rho) { const int n = rho >> 4, i = rho & 15; return 8 * (i >> 2) + 4 * n + (i & 3); }

struct Unit { int pm, pn, e, ks, ar; };

struct Order {
    int nM, nN, nwg, G, c, nx, use_ar; const char* A; const char* B; size_t tstep, estride; const int* tile_e;
    __device__ __forceinline__ void init(int nM_, int nN_, int KB, int G_, int c_, const void* A_, const void* B_, size_t estride_, const int* tile_e_, int nx_ = NXCD, int use_ar_ = 0) {
        use_ar = use_ar_; nM = nM_; nN = nN_; nwg = nM * nN; G = G_; c = c_; nx = nx_; A = (const char*)A_; B = (const char*)B_; tstep = (size_t)BM * KB; estride = estride_; tile_e = tile_e_; }
    __device__ __forceinline__ bool next(int i, Unit& u) const {
        const long L = (long)i * G + c; if (L >= nwg) return false;
        int wgid = (int)L; { const int q = nwg / nx, r = nwg % nx, xcd = wgid % nx, off = wgid / nx; wgid = (xcd < r ? xcd * (q + 1) : r * (q + 1) + (xcd - r) * q) + off; }
        const int nig = WGM * nN, gid = wgid / nig, fm = gid * WGM, gsz = (nM - fm) < WGM ? (nM - fm) : WGM;
        u.pm = fm + ((wgid % nig) % gsz); u.pn = (wgid % nig) / gsz; const int v = tile_e ? tile_e[u.pm] : 0; u.e = v & 15; u.ar = use_ar ? (v >> 4) : u.pm; u.ks = 0; return true;
    }
    __device__ __forceinline__ const char* a_base(const Unit& u) const { return A + (size_t)u.ar * tstep; }
    __device__ __forceinline__ const char* b_base(const Unit& u) const { return B + (size_t)u.e * estride + (size_t)u.pn * tstep; }
};

struct TailOrder {
    int nsub, G, c, pm0, NS; const char* A; const char* B; size_t tstep, estride, kslice; const int* tile_e;
    __device__ __forceinline__ bool next(int i, Unit& u) const { const int L = i * G + c; if (L >= nsub) return false; const int per = 8 * NS; u.pm = pm0 + L / per; const int rem = L % per; u.pn = rem / NS; u.ks = rem % NS; u.e = tile_e[u.pm] & 15; u.ar = u.pm; return true; }
    __device__ __forceinline__ const char* a_base(const Unit& u) const { return A + (size_t)u.pm * tstep + (size_t)u.ks * kslice; }
    __device__ __forceinline__ const char* b_base(const Unit& u) const { return B + (size_t)u.e * estride + (size_t)u.pn * tstep + (size_t)u.ks * kslice; }
};

template <bool SCALE, bool BOUND = false> struct EpiBf16Out {
    static constexpr bool PERM = true;
    bf16_t* O; int ldc; const u64* ss; float csc; unsigned* bnd; int pm0;
    __device__ __forceinline__ void operator()(const f32x4 (&acc)[2][2][4][2], const Unit& u, int wr, int wc, int fr, int fq) const {
        const int row0 = u.pm * BM + wr * 64 + fr, col0 = u.pn * BM + wc * 32 + 8 * fq; float mx[2] = {0.f, 0.f};
        u64 ssv[2][4];
#pragma unroll
        for (int ai = 0; ai < 2; ++ai)
#pragma unroll
            for (int m = 0; m < 4; ++m) ssv[ai][m] = SCALE ? ss[row0 + ai * HALF + m * 16] : 0ull;
#pragma unroll
        for (int ai = 0; ai < 2; ++ai)
#pragma unroll
            for (int m = 0; m < 4; ++m) { const int row = row0 + ai * HALF + m * 16; float rs = csc; if (SCALE) rs = rstd_q(ssv[ai][m]);
                bf16_t* rowp = O + (size_t)row * ldc + col0;
#pragma unroll
                for (int bj = 0; bj < 2; ++bj) { const f32x4 v0 = acc[ai][bj][m][0] * rs, v1 = acc[ai][bj][m][1] * rs;
                    u32x4 w; w.x = cvt_pk_bf16(v0[0], v0[1]); w.y = cvt_pk_bf16(v0[2], v0[3]); w.z = cvt_pk_bf16(v1[0], v1[1]); w.w = cvt_pk_bf16(v1[2], v1[3]);
                    *(u32x4*)(rowp + bj * HALF) = w;
                    if (BOUND) { float sq = ((v0[0] * v0[0] + v0[1] * v0[1]) + (v0[2] * v0[2] + v0[3] * v0[3])) + ((v1[0] * v1[0] + v1[1] * v1[1]) + (v1[2] * v1[2] + v1[3] * v1[3]));
                        sq = sum_xor32(sum_xor16(sq)); mx[bj] = __builtin_fmaxf(mx[bj], sq); } } }
        if (BOUND) {
#pragma unroll
            for (int bj = 0; bj < 2; ++bj) { const float v = row_max16(mx[bj]);
                if (fr == 0 && fq == 0) __hip_atomic_fetch_max(bnd + ((size_t)(2 * u.pn + bj) * 64 + u.pm + pm0) * 4 + wc, __float_as_uint(v), __ATOMIC_RELAXED, __HIP_MEMORY_SCOPE_AGENT); } }
    }
};
__device__ __forceinline__ float clamp448(float x) { return __builtin_fminf(__builtin_fmaxf(x, -448.0f), 448.0f); }
__device__ __forceinline__ unsigned pk4_fp8(float a, float b, float c, float d) { int v = __builtin_amdgcn_cvt_pk_fp8_f32(clamp448(a), clamp448(b), 0, false); v = __builtin_amdgcn_cvt_pk_fp8_f32(clamp448(c), clamp448(d), v, true); return (unsigned)v; }
__device__ __forceinline__ float silu_mul(float g, float u) { return g * __builtin_amdgcn_rcpf(1.0f + __builtin_amdgcn_exp2f(-1.4426950408889634f * g)) * u; }
__device__ __forceinline__ float silu_mul_c(float g, float u, float c1, float c2) { return (g * u) * (c2 * __builtin_amdgcn_rcpf(1.0f + __builtin_amdgcn_exp2f(g * c1))); }
typedef float f32x2 __attribute__((ext_vector_type(2)));
__device__ __forceinline__ f32x2 silu_mul2(f32x2 g, f32x2 u, float c1, float k) {
    const f32x2 t = g * c1; f32x2 e; e.x = __builtin_amdgcn_exp2f(t.x); e.y = __builtin_amdgcn_exp2f(t.y);
    const f32x2 d = e * k + k; f32x2 r; r.x = __builtin_amdgcn_rcpf(d.x); r.y = __builtin_amdgcn_rcpf(d.y);
    return (g * u) * r;
}
__device__ __forceinline__ f32x4 silu_mul4(f32x4 g, f32x4 u, float c1, float k) { const f32x2 a = silu_mul2(g.xy, u.xy, c1, k), b = silu_mul2(g.zw, u.zw, c1, k); return (f32x4){a.x, a.y, b.x, b.y}; }
template <bool RAW> struct EpiSwiGLU {
    static constexpr bool PERM = true;
    bf16_t* O; int ldc; const void* rsrc;
    __device__ __forceinline__ void operator()(const f32x4 (&acc)[2][2][4][2], const Unit& u, int wr, int wc, int fr, int fq) const {
        const int row0 = u.pm * BM + wr * 64 + fr, col0 = u.pn * HALF + wc * 32 + 8 * fq;
        float rsv[2][4];
#pragma unroll
        for (int ai = 0; ai < 2; ++ai)
#pragma unroll
            for (int m = 0; m < 4; ++m) { const int row = row0 + ai * HALF + m * 16; if (RAW) rsv[ai][m] = ((const float*)rsrc)[row]; else rsv[ai][m] = rstd_q(((const u64*)rsrc)[row]); }
#pragma unroll
        for (int ai = 0; ai < 2; ++ai)
#pragma unroll
            for (int m = 0; m < 4; ++m) { const int row = row0 + ai * HALF + m * 16; const float rs = rsv[ai][m];
                const float c1 = -1.4426950408889634f * rs, kk = __builtin_amdgcn_rcpf(rs * rs);
                const f32x4 a0 = silu_mul4(acc[ai][0][m][0], acc[ai][1][m][0], c1, kk), a1 = silu_mul4(acc[ai][0][m][1], acc[ai][1][m][1], c1, kk);
                u32x4 w; w.x = cvt_pk_bf16(a0[0], a0[1]); w.y = cvt_pk_bf16(a0[2], a0[3]); w.z = cvt_pk_bf16(a1[0], a1[1]); w.w = cvt_pk_bf16(a1[2], a1[3]);
                *(u32x4*)(O + (size_t)row * ldc + col0) = w; }
    }
};
struct EpiSwiGLU8 {
    static constexpr bool PERM = true;
    unsigned char* O; int ldc; float isc, osc; int skip;
    __device__ __forceinline__ void operator()(const f32x4 (&acc)[2][2][4][2], const Unit& u, int wr, int wc, int fr, int fq) const {
        if (skip) return;
        const int row0 = u.pm * BM + wr * 64 + fr, col0 = u.pn * HALF + wc * 32 + 8 * fq; const float c1 = -1.4426950408889634f * isc, kk = 1.0f / (isc * isc * osc);
#pragma unroll
        for (int ai = 0; ai < 2; ++ai)
#pragma unroll
            for (int m = 0; m < 4; ++m) { const int row = row0 + ai * HALF + m * 16;
                const f32x4 a0 = silu_mul4(acc[ai][0][m][0], acc[ai][1][m][0], c1, kk), a1 = silu_mul4(acc[ai][0][m][1], acc[ai][1][m][1], c1, kk);
                u32x2 w; w.x = pk4_fp8(a0[0], a0[1], a0[2], a0[3]); w.y = pk4_fp8(a1[0], a1[1], a1[2], a1[3]);
                *(u32x2*)(O + (size_t)row * ldc + col0) = w; }
    }
};
struct EpiPart {
    static constexpr bool PERM = false;
    float* slab; int row_base; size_t ks_stride;
    __device__ __forceinline__ void operator()(const f32x4 (&acc)[2][2][4][2], const Unit& u, int wr, int wc, int fr, int fq) const {
        const int row0 = u.pm * BM + wr * 64 + fr - row_base, col0 = u.pn * BM + wc * 32 + 4 * fq; float* sp = slab + (size_t)u.ks * ks_stride;
#pragma unroll
        for (int ai = 0; ai < 2; ++ai)
#pragma unroll
            for (int m = 0; m < 4; ++m) { float* rowp = sp + (size_t)(row0 + ai * HALF + m * 16) * DM + col0;
#pragma unroll
                for (int bj = 0; bj < 2; ++bj)
#pragma unroll
                    for (int n = 0; n < 2; ++n) *(f32x4*)(rowp + bj * HALF + n * 16) = acc[ai][bj][m][n]; }
    }
};
template <bool BASE_BF16, bool WRITE_F32> struct EpiResid {
    static constexpr bool PERM = true;
    const void* base; float* xr; bf16_t* xb; u64* ssout;
    __device__ __forceinline__ void operator()(const f32x4 (&acc)[2][2][4][2], const Unit& u, int wr, int wc, int fr, int fq) const {
        const int row0 = u.pm * BM + wr * 64 + fr, col0 = u.pn * BM + wc * 32 + 8 * fq;
#pragma unroll
        for (int ai = 0; ai < 2; ++ai) { u32x4 qv[4][2];
            if (BASE_BF16) {
#pragma unroll
                for (int m = 0; m < 4; ++m)
#pragma unroll
                    for (int bj = 0; bj < 2; ++bj) qv[m][bj] = *(const u32x4*)((const bf16_t*)base + (size_t)(row0 + ai * HALF + m * 16) * DM + col0 + bj * HALF); }
#pragma unroll
            for (int m = 0; m < 4; ++m) { const int row = row0 + ai * HALF + m * 16; const size_t off = (size_t)row * DM + col0; float s = 0.f;
#pragma unroll
                for (int bj = 0; bj < 2; ++bj) { const int c = bj * HALF; f32x4 b0, b1;
                    if (BASE_BF16) { const u32x4 q = qv[m][bj];
                        b0 = (f32x4){__uint_as_float(q.x << 16), __uint_as_float(q.x & 0xffff0000u), __uint_as_float(q.y << 16), __uint_as_float(q.y & 0xffff0000u)};
                        b1 = (f32x4){__uint_as_float(q.z << 16), __uint_as_float(q.z & 0xffff0000u), __uint_as_float(q.w << 16), __uint_as_float(q.w & 0xffff0000u)}; }
                    else { b0 = *(const f32x4*)((const float*)base + off + c); b1 = *(const f32x4*)((const float*)base + off + c + 4); }
                    const f32x4 o0 = b0 + acc[ai][bj][m][0], o1 = b1 + acc[ai][bj][m][1];
                    if (WRITE_F32) { *(f32x4*)(xr + off + c) = o0; *(f32x4*)(xr + off + c + 4) = o1; }
                    u32x4 w; w.x = cvt_pk_bf16(o0[0], o0[1]); w.y = cvt_pk_bf16(o0[2], o0[3]); w.z = cvt_pk_bf16(o1[0], o1[1]); w.w = cvt_pk_bf16(o1[2], o1[3]); *(u32x4*)(xb + off + c) = w;
                    s += (o0[0] * o0[0] + o0[1] * o0[1]) + (o0[2] * o0[2] + o0[3] * o0[3]); s += (o1[0] * o1[0] + o1[1] * o1[1]) + (o1[2] * o1[2] + o1[3] * o1[3]); }
                s = sum_xor32(sum_xor16(s));
                if (fq == 0) __hip_atomic_fetch_add(ssout + row, ss_fix(s), __ATOMIC_RELAXED, __HIP_MEMORY_SCOPE_AGENT); } }
    }
};

typedef int i32x8 __attribute__((ext_vector_type(8)));
__device__ __forceinline__ i32x8 cat16(bf16x8 lo, bf16x8 hi) { typedef int i32x4 __attribute__((ext_vector_type(4))); const i32x4 a = __builtin_bit_cast(i32x4, lo), b = __builtin_bit_cast(i32x4, hi); return (i32x8){a[0], a[1], a[2], a[3], b[0], b[1], b[2], b[3]}; }
__device__ __forceinline__ void mfma_fp8(f32x4& acc, i32x8 a, i32x8 b) { asm volatile("v_mfma_f32_16x16x128_f8f6f4 %0, %1, %2, %0" : "+v"(acc) : "v"(a), "v"(b)); }
template <class Epi, bool ALIGN_EPI, bool SP2, bool FP8 = false, class Sched = Order>
__device__ __forceinline__ void gemm_phase(LAS unsigned char* lds, const int KB, const Sched& S, const Epi& E, const int nt_override = 0, volatile LAS unsigned* prb = nullptr) {
    unsigned long long pk_ = 0, pg_ = 0, pl_ = 0; unsigned pnk_ = 0, png_ = 0;
#define PG8_STAMP(x) do { if (prb) { asm volatile("s_memtime %0\n\ts_waitcnt lgkmcnt(0)" : "=s"(x) :: "memory"); } } while (0)
    int tid_ = threadIdx.x; asm volatile("" : "+v"(tid_));
    const int tid = tid_, wid = __builtin_amdgcn_readfirstlane(tid >> 6), lane = tid & 63, wr = wid >> 2, wc = wid & 3, fr = lane & 15, fq = lane >> 4;
    const int nt = nt_override ? nt_override : KB / 128;
    unsigned voffA[2], voffB[2];
#pragma unroll
    for (int i = 0; i < 2; ++i) { int R, C; stage_rc(tid * 16 + i * 8192, R, C); const int Rb = Epi::PERM ? ((R & ~31) + perm32(R & 31)) : R;
        voffA[i] = (unsigned)(R * KB + C * 2); voffB[i] = (unsigned)(Rb * KB + C * 2); }
    const size_t kstep = (size_t)(BK * 2);
    const size_t hstep = (size_t)HALF * KB;
    const unsigned ldsw = (unsigned)wid * 1024u;
    const int aoff = lds_byte(wr * 64 + fr, fq * 8), boff = lds_byte(wc * 32 + fr, fq * 8);
#define PG8_SA(b, h) (((b) * 2 + (h)) * HTB)
#define PG8_SB(b, h) ((4 + (b) * 2 + (h)) * HTB)
#define PG8_STAGE(bufoff, gbase, voff) do { _Pragma("unroll") for (int _i = 0; _i < 2; ++_i) \
        __builtin_amdgcn_global_load_lds((const unsigned*)((const char*)(gbase) + (voff)[_i]), (LAS unsigned*)(lds + (bufoff) + ldsw + _i * 8192), 16, 0, 0); } while (0)
#define PG8_LDA(dst, b, h) do { _Pragma("unroll") for (int m = 0; m < 4; ++m) _Pragma("unroll") for (int k = 0; k < 2; ++k) dst[m][k] = *(const LAS bf16x8*)(lds + PG8_SA(b, h) + aoff + m * 2048 + k * 1024); } while (0)
#define PG8_LDB(dst, b, h) do { _Pragma("unroll") for (int n = 0; n < 2; ++n) _Pragma("unroll") for (int k = 0; k < 2; ++k) dst[n][k] = *(const LAS bf16x8*)(lds + PG8_SB(b, h) + boff + n * 2048 + k * 1024); } while (0)
#define PG8_MMA(ai, bj, At, Bt) do { __builtin_amdgcn_s_setprio(1); _Pragma("unroll") for (int m = 0; m < 4; ++m) _Pragma("unroll") for (int n = 0; n < 2; ++n) { \
        if constexpr (FP8) mfma_fp8(acc[ai][bj][m][n], cat16(Bt[n][0], Bt[n][1]), cat16(At[m][0], At[m][1])); \
        else { _Pragma("unroll") for (int k = 0; k < 2; ++k) acc[ai][bj][m][n] = __builtin_amdgcn_mfma_f32_16x16x32_bf16(Bt[n][k], At[m][k], acc[ai][bj][m][n], 0, 0, 0); } } \
        __builtin_amdgcn_s_setprio(0); } while (0)
#define PG8_WAIT_V(n) asm volatile("s_waitcnt vmcnt(" #n ")" ::: "memory")
#define PG8_WAIT_L(n) asm volatile("s_waitcnt lgkmcnt(" #n ")" ::: "memory")
#define PG8_BAR __builtin_amdgcn_s_barrier()
#define PG8_SCHED __builtin_amdgcn_sched_barrier(0)
    Unit cur, nxt; int ui = 0;
    if (!S.next(0, cur)) return;
    f32x4 acc[2][2][4][2];
#pragma unroll
    for (int a = 0; a < 2; ++a)
#pragma unroll
        for (int b = 0; b < 2; ++b)
#pragma unroll
            for (int m = 0; m < 4; ++m)
#pragma unroll
                for (int n = 0; n < 2; ++n) acc[a][b][m][n] = (f32x4){0.f, 0.f, 0.f, 0.f};
    bf16x8 At[4][2], B0[2][2], B1[2][2];
    const char* cA = S.a_base(cur); const char* cB = S.b_base(cur);
    if constexpr (SP2) {
        PG8_STAGE(PG8_SB(0, 0), cB, voffB); PG8_STAGE(PG8_SB(0, 1), cB + hstep, voffB); PG8_STAGE(PG8_SA(0, 0), cA, voffA); PG8_STAGE(PG8_SA(0, 1), cA + hstep, voffA);
        if (wr == 1) PG8_BAR;
        PG8_WAIT_V(2); PG8_BAR;
        PG8_STAGE(PG8_SB(1, 0), cB + kstep, voffB); PG8_STAGE(PG8_SA(1, 0), cA + kstep, voffA); PG8_STAGE(PG8_SB(1, 1), cB + hstep + kstep, voffB);
        PG8_WAIT_V(6); PG8_BAR;
    } else {
        PG8_STAGE(PG8_SB(0, 0), cB, voffB); PG8_STAGE(PG8_SA(0, 0), cA, voffA); PG8_STAGE(PG8_SB(0, 1), cB + hstep, voffB); PG8_STAGE(PG8_SA(0, 1), cA + hstep, voffA);
        if (wr == 1) PG8_BAR;
        PG8_WAIT_V(4); PG8_BAR;
        PG8_STAGE(PG8_SB(1, 0), cB + kstep, voffB); PG8_STAGE(PG8_SA(1, 0), cA + kstep, voffA); PG8_STAGE(PG8_SB(1, 1), cB + hstep + kstep, voffB);
        PG8_WAIT_V(6); PG8_BAR;
    }
    for (;;) {
        const bool has_next = S.next(ui + 1, nxt);
        const char* nA = has_next ? S.a_base(nxt) : cA; const char* nB = has_next ? S.b_base(nxt) : cB;
        { unsigned long long ts_; PG8_STAMP(ts_); if (prb && pl_) { pg_ += ts_ - pl_; ++png_; } pl_ = ts_; }
        for (int t = 0; t < nt; t += 2) {
            const bool last = (t == nt - 2);
            const char* a1 = cA + (size_t)(t + 1) * kstep;
            const char* a2 = last ? nA : cA + (size_t)(t + 2) * kstep; const char* b2 = last ? nB : cB + (size_t)(t + 2) * kstep;
            const char* a3 = a2 + kstep; const char* b3 = b2 + kstep;
            if constexpr (SP2) {
            PG8_LDB(B0, 0, 0); PG8_LDB(B1, 0, 1); PG8_SCHED; PG8_LDA(At, 0, 0); PG8_STAGE(PG8_SA(1, 1), a1 + hstep, voffA);
            PG8_WAIT_V(8); PG8_WAIT_L(0); PG8_BAR; PG8_MMA(0, 0, At, B0); PG8_MMA(0, 1, At, B1); PG8_BAR; PG8_SCHED;
            PG8_LDA(At, 0, 1); PG8_STAGE(PG8_SB(0, 0), b2, voffB); PG8_STAGE(PG8_SB(0, 1), b2 + hstep, voffB); PG8_STAGE(PG8_SA(0, 0), a2, voffA);
            PG8_WAIT_V(8); PG8_WAIT_L(0); PG8_BAR; PG8_MMA(1, 0, At, B0); PG8_MMA(1, 1, At, B1); PG8_BAR; PG8_SCHED;
            PG8_LDB(B0, 1, 0); PG8_LDB(B1, 1, 1); PG8_SCHED; PG8_LDA(At, 1, 0); PG8_STAGE(PG8_SA(0, 1), a2 + hstep, voffA);
            PG8_WAIT_V(8); PG8_WAIT_L(0); PG8_BAR; PG8_MMA(0, 0, At, B0); PG8_MMA(0, 1, At, B1); PG8_BAR; PG8_SCHED;
            PG8_LDA(At, 1, 1); PG8_STAGE(PG8_SB(1, 0), b3, voffB); PG8_STAGE(PG8_SB(1, 1), b3 + hstep, voffB); PG8_STAGE(PG8_SA(1, 0), a3, voffA);
            PG8_WAIT_V(8); PG8_WAIT_L(0); PG8_BAR; PG8_MMA(1, 0, At, B0); PG8_MMA(1, 1, At, B1); PG8_BAR; PG8_SCHED;
            } else {
            PG8_LDB(B0, 0, 0); PG8_SCHED; PG8_LDA(At, 0, 0); PG8_STAGE(PG8_SA(1, 1), a1 + hstep, voffA);
            PG8_WAIT_L(8); PG8_BAR; PG8_WAIT_L(0); PG8_MMA(0, 0, At, B0); PG8_BAR; PG8_SCHED;
            PG8_LDB(B1, 0, 1); PG8_STAGE(PG8_SB(0, 0), b2, voffB);
            PG8_BAR; PG8_WAIT_L(0); PG8_MMA(0, 1, At, B1); PG8_BAR;
            PG8_LDA(At, 0, 1); PG8_STAGE(PG8_SA(0, 0), a2, voffA);
            PG8_BAR; PG8_WAIT_L(0); PG8_MMA(1, 0, At, B0); PG8_BAR; PG8_SCHED;
            PG8_STAGE(PG8_SB(0, 1), b2 + hstep, voffB);
            PG8_WAIT_V(6); PG8_BAR; PG8_MMA(1, 1, At, B1); PG8_BAR;
            PG8_LDB(B0, 1, 0); PG8_SCHED; PG8_LDA(At, 1, 0); PG8_STAGE(PG8_SA(0, 1), a2 + hstep, voffA);
            PG8_WAIT_L(8); PG8_BAR; PG8_WAIT_L(0); PG8_MMA(0, 0, At, B0); PG8_BAR; PG8_SCHED;
            PG8_LDB(B1, 1, 1); PG8_STAGE(PG8_SB(1, 0), b3, voffB);
            PG8_BAR; PG8_WAIT_L(0); PG8_MMA(0, 1, At, B1); PG8_BAR;
            PG8_LDA(At, 1, 1); PG8_STAGE(PG8_SA(1, 0), a3, voffA);
            PG8_BAR; PG8_WAIT_L(0); PG8_MMA(1, 0, At, B0); PG8_BAR; PG8_SCHED;
            PG8_STAGE(PG8_SB(1, 1), b3 + hstep, voffB);
            PG8_WAIT_V(6); PG8_BAR; PG8_MMA(1, 1, At, B1); PG8_BAR;
            }
        }
        { unsigned long long ts_; PG8_STAMP(ts_); if (prb) { pk_ += ts_ - pl_; pnk_ += (unsigned)nt; pl_ = ts_; } }
        if constexpr (FP8) asm volatile("s_nop 15\n\ts_nop 15" ::: "memory");
        if constexpr (ALIGN_EPI) { if (wr == 0) PG8_BAR; }
        E(acc, cur, wr, wc, fr, fq);
        if (!has_next) break;
#pragma unroll
        for (int a = 0; a < 2; ++a)
#pragma unroll
            for (int b = 0; b < 2; ++b)
#pragma unroll
                for (int m = 0; m < 4; ++m)
#pragma unroll
                    for (int n = 0; n < 2; ++n) acc[a][b][m][n] = (f32x4){0.f, 0.f, 0.f, 0.f};
        cur = nxt; cA = nA; cB = nB; ++ui;
        if constexpr (ALIGN_EPI) { if (wr == 1) PG8_BAR; }
    }
    PG8_WAIT_V(0);
    if constexpr (!ALIGN_EPI) { if (wr == 0) PG8_BAR; }
    PG8_BAR;
    if (prb && blockIdx.x == 0 && tid == 0) { if (PROBE_KIND == 4) prb[20] = (unsigned)((pk_ / (pnk_ ? pnk_ : 1u)) * 100ull); if (PROBE_KIND == 5) prb[20] = (unsigned)((pg_ / (png_ ? png_ : 1u)) * 10ull); }
#undef PG8_STAMP
#undef PG8_SA
#undef PG8_SB
#undef PG8_STAGE
#undef PG8_LDA
#undef PG8_LDB
#undef PG8_MMA
#undef PG8_WAIT_V
#undef PG8_WAIT_L
#undef PG8_BAR
#undef PG8_SCHED
}
}
constexpr bool GEMM_SP2 = true, GEMM_ALIGN = true;

namespace att {
constexpr int D = 128, LDQ = NQKV, LDO = DM;
constexpr float SCALE = 0.08838834764831845f, THR = 8.f;
constexpr int NW = 8, QBLK = 32, KVBLK = 64, QB = NW * QBLK;
constexpr int SHM_V = KVBLK * D * 2, SHM_K = KVBLK * D * 2;
constexpr int LDS_ATT = 2 * SHM_V + 2 * SHM_K + NW * 64 * 4;
constexpr unsigned BIGW = 0x40000000u;
#define KSWZ(row, colB) ((row) * 256 + ((colB) ^ (((row) & 7) << 4)))
#define SBAR() __builtin_amdgcn_sched_barrier(0)
__device__ __forceinline__ int v_st(int k, int c) { const int kk = (k & ~0xC) | ((k & 4) << 1) | ((k & 8) >> 1); return ((kk >> 3) * 4 + (c >> 5)) * 512 + ((kk & 7) * 32 + (c & 31)) * 2; }
__device__ __forceinline__ int v_rd_base(int lane) { return ((lane & 3) << 3) | (((lane >> 2) & 3) << 6) | (((lane >> 4) & 1) << 5) | (((lane >> 5) & 1) << 8); }
constexpr int v_rd_off(int d0, int ks, int half) { return d0 * 512 + ks * 4096 + half * 2048; }
__device__ __forceinline__ int crow(int r, int hi) { return (r & 3) + 8 * (r >> 2) + 4 * hi; }
__device__ __forceinline__ bf16x8 ld8(const bf16_t* p) { return *reinterpret_cast<const bf16x8*>(p); }
__device__ __forceinline__ void mask_tile(f32x16& p0, f32x16& p1, int dq) {
    const float NEG = -__builtin_inff();
#pragma unroll
    for (int r = 0; r < 16; ++r) {
        const int c = (r & 3) + 8 * (r >> 2);
        if ((unsigned)(dq - c) >= BIGW) p0[r] = NEG;
        if ((unsigned)(dq - c - 32) >= BIGW) p1[r] = NEG;
    }
}
__device__ __forceinline__ void mask_lane(f32x16& p0, f32x16& p1, bool keep) {
    const float NEG = -__builtin_inff();
#pragma unroll
    for (int r = 0; r < 16; ++r) { p0[r] = keep ? p0[r] : NEG; p1[r] = keep ? p1[r] : NEG; }
}
__device__ __forceinline__ void partialSM(f32x16& p0, f32x16& p1, float& m_reg, float& mn, float& alpha) {
    float pmax = p0[0]; for (int r = 1; r < 16; ++r) pmax = fmaxf(pmax, p0[r]); for (int r = 0; r < 16; ++r) pmax = fmaxf(pmax, p1[r]);
    { auto rr = __builtin_amdgcn_permlane32_swap(__float_as_uint(pmax), __float_as_uint(pmax), false, false);
      pmax = fmaxf(__uint_as_float(rr[0]), __uint_as_float(rr[1])); }
    constexpr float C2 = 1.4426950408889634f * SCALE;
    if (__builtin_expect(__all((pmax - m_reg) * SCALE <= THR), 1)) { mn = m_reg; alpha = 1.f; }
    else { mn = fmaxf(m_reg, pmax); alpha = __builtin_amdgcn_exp2f((m_reg - mn) * C2); m_reg = mn; }
    const float mnL = -mn * C2;
    for (int r = 0; r < 16; ++r) p0[r] = fmaf(p0[r], C2, mnL); for (int r = 0; r < 16; ++r) p1[r] = fmaf(p1[r], C2, mnL);
    for (int r = 0; r < 16; ++r) p0[r] = __builtin_amdgcn_exp2f(p0[r]);
}
__device__ __forceinline__ void finishSM(f32x16& p0, f32x16& p1, float alpha, float& l_reg, bf16x8& pa0, bf16x8& pa1, bf16x8& pa2, bf16x8& pa3) {
    for (int r = 0; r < 16; ++r) p1[r] = __builtin_amdgcn_exp2f(p1[r]);
    float ps = 0; for (int r = 0; r < 16; ++r) ps += p0[r]; for (int r = 0; r < 16; ++r) ps += p1[r];
    { auto rr = __builtin_amdgcn_permlane32_swap(__float_as_uint(ps), __float_as_uint(ps), false, false);
      ps = __uint_as_float(rr[0]) + __uint_as_float(rr[1]); }
    l_reg = l_reg * alpha + ps;
#define PK4(P, B_, OUT) do { unsigned a0 = cvt_pk_bf16(P[B_+0], P[B_+1]), a1 = cvt_pk_bf16(P[B_+2], P[B_+3]);                          \
        unsigned b0 = cvt_pk_bf16(P[B_+4], P[B_+5]), b1 = cvt_pk_bf16(P[B_+6], P[B_+7]);                                             \
        auto r0 = __builtin_amdgcn_permlane32_swap(a0, b0, false, false); auto r1 = __builtin_amdgcn_permlane32_swap(a1, b1, false, false); \
        u32x4 w = {r0[0], r1[0], r0[1], r1[1]}; OUT = *reinterpret_cast<bf16x8*>(&w); } while (0)
    PK4(p0, 0, pa0); PK4(p0, 8, pa1); PK4(p1, 0, pa2); PK4(p1, 8, pa3);
#undef PK4
}
template <int KB>
__device__ __forceinline__ void qkt(f32x16& p0, f32x16& p1, const char* K_lds, int r32, int hi, const bf16x8* qr, float a, float bias0) {
#pragma unroll
    for (int r = 0; r < 16; ++r) { const float c = (float)((r & 3) + 8 * (r >> 2)); p0[r] = fmaf(a, c, bias0); p1[r] = fmaf(a, c + 32.f, bias0); }
    const char* kb[4];
#pragma unroll
    for (int dd = 0; dd < 4; ++dd) kb[dd] = K_lds + KB * SHM_K + KSWZ(r32, (dd * 16 + hi * 8) * 2);
#pragma unroll
    for (int d0 = 0; d0 < 8; ++d0) { const char* ap = kb[d0 & 3] + (d0 >> 2) * 128;
        bf16x8 b0 = *reinterpret_cast<const bf16x8*>(ap);
        bf16x8 b1 = *reinterpret_cast<const bf16x8*>(ap + 32 * 256);
        p0 = __builtin_amdgcn_mfma_f32_32x32x16_bf16(b0, qr[d0], p0, 0, 0, 0);
        p1 = __builtin_amdgcn_mfma_f32_32x32x16_bf16(b1, qr[d0], p1, 0, 0, 0); }
}
template <int VB>
__device__ __forceinline__ void pv_tile(f32x16* o, int vb0, bf16x8 pa0, bf16x8 pa1, bf16x8 pa2, bf16x8 pa3) {
#define TRRD(dst, off) asm volatile("ds_read_b64_tr_b16 %0, %1 offset:%2" : "=&v"(dst) : "v"(vb0), "i"(off) : "memory")
#define PV_D0(d0) do { s16x4 l0, l1, l2, l3, h0, h1, h2, h3; constexpr int b_ = VB * SHM_V + v_rd_off(d0, 0, 0); \
        TRRD(l0, b_); TRRD(h0, b_ + 2048); TRRD(l1, b_ + 4096); TRRD(h1, b_ + 6144); TRRD(l2, b_ + 8192); TRRD(h2, b_ + 10240); TRRD(l3, b_ + 12288); TRRD(h3, b_ + 14336); \
        asm volatile("s_waitcnt lgkmcnt(0)" ::: "memory"); SBAR();   \
        o[d0] = __builtin_amdgcn_mfma_f32_32x32x16_bf16(pa0, (bf16x8){l0[0], l0[1], l0[2], l0[3], h0[0], h0[1], h0[2], h0[3]}, o[d0], 0, 0, 0);   \
        o[d0] = __builtin_amdgcn_mfma_f32_32x32x16_bf16(pa1, (bf16x8){l1[0], l1[1], l1[2], l1[3], h1[0], h1[1], h1[2], h1[3]}, o[d0], 0, 0, 0);   \
        o[d0] = __builtin_amdgcn_mfma_f32_32x32x16_bf16(pa2, (bf16x8){l2[0], l2[1], l2[2], l2[3], h2[0], h2[1], h2[2], h2[3]}, o[d0], 0, 0, 0);   \
        o[d0] = __builtin_amdgcn_mfma_f32_32x32x16_bf16(pa3, (bf16x8){l3[0], l3[1], l3[2], l3[3], h3[0], h3[1], h3[2], h3[3]}, o[d0], 0, 0, 0); } while (0)
    PV_D0(0); PV_D0(1); PV_D0(2); PV_D0(3);
#undef PV_D0
#undef TRRD
}
struct BlockRef { const bf16_t* Q; const bf16_t* K; const bf16_t* V; bf16_t* O; const unsigned char* sel; int P0; float a; int jlo; };
struct Seam { bf16x8 qr[8]; bf16x8 st_v0, st_v1, st_k0, st_k1; };
#define AROW(p, k0, rr) (((p) + (size_t)((k0) + (rr)) * LDQ) + toff)
#define VMW() asm volatile("s_waitcnt vmcnt(0)" ::: "memory")
#define VMWN(n) asm volatile("s_waitcnt vmcnt(%0)" :: "i"(n) : "memory")
#define SLOAD_H(Kp, Vp, k0) do { S.st_v0 = ld8(AROW(Vp, k0, 0)); S.st_v1 = ld8(AROW(Vp, k0, 32));              \
                         S.st_k0 = ld8(AROW(Kp, k0, 0)); S.st_k1 = ld8(AROW(Kp, k0, 32)); } while (0)
#define SWRITE_HK(bf) do { *(bf16x8*)(K_lds + (bf) * SHM_K + kws) = S.st_k0; *(bf16x8*)(K_lds + (bf) * SHM_K + kws + 32 * 256) = S.st_k1; } while (0)
#define SWRITE_HV(bf) do { *(bf16x8*)(V_lds + (bf) * SHM_V + vst0) = S.st_v0; *(bf16x8*)(V_lds + (bf) * SHM_V + vst1) = S.st_v1; } while (0)
#define SWRITE_H(bf) do { SWRITE_HV(bf); SWRITE_HK(bf); } while (0)
__device__ __forceinline__ int attn_jlo(const unsigned* bnd, int qseg, int kseg, int b, int qb, float slope) {
    float q2 = 0.f, k2 = 0.f;
#pragma unroll
    for (int w = 0; w < 4; ++w) q2 += __uint_as_float(bnd[((size_t)qseg * 64 + b * 8 + qb) * 4 + w]);
    for (int t = 0; t <= qb; ++t) { float s2 = 0.f;
#pragma unroll
        for (int w = 0; w < 4; ++w) s2 += __uint_as_float(bnd[((size_t)kseg * 64 + b * 8 + t) * 4 + w]);
        k2 = __builtin_fmaxf(k2, s2); }
    const float W = (2.0f * 1.02f * __builtin_sqrtf(q2 * k2) * SCALE + 30.0f) / slope, lo = (float)(qb * 256) - W;
    return lo > 0.f ? (int)(lo * (1.0f / 64.0f)) : 0;
}
struct DynCtx { const bf16_t* qkv; bf16_t* out; const unsigned char* sel; const unsigned* bnd; unsigned* qctr; volatile LAS int* nw; int q0, qb0, nq; const LAS int* jt; };
template <bool MOBA> __device__ __forceinline__ BlockRef attn_ref_blk(int code, const DynCtx& C) {
    constexpr int NH = MOBA ? HA : HB * 4, NPB = NH * 8;
    const int b = code / NPB, idx = code % NPB, qb = 7 - idx / NH, hh = NH - 1 - idx % NH; BlockRef r; const size_t t0 = (size_t)b * SEQ;
    if (MOBA) { const int h = hh; const float slope = __builtin_amdgcn_exp2f(-0.5f * (float)(h + 1));
        r.Q = C.qkv + (t0 + qb * 256) * NQKV + h * 128; r.K = C.qkv + t0 * NQKV + DM + h * 128; r.V = C.qkv + t0 * NQKV + 2 * DM + h * 128;
        r.O = C.out + (t0 + qb * 256) * DM + h * 128; r.sel = C.sel + (size_t)(b * HA + h) * SEQ; r.P0 = qb * 256; r.a = slope * (1.0f / SCALE); r.jlo = C.jt[(b - C.qb0) * 128 + h * 8 + qb]; }
    else { const int h = hh >> 2, c = (hh >> 1) & 1, vh = hh & 1; const float slope = __builtin_amdgcn_exp2f(-(float)(h + 1));
        r.Q = C.qkv + (t0 + qb * 256) * NQKV + 2 * DM + h * 256 + c * 128; r.K = C.qkv + t0 * NQKV + h * 256 + c * 128; r.V = C.qkv + t0 * NQKV + DM + h * 256 + vh * 128;
        r.O = C.out + (size_t)c * MTOK * DM + (t0 + qb * 256) * DM + h * 256 + vh * 128; r.sel = nullptr; r.P0 = qb * 256; r.a = slope * (1.0f / SCALE); r.jlo = C.jt[(b - C.qb0) * 128 + (2 * h + c) * 8 + qb]; }
    return r;
}
__device__ __forceinline__ int attn_pull_from(unsigned* qctr, int q0, int k0, int npb, int qb0, int nq) {
    for (int k = k0; k < nq; ++k) { const int q = qb0 + ((q0 - qb0 + k) & (nq - 1)); if (xb_ld(qctr + 64 * q) >= (unsigned)npb) continue;
        const unsigned i = xb_add(qctr + 64 * q, 1u); if (i < (unsigned)npb) return q * npb + (int)i; }
    return -1;
}
__device__ __forceinline__ void attn_prime(const BlockRef& cur, char* lds, Seam& S) {
    int tid_ = threadIdx.x; asm volatile("" : "+v"(tid_));
    const int tid = tid_, wid = __builtin_amdgcn_readfirstlane(tid >> 6), lane = tid & 63, r32 = lane & 31, hi = lane >> 5;
    const int sr = tid >> 4, sc = (tid & 15) * 8, kws = KSWZ(sr, sc * 2); char* K_lds = lds + 2 * SHM_V; const unsigned toff = (unsigned)(sr * LDQ + sc);
    { const unsigned qoff = (unsigned)(r32 * LDQ + hi * 8); const bf16_t* qb_ = cur.Q + (size_t)(wid * QBLK) * LDQ;
      for (int d0 = 0; d0 < 8; ++d0) S.qr[d0] = ld8(qb_ + qoff + d0 * 16); }
    SLOAD_H(cur.K, cur.V, cur.jlo * KVBLK); VMW(); SWRITE_HK(0);
    __syncthreads();
}
template <bool MOBA>
__device__ __forceinline__ int attn_block(const BlockRef& cur, const DynCtx& C, char* lds, Seam& S) {
    int tid_ = threadIdx.x; asm volatile("" : "+v"(tid_));
    const int tid = tid_, wid = __builtin_amdgcn_readfirstlane(tid >> 6), lane = tid & 63, r32 = lane & 31, hi = lane >> 5;
    const int NT = (cur.P0 + QB) / KVBLK - cur.jlo;
    const int qlo = cur.P0 + wid * QBLK, qm = qlo + r32 - 4 * hi;
    char* V_lds = lds; char* K_lds = lds + 2 * SHM_V;
    float* ws = (float*)(lds + 2 * SHM_V + 2 * SHM_K) + wid * 64; float* li_l = ws, * al_l = ws + 32;
    float m_reg = -1e30f, l_reg = 0; f32x16 o[4] = {};
    const int sr = tid >> 4, sc = (tid & 15) * 8, vst0 = v_st(sr, sc), vst1 = v_st(32 + sr, sc), kws = KSWZ(sr, sc * 2); const unsigned toff = (unsigned)(sr * LDQ + sc);
    const int vb0 = (int)(uintptr_t)V_lds + v_rd_base(lane);
    const bf16_t* Kh = cur.K; const bf16_t* Vh = cur.V;
    unsigned selm = 0xffu; if (MOBA) selm = cur.sel[cur.P0 + wid * QBLK + r32];
    const float aa = cur.a, abase = -aa * (float)qm;
#define RESC(a) do { if (__any((a) < 1.f)) { if (hi == 0) al_l[r32] = (a); asm volatile("s_waitcnt lgkmcnt(0)" ::: "memory");              \
                     for (int d_ = 0; d_ < 4; ++d_) for (int r = 0; r < 16; ++r) o[d_][r] *= al_l[crow(r, hi)]; } } while (0)
#define KBASE(t) ((cur.jlo + (t)) * KVBLK)
#define BIAS(t) fmaf(aa, (float)KBASE(t), abase)
#define MASKT(P0_, P1_, t) do { const int kb_ = KBASE(t); \
        if (!MOBA || kb_ >= cur.P0) { if (kb_ + KVBLK - 1 > qlo) mask_tile(P0_, P1_, qm - kb_); } \
        else { const bool keep_ = ((selm >> (kb_ >> 8)) & 1u) != 0u; if (!__all(keep_)) mask_lane(P0_, P1_, keep_); } } while (0)
#define SEAM_K0() do { VMWN(8); SWRITE_HK(0); SBAR(); } while (0)
    f32x16 pA0, pA1, pB0, pB1; float mnA, mnB, alA, alB; bf16x8 pa0, pa1, pa2, pa3;
    SWRITE_HV(0); SBAR();
    if (NT > 1) { SLOAD_H(Kh, Vh, KBASE(1)); }
    constexpr int NPB_ = (MOBA ? HA : HB * 4) * 8; unsigned pi_ = 0u; if (tid == 0) pi_ = xb_add(C.qctr + 64 * C.q0, 1u);
    SBAR(); qkt<0>(pA0, pA1, K_lds, r32, hi, S.qr, aa, BIAS(0));
    MASKT(pA0, pA1, 0); partialSM(pA0, pA1, m_reg, mnA, alA);
    if (NT > 1) { VMW(); SWRITE_H(1); }
    if (tid == 0) *C.nw = pi_ < (unsigned)NPB_ ? C.q0 * NPB_ + (int)pi_ : attn_pull_from(C.qctr, C.q0, 1, NPB_, C.qb0, C.nq);
    __syncthreads();
#define HALF_STEP(PX0, PX1, mnX, alX, PY0, PY1, alY, t, KB, VB, SB) do {                                                      \
        SBAR(); qkt<KB>(PX0, PX1, K_lds, r32, hi, S.qr, aa, BIAS(t));                                                         \
        finishSM(PY0, PY1, alY, l_reg, pa0, pa1, pa2, pa3); SBAR();                                                           \
        if ((t) + 1 < NT) { SLOAD_H(Kh, Vh, KBASE((t) + 1)); SBAR(); }                                                        \
        pv_tile<VB>(o, vb0, pa0, pa1, pa2, pa3); MASKT(PX0, PX1, (t)); partialSM(PX0, PX1, m_reg, mnX, alX);                  \
        __syncthreads();                                                                                                      \
        if ((t) + 1 < NT) { VMW(); SWRITE_H(SB); }                                                                            \
        RESC(alX); __syncthreads(); } while (0)
    for (int t = 1; t + 1 < NT; t += 2) {
        HALF_STEP(pB0, pB1, mnB, alB, pA0, pA1, alA, t, 1, 0, 0);
        HALF_STEP(pA0, pA1, mnA, alA, pB0, pB1, alB, t + 1, 0, 1, 1);
    }
    const bool even = (NT & 1) == 0;
    if (even) { SBAR(); qkt<1>(pB0, pB1, K_lds, r32, hi, S.qr, aa, BIAS(NT - 1)); SBAR(); }
    const int nc_ = __builtin_amdgcn_readfirstlane(*C.nw); const BlockRef nxt = nc_ >= 0 ? attn_ref_blk<MOBA>(nc_, C) : cur;
    SLOAD_H(nxt.K, nxt.V, nxt.jlo * KVBLK); SBAR();
    { const unsigned qoff = (unsigned)(r32 * LDQ + hi * 8); const bf16_t* qb_ = nxt.Q + (size_t)(wid * QBLK) * LDQ;
      _Pragma("unroll") for (int d0 = 0; d0 < 8; ++d0) S.qr[d0] = ld8(qb_ + qoff + d0 * 16); }
    SBAR();
    finishSM(pA0, pA1, alA, l_reg, pa0, pa1, pa2, pa3); SBAR();
    pv_tile<0>(o, vb0, pa0, pa1, pa2, pa3);
    if (even) { MASKT(pB0, pB1, NT - 1); partialSM(pB0, pB1, m_reg, mnB, alB); __syncthreads(); RESC(alB);
        finishSM(pB0, pB1, alB, l_reg, pa0, pa1, pa2, pa3); SBAR(); pv_tile<1>(o, vb0, pa0, pa1, pa2, pa3); }
    SBAR(); SEAM_K0();
    if (hi == 0) li_l[r32] = l_reg; asm volatile("s_waitcnt lgkmcnt(0)" ::: "memory");
    float rli[16];
#pragma unroll
    for (int r = 0; r < 16; ++r) rli[r] = __builtin_amdgcn_rcpf(li_l[crow(r, hi)]);
    bf16_t* Ow = cur.O + (size_t)(wid * QBLK) * LDO;
#pragma unroll
    for (int r = 0; r < 16; ++r) { const int orow = crow(r, hi);
#pragma unroll
        for (int d0 = 0; d0 < 4; ++d0) { const float v = o[d0][r] * rli[r];
            const float vn = xor1_get(v);
            if ((r32 & 1) == 0) *(unsigned*)(Ow + (size_t)orow * LDO + d0 * 32 + r32) = cvt_pk_bf16(v, vn); } }
    __syncthreads();
    return nc_;
#undef RESC
#undef KBASE
#undef BIAS
#undef MASKT
#undef SEAM_K0
#undef HALF_STEP
}
#undef AROW
#undef VMW
#undef VMWN
#undef SLOAD_H
#undef SWRITE_HK
#undef SWRITE_HV
#undef SWRITE_H
}

constexpr int NWAVES = 8, NTHREADS = NWAVES * 64, NPHASE = 17;
struct Args { const float* in[23]; float* out; unsigned char* ws; int ph_lo, ph_hi; };
struct Frame { LAS unsigned char* lds; int tid, lane, wave, G, vc, gw, NGW; };
typedef const __attribute__((address_space(4))) Args* KAP;

struct WJob { const float* src; void* dst; const float* gain; float sc; int K, N, mode, kb, nb, f8; };
__device__ __forceinline__ int wdrow(int n, int mode) { return mode == 0 ? n : ((n >> 7) * 256 + (mode == 2 ? 128 : 0) + (n & 127)); }
constexpr int I_QKV = 32 * 24, I_OA = 32 * 8, I_G = 32 * 22, I_DN = 88 * 8, I_KV = 32 * 16, I_QB = 32 * 8, I_OB = 32 * 8, I_E1 = 32 * 28, I_EG = 8 * I_E1, I_ED1 = 112 * 8, I_ED = 8 * I_ED1;
constexpr int W_NITEMS0 = I_QKV + I_OA + 2 * I_G + I_DN + I_KV + I_QB + I_OB;
constexpr int W_NEXP = 2 * I_EG + I_ED, W_NITEMS = W_NITEMS0 + W_NEXP;
__device__ __forceinline__ void wjob_decode(KAP ap, int item, WJob& j) {
    unsigned char* ws = ap->ws; int r = item; int nbn; j.f8 = 0; j.sc = 1.0f;
    if (r < I_QKV) { j.src = ap->in[2]; j.dst = (bf16_t*)(ws + WS_WQKV); j.gain = ap->in[1]; j.K = DM; j.N = NQKV; j.mode = 0; }
    else if ((r -= I_QKV) < I_OA) { j.src = ap->in[3]; j.dst = (bf16_t*)(ws + WS_WOA); j.gain = nullptr; j.K = DM; j.N = DM; j.mode = 0; }
    else if ((r -= I_OA) < I_G) { j.src = ap->in[15]; j.dst = (bf16_t*)(ws + WS_WGU); j.gain = ap->in[14]; j.K = DM; j.N = FF; j.mode = 1; }
    else if ((r -= I_G) < I_G) { j.src = ap->in[16]; j.dst = (bf16_t*)(ws + WS_WGU); j.gain = ap->in[14]; j.K = DM; j.N = FF; j.mode = 2; }
    else if ((r -= I_G) < I_DN) { j.src = ap->in[17]; j.dst = (bf16_t*)(ws + WS_WDN); j.gain = nullptr; j.K = FF; j.N = DM; j.mode = 0; }
    else if ((r -= I_DN) < I_KV) { j.src = ap->in[5]; j.dst = (bf16_t*)(ws + WS_WKVQ); j.gain = ap->in[4]; j.K = DM; j.N = 2 * DM; j.mode = 0; }
    else if ((r -= I_KV) < I_QB) { j.src = ap->in[7]; j.dst = (bf16_t*)(ws + WS_WKVQ) + (size_t)2 * DM * DM; j.gain = ap->in[6]; j.K = DM; j.N = DM; j.mode = 0; }
    else if ((r -= I_QB) < I_OB) { j.src = ap->in[13]; j.dst = (bf16_t*)(ws + WS_WOB); j.gain = nullptr; j.K = DM; j.N = DM; j.mode = 0; }
    else if ((r -= I_OB) < I_EG) { const int e = r / I_E1; r -= e * I_E1; j.src = ap->in[19] + (size_t)e * DM * FE; j.dst = ws + WS_WEGU + (size_t)e * 2 * FE * DM; j.gain = ap->in[14] + DM; j.K = DM; j.N = FE; j.mode = 1; j.f8 = 1; j.sc = WEGU_SC; }
    else if ((r -= I_EG) < I_EG) { const int e = r / I_E1; r -= e * I_E1; j.src = ap->in[20] + (size_t)e * DM * FE; j.dst = ws + WS_WEGU + (size_t)e * 2 * FE * DM; j.gain = ap->in[14] + DM; j.K = DM; j.N = FE; j.mode = 2; j.f8 = 1; j.sc = WEGU_SC; }
    else { r -= I_EG; const int e = r / I_ED1; r -= e * I_ED1; j.src = ap->in[21] + (size_t)e * FE * DM; j.dst = ws + WS_WEDN + (size_t)e * DM * FE; j.gain = nullptr; j.K = FE; j.N = DM; j.mode = 0; j.f8 = 1; j.sc = WEDN_SC; }
    nbn = j.N >> 8; j.kb = r / nbn; j.nb = r - j.kb * nbn;
}
__device__ __forceinline__ void p0_weights(KAP a, Frame& F, int first, const int end, const int stride) {
    LAS float* tile = (LAS float*)F.lds;
    const int w = F.wave, l = F.lane;
    float v[32];
    int item = first; bool have = item < end; WJob j;
#define W_LOAD() do { const float* sp = j.src + (size_t)(j.kb * 64 + w) * j.N + j.nb * 256 + l; \
        _Pragma("unroll") for (int i = 0; i < 8; ++i) _Pragma("unroll") for (int c = 0; c < 4; ++c) v[i * 4 + c] = __builtin_nontemporal_load(sp + (size_t)(8 * i) * j.N + 64 * c); } while (0)
    if (have) { wjob_decode(a, item, j); W_LOAD(); }
    while (have) {
        __syncthreads();
#pragma unroll
        for (int i = 0; i < 8; ++i) { const int k = w + 8 * i; const float g = (j.gain ? j.gain[j.kb * 64 + k] : 1.0f) * j.sc;
#pragma unroll
            for (int c = 0; c < 4; ++c) tile[k * 257 + l + 64 * c] = v[i * 4 + c] * g; }
        void* cdst = j.dst; const int cK = j.K, cmode = j.mode, ckb = j.kb, cnb = j.nb, cf8 = j.f8;
        item += stride; const bool have_next = item < end;
        if (have_next) { wjob_decode(a, item, j); W_LOAD(); }
        __syncthreads();
        if (cf8) {
            const int c4 = l >> 4, n16 = l & 15;
#pragma unroll
            for (int jj = 0; jj < 2; ++jj) { const int n = n16 + 16 * w + 128 * jj; const LAS float* s = tile + (16 * c4) * 257 + n;
                u32x4 o; o.x = pg8::pk4_fp8(s[0], s[257], s[2 * 257], s[3 * 257]); o.y = pg8::pk4_fp8(s[4 * 257], s[5 * 257], s[6 * 257], s[7 * 257]);
                o.z = pg8::pk4_fp8(s[8 * 257], s[9 * 257], s[10 * 257], s[11 * 257]); o.w = pg8::pk4_fp8(s[12 * 257], s[13 * 257], s[14 * 257], s[15 * 257]);
                *(u32x4*)((unsigned char*)cdst + (size_t)wdrow(cnb * 256 + n, cmode) * cK + ckb * 64 + 16 * c4) = o; }
        } else {
        const int c8 = l >> 3, nn = l & 7;
#pragma unroll
        for (int jj = 0; jj < 4; ++jj) { const int n = nn + 8 * w + 64 * jj; const LAS float* s = tile + (8 * c8) * 257 + n;
            u32x4 o; o.x = cvt_pk_bf16(s[0], s[257]); o.y = cvt_pk_bf16(s[2 * 257], s[3 * 257]); o.z = cvt_pk_bf16(s[4 * 257], s[5 * 257]); o.w = cvt_pk_bf16(s[6 * 257], s[7 * 257]);
            *(u32x4*)((bf16_t*)cdst + (size_t)wdrow(cnb * 256 + n, cmode) * cK + ckb * 64 + 8 * c8) = o; }
        }
        have = have_next;
    }
#undef W_LOAD
    __syncthreads();
}
#ifndef W_DEEP4
#define W_DEEP4 1
#endif
__device__ __forceinline__ void p0_weights2(KAP a, Frame& F, int first, const int end, const int stride) {
    const int w = F.wave, l = F.lane;
    float va[32], vb[32];
    WJob ja, jb;
#define W_LOAD2(J, V) do { const float* sp = (J).src + (size_t)((J).kb * 64 + w) * (J).N + (J).nb * 256 + l; \
        _Pragma("unroll") for (int i = 0; i < 8; ++i) _Pragma("unroll") for (int c = 0; c < 4; ++c) (V)[i * 4 + c] = __builtin_nontemporal_load(sp + (size_t)(8 * i) * (J).N + 64 * c); } while (0)
#define W_ITEM2(J, V, TILE, NEXT_ITEM) do { \
        LAS float* tile = (LAS float*)F.lds + (TILE) * (64 * 257); \
        _Pragma("unroll") for (int i = 0; i < 8; ++i) { const int k = w + 8 * i; const float g = ((J).gain ? (J).gain[(J).kb * 64 + k] : 1.0f) * (J).sc; \
            _Pragma("unroll") for (int c = 0; c < 4; ++c) tile[k * 257 + l + 64 * c] = (V)[i * 4 + c] * g; } \
        void* cdst = (J).dst; const int cK = (J).K, cmode = (J).mode, ckb = (J).kb, cnb = (J).nb, cf8 = (J).f8; \
        if ((NEXT_ITEM) < end) { wjob_decode(a, (NEXT_ITEM), (J)); W_LOAD2(J, V); } \
        __syncthreads(); \
        if (cf8) { const int c4 = l >> 4, n16 = l & 15; \
            _Pragma("unroll") for (int jj = 0; jj < 2; ++jj) { const int n = n16 + 16 * w + 128 * jj; const LAS float* s = tile + (16 * c4) * 257 + n; \
                u32x4 o; o.x = pg8::pk4_fp8(s[0], s[257], s[2 * 257], s[3 * 257]); o.y = pg8::pk4_fp8(s[4 * 257], s[5 * 257], s[6 * 257], s[7 * 257]); \
                o.z = pg8::pk4_fp8(s[8 * 257], s[9 * 257], s[10 * 257], s[11 * 257]); o.w = pg8::pk4_fp8(s[12 * 257], s[13 * 257], s[14 * 257], s[15 * 257]); \
                *(u32x4*)((unsigned char*)cdst + (size_t)wdrow(cnb * 256 + n, cmode) * cK + ckb * 64 + 16 * c4) = o; } \
        } else { const int c8 = l >> 3, nn = l & 7; \
            _Pragma("unroll") for (int jj = 0; jj < 4; ++jj) { const int n = nn + 8 * w + 64 * jj; const LAS float* s = tile + (8 * c8) * 257 + n; \
                u32x4 o; o.x = cvt_pk_bf16(s[0], s[257]); o.y = cvt_pk_bf16(s[2 * 257], s[3 * 257]); o.z = cvt_pk_bf16(s[4 * 257], s[5 * 257]); o.w = cvt_pk_bf16(s[6 * 257], s[7 * 257]); \
                *(u32x4*)((bf16_t*)cdst + (size_t)wdrow(cnb * 256 + n, cmode) * cK + ckb * 64 + 8 * c8) = o; } } \
    } while (0)
    int item = first;
    __syncthreads();
#if W_DEEP4
    float vc[32], vd[32]; WJob jc, jd;
    if (item < end) { wjob_decode(a, item, ja); W_LOAD2(ja, va); }
    if (item + stride < end) { wjob_decode(a, item + stride, jb); W_LOAD2(jb, vb); }
    if (item + 2 * stride < end) { wjob_decode(a, item + 2 * stride, jc); W_LOAD2(jc, vc); }
    if (item + 3 * stride < end) { wjob_decode(a, item + 3 * stride, jd); W_LOAD2(jd, vd); }
    for (; item < end; item += 4 * stride) {
        W_ITEM2(ja, va, 0, item + 4 * stride);
        if (item + stride < end) W_ITEM2(jb, vb, 1, item + 5 * stride);
        if (item + 2 * stride < end) W_ITEM2(jc, vc, 0, item + 6 * stride);
        if (item + 3 * stride < end) W_ITEM2(jd, vd, 1, item + 7 * stride);
    }
#else
    if (item < end) { wjob_decode(a, item, ja); W_LOAD2(ja, va); }
    if (item + stride < end) { wjob_decode(a, item + stride, jb); W_LOAD2(jb, vb); }
    for (; item < end; item += 2 * stride) {
        W_ITEM2(ja, va, 0, item + 2 * stride);
        if (item + stride < end) W_ITEM2(jb, vb, 1, item + 3 * stride);
    }
#endif
#undef W_LOAD2
#undef W_ITEM2
    __syncthreads();
}
__device__ __forceinline__ void p0_weights_r(KAP a, Frame& F, int first, const int end, const int wg, const int nwg) {
    const int t = F.tid & 255, half = __builtin_amdgcn_readfirstlane(F.tid >> 8), nq = t & 15, kq = (t >> 4) & 3, ng = t >> 6;
    const int n0 = ng * 64 + nq * 4, k0 = kq * 16, nworkers = 2 * nwg;
    f32x4 va[16], vb[16], ga[4], gb[4]; WJob ja, jb;
#define WR_LOAD(J, V, G) do { const char* ub = (const char*)((J).src + (size_t)(J).kb * 64 * (J).N + (J).nb * 256); const unsigned loff = (unsigned)(k0 * (J).N + n0) * 4u; \
        _Pragma("unroll") for (int i = 0; i < 16; ++i) (V)[i] = __builtin_nontemporal_load((const f32x4*)(ub + (size_t)i * (J).N * 4 + loff)); \
        _Pragma("unroll") for (int i = 0; i < 4; ++i) (G)[i] = (J).gain ? *(const f32x4*)((J).gain + (J).kb * 64 + k0 + 4 * i) : (f32x4){1.f, 1.f, 1.f, 1.f}; } while (0)
#define WR_ITEM(J, V, G, NEXT_ITEM) do { \
        _Pragma("unroll") for (int i = 0; i < 4; ++i) (G)[i] = (G)[i] * (J).sc; \
        unsigned char* cdst = (unsigned char*)(J).dst; const int cK = (J).K, cmode = (J).mode, ckb = (J).kb, cnb = (J).nb; \
        _Pragma("unroll") for (int j = 0; j < 4; ++j) { u32x4 o; \
            o.x = pg8::pk4_fp8((V)[0][j] * (G)[0][0], (V)[1][j] * (G)[0][1], (V)[2][j] * (G)[0][2], (V)[3][j] * (G)[0][3]); o.y = pg8::pk4_fp8((V)[4][j] * (G)[1][0], (V)[5][j] * (G)[1][1], (V)[6][j] * (G)[1][2], (V)[7][j] * (G)[1][3]); \
            o.z = pg8::pk4_fp8((V)[8][j] * (G)[2][0], (V)[9][j] * (G)[2][1], (V)[10][j] * (G)[2][2], (V)[11][j] * (G)[2][3]); o.w = pg8::pk4_fp8((V)[12][j] * (G)[3][0], (V)[13][j] * (G)[3][1], (V)[14][j] * (G)[3][2], (V)[15][j] * (G)[3][3]); \
            *(u32x4*)(cdst + (size_t)wdrow(cnb * 256 + n0 + j, cmode) * cK + ckb * 64 + k0) = o; } \
        if ((NEXT_ITEM) < end) { wjob_decode(a, (NEXT_ITEM), (J)); WR_LOAD(J, V, G); } \
    } while (0)
    int item = first + 2 * wg + half;
    if (item < end) { wjob_decode(a, item, ja); WR_LOAD(ja, va, ga); }
    if (item + nworkers < end) { wjob_decode(a, item + nworkers, jb); WR_LOAD(jb, vb, gb); }
    for (; item < end; item += 2 * nworkers) {
        WR_ITEM(ja, va, ga, item + 2 * nworkers);
        if (item + nworkers < end) WR_ITEM(jb, vb, gb, item + 3 * nworkers);
    }
#undef WR_LOAD
#undef WR_ITEM
}
__device__ __forceinline__ void p0_x(const float* x, bf16_t* xb, u64* ss0, Frame& F) {
    for (int row = F.gw; row < MTOK; row += F.NGW) {
        const f32x4* xr = (const f32x4*)(x + (size_t)row * DM) + F.lane; f32x4 v[8]; float s = 0.f;
#pragma unroll
        for (int j = 0; j < 8; ++j) { v[j] = __builtin_nontemporal_load(xr + 64 * j); s += (v[j].x * v[j].x + v[j].y * v[j].y) + (v[j].z * v[j].z + v[j].w * v[j].w); }
        s = wave_sum(s);
        u32x2* o8 = (u32x2*)(xb + (size_t)row * DM) + F.lane;
#pragma unroll
        for (int j = 0; j < 8; ++j) { u32x2 w; w.x = cvt_pk_bf16(v[j].x, v[j].y); w.y = cvt_pk_bf16(v[j].z, v[j].w); o8[64 * j] = w; }
        if (F.lane == 0) ss0[row] = ss_fix(s);
    }
}
__device__ __forceinline__ void p2_kmean(const bf16_t* qkv, float* kmean, Frame& F, int u0, int nu) {
    const int c16 = F.lane & 15, rg = F.lane >> 4;
    for (int u = u0 + F.gw; u < u0 + nu; u += F.NGW) {
        const int bh = u >> 3, jb = u & 7, b = bh / HA, h = bh % HA;
        const bf16_t* kp = qkv + (size_t)(b * SEQ + jb * 256 + rg) * NQKV + DM + h * 128 + 8 * c16;
        float s[8] = {0.f, 0.f, 0.f, 0.f, 0.f, 0.f, 0.f, 0.f};
#pragma unroll 8
        for (int i = 0; i < 64; ++i) { const u32x4 q = *(const u32x4*)(kp + (size_t)(4 * i) * NQKV);
            s[0] += __uint_as_float(q.x << 16); s[1] += __uint_as_float(q.x & 0xffff0000u); s[2] += __uint_as_float(q.y << 16); s[3] += __uint_as_float(q.y & 0xffff0000u);
            s[4] += __uint_as_float(q.z << 16); s[5] += __uint_as_float(q.z & 0xffff0000u); s[6] += __uint_as_float(q.w << 16); s[7] += __uint_as_float(q.w & 0xffff0000u); }
#pragma unroll
        for (int e = 0; e < 8; ++e) s[e] = sum_xor32(sum_xor16(s[e]));
        if (rg == 0) { float* kd = kmean + (size_t)u * 128 + 8 * c16;
            *(f32x4*)kd = (f32x4){s[0], s[1], s[2], s[3]} * (1.0f / 256.0f); *(f32x4*)(kd + 4) = (f32x4){s[4], s[5], s[6], s[7]} * (1.0f / 256.0f); }
    }
}
__device__ __forceinline__ void p3_select(const bf16_t* qkv, const float* kmean, unsigned char* sel, Frame& F, int u0, int nu) {
    LAS float* km = (LAS float*)F.lds;
    for (int u = u0 + F.vc; u < u0 + nu; u += F.G) {
        const int bh = u >> 2, ch = u & 3, b = bh / HA, h = bh % HA;
        __syncthreads();
        km[F.tid] = kmean[(size_t)bh * 1024 + F.tid]; km[F.tid + 512] = kmean[(size_t)bh * 1024 + 512 + F.tid];
        __syncthreads();
        const int s = ch * 512 + F.tid, own = s >> 8;
        const bf16_t* qp = qkv + (size_t)(b * SEQ + s) * NQKV + h * 128;
        float gate[8] = {0.f, 0.f, 0.f, 0.f, 0.f, 0.f, 0.f, 0.f};
        if (own > 0) {
#pragma unroll 4
            for (int c = 0; c < 16; ++c) { const u32x4 q = *(const u32x4*)(qp + 8 * c);
                const float q0 = __uint_as_float(q.x << 16), q1 = __uint_as_float(q.x & 0xffff0000u), q2 = __uint_as_float(q.y << 16), q3 = __uint_as_float(q.y & 0xffff0000u);
                const float q4 = __uint_as_float(q.z << 16), q5 = __uint_as_float(q.z & 0xffff0000u), q6 = __uint_as_float(q.w << 16), q7 = __uint_as_float(q.w & 0xffff0000u);
#pragma unroll
                for (int jb = 0; jb < 8; ++jb) { const f32x4 k0 = *(const LAS f32x4*)(km + jb * 128 + 8 * c), k1 = *(const LAS f32x4*)(km + jb * 128 + 8 * c + 4);
                    gate[jb] += (q0 * k0.x + q1 * k0.y) + (q2 * k0.z + q3 * k0.w) + (q4 * k1.x + q5 * k1.y) + (q6 * k1.z + q7 * k1.w); } }
        }
        unsigned mask = 0u; const int nsel = own < 3 ? own : 3;
#pragma unroll
        for (int it = 0; it < 3; ++it) { if (it < nsel) { int best = -1; float bv = -__builtin_inff();
#pragma unroll
                for (int jb = 0; jb < 8; ++jb) { const bool ok = (jb < own) && (((mask >> jb) & 1u) == 0u) && (best < 0 || gate[jb] > bv); if (ok) { bv = gate[jb]; best = jb; } }
                if (best >= 0) mask |= 1u << best; } }
        sel[(size_t)bh * SEQ + s] = (unsigned char)mask;
    }
    __syncthreads();
}
template <bool MOBA> __device__ __forceinline__ void attn_phase(char* lds, const bf16_t* qkv, bf16_t* out, const unsigned char* sel, const unsigned* bnd, unsigned* qctr, int qb0, int nq, Frame& F) {
    constexpr int NPB = (MOBA ? HA : HB * 4) * 8;
    LAS int* jt = (LAS int*)(F.lds + 70016);
    att::DynCtx C{qkv, out, sel, bnd, qctr, (volatile LAS int*)(F.lds + 70000), qb0 + (int)(xb_xcc_id() & (unsigned)(nq - 1)), qb0, nq, jt};
    __syncthreads();
    for (int i = F.tid; i < nq * 128; i += NTHREADS) { const int b = qb0 + (i >> 7), seg = (i >> 3) & 15, qb = i & 7;
        if (MOBA) jt[i] = att::attn_jlo(bnd, seg, 16 + seg, b, qb, __builtin_amdgcn_exp2f(-0.5f * (float)(seg + 1)));
        else jt[i] = att::attn_jlo(bnd, 32 + seg, seg, b, qb, __builtin_amdgcn_exp2f(-(float)((seg >> 1) + 1))); }
    if (F.tid == 0) *C.nw = att::attn_pull_from(qctr, C.q0, 0, NPB, qb0, nq);
    __syncthreads();
    int code = __builtin_amdgcn_readfirstlane(*C.nw); if (code < 0) return;
    att::BlockRef cur = att::attn_ref_blk<MOBA>(code, C); att::Seam S;
    att::attn_prime(cur, lds, S);
    for (;;) {
        code = att::attn_block<MOBA>(cur, C, lds, S);
        if (code < 0) break;
        cur = att::attn_ref_blk<MOBA>(code, C);
    }
}
__device__ __forceinline__ void p10_combine(KAP a, const bf16_t* omap, bf16_t* ao, Frame& F, int t0, int nt) {
    const int l = F.lane;
    float d1 = a->in[8][l] * a->in[9][l] + a->in[8][l + 64] * a->in[9][l + 64], d2 = a->in[10][l] * a->in[11][l] + a->in[10][l + 64] * a->in[11][l + 64];
    d1 = wave_sum(d1); d2 = wave_sum(d2);
    const float lam = __expf(d1) - __expf(d2) + LAM_INIT;
    const f32x4 g = *(const f32x4*)(a->in[12] + 4 * l);
    u32x2 x1v[HB], x2v[HB];
    int tok = t0 + F.gw;
    if (tok < t0 + nt) { const bf16_t* p1 = omap + (size_t)tok * DM + 4 * l; const bf16_t* p2 = p1 + (size_t)MTOK * DM;
#pragma unroll
        for (int h = 0; h < HB; ++h) { x1v[h] = *(const u32x2*)(p1 + h * 256); x2v[h] = *(const u32x2*)(p2 + h * 256); } }
    for (; tok < t0 + nt; tok += F.NGW) {
        bf16_t* po = ao + (size_t)tok * DM + 4 * l;
        u32x2 n1v[HB], n2v[HB]; const int nxt = tok + F.NGW;
        if (nxt < t0 + nt) { const bf16_t* p1 = omap + (size_t)nxt * DM + 4 * l; const bf16_t* p2 = p1 + (size_t)MTOK * DM;
#pragma unroll
            for (int h = 0; h < HB; ++h) { n1v[h] = *(const u32x2*)(p1 + h * 256); n2v[h] = *(const u32x2*)(p2 + h * 256); } }
        else {
#pragma unroll
            for (int h = 0; h < HB; ++h) { n1v[h] = (u32x2){0u, 0u}; n2v[h] = (u32x2){0u, 0u}; } }
#pragma unroll
        for (int h = 0; h < HB; ++h) { const u32x2 x1 = x1v[h], x2 = x2v[h];
            f32x4 d; d.x = __uint_as_float(x1.x << 16) - lam * __uint_as_float(x2.x << 16); d.y = __uint_as_float(x1.x & 0xffff0000u) - lam * __uint_as_float(x2.x & 0xffff0000u);
            d.z = __uint_as_float(x1.y << 16) - lam * __uint_as_float(x2.y << 16); d.w = __uint_as_float(x1.y & 0xffff0000u) - lam * __uint_as_float(x2.y & 0xffff0000u);
            float ss = wave_sum((d.x * d.x + d.y * d.y) + (d.z * d.z + d.w * d.w));
            const float r = __builtin_amdgcn_rsqf(ss * (1.0f / 256.0f) + RMS_EPS) * (1.0f - LAM_INIT);
            u32x2 w; w.x = cvt_pk_bf16(d.x * r * g.x, d.y * r * g.y); w.y = cvt_pk_bf16(d.z * r * g.z, d.w * r * g.w); *(u32x2*)(po + h * 256) = w; }
#pragma unroll
        for (int h = 0; h < HB; ++h) { x1v[h] = n1v[h]; x2v[h] = n2v[h]; }
    }
}
__device__ __forceinline__ void p12_router(KAP a, const bf16_t* xb, const u64* ss3, unsigned* gcnt, int* tokinfo, unsigned char* xs, Frame& F, int c0, int nc) {
    LAS float* gwt = (LAS float*)F.lds;
    LAS unsigned* cnt = (LAS unsigned*)(F.lds + 65536); LAS unsigned* base = cnt + 8;
    const float* wr = a->in[18]; const float* g1 = a->in[14] + DM;
    __syncthreads();
    for (int idx = F.tid; idx < DM * NE; idx += NTHREADS) gwt[idx] = wr[idx] * g1[idx >> 3];
    if (F.tid < 8) cnt[F.tid] = 0u;
    __syncthreads();
    const int l = F.lane;
    for (int chunk = c0 + F.vc; chunk < c0 + nc; chunk += F.G) {
        int e0v = 0, e1v = 0, i0v = 0, i1v = 0; float g0v = 0.f, g1v = 0.f;
        float lgs[8][8];
#pragma unroll
        for (int i = 0; i < 8; ++i)
#pragma unroll
            for (int e = 0; e < 8; ++e) lgs[i][e] = 0.f;
        { const bf16_t* xp0 = xb + (size_t)(chunk * 64 + F.wave * 8) * DM + l;
#pragma unroll 4
          for (int j = 0; j < 32; ++j) { const LAS f32x4* wp = (const LAS f32x4*)(gwt + (l + 64 * j) * 8); const f32x4 w0 = wp[0], w1 = wp[1];
#pragma unroll
              for (int i = 0; i < 8; ++i) { const float xv = bf2f(xp0[(size_t)i * DM + 64 * j]);
                  lgs[i][0] += xv * w0.x; lgs[i][1] += xv * w0.y; lgs[i][2] += xv * w0.z; lgs[i][3] += xv * w0.w; lgs[i][4] += xv * w1.x; lgs[i][5] += xv * w1.y; lgs[i][6] += xv * w1.z; lgs[i][7] += xv * w1.w; } } }
#pragma unroll
        for (int i = 0; i < 8; ++i) {
            const int tok = chunk * 64 + F.wave * 8 + i;
            float lg[8];
            const float rs = rstd_q(ss3[tok]);
#pragma unroll
            for (int e = 0; e < 8; ++e) lg[e] = wave_sum(lgs[i][e]) * rs;
            int b0 = 0; float v0 = lg[0];
#pragma unroll
            for (int e = 1; e < 8; ++e) if (lg[e] > v0) { v0 = lg[e]; b0 = e; }
            int b1 = -1; float v1 = -__builtin_inff();
#pragma unroll
            for (int e = 0; e < 8; ++e) if (e != b0 && (b1 < 0 || lg[e] > v1)) { v1 = lg[e]; b1 = e; }
            const float ga = 1.0f / (1.0f + __expf(v1 - v0));
            unsigned i0 = 0u, i1 = 0u;
            if (l == 0) { i0 = __hip_atomic_fetch_add(&cnt[b0], 1u, __ATOMIC_RELAXED, __HIP_MEMORY_SCOPE_WORKGROUP); i1 = __hip_atomic_fetch_add(&cnt[b1], 1u, __ATOMIC_RELAXED, __HIP_MEMORY_SCOPE_WORKGROUP); }
            i0 = __builtin_amdgcn_readfirstlane(i0); i1 = __builtin_amdgcn_readfirstlane(i1);
            if (l == i) { e0v = b0; e1v = b1; i0v = (int)i0; i1v = (int)i1; g0v = ga; g1v = 1.0f - ga; }
        }
        __syncthreads();
        if (F.tid < 8) base[F.tid] = __hip_atomic_fetch_add(gcnt + 64 * F.tid, cnt[F.tid], __ATOMIC_RELAXED, __HIP_MEMORY_SCOPE_AGENT);
        __syncthreads();
        if (l < 8) { const int tok = chunk * 64 + F.wave * 8 + l; int* ti = tokinfo + (size_t)tok * 8;
            ti[0] = e0v; ti[1] = e1v; ti[2] = (int)base[e0v] + i0v; ti[3] = (int)base[e1v] + i1v; ti[4] = __float_as_int(g0v); ti[5] = __float_as_int(g1v); }
#pragma unroll
        for (int h = 0; h < 2; ++h) { u32x2 xv[4][8];
#pragma unroll
            for (int i = 0; i < 4; ++i) { const u32x2* sp = (const u32x2*)(xb + (size_t)(chunk * 64 + F.wave * 8 + 4 * h + i) * DM) + l;
#pragma unroll
                for (int j = 0; j < 8; ++j) xv[i][j] = sp[64 * j]; }
#pragma unroll
            for (int i = 0; i < 4; ++i) { const int ii = 4 * h + i, tok = chunk * 64 + F.wave * 8 + ii;
                const int e0 = __builtin_amdgcn_readlane(e0v, ii), e1 = __builtin_amdgcn_readlane(e1v, ii), q0 = __builtin_amdgcn_readlane(i0v, ii), q1 = __builtin_amdgcn_readlane(i1v, ii);
                const size_t row0 = (size_t)e0 * MTOK + base[e0] + q0, row1 = (size_t)e1 * MTOK + base[e1] + q1;
                const float rs = rstd_q(ss3[tok]) * XS_SC;
                unsigned* d0 = (unsigned*)(xs + row0 * DM) + l; unsigned* d1 = (unsigned*)(xs + row1 * DM) + l;
#pragma unroll
                for (int j = 0; j < 8; ++j) { const u32x2 b = xv[i][j];
                    const unsigned q = pg8::pk4_fp8(__uint_as_float(b.x << 16) * rs, __uint_as_float(b.x & 0xffff0000u) * rs, __uint_as_float(b.y << 16) * rs, __uint_as_float(b.y & 0xffff0000u) * rs); d0[64 * j] = q; d1[64 * j] = q; } } }
        __syncthreads();
        if (F.tid < 8) cnt[F.tid] = 0u;
        __syncthreads();
    }
}
__device__ __forceinline__ void p13_gather(const bf16_t* xb, const u64* ss3, unsigned* gcnt, int* tiles, int* tokinfo, unsigned char* xs, Frame& F) {
    LAS int* pst = (LAS int*)F.lds;
    __syncthreads();
    if (F.tid == 0) { int acc = 0;
        for (int e = 0; e < NE; ++e) { const int c = (int)__hip_atomic_load(gcnt + 64 * e, __ATOMIC_RELAXED, __HIP_MEMORY_SCOPE_AGENT); const int p = (c + 255) & ~255;
            pst[e] = acc; pst[8 + e] = c; pst[16 + e] = p;
            if (blockIdx.x == 0) for (int t = acc >> 8; t < (acc + p) >> 8; ++t) tiles[1 + t] = e;
            acc += p; }
        if (blockIdx.x == 0) tiles[0] = acc >> 8; }
    __syncthreads();
    const int l = F.lane;
    for (int tok = F.gw; tok < MTOK; tok += F.NGW) {
        int* ti = tokinfo + (size_t)tok * 8;
        const int row0 = pst[ti[0]] + ti[2], row1 = pst[ti[1]] + ti[3];
        if (l == 0) { ti[6] = row0; ti[7] = row1; }
        const float rs = rstd_q(ss3[tok]) * XS_SC;
        const u32x2* sp = (const u32x2*)(xb + (size_t)tok * DM) + l; unsigned* d0 = (unsigned*)(xs + (size_t)row0 * DM) + l; unsigned* d1 = (unsigned*)(xs + (size_t)row1 * DM) + l;
#pragma unroll
        for (int j = 0; j < 8; ++j) { const u32x2 b = sp[64 * j];
            const unsigned q = pg8::pk4_fp8(__uint_as_float(b.x << 16) * rs, __uint_as_float(b.x & 0xffff0000u) * rs, __uint_as_float(b.y << 16) * rs, __uint_as_float(b.y & 0xffff0000u) * rs); d0[64 * j] = q; d1[64 * j] = q; }
    }
    for (int e = 0; e < NE; ++e) { const int lo = pst[e] + pst[8 + e], hi = pst[e] + pst[16 + e];
        for (int r = lo + F.gw; r < hi; r += F.NGW) { u32x4* d = (u32x4*)(xs + (size_t)r * DM) + l; d[0] = (u32x4){0u, 0u, 0u, 0u}; d[64] = (u32x4){0u, 0u, 0u, 0u}; } }
    __syncthreads();
}
__device__ __forceinline__ void ys_row(const bf16_t* ys, const float* slab, int split0, size_t ks_stride, int row, int l, f32x4 (&a)[8]) {
    if (row >= split0) { const float* p = slab + (size_t)(row - split0) * DM + 4 * l;
#pragma unroll
        for (int j = 0; j < 8; ++j) { f32x4 t = *(const f32x4*)(p + 256 * j);
#pragma unroll
            for (int ks = 1; ks < TAIL_NS; ++ks) t = t + *(const f32x4*)(p + 256 * j + (size_t)ks * ks_stride);
            a[j] = t * (1.0f / (ACT_SC * WEDN_SC)); } }
    else { const u32x2* p = (const u32x2*)(ys + (size_t)row * DM) + l;
#pragma unroll
        for (int j = 0; j < 8; ++j) { const u32x2 q = p[64 * j]; a[j] = (f32x4){__uint_as_float(q.x << 16), __uint_as_float(q.x & 0xffff0000u), __uint_as_float(q.y << 16), __uint_as_float(q.y & 0xffff0000u)}; } }
}
constexpr int MOE_T_OFF = 131072;
__device__ __forceinline__ void moe_tables(const unsigned* gcnt, LAS int* T, Frame& F) {
    __syncthreads();
    if (F.tid == 0) { int acc = 0;
        for (int e = 0; e < NE; ++e) { const int c = (int)__hip_atomic_load(gcnt + 64 * e, __ATOMIC_RELAXED, __HIP_MEMORY_SCOPE_AGENT); const int p = (c + 255) & ~255;
            T[256 + e] = acc;
            for (int j = 0; j < (p >> 8); ++j) T[1 + (acc >> 8) + j] = e + 16 * (e * (MTOK / 256) + j);
            acc += p; }
        T[0] = acc >> 8; }
    __syncthreads();
}
__device__ __forceinline__ void p16_final(const bf16_t* xb, const bf16_t* ys, const float* slab, const int* tiles, const int* tokinfo, const float* fg, float* out, Frame& F) {
    const int l = F.lane; const int nT = tiles[0]; int rt = nT & 31; if (rt > 7) rt = 0; const int split0 = (nT - rt) * 256; const size_t ks_stride = (size_t)rt * 256 * DM;
    for (int tok = F.gw; tok < MTOK; tok += F.NGW) {
        const int* ti = tokinfo + (size_t)tok * 8; const float g0 = __int_as_float(ti[4]), g1 = __int_as_float(ti[5]); const int row0 = tiles[256 + ti[0]] + ti[2], row1 = tiles[256 + ti[1]] + ti[3];
        const u32x2* xp = (const u32x2*)(xb + (size_t)tok * DM) + l;
        f32x4 v[8], a0[8], a1[8]; float s = 0.f;
#pragma unroll
        for (int j = 0; j < 8; ++j) { const u32x2 q = xp[64 * j]; v[j] = (f32x4){__uint_as_float(q.x << 16), __uint_as_float(q.x & 0xffff0000u), __uint_as_float(q.y << 16), __uint_as_float(q.y & 0xffff0000u)}; }
        ys_row(ys, slab, split0, ks_stride, row0, l, a0); ys_row(ys, slab, split0, ks_stride, row1, l, a1);
#pragma unroll
        for (int j = 0; j < 8; ++j) { v[j] = v[j] + g0 * a0[j] + g1 * a1[j]; s += (v[j].x * v[j].x + v[j].y * v[j].y) + (v[j].z * v[j].z + v[j].w * v[j].w); }
        const float r = rstd_of(wave_sum(s));
        f32x4* op = (f32x4*)(out + (size_t)tok * DM) + l; const f32x4* gp = (const f32x4*)fg + l;
#pragma unroll
        for (int j = 0; j < 8; ++j) op[64 * j] = v[j] * r * gp[64 * j];
    }
}

#ifndef PH_MASK
#define PH_MASK 0x1ffff
#endif
__global__ void __launch_bounds__(NTHREADS, 2) mega_fwd(Args args_by_value) {
    extern __shared__ __attribute__((aligned(16))) unsigned char lds[];
    (void)args_by_value;
    const KAP kap0 = (KAP)__builtin_amdgcn_kernarg_segment_ptr();
#define KARGS() ({ KAP p_ = kap0; asm volatile("" : "+s"(p_)); p_; })
    Frame F0;
#define F F0
    F.lds = (LAS unsigned char*)lds;
    F.tid = threadIdx.x; F.lane = F.tid & 63; F.wave = __builtin_amdgcn_readfirstlane(F.tid >> 6);
    F.G = gridDim.x; { const int bx = blockIdx.x; F.vc = (F.G % 8 == 0) ? (bx % 8) * (F.G / 8) + bx / 8 : bx; }
    F.gw = F.vc * NWAVES + F.wave; F.NGW = F.G * NWAVES;
    volatile LAS unsigned* MISC = (volatile LAS unsigned*)(F.lds + LDSCTL_OFF);
    for (int u = F.tid; u < (LDS_BYTES - LDSCTL_OFF) / 4; u += NTHREADS) ((LAS unsigned*)(F.lds + LDSCTL_OFF))[u] = 0u;
    __syncthreads();
    const int lo = kap0->ph_lo, hi = kap0->ph_hi;
    const bool use_bar = (hi - lo) > 1;
    XcdBarrier bar; bar.bar = (unsigned*)(kap0->ws + CTL_BAR); bar.x = 0; bar.st = MISC + 8;
    if (use_bar) bar = xcd_barrier_post((unsigned*)(kap0->ws + CTL_BAR), MISC + 8, (unsigned)F.G);
#ifndef DUP_MASK
#define DUP_MASK 0
#endif
#ifndef PROBE_SKIP_EPI
#define PROBE_SKIP_EPI 0
#endif
#ifndef PROBE_KIND
#define PROBE_KIND 4
#endif
#ifndef PROBE_PH
#define PROBE_PH 6
#endif
#ifndef PROBE_AMP
#define PROBE_AMP 4
#endif
#ifndef PROBE_PHM
#define PROBE_PHM (1 << PROBE_PH)
#endif
#define PROBE_SEL(k) ((PROBE_KIND == 2 || PROBE_KIND == 3) ? ((PROBE_PHM >> (k)) & 1) : ((k) == PROBE_PH))
#if PROBE_KIND
#define PROBE_ME (blockIdx.x == 0 && F0.tid == 0)
#define PROBE_B(k) do { if (PROBE_SEL(k) && PROBE_ME) { const unsigned long long r_ = __builtin_amdgcn_s_memrealtime(), t_ = __builtin_amdgcn_s_memtime(); MISC[16] = (unsigned)r_; MISC[17] = (unsigned)(r_ >> 32); MISC[18] = (unsigned)t_; MISC[19] = (unsigned)(t_ >> 32); } } while (0)
#define PROBE_E(k) do { if (PROBE_SEL(k) && PROBE_ME) { const unsigned long long r_ = __builtin_amdgcn_s_memrealtime(), t_ = __builtin_amdgcn_s_memtime(); \
        const unsigned long long r0_ = ((unsigned long long)MISC[17] << 32) | MISC[16], t0_ = ((unsigned long long)MISC[19] << 32) | MISC[18]; const unsigned long long dr_ = r_ - r0_, dt_ = t_ - t0_; \
        if (PROBE_KIND == 1) MISC[20] = (unsigned)((dt_ * 10000ull) / (dr_ ? dr_ : 1ull));   \
        if (PROBE_KIND == 2) MISC[20] = MISC[20] + (unsigned)(dr_ * PROBE_AMP); \
        if (PROBE_KIND == 3) { MISC[16] = (unsigned)r_; MISC[17] = (unsigned)(r_ >> 32); } } } while (0)
#define PROBE_S(k) do { if (PROBE_KIND == 3 && PROBE_SEL(k) && PROBE_ME) { const unsigned long long r_ = __builtin_amdgcn_s_memrealtime(); const unsigned long long r0_ = ((unsigned long long)MISC[17] << 32) | MISC[16]; MISC[20] = MISC[20] + (unsigned)((r_ - r0_) * PROBE_AMP); } } while (0)
#define PROBE_FIN() do { if (PROBE_ME) { const unsigned long long r0_ = __builtin_amdgcn_s_memrealtime(); const unsigned long long d_ = MISC[20]; while (__builtin_amdgcn_s_memrealtime() - r0_ < d_) __builtin_amdgcn_s_sleep(8); } } while (0)
#else
#define PROBE_B(k) do { } while (0)
#define PROBE_E(k) do { } while (0)
#define PROBE_S(k) do { } while (0)
#define PROBE_FIN() do { } while (0)
#endif
#define PRB(k) (((PROBE_KIND == 4 || PROBE_KIND == 5) && (k) == PROBE_PH) ? MISC : (volatile LAS unsigned*)nullptr)
#define IN(k) (((PH_MASK >> (k)) & 1) && lo <= (k) && (k) < hi)
#define REP(k) for (int rep_ = 0; rep_ < (((DUP_MASK >> (k)) & 1) ? 2 : 1); ++rep_)
#define SEAM(k) do { if (IN(k) && IN((k) + 1)) { if ((k) >= 1 && (k) <= 10) xcd_barrier(barh); else xcd_barrier(bar); } } while (0)
#define WSP(T, off) ((T*)(ws + (off)))
#define FRL() ({ Frame f_ = F0; asm volatile("" : "+v"(f_.tid), "+v"(f_.lane)); f_; })
#undef F
    const int bx = blockIdx.x;
    const int ngrp = (F0.G % 8 == 0) ? 8 : 1, hb = (ngrp == 8) ? (bx & 7) : 0, nxh = 8 / ngrp, Gh = F0.G / ngrp;
    const int hidx = (ngrp == 8) ? (bx >> 3) : bx;
    const int Mh = MTOK / ngrp, R0 = hb * Mh, nMh = Mh / 256, pm0 = hb * nMh;
    Frame FH0 = F0; FH0.G = Gh; FH0.vc = (Gh % nxh == 0) ? (hidx % nxh) * (Gh / nxh) + hidx / nxh : hidx; FH0.gw = FH0.vc * NWAVES + F0.wave; FH0.NGW = Gh * NWAVES;
#define FRH() ({ Frame f_ = FH0; asm volatile("" : "+v"(f_.tid), "+v"(f_.lane)); f_; })
    const int shn = W_NEXP / ngrp, sh0 = W_NITEMS0 + hb * shn;
    const int per = (shn + Gh - 1) / Gh, nbef = (ngrp == 8) ? (per * hb) / 7 : per;
    XcdBarrier barh = bar;
    if (use_bar) barh = xcd_barrier_post((unsigned*)(kap0->ws + CTL_BARH + (size_t)hb * CTL_BARH_STRIDE), MISC + 10, (unsigned)Gh);

    PROBE_B(0); if (IN(0)) REP(0) { KAP ap = KARGS(); Frame F = FRL(); unsigned char* ws = ap->ws; p0_weights(ap, F, F.vc, W_NITEMS0, F.G); p0_x(ap->in[0], WSP(bf16_t, WS_XB), WSP(u64, CTL_SS), F); }
    PROBE_E(0); SEAM(0); PROBE_S(0);
    if (IN(0)) { KAP ap = KARGS(); Frame F = FRH(); const int e_ = sh0 + nbef * Gh < sh0 + shn ? sh0 + nbef * Gh : sh0 + shn; p0_weights_r(ap, F, sh0, e_, hidx, Gh); }
    PROBE_B(1); if (IN(1)) REP(1) {
        KAP ap = KARGS(); Frame F = FRH(); unsigned char* ws = ap->ws;
        pg8::Order S; S.init(nMh, NQKV / 256, 2 * DM, F.G, hidx, ws + WS_XB + (size_t)R0 * DM * 2, ws + WS_WQKV, 0, nullptr, nxh);
        pg8::EpiBf16Out<true, true> E{WSP(bf16_t, WS_QKV) + (size_t)R0 * NQKV, NQKV, WSP(u64, CTL_SS) + R0, 1.f, WSP(unsigned, CTL_BND1), pm0};
        pg8::gemm_phase<pg8::EpiBf16Out<true, true>, GEMM_ALIGN, GEMM_SP2>(F.lds, 2 * DM, S, E, 0, PRB(1));
    }
    PROBE_E(1); SEAM(1); PROBE_S(1);
    PROBE_B(2); if (IN(2)) REP(2) { KAP ap = KARGS(); Frame F = FRH(); unsigned char* ws = ap->ws; p2_kmean(WSP(bf16_t, WS_QKV), WSP(float, WS_KMEAN), F, hb * nxh * HA * 8, nxh * HA * 8); }
    PROBE_E(2); SEAM(2); PROBE_S(2);
    PROBE_B(3); if (IN(3)) REP(3) { KAP ap = KARGS(); Frame F = FRH(); unsigned char* ws = ap->ws; p3_select(WSP(bf16_t, WS_QKV), WSP(float, WS_KMEAN), WSP(unsigned char, WS_SEL), F, hb * nxh * HA * 4, nxh * HA * 4); }
    PROBE_E(3); SEAM(3); PROBE_S(3);
    PROBE_B(4); if (IN(4)) REP(4) { KAP ap = KARGS(); Frame F = FRH(); unsigned char* ws = ap->ws; attn_phase<true>((char*)lds, WSP(bf16_t, WS_QKV), WSP(bf16_t, WS_AO), WSP(unsigned char, WS_SEL), WSP(unsigned, CTL_BND1), WSP(unsigned, CTL_AQ), hb * nxh, nxh, F); }
    PROBE_E(4); SEAM(4); PROBE_S(4);
    PROBE_B(5); if (IN(5)) REP(5) {
        KAP ap = KARGS(); Frame F = FRH(); unsigned char* ws = ap->ws;
        pg8::Order S; S.init(nMh, DM / 256, 2 * DM, F.G, hidx, ws + WS_AO + (size_t)R0 * DM * 2, ws + WS_WOA, 0, nullptr, nxh);
        pg8::EpiResid<true, false> E{WSP(bf16_t, WS_XB) + (size_t)R0 * DM, nullptr, WSP(bf16_t, WS_XB) + (size_t)R0 * DM, WSP(u64, CTL_SS) + MTOK + R0};
        pg8::gemm_phase<pg8::EpiResid<true, false>, GEMM_ALIGN, GEMM_SP2>(F.lds, 2 * DM, S, E);
    }
    PROBE_E(5); SEAM(5); PROBE_S(5);
    PROBE_B(6); if (IN(6)) REP(6) {
        KAP ap = KARGS(); Frame F = FRH(); unsigned char* ws = ap->ws;
        pg8::Order S; S.init(nMh, 2 * FF / 256, 2 * DM, F.G, hidx, ws + WS_XB + (size_t)R0 * DM * 2, ws + WS_WGU, 0, nullptr, nxh);
        pg8::EpiSwiGLU<false> E{WSP(bf16_t, WS_ACT) + (size_t)R0 * FF, FF, WSP(u64, CTL_SS) + MTOK + R0};
        pg8::gemm_phase<pg8::EpiSwiGLU<false>, GEMM_ALIGN, GEMM_SP2>(F.lds, 2 * DM, S, E, 0, PRB(6));
    }
    PROBE_E(6); SEAM(6); PROBE_S(6);
    PROBE_B(7); if (IN(7)) REP(7) {
        KAP ap = KARGS(); Frame F = FRH(); unsigned char* ws = ap->ws;
        pg8::Order S; S.init(nMh, DM / 256, 2 * FF, F.G, hidx, ws + WS_ACT + (size_t)R0 * FF * 2, ws + WS_WDN, 0, nullptr, nxh);
        pg8::EpiResid<true, false> E{WSP(bf16_t, WS_XB) + (size_t)R0 * DM, nullptr, WSP(bf16_t, WS_XB) + (size_t)R0 * DM, WSP(u64, CTL_SS) + 2 * MTOK + R0};
        pg8::gemm_phase<pg8::EpiResid<true, false>, GEMM_ALIGN, GEMM_SP2>(F.lds, 2 * FF, S, E);
    }
    PROBE_E(7); SEAM(7); PROBE_S(7);
    PROBE_B(8); if (IN(8)) REP(8) {
        KAP ap = KARGS(); Frame F = FRH(); unsigned char* ws = ap->ws;
        pg8::Order S; S.init(nMh, NQKV / 256, 2 * DM, F.G, hidx, ws + WS_XB + (size_t)R0 * DM * 2, ws + WS_WKVQ, 0, nullptr, nxh);
        pg8::EpiBf16Out<true, true> E{WSP(bf16_t, WS_QKV) + (size_t)R0 * NQKV, NQKV, WSP(u64, CTL_SS) + 2 * MTOK + R0, 1.f, WSP(unsigned, CTL_BND2), pm0};
        pg8::gemm_phase<pg8::EpiBf16Out<true, true>, GEMM_ALIGN, GEMM_SP2>(F.lds, 2 * DM, S, E, 0, PRB(1));
    }
    PROBE_E(8); SEAM(8); PROBE_S(8);
    PROBE_B(9); if (IN(9)) REP(9) { KAP ap = KARGS(); Frame F = FRH(); unsigned char* ws = ap->ws; attn_phase<false>((char*)lds, WSP(bf16_t, WS_QKV), WSP(bf16_t, WS_XR), nullptr, WSP(unsigned, CTL_BND2), WSP(unsigned, CTL_AQ) + 8 * 64, hb * nxh, nxh, F); }
    PROBE_E(9); SEAM(9); PROBE_S(9);
    PROBE_B(10); if (IN(10)) REP(10) { KAP ap = KARGS(); Frame F = FRH(); unsigned char* ws = ap->ws; p10_combine(ap, WSP(bf16_t, WS_XR), WSP(bf16_t, WS_AO), F, R0, Mh); }
    PROBE_E(10); SEAM(10); PROBE_S(10);
    PROBE_B(11); if (IN(11)) REP(11) {
        KAP ap = KARGS(); Frame F = FRH(); unsigned char* ws = ap->ws;
        pg8::Order S; S.init(nMh, DM / 256, 2 * DM, F.G, hidx, ws + WS_AO + (size_t)R0 * DM * 2, ws + WS_WOB, 0, nullptr, nxh);
        pg8::EpiResid<true, false> E{WSP(bf16_t, WS_XB) + (size_t)R0 * DM, nullptr, WSP(bf16_t, WS_XB) + (size_t)R0 * DM, WSP(u64, CTL_SS) + 3 * MTOK + R0};
        pg8::gemm_phase<pg8::EpiResid<true, false>, GEMM_ALIGN, GEMM_SP2>(F.lds, 2 * DM, S, E);
    }
    PROBE_E(11); if (IN(11) && IN(12)) xcd_barrier(barh); PROBE_S(11);
    PROBE_B(12); if (IN(12)) REP(12) { KAP ap = KARGS(); Frame F = FRH(); unsigned char* ws = ap->ws; p12_router(ap, WSP(bf16_t, WS_XB), WSP(u64, CTL_SS) + 3 * MTOK, WSP(unsigned, CTL_CNT), WSP(int, CTL_TOKINFO), WSP(unsigned char, WS_XSC), F, hb * (Mh / 64), Mh / 64); }
    if (IN(12)) { KAP ap = KARGS(); Frame F = FRH(); p0_weights_r(ap, F, sh0 + nbef * Gh, sh0 + shn, hidx, Gh); }
    PROBE_E(12); SEAM(12); PROBE_S(12);
    PROBE_B(14); if (IN(14)) REP(14) {
        KAP ap = KARGS(); Frame F = FRL(); unsigned char* ws = ap->ws;
        moe_tables(WSP(unsigned, CTL_CNT), (LAS int*)(F.lds + MOE_T_OFF), F);
        const int* tiles = (const int*)(LAS int*)(F.lds + MOE_T_OFF); const int nT = tiles[0];
        pg8::Order S; S.init(nT, 2 * FE / 256, DM, F.G, bx, ws + WS_XSC, ws + WS_WEGU, (size_t)2 * FE * DM, tiles + 1, pg8::NXCD, 1);
        pg8::EpiSwiGLU8 E{WSP(unsigned char, WS_ACTE), FE, 1.0f / (XS_SC * WEGU_SC), ACT_SC, (PROBE_SKIP_EPI && rep_ == 1) ? 1 : 0};
        pg8::gemm_phase<pg8::EpiSwiGLU8, GEMM_ALIGN, false, true>(F.lds, DM, S, E, 0, PRB(14));
    }
    PROBE_E(14); SEAM(14); PROBE_S(14);
    PROBE_B(15); if (IN(15)) REP(15) {
        KAP ap = KARGS(); Frame F = FRL(); unsigned char* ws = ap->ws;
        if (!IN(14)) moe_tables(WSP(unsigned, CTL_CNT), (LAS int*)(F.lds + MOE_T_OFF), F);
        const int* tiles = (const int*)(LAS int*)(F.lds + MOE_T_OFF); const int nT = tiles[0];
        int rt = nT & 31; if (rt > 7) rt = 0;
        pg8::Order S; S.init(nT - rt, DM / 256, FE, F.G, bx, ws + WS_ACTE, ws + WS_WEDN, (size_t)DM * FE, tiles + 1);
        pg8::EpiBf16Out<false> E{WSP(bf16_t, WS_YS), DM, nullptr, 1.0f / (ACT_SC * WEDN_SC), nullptr, 0};
        pg8::gemm_phase<pg8::EpiBf16Out<false>, GEMM_ALIGN, false, true>(F.lds, FE, S, E);
        if (rt) { pg8::TailOrder S2{rt * 8 * TAIL_NS, F.G, bx, nT - rt, TAIL_NS, (const char*)(ws + WS_ACTE), (const char*)(ws + WS_WEDN), (size_t)256 * FE, (size_t)DM * FE, (size_t)(FE / TAIL_NS), tiles + 1};
            pg8::EpiPart E2{WSP(float, WS_SLAB), (nT - rt) * 256, (size_t)rt * 256 * DM};
            pg8::gemm_phase<pg8::EpiPart, GEMM_ALIGN, false, true, pg8::TailOrder>(F.lds, FE, S2, E2, FE / TAIL_NS / 128); }
    }
    PROBE_E(15); SEAM(15); PROBE_S(15);
    PROBE_B(16); if (IN(16)) REP(16) { KAP ap = KARGS(); Frame F = FRL(); unsigned char* ws = ap->ws; if (!IN(14)) moe_tables(WSP(unsigned, CTL_CNT), (LAS int*)(F.lds + MOE_T_OFF), F);
        p16_final(WSP(bf16_t, WS_XB), WSP(bf16_t, WS_YS), WSP(float, WS_SLAB), (const int*)(LAS int*)(F.lds + MOE_T_OFF), WSP(int, CTL_TOKINFO), ap->in[22], ap->out, F); }
PROBE_E(16); PROBE_FIN();
#undef IN
#undef REP
#undef SEAM
#undef WSP
#undef FRL
#undef FRH
#undef KARGS
}

#ifndef MK_ONE_LAUNCH
#define MK_ONE_LAUNCH 1
#endif
extern "C" void kernel_launch(void* const* d_in, const int* in_sizes, int n_in, void* d_out, int out_size, void* d_ws, size_t ws_size, hipStream_t stream) {
    static int grid = 0;
    if (grid == 0) {
        if (n_in != 23 || out_size != MTOK * DM || ws_size < WS_END) { fprintf(stderr, "kernel_launch: unexpected shapes (n_in %d, out %d, ws %zu)\n", n_in, out_size, ws_size); grid = -1; return; }
        int dev = 0, cus = 0, per_cu = 0;
        if (hipGetDevice(&dev) != hipSuccess || hipDeviceGetAttribute(&cus, hipDeviceAttributeMultiprocessorCount, dev) != hipSuccess) { grid = -1; return; }
        if (hipFuncSetAttribute((const void*)mega_fwd, hipFuncAttributeMaxDynamicSharedMemorySize, LDS_BYTES) != hipSuccess) { fprintf(stderr, "kernel_launch: hipFuncSetAttribute failed\n"); grid = -1; return; }
        if (hipOccupancyMaxActiveBlocksPerMultiprocessor(&per_cu, (const void*)mega_fwd, NTHREADS, LDS_BYTES) != hipSuccess || per_cu < 1) { fprintf(stderr, "kernel_launch: occupancy query reports %d\n", per_cu); (void)hipGetLastError(); per_cu = 1; }
        grid = cus;
    }
    if (grid < 0) return;
    if (hipMemsetAsync((char*)d_ws + WS_CTL, 0, CTL_ZERO_BYTES, stream) != hipSuccess) return;
    Args a{};
    for (int i = 0; i < 23; ++i) a.in[i] = (const float*)d_in[i];
    a.out = (float*)d_out; a.ws = (unsigned char*)d_ws;
#if MK_ONE_LAUNCH
    a.ph_lo = 0; a.ph_hi = NPHASE;
    hipLaunchKernelGGL(mega_fwd, dim3(grid), dim3(NTHREADS), LDS_BYTES, stream, a);
#else
    for (int p = 0; p < NPHASE; ++p) { a.ph_lo = p; a.ph_hi = p + 1; hipLaunchKernelGGL(mega_fwd, dim3(grid), dim3(NTHREADS), LDS_BYTES, stream, a); }
#endif
}
```

```cpp
#include <hip/hip_runtime.h>
#include <cstdio>
#include <cstdint>

#define GAS __attribute__((address_space(1)))
#define LAS __attribute__((address_space(3)))
#ifndef PROBE_KIND
#define PROBE_KIND 0
#endif
typedef unsigned short bf16_t;
typedef short bf16x8 __attribute__((ext_vector_type(8)));
typedef short s16x4 __attribute__((ext_vector_type(4)));
typedef float f32x2 __attribute__((ext_vector_type(2)));
typedef float f32x4 __attribute__((ext_vector_type(4)));
typedef float f32x16 __attribute__((ext_vector_type(16)));
typedef unsigned u32x2 __attribute__((ext_vector_type(2)));
typedef unsigned u32x4 __attribute__((ext_vector_type(4)));

constexpr int NB = 8, SEQ = 2048, DM = 2048, MTOK = NB * SEQ;
constexpr int NQKV = 3 * DM, FF = 5632, FE = 7168, NE = 8;
constexpr int HA = 16, HB = 8;
constexpr float RMS_EPS = 1e-6f;
constexpr float LAM_INIT = 0.35550906759096996f;
constexpr int MAXTILES = 136;
constexpr int MOE_ROWS = 135 * 256;

constexpr size_t MiB = 1u << 20;
constexpr size_t WS_CTL = 0, CTL_ZERO_BYTES = 960 * 1024;
constexpr size_t CTL_BAR = 4096;
constexpr size_t CTL_BARH = 832 * 1024, CTL_BARH_STRIDE = 16384;
constexpr size_t CTL_SS = 64 * 1024;
constexpr size_t CTL_AQ = 580 * 1024;
constexpr size_t CTL_CNT = 576 * 1024;
constexpr size_t CTL_BND1 = 640 * 1024, CTL_BND2 = 704 * 1024;
constexpr size_t CTL_TILES = 768 * 1024;
constexpr size_t CTL_TOKINFO = 1 * MiB;
constexpr size_t WS_WQKV = 2 * MiB, WS_WOA = 26 * MiB, WS_WGU = 34 * MiB, WS_WDN = 78 * MiB, WS_WKVQ = 100 * MiB, WS_WOB = 124 * MiB;
constexpr size_t WS_XB = 132 * MiB, WS_XR = 196 * MiB, WS_WEGU = 324 * MiB, WS_WEDN = 548 * MiB, WS_BIG = 660 * MiB;
constexpr size_t WS_QKV = WS_BIG, WS_AO = WS_BIG + 192 * MiB, WS_ACT = WS_BIG + 256 * MiB, WS_KMEAN = WS_BIG + 432 * MiB, WS_SEL = WS_BIG + 433 * MiB;
constexpr size_t WS_ACTE = WS_BIG, WS_XS = WS_BIG + 237 * MiB, WS_YS = WS_BIG + 305 * MiB, WS_SLAB = WS_BIG + 440 * MiB, WS_XSC = WS_BIG + 500 * MiB, WS_END = WS_XSC + 256 * MiB;
static_assert(WS_END <= 1792 * MiB, "workspace map");
static_assert((size_t)MOE_ROWS * FE <= 237 * MiB && (size_t)MOE_ROWS * DM <= 68 * MiB && (size_t)MOE_ROWS * DM * 2 <= 135 * MiB && WS_SEL + MiB <= WS_END, "moe buffers");
constexpr float XS_SC = 16.f, WEGU_SC = 256.f, ACT_SC = 8.f, WEDN_SC = 512.f;
constexpr int TAIL_NS = 4, TAIL_MAXROWS = 31 * 256;
static_assert((size_t)TAIL_NS * 7 * 256 * DM * 4 <= 60 * MiB, "slab (nT in [128, 135] -> at most 7 tail row tiles)");

constexpr int RING_BYTES = 131072, LDS_BYTES = 147456, LDSCTL_OFF = LDS_BYTES - 512;

#define LDS_WAIT() asm volatile("s_waitcnt lgkmcnt(0)" ::: "memory")
#define VM_WAIT() asm volatile("s_waitcnt vmcnt(0)" ::: "memory")
__device__ __forceinline__ unsigned cvt_pk_bf16(float lo, float hi) { unsigned r; asm volatile("v_cvt_pk_bf16_f32 %0, %1, %2" : "=v"(r) : "v"(lo), "v"(hi)); return r; }
__device__ __forceinline__ float bf2f(unsigned short b) { return __uint_as_float(((unsigned)b) << 16); }
template <int CTRL> __device__ __forceinline__ float dppx(float v) { return __builtin_bit_cast(float, __builtin_amdgcn_update_dpp(0, __builtin_bit_cast(int, v), CTRL, 0xf, 0xf, true)); }
__device__ __forceinline__ float xor1_get(float v) { return dppx<0xB1>(v); }
__device__ __forceinline__ float sum_xor16(float v) { auto r = __builtin_amdgcn_permlane16_swap(__float_as_uint(v), __float_as_uint(v), false, false); return __uint_as_float(r[0]) + __uint_as_float(r[1]); }
__device__ __forceinline__ float sum_xor32(float v) { auto r = __builtin_amdgcn_permlane32_swap(__float_as_uint(v), __float_as_uint(v), false, false); return __uint_as_float(r[0]) + __uint_as_float(r[1]); }
__device__ __forceinline__ float row_sum16(float v) { v += dppx<0xB1>(v); v += dppx<0x4E>(v); v += dppx<0x141>(v); v += dppx<0x140>(v); return v; }
__device__ __forceinline__ float row_max16(float v) { v = __builtin_fmaxf(v, dppx<0xB1>(v)); v = __builtin_fmaxf(v, dppx<0x4E>(v)); v = __builtin_fmaxf(v, dppx<0x141>(v)); v = __builtin_fmaxf(v, dppx<0x140>(v)); return v; }
__device__ __forceinline__ float wave_sum(float v) { return sum_xor32(sum_xor16(row_sum16(v))); }
typedef unsigned long long u64;
__device__ __forceinline__ float rstd_of(float ss) { return __builtin_amdgcn_rsqf(ss * (1.0f / (float)DM) + RMS_EPS); }
__device__ __forceinline__ u64 ss_fix(float s) { return (u64)(s * 16777216.0f); }
__device__ __forceinline__ float rstd_q(u64 q) { return rstd_of((float)q * (1.0f / 16777216.0f)); }

#define XB_TMO      128
#define XB_XCNT(j)  (256  + 64 * (j))
#define XB_XSUB(j)  (1280 + 64 * (j))
#define XB_XGEN(j)  (2304 + 64 * (j))
#define XB_TOP      3328
#define XB_TOPGEN   3392
#define XCD_BAR_WORDS 3456
#define XB_SPIN_CAP (1u << 18)
__device__ __forceinline__ unsigned xb_ld(unsigned* p)              { return __hip_atomic_load(p, __ATOMIC_RELAXED, __HIP_MEMORY_SCOPE_AGENT); }
__device__ __forceinline__ unsigned xb_add(unsigned* p, unsigned v) { return __hip_atomic_fetch_add(p, v, __ATOMIC_RELAXED, __HIP_MEMORY_SCOPE_AGENT); }
__device__ __forceinline__ unsigned xb_xcc_id() { return (unsigned)__builtin_amdgcn_s_getreg((3 << 11) | 20) & 0xFu; }
#define XB_SPIN(cond, bar) do { unsigned _sp = 0; while (cond) { __builtin_amdgcn_s_sleep(1); \
    if ((++_sp & 255u) == 0u) { if (xb_ld(&(bar)[XB_TMO])) break; if (_sp > XB_SPIN_CAP) { atomicAdd(&(bar)[XB_TMO], 1u); break; } } } } while (0)
struct XcdBarrier { unsigned* bar; unsigned x; volatile LAS unsigned* st; unsigned members; };
__device__ __forceinline__ XcdBarrier xcd_barrier_post(unsigned* bar, volatile LAS unsigned* st, unsigned members) {
    XcdBarrier b; b.bar = bar; b.x = xb_xcc_id(); b.st = st; b.members = members;
    if (threadIdx.x == 0) (void)xb_add(&bar[XB_XCNT(b.x)], 1u);
    return b;
}
__device__ __forceinline__ void xcd_barrier_complete(unsigned* bar, unsigned x, unsigned& nloc, unsigned& nx, const unsigned G) {
    unsigned sum, cnt, mine, sp = 0u;
    for (;;) {
        sum = 0u; cnt = 0u; mine = 0u;
#pragma unroll
        for (unsigned j = 0; j < 16; ++j) { const unsigned c = xb_ld(&bar[XB_XCNT(j)]); sum += c; cnt += (c > 0u) ? 1u : 0u; mine = (j == x) ? c : mine; }
        if (sum == G) break;
        __builtin_amdgcn_s_sleep(1);
        if ((++sp & 255u) == 0u) { if (xb_ld(&bar[XB_TMO])) break; if (sp > XB_SPIN_CAP) { atomicAdd(&bar[XB_TMO], 1u); break; } }
    }
    nloc = mine > 0u ? mine : 1u; nx = cnt > 0u ? cnt : 1u;
}
__device__ __forceinline__ void xcd_barrier(const XcdBarrier& b) {
    asm volatile("s_waitcnt vmcnt(0)" ::: "memory");
    __syncthreads();
    if (threadIdx.x == 0) {
        unsigned* bar = b.bar;
        __builtin_amdgcn_s_waitcnt(0);
        unsigned nloc = b.st[0], nx = b.st[1];
        if (nloc == 0u) { xcd_barrier_complete(bar, b.x, nloc, nx, b.members); b.st[0] = nloc; b.st[1] = nx; }
        const unsigned old = xb_add(&bar[XB_XSUB(b.x)], 1u);
        const unsigned gen = old / nloc;
        if (old + 1u == (gen + 1u) * nloc) {
            __builtin_amdgcn_fence(__ATOMIC_RELEASE, "agent");
            asm volatile("s_waitcnt vmcnt(0)" ::: "memory");
            const unsigned og = xb_add(&bar[XB_TOP], 1u);
            const unsigned tg = og / nx;
            if (og + 1u == (tg + 1u) * nx) xb_add(&bar[XB_TOPGEN], 1u);
            else XB_SPIN(xb_ld(&bar[XB_TOPGEN]) == tg, bar);
            __builtin_amdgcn_fence(__ATOMIC_ACQUIRE, "agent");
            xb_add(&bar[XB_XGEN(b.x)], 1u);
            asm volatile("s_waitcnt vmcnt(0)" ::: "memory");
        } else {
            XB_SPIN(xb_ld(&bar[XB_XGEN(b.x)]) == gen, bar);
            __builtin_amdgcn_fence(__ATOMIC_ACQUIRE, "agent");
            asm volatile("s_waitcnt vmcnt(0)" ::: "memory");
        }
    }
    __syncthreads();
}

namespace pg8 {
constexpr int BM = 256, BK = 64, HALF = 128, HTB = HALF * BK * 2, STAGE_BYTES = 8 * HTB, NXCD = 8, WGM = 8;
__host__ __device__ __forceinline__ int lds_byte(int r, int c) { const int st = (r >> 4) * 2 + (c >> 5), rr = r & 15, cc = c & 31, ob = rr * 64 + cc * 2; return st * 1024 + (ob ^ (((ob >> 9) & 1) << 5)); }
__host__ __device__ __forceinline__ void stage_rc(int b, int& R, int& C) { const int st = b / 1024, sb = b % 1024, swz = sb ^ (((sb >> 9) & 1) << 5); R = (st >> 1) * 16 + swz / 64; C = (st & 1) * 32 + (swz % 64) / 2; }
__host__ __device__ __forceinline__ int perm32(int rho) { const int n = rho >> 4, i = rho & 15; return 8 * (i >> 2) + 4 * n + (i & 3); }

struct Unit { int pm, pn, e, ks, ar; };

struct Order {
    int nM, nN, nwg, G, c, nx, use_ar; const char* A; const char* B; size_t tstep, estride; const int* tile_e; const LAS int* tile_l = nullptr;
    __device__ __forceinline__ void init(int nM_, int nN_, int KB, int G_, int c_, const void* A_, const void* B_, size_t estride_, const int* tile_e_, int nx_ = NXCD, int use_ar_ = 0) {
        use_ar = use_ar_; nM = nM_; nN = nN_; nwg = nM * nN; G = G_; c = c_; nx = nx_; A = (const char*)A_; B = (const char*)B_; tstep = (size_t)BM * KB; estride = estride_; tile_e = tile_e_; }
    __device__ __forceinline__ bool next(int i, Unit& u) const {
        const long L = (long)i * G + c; if (L >= nwg) return false;
        int wgid = (int)L; { const int q = nwg / nx, r = nwg % nx, xcd = wgid % nx, off = wgid / nx; wgid = (xcd < r ? xcd * (q + 1) : r * (q + 1) + (xcd - r) * q) + off; }
        const int nig = WGM * nN, gid = wgid / nig, fm = gid * WGM, gsz = (nM - fm) < WGM ? (nM - fm) : WGM;
        u.pm = fm + ((wgid % nig) % gsz); u.pn = (wgid % nig) / gsz; const int v = tile_l ? tile_l[u.pm] : (tile_e ? tile_e[u.pm] : 0); u.e = v & 15; u.ar = use_ar ? (v >> 4) : u.pm; u.ks = 0; return true;
    }
    __device__ __forceinline__ const char* a_base(const Unit& u) const { return A + (size_t)u.ar * tstep; }
    __device__ __forceinline__ const char* b_base(const Unit& u) const { return B + (size_t)u.e * estride + (size_t)u.pn * tstep; }
};

struct TailOrder {
    int nsub, G, c, pm0, NS; const char* A; const char* B; size_t tstep, estride, kslice; const int* tile_e; const LAS int* tile_l = nullptr;
    __device__ __forceinline__ bool next(int i, Unit& u) const { const int L = i * G + c; if (L >= nsub) return false; const int per = 8 * NS; u.pm = pm0 + L / per; const int rem = L % per; u.pn = rem / NS; u.ks = rem % NS; u.e = (tile_l ? tile_l[u.pm] : tile_e[u.pm]) & 15; u.ar = u.pm; return true; }
    __device__ __forceinline__ const char* a_base(const Unit& u) const { return A + (size_t)u.pm * tstep + (size_t)u.ks * kslice; }
    __device__ __forceinline__ const char* b_base(const Unit& u) const { return B + (size_t)u.e * estride + (size_t)u.pn * tstep + (size_t)u.ks * kslice; }
};

template <bool SCALE, bool BOUND = false> struct EpiBf16Out {
    static constexpr bool PERM = true;
    bf16_t* O; int ldc; const u64* ss; float csc; unsigned* bnd; int pm0;
    __device__ __forceinline__ void operator()(const f32x4 (&acc)[2][2][4][2], const Unit& u, int wr, int wc, int fr, int fq) const {
        const int row0 = u.pm * BM + wr * 64 + fr, col0 = u.pn * BM + wc * 32 + 8 * fq; float mx[2] = {0.f, 0.f};
        u64 ssv[2][4];
#pragma unroll
        for (int ai = 0; ai < 2; ++ai)
#pragma unroll
            for (int m = 0; m < 4; ++m) ssv[ai][m] = SCALE ? ss[row0 + ai * HALF + m * 16] : 0ull;
#pragma unroll
        for (int ai = 0; ai < 2; ++ai)
#pragma unroll
            for (int m = 0; m < 4; ++m) { const int row = row0 + ai * HALF + m * 16; float rs = csc; if (SCALE) rs = rstd_q(ssv[ai][m]);
                bf16_t* rowp = O + (size_t)row * ldc + col0;
#pragma unroll
                for (int bj = 0; bj < 2; ++bj) { const f32x4 v0 = acc[ai][bj][m][0] * rs, v1 = acc[ai][bj][m][1] * rs;
                    u32x4 w; w.x = cvt_pk_bf16(v0[0], v0[1]); w.y = cvt_pk_bf16(v0[2], v0[3]); w.z = cvt_pk_bf16(v1[0], v1[1]); w.w = cvt_pk_bf16(v1[2], v1[3]);
                    *(u32x4*)(rowp + bj * HALF) = w;
                    if (BOUND) { float sq = ((v0[0] * v0[0] + v0[1] * v0[1]) + (v0[2] * v0[2] + v0[3] * v0[3])) + ((v1[0] * v1[0] + v1[1] * v1[1]) + (v1[2] * v1[2] + v1[3] * v1[3]));
                        sq = sum_xor32(sum_xor16(sq)); mx[bj] = __builtin_fmaxf(mx[bj], sq); } } }
        if (BOUND) {
#pragma unroll
            for (int bj = 0; bj < 2; ++bj) { const float v = row_max16(mx[bj]);
                if (fr == 0 && fq == 0) __hip_atomic_fetch_max(bnd + ((size_t)(2 * u.pn + bj) * 64 + u.pm + pm0) * 4 + wc, __float_as_uint(v), __ATOMIC_RELAXED, __HIP_MEMORY_SCOPE_AGENT); } }
    }
};
__device__ __forceinline__ float clamp448(float x) { return __builtin_fminf(__builtin_fmaxf(x, -448.0f), 448.0f); }
__device__ __forceinline__ unsigned pk4_fp8(float a, float b, float c, float d) { int v = __builtin_amdgcn_cvt_pk_fp8_f32(clamp448(a), clamp448(b), 0, false); v = __builtin_amdgcn_cvt_pk_fp8_f32(clamp448(c), clamp448(d), v, true); return (unsigned)v; }
__device__ __forceinline__ float silu_mul(float g, float u) { return g * __builtin_amdgcn_rcpf(1.0f + __builtin_amdgcn_exp2f(-1.4426950408889634f * g)) * u; }
__device__ __forceinline__ float silu_mul_c(float g, float u, float c1, float c2) { return (g * u) * (c2 * __builtin_amdgcn_rcpf(1.0f + __builtin_amdgcn_exp2f(g * c1))); }
typedef float f32x2 __attribute__((ext_vector_type(2)));
__device__ __forceinline__ f32x2 silu_mul2(f32x2 g, f32x2 u, float c1, float k) {
    const f32x2 t = g * c1; f32x2 e; e.x = __builtin_amdgcn_exp2f(t.x); e.y = __builtin_amdgcn_exp2f(t.y);
    const f32x2 d = e * k + k; f32x2 r; r.x = __builtin_amdgcn_rcpf(d.x); r.y = __builtin_amdgcn_rcpf(d.y);
    return (g * u) * r;
}
__device__ __forceinline__ f32x4 silu_mul4(f32x4 g, f32x4 u, float c1, float k) { const f32x2 a = silu_mul2(g.xy, u.xy, c1, k), b = silu_mul2(g.zw, u.zw, c1, k); return (f32x4){a.x, a.y, b.x, b.y}; }
template <bool RAW> struct EpiSwiGLU {
    static constexpr bool PERM = true;
    bf16_t* O; int ldc; const void* rsrc;
    __device__ __forceinline__ void operator()(const f32x4 (&acc)[2][2][4][2], const Unit& u, int wr, int wc, int fr, int fq) const {
        const int row0 = u.pm * BM + wr * 64 + fr, col0 = u.pn * HALF + wc * 32 + 8 * fq;
        float rsv[2][4];
#pragma unroll
        for (int ai = 0; ai < 2; ++ai)
#pragma unroll
            for (int m = 0; m < 4; ++m) { const int row = row0 + ai * HALF + m * 16; if (RAW) rsv[ai][m] = ((const float*)rsrc)[row]; else rsv[ai][m] = rstd_q(((const u64*)rsrc)[row]); }
#pragma unroll
        for (int ai = 0; ai < 2; ++ai)
#pragma unroll
            for (int m = 0; m < 4; ++m) { const int row = row0 + ai * HALF + m * 16; const float rs = rsv[ai][m];
                const float c1 = -1.4426950408889634f * rs, kk = __builtin_amdgcn_rcpf(rs * rs);
                const f32x4 a0 = silu_mul4(acc[ai][0][m][0], acc[ai][1][m][0], c1, kk), a1 = silu_mul4(acc[ai][0][m][1], acc[ai][1][m][1], c1, kk);
                u32x4 w; w.x = cvt_pk_bf16(a0[0], a0[1]); w.y = cvt_pk_bf16(a0[2], a0[3]); w.z = cvt_pk_bf16(a1[0], a1[1]); w.w = cvt_pk_bf16(a1[2], a1[3]);
                *(u32x4*)(O + (size_t)row * ldc + col0) = w; }
    }
};
struct EpiSwiGLU8 {
    static constexpr bool PERM = true;
    unsigned char* O; int ldc; float isc, osc; int skip;
    __device__ __forceinline__ void operator()(const f32x4 (&acc)[2][2][4][2], const Unit& u, int wr, int wc, int fr, int fq) const {
        if (skip) return;
        const int row0 = u.pm * BM + wr * 64 + fr, col0 = u.pn * HALF + wc * 32 + 8 * fq; const float c1 = -1.4426950408889634f * isc, kk = 1.0f / (isc * isc * osc);
#pragma unroll
        for (int ai = 0; ai < 2; ++ai)
#pragma unroll
            for (int m = 0; m < 4; ++m) { const int row = row0 + ai * HALF + m * 16;
                const f32x4 a0 = silu_mul4(acc[ai][0][m][0], acc[ai][1][m][0], c1, kk), a1 = silu_mul4(acc[ai][0][m][1], acc[ai][1][m][1], c1, kk);
                u32x2 w; w.x = pk4_fp8(a0[0], a0[1], a0[2], a0[3]); w.y = pk4_fp8(a1[0], a1[1], a1[2], a1[3]);
                *(u32x2*)(O + (size_t)row * ldc + col0) = w; }
    }
};
struct EpiPart {
    static constexpr bool PERM = false;
    float* slab; int row_base; size_t ks_stride;
    __device__ __forceinline__ void operator()(const f32x4 (&acc)[2][2][4][2], const Unit& u, int wr, int wc, int fr, int fq) const {
        const int row0 = u.pm * BM + wr * 64 + fr - row_base, col0 = u.pn * BM + wc * 32 + 4 * fq; float* sp = slab + (size_t)u.ks * ks_stride;
#pragma unroll
        for (int ai = 0; ai < 2; ++ai)
#pragma unroll
            for (int m = 0; m < 4; ++m) { float* rowp = sp + (size_t)(row0 + ai * HALF + m * 16) * DM + col0;
#pragma unroll
                for (int bj = 0; bj < 2; ++bj)
#pragma unroll
                    for (int n = 0; n < 2; ++n) *(f32x4*)(rowp + bj * HALF + n * 16) = acc[ai][bj][m][n]; }
    }
};
template <bool BASE_BF16, bool WRITE_F32> struct EpiResid {
    static constexpr bool PERM = true;
    const void* base; float* xr; bf16_t* xb; u64* ssout;
    __device__ __forceinline__ void operator()(const f32x4 (&acc)[2][2][4][2], const Unit& u, int wr, int wc, int fr, int fq) const {
        const int row0 = u.pm * BM + wr * 64 + fr, col0 = u.pn * BM + wc * 32 + 8 * fq;
#pragma unroll
        for (int ai = 0; ai < 2; ++ai) { u32x4 qv[4][2];
            if (BASE_BF16) {
#pragma unroll
                for (int m = 0; m < 4; ++m)
#pragma unroll
                    for (int bj = 0; bj < 2; ++bj) qv[m][bj] = *(const u32x4*)((const bf16_t*)base + (size_t)(row0 + ai * HALF + m * 16) * DM + col0 + bj * HALF); }
#pragma unroll
            for (int m = 0; m < 4; ++m) { const int row = row0 + ai * HALF + m * 16; const size_t off = (size_t)row * DM + col0; float s = 0.f;
#pragma unroll
                for (int bj = 0; bj < 2; ++bj) { const int c = bj * HALF; f32x4 b0, b1;
                    if (BASE_BF16) { const u32x4 q = qv[m][bj];
                        b0 = (f32x4){__uint_as_float(q.x << 16), __uint_as_float(q.x & 0xffff0000u), __uint_as_float(q.y << 16), __uint_as_float(q.y & 0xffff0000u)};
                        b1 = (f32x4){__uint_as_float(q.z << 16), __uint_as_float(q.z & 0xffff0000u), __uint_as_float(q.w << 16), __uint_as_float(q.w & 0xffff0000u)}; }
                    else { b0 = *(const f32x4*)((const float*)base + off + c); b1 = *(const f32x4*)((const float*)base + off + c + 4); }
                    const f32x4 o0 = b0 + acc[ai][bj][m][0], o1 = b1 + acc[ai][bj][m][1];
                    if (WRITE_F32) { *(f32x4*)(xr + off + c) = o0; *(f32x4*)(xr + off + c + 4) = o1; }
                    u32x4 w; w.x = cvt_pk_bf16(o0[0], o0[1]); w.y = cvt_pk_bf16(o0[2], o0[3]); w.z = cvt_pk_bf16(o1[0], o1[1]); w.w = cvt_pk_bf16(o1[2], o1[3]); *(u32x4*)(xb + off + c) = w;
                    s += (o0[0] * o0[0] + o0[1] * o0[1]) + (o0[2] * o0[2] + o0[3] * o0[3]); s += (o1[0] * o1[0] + o1[1] * o1[1]) + (o1[2] * o1[2] + o1[3] * o1[3]); }
                s = sum_xor32(sum_xor16(s));
                if (fq == 0) __hip_atomic_fetch_add(ssout + row, ss_fix(s), __ATOMIC_RELAXED, __HIP_MEMORY_SCOPE_AGENT); } }
    }
};

typedef int i32x8 __attribute__((ext_vector_type(8)));
__device__ __forceinline__ i32x8 cat16(bf16x8 lo, bf16x8 hi) { typedef int i32x4 __attribute__((ext_vector_type(4))); const i32x4 a = __builtin_bit_cast(i32x4, lo), b = __builtin_bit_cast(i32x4, hi); return (i32x8){a[0], a[1], a[2], a[3], b[0], b[1], b[2], b[3]}; }
__device__ __forceinline__ void mfma_fp8(f32x4& acc, i32x8 a, i32x8 b) { asm volatile("v_mfma_f32_16x16x128_f8f6f4 %0, %1, %2, %0" : "+v"(acc) : "v"(a), "v"(b)); }
template <class Epi, bool ALIGN_EPI, bool SP2, bool FP8 = false, class Sched = Order>
__device__ __forceinline__ void gemm_phase(LAS unsigned char* lds, const int KB, const Sched& S, const Epi& E, const int nt_override = 0, volatile LAS unsigned* prb = nullptr) {
    unsigned long long pk_ = 0, pg_ = 0, pl_ = 0; unsigned pnk_ = 0, png_ = 0;
#define PG8_STAMP(x) do { if (prb) { asm volatile("s_memtime %0\n\ts_waitcnt lgkmcnt(0)" : "=s"(x) :: "memory"); } } while (0)
    int tid_ = threadIdx.x; asm volatile("" : "+v"(tid_));
    const int tid = tid_, wid = __builtin_amdgcn_readfirstlane(tid >> 6), lane = tid & 63, wr = wid >> 2, wc = wid & 3, fr = lane & 15, fq = lane >> 4;
    const int nt = nt_override ? nt_override : KB / 128;
    unsigned voffA[2], voffB[2];
#pragma unroll
    for (int i = 0; i < 2; ++i) { int R, C; stage_rc(tid * 16 + i * 8192, R, C); const int Rb = Epi::PERM ? ((R & ~31) + perm32(R & 31)) : R;
        voffA[i] = (unsigned)(R * KB + C * 2); voffB[i] = (unsigned)(Rb * KB + C * 2); }
    const size_t kstep = (size_t)(BK * 2);
    const size_t hstep = (size_t)HALF * KB;
    const unsigned ldsw = (unsigned)wid * 1024u;
    const int aoff = lds_byte(wr * 64 + fr, fq * 8), boff = lds_byte(wc * 32 + fr, fq * 8);
#define PG8_SA(b, h) (((b) * 2 + (h)) * HTB)
#define PG8_SB(b, h) ((4 + (b) * 2 + (h)) * HTB)
#define PG8_STAGE(bufoff, gbase, voff) do { _Pragma("unroll") for (int _i = 0; _i < 2; ++_i) \
        __builtin_amdgcn_global_load_lds((const unsigned*)((const char*)(gbase) + (voff)[_i]), (LAS unsigned*)(lds + (bufoff) + ldsw + _i * 8192), 16, 0, 0); } while (0)
#define PG8_LDA(dst, b, h) do { _Pragma("unroll") for (int m = 0; m < 4; ++m) _Pragma("unroll") for (int k = 0; k < 2; ++k) dst[m][k] = *(const LAS bf16x8*)(lds + PG8_SA(b, h) + aoff + m * 2048 + k * 1024); } while (0)
#define PG8_LDB(dst, b, h) do { _Pragma("unroll") for (int n = 0; n < 2; ++n) _Pragma("unroll") for (int k = 0; k < 2; ++k) dst[n][k] = *(const LAS bf16x8*)(lds + PG8_SB(b, h) + boff + n * 2048 + k * 1024); } while (0)
#define PG8_MMA(ai, bj, At, Bt) do { __builtin_amdgcn_s_setprio(1); _Pragma("unroll") for (int m = 0; m < 4; ++m) _Pragma("unroll") for (int n = 0; n < 2; ++n) { \
        if constexpr (FP8) mfma_fp8(acc[ai][bj][m][n], cat16(Bt[n][0], Bt[n][1]), cat16(At[m][0], At[m][1])); \
        else { _Pragma("unroll") for (int k = 0; k < 2; ++k) acc[ai][bj][m][n] = __builtin_amdgcn_mfma_f32_16x16x32_bf16(Bt[n][k], At[m][k], acc[ai][bj][m][n], 0, 0, 0); } } \
        __builtin_amdgcn_s_setprio(0); } while (0)
#define PG8_WAIT_V(n) asm volatile("s_waitcnt vmcnt(" #n ")" ::: "memory")
#define PG8_WAIT_L(n) asm volatile("s_waitcnt lgkmcnt(" #n ")" ::: "memory")
#define PG8_BAR __builtin_amdgcn_s_barrier()
#define PG8_SCHED __builtin_amdgcn_sched_barrier(0)
    Unit cur, nxt; int ui = 0;
    if (!S.next(0, cur)) return;
    f32x4 acc[2][2][4][2];
#pragma unroll
    for (int a = 0; a < 2; ++a)
#pragma unroll
        for (int b = 0; b < 2; ++b)
#pragma unroll
            for (int m = 0; m < 4; ++m)
#pragma unroll
                for (int n = 0; n < 2; ++n) acc[a][b][m][n] = (f32x4){0.f, 0.f, 0.f, 0.f};
    bf16x8 At[4][2], B0[2][2], B1[2][2];
    const char* cA = S.a_base(cur); const char* cB = S.b_base(cur);
    if constexpr (SP2) {
        PG8_STAGE(PG8_SB(0, 0), cB, voffB); PG8_STAGE(PG8_SB(0, 1), cB + hstep, voffB); PG8_STAGE(PG8_SA(0, 0), cA, voffA); PG8_STAGE(PG8_SA(0, 1), cA + hstep, voffA);
        if (wr == 1) PG8_BAR;
        PG8_WAIT_V(2); PG8_BAR;
        PG8_STAGE(PG8_SB(1, 0), cB + kstep, voffB); PG8_STAGE(PG8_SA(1, 0), cA + kstep, voffA); PG8_STAGE(PG8_SB(1, 1), cB + hstep + kstep, voffB);
        PG8_WAIT_V(6); PG8_BAR;
    } else {
        PG8_STAGE(PG8_SB(0, 0), cB, voffB); PG8_STAGE(PG8_SA(0, 0), cA, voffA); PG8_STAGE(PG8_SB(0, 1), cB + hstep, voffB); PG8_STAGE(PG8_SA(0, 1), cA + hstep, voffA);
        if (wr == 1) PG8_BAR;
        PG8_WAIT_V(4); PG8_BAR;
        PG8_STAGE(PG8_SB(1, 0), cB + kstep, voffB); PG8_STAGE(PG8_SA(1, 0), cA + kstep, voffA); PG8_STAGE(PG8_SB(1, 1), cB + hstep + kstep, voffB);
        PG8_WAIT_V(6); PG8_BAR;
    }
    for (;;) {
        const bool has_next = S.next(ui + 1, nxt);
        const char* nA = has_next ? S.a_base(nxt) : cA; const char* nB = has_next ? S.b_base(nxt) : cB;
        { unsigned long long ts_; PG8_STAMP(ts_); if (prb && pl_) { pg_ += ts_ - pl_; ++png_; } pl_ = ts_; }
        for (int t = 0; t < nt; t += 2) {
            const bool last = (t == nt - 2);
            const char* a1 = cA + (size_t)(t + 1) * kstep;
            const char* a2 = last ? nA : cA + (size_t)(t + 2) * kstep; const char* b2 = last ? nB : cB + (size_t)(t + 2) * kstep;
            const char* a3 = a2 + kstep; const char* b3 = b2 + kstep;
            if constexpr (SP2) {
            PG8_LDB(B0, 0, 0); PG8_LDB(B1, 0, 1); PG8_SCHED; PG8_LDA(At, 0, 0); PG8_STAGE(PG8_SA(1, 1), a1 + hstep, voffA);
            PG8_WAIT_V(8); PG8_WAIT_L(0); PG8_BAR; PG8_MMA(0, 0, At, B0); PG8_MMA(0, 1, At, B1); PG8_BAR; PG8_SCHED;
            PG8_LDA(At, 0, 1); PG8_STAGE(PG8_SB(0, 0), b2, voffB); PG8_STAGE(PG8_SB(0, 1), b2 + hstep, voffB); PG8_STAGE(PG8_SA(0, 0), a2, voffA);
            PG8_WAIT_V(8); PG8_WAIT_L(0); PG8_BAR; PG8_MMA(1, 0, At, B0); PG8_MMA(1, 1, At, B1); PG8_BAR; PG8_SCHED;
            PG8_LDB(B0, 1, 0); PG8_LDB(B1, 1, 1); PG8_SCHED; PG8_LDA(At, 1, 0); PG8_STAGE(PG8_SA(0, 1), a2 + hstep, voffA);
            PG8_WAIT_V(8); PG8_WAIT_L(0); PG8_BAR; PG8_MMA(0, 0, At, B0); PG8_MMA(0, 1, At, B1); PG8_BAR; PG8_SCHED;
            PG8_LDA(At, 1, 1); PG8_STAGE(PG8_SB(1, 0), b3, voffB); PG8_STAGE(PG8_SB(1, 1), b3 + hstep, voffB); PG8_STAGE(PG8_SA(1, 0), a3, voffA);
            PG8_WAIT_V(8); PG8_WAIT_L(0); PG8_BAR; PG8_MMA(1, 0, At, B0); PG8_MMA(1, 1, At, B1); PG8_BAR; PG8_SCHED;
            } else {
            PG8_LDB(B0, 0, 0); PG8_SCHED; PG8_LDA(At, 0, 0); PG8_STAGE(PG8_SA(1, 1), a1 + hstep, voffA);
            PG8_WAIT_L(8); PG8_BAR; PG8_WAIT_L(0); PG8_MMA(0, 0, At, B0); PG8_BAR; PG8_SCHED;
            PG8_LDB(B1, 0, 1); PG8_STAGE(PG8_SB(0, 0), b2, voffB);
            PG8_BAR; PG8_WAIT_L(0); PG8_MMA(0, 1, At, B1); PG8_BAR;
            PG8_LDA(At, 0, 1); PG8_STAGE(PG8_SA(0, 0), a2, voffA);
            PG8_BAR; PG8_WAIT_L(0); PG8_MMA(1, 0, At, B0); PG8_BAR; PG8_SCHED;
            PG8_STAGE(PG8_SB(0, 1), b2 + hstep, voffB);
            PG8_WAIT_V(6); PG8_BAR; PG8_MMA(1, 1, At, B1); PG8_BAR;
            PG8_LDB(B0, 1, 0); PG8_SCHED; PG8_LDA(At, 1, 0); PG8_STAGE(PG8_SA(0, 1), a2 + hstep, voffA);
            PG8_WAIT_L(8); PG8_BAR; PG8_WAIT_L(0); PG8_MMA(0, 0, At, B0); PG8_BAR; PG8_SCHED;
            PG8_LDB(B1, 1, 1); PG8_STAGE(PG8_SB(1, 0), b3, voffB);
            PG8_BAR; PG8_WAIT_L(0); PG8_MMA(0, 1, At, B1); PG8_BAR;
            PG8_LDA(At, 1, 1); PG8_STAGE(PG8_SA(1, 0), a3, voffA);
            PG8_BAR; PG8_WAIT_L(0); PG8_MMA(1, 0, At, B0); PG8_BAR; PG8_SCHED;
            PG8_STAGE(PG8_SB(1, 1), b3 + hstep, voffB);
            PG8_WAIT_V(6); PG8_BAR; PG8_MMA(1, 1, At, B1); PG8_BAR;
            }
        }
        { unsigned long long ts_; PG8_STAMP(ts_); if (prb) { pk_ += ts_ - pl_; pnk_ += (unsigned)nt; pl_ = ts_; } }
        if constexpr (FP8) asm volatile("s_nop 15\n\ts_nop 15" ::: "memory");
        if constexpr (ALIGN_EPI) { if (wr == 0) PG8_BAR; }
        E(acc, cur, wr, wc, fr, fq);
        if (!has_next) break;
#pragma unroll
        for (int a = 0; a < 2; ++a)
#pragma unroll
            for (int b = 0; b < 2; ++b)
#pragma unroll
                for (int m = 0; m < 4; ++m)
#pragma unroll
                    for (int n = 0; n < 2; ++n) acc[a][b][m][n] = (f32x4){0.f, 0.f, 0.f, 0.f};
        cur = nxt; cA = nA; cB = nB; ++ui;
        if constexpr (ALIGN_EPI) { if (wr == 1) PG8_BAR; }
    }
    PG8_WAIT_V(0);
    if constexpr (!ALIGN_EPI) { if (wr == 0) PG8_BAR; }
    PG8_BAR;
    if (prb && blockIdx.x == 0 && tid == 0) { if (PROBE_KIND == 4) prb[20] = (unsigned)((pk_ / (pnk_ ? pnk_ : 1u)) * 100ull); if (PROBE_KIND == 5) prb[20] = (unsigned)((pg_ / (png_ ? png_ : 1u)) * 10ull); }
#undef PG8_STAMP
#undef PG8_SA
#undef PG8_SB
#undef PG8_STAGE
#undef PG8_LDA
#undef PG8_LDB
#undef PG8_MMA
#undef PG8_WAIT_V
#undef PG8_WAIT_L
#undef PG8_BAR
#undef PG8_SCHED
}
}
constexpr bool GEMM_SP2 = true, GEMM_ALIGN = true;

namespace att {
constexpr int D = 128, LDQ = NQKV, LDO = DM;
constexpr float SCALE = 0.08838834764831845f, THR = 8.f;
constexpr int NW = 8, QBLK = 32, KVBLK = 64, QB = NW * QBLK;
constexpr int SHM_V = KVBLK * D * 2, SHM_K = KVBLK * D * 2;
constexpr int LDS_ATT = 2 * SHM_V + 2 * SHM_K + NW * 64 * 4;
constexpr unsigned BIGW = 0x40000000u;
#define KSWZ(row, colB) ((row) * 256 + ((colB) ^ (((row) & 7) << 4)))
#define SBAR() __builtin_amdgcn_sched_barrier(0)
__device__ __forceinline__ int v_st(int k, int c) { const int kk = (k & ~0xC) | ((k & 4) << 1) | ((k & 8) >> 1); return ((kk >> 3) * 4 + (c >> 5)) * 512 + ((kk & 7) * 32 + (c & 31)) * 2; }
__device__ __forceinline__ int v_rd_base(int lane) { return ((lane & 3) << 3) | (((lane >> 2) & 3) << 6) | (((lane >> 4) & 1) << 5) | (((lane >> 5) & 1) << 8); }
constexpr int v_rd_off(int d0, int ks, int half) { return d0 * 512 + ks * 4096 + half * 2048; }
__device__ __forceinline__ int crow(int r, int hi) { return (r & 3) + 8 * (r >> 2) + 4 * hi; }
__device__ __forceinline__ bf16x8 ld8(const bf16_t* p) { return *reinterpret_cast<const bf16x8*>(p); }
__device__ __forceinline__ void mask_tile(f32x16& p0, f32x16& p1, int dq) {
    const float NEG = -__builtin_inff();
#pragma unroll
    for (int r = 0; r < 16; ++r) {
        const int c = (r & 3) + 8 * (r >> 2);
        if ((unsigned)(dq - c) >= BIGW) p0[r] = NEG;
        if ((unsigned)(dq - c - 32) >= BIGW) p1[r] = NEG;
    }
}
__device__ __forceinline__ void mask_lane(f32x16& p0, f32x16& p1, bool keep) {
    const float NEG = -__builtin_inff();
#pragma unroll
    for (int r = 0; r < 16; ++r) { p0[r] = keep ? p0[r] : NEG; p1[r] = keep ? p1[r] : NEG; }
}
__device__ __forceinline__ void partialSM(f32x16& p0, f32x16& p1, float& m_reg, float& mn, float& alpha) {
    float pmax = p0[0]; for (int r = 1; r < 16; ++r) pmax = fmaxf(pmax, p0[r]); for (int r = 0; r < 16; ++r) pmax = fmaxf(pmax, p1[r]);
    { auto rr = __builtin_amdgcn_permlane32_swap(__float_as_uint(pmax), __float_as_uint(pmax), false, false);
      pmax = fmaxf(__uint_as_float(rr[0]), __uint_as_float(rr[1])); }
    constexpr float C2 = 1.4426950408889634f * SCALE;
    if (__builtin_expect(__all((pmax - m_reg) * SCALE <= THR), 1)) { mn = m_reg; alpha = 1.f; }
    else { mn = fmaxf(m_reg, pmax); alpha = __builtin_amdgcn_exp2f((m_reg - mn) * C2); m_reg = mn; }
    const float mnL = -mn * C2;
    for (int r = 0; r < 16; ++r) p0[r] = fmaf(p0[r], C2, mnL); for (int r = 0; r < 16; ++r) p1[r] = fmaf(p1[r], C2, mnL);
    for (int r = 0; r < 16; ++r) p0[r] = __builtin_amdgcn_exp2f(p0[r]);
}
__device__ __forceinline__ void finishSM(f32x16& p0, f32x16& p1, float alpha, float& l_reg, bf16x8& pa0, bf16x8& pa1, bf16x8& pa2, bf16x8& pa3) {
    for (int r = 0; r < 16; ++r) p1[r] = __builtin_amdgcn_exp2f(p1[r]);
    float ps = 0; for (int r = 0; r < 16; ++r) ps += p0[r]; for (int r = 0; r < 16; ++r) ps += p1[r];
    { auto rr = __builtin_amdgcn_permlane32_swap(__float_as_uint(ps), __float_as_uint(ps), false, false);
      ps = __uint_as_float(rr[0]) + __uint_as_float(rr[1]); }
    l_reg = l_reg * alpha + ps;
#define PK4(P, B_, OUT) do { unsigned a0 = cvt_pk_bf16(P[B_+0], P[B_+1]), a1 = cvt_pk_bf16(P[B_+2], P[B_+3]);                          \
        unsigned b0 = cvt_pk_bf16(P[B_+4], P[B_+5]), b1 = cvt_pk_bf16(P[B_+6], P[B_+7]);                                             \
        auto r0 = __builtin_amdgcn_permlane32_swap(a0, b0, false, false); auto r1 = __builtin_amdgcn_permlane32_swap(a1, b1, false, false); \
        u32x4 w = {r0[0], r1[0], r0[1], r1[1]}; OUT = *reinterpret_cast<bf16x8*>(&w); } while (0)
    PK4(p0, 0, pa0); PK4(p0, 8, pa1); PK4(p1, 0, pa2); PK4(p1, 8, pa3);
#undef PK4
}
template <int KB>
__device__ __forceinline__ void qkt(f32x16& p0, f32x16& p1, const char* K_lds, int r32, int hi, const bf16x8* qr, float a, float bias0) {
#pragma unroll
    for (int r = 0; r < 16; ++r) { const float c = (float)((r & 3) + 8 * (r >> 2)); p0[r] = fmaf(a, c, bias0); p1[r] = fmaf(a, c + 32.f, bias0); }
    const char* kb[4];
#pragma unroll
    for (int dd = 0; dd < 4; ++dd) kb[dd] = K_lds + KB * SHM_K + KSWZ(r32, (dd * 16 + hi * 8) * 2);
#pragma unroll
    for (int d0 = 0; d0 < 8; ++d0) { const char* ap = kb[d0 & 3] + (d0 >> 2) * 128;
        bf16x8 b0 = *reinterpret_cast<const bf16x8*>(ap);
        bf16x8 b1 = *reinterpret_cast<const bf16x8*>(ap + 32 * 256);
        p0 = __builtin_amdgcn_mfma_f32_32x32x16_bf16(b0, qr[d0], p0, 0, 0, 0);
        p1 = __builtin_amdgcn_mfma_f32_32x32x16_bf16(b1, qr[d0], p1, 0, 0, 0); }
}
template <int VB>
__device__ __forceinline__ void pv_tile(f32x16* o, int vb0, bf16x8 pa0, bf16x8 pa1, bf16x8 pa2, bf16x8 pa3) {
#define TRRD(dst, off) asm volatile("ds_read_b64_tr_b16 %0, %1 offset:%2" : "=&v"(dst) : "v"(vb0), "i"(off) : "memory")
#define PV_D0(d0) do { s16x4 l0, l1, l2, l3, h0, h1, h2, h3; constexpr int b_ = VB * SHM_V + v_rd_off(d0, 0, 0); \
        TRRD(l0, b_); TRRD(h0, b_ + 2048); TRRD(l1, b_ + 4096); TRRD(h1, b_ + 6144); TRRD(l2, b_ + 8192); TRRD(h2, b_ + 10240); TRRD(l3, b_ + 12288); TRRD(h3, b_ + 14336); \
        asm volatile("s_waitcnt lgkmcnt(0)" ::: "memory"); SBAR();   \
        o[d0] = __builtin_amdgcn_mfma_f32_32x32x16_bf16(pa0, (bf16x8){l0[0], l0[1], l0[2], l0[3], h0[0], h0[1], h0[2], h0[3]}, o[d0], 0, 0, 0);   \
        o[d0] = __builtin_amdgcn_mfma_f32_32x32x16_bf16(pa1, (bf16x8){l1[0], l1[1], l1[2], l1[3], h1[0], h1[1], h1[2], h1[3]}, o[d0], 0, 0, 0);   \
        o[d0] = __builtin_amdgcn_mfma_f32_32x32x16_bf16(pa2, (bf16x8){l2[0], l2[1], l2[2], l2[3], h2[0], h2[1], h2[2], h2[3]}, o[d0], 0, 0, 0);   \
        o[d0] = __builtin_amdgcn_mfma_f32_32x32x16_bf16(pa3, (bf16x8){l3[0], l3[1], l3[2], l3[3], h3[0], h3[1], h3[2], h3[3]}, o[d0], 0, 0, 0); } while (0)
    PV_D0(0); PV_D0(1); PV_D0(2); PV_D0(3);
#undef PV_D0
#undef TRRD
}
struct BlockRef { const bf16_t* Q; const bf16_t* K; const bf16_t* V; bf16_t* O; const unsigned char* sel; int P0; float a; int jlo; };
struct Seam { bf16x8 qr[8]; bf16x8 st_v0, st_v1, st_k0, st_k1; };
#define AROW(p, k0, rr) (((p) + (size_t)((k0) + (rr)) * LDQ) + toff)
#define VMW() asm volatile("s_waitcnt vmcnt(0)" ::: "memory")
#define VMWN(n) asm volatile("s_waitcnt vmcnt(%0)" :: "i"(n) : "memory")
#define SLOAD_H(Kp, Vp, k0) do { S.st_v0 = ld8(AROW(Vp, k0, 0)); S.st_v1 = ld8(AROW(Vp, k0, 32));              \
                         S.st_k0 = ld8(AROW(Kp, k0, 0)); S.st_k1 = ld8(AROW(Kp, k0, 32)); } while (0)
#define SWRITE_HK(bf) do { *(bf16x8*)(K_lds + (bf) * SHM_K + kws) = S.st_k0; *(bf16x8*)(K_lds + (bf) * SHM_K + kws + 32 * 256) = S.st_k1; } while (0)
#define SWRITE_HV(bf) do { *(bf16x8*)(V_lds + (bf) * SHM_V + vst0) = S.st_v0; *(bf16x8*)(V_lds + (bf) * SHM_V + vst1) = S.st_v1; } while (0)
#define SWRITE_H(bf) do { SWRITE_HV(bf); SWRITE_HK(bf); } while (0)
__device__ __forceinline__ int attn_jlo(const unsigned* bnd, int qseg, int kseg, int b, int qb, float slope) {
    float q2 = 0.f, k2 = 0.f;
#pragma unroll
    for (int w = 0; w < 4; ++w) q2 += __uint_as_float(bnd[((size_t)qseg * 64 + b * 8 + qb) * 4 + w]);
    for (int t = 0; t <= qb; ++t) { float s2 = 0.f;
#pragma unroll
        for (int w = 0; w < 4; ++w) s2 += __uint_as_float(bnd[((size_t)kseg * 64 + b * 8 + t) * 4 + w]);
        k2 = __builtin_fmaxf(k2, s2); }
    const float W = (2.0f * 1.02f * __builtin_sqrtf(q2 * k2) * SCALE + 30.0f) / slope, lo = (float)(qb * 256) - W;
    return lo > 0.f ? (int)(lo * (1.0f / 64.0f)) : 0;
}
struct DynCtx { const bf16_t* qkv; bf16_t* out; const unsigned char* sel; const unsigned* bnd; unsigned* qctr; volatile LAS int* nw; int q0, qb0, nq; const LAS int* jt; };
template <bool MOBA> __device__ __forceinline__ BlockRef attn_ref_blk(int code, const DynCtx& C) {
    constexpr int NH = MOBA ? HA : HB * 4, NPB = NH * 8;
    const int b = code / NPB, idx = code % NPB, qb = 7 - idx / NH, hh = NH - 1 - idx % NH; BlockRef r; const size_t t0 = (size_t)b * SEQ;
    if (MOBA) { const int h = hh; const float slope = __builtin_amdgcn_exp2f(-0.5f * (float)(h + 1));
        r.Q = C.qkv + (t0 + qb * 256) * NQKV + h * 128; r.K = C.qkv + t0 * NQKV + DM + h * 128; r.V = C.qkv + t0 * NQKV + 2 * DM + h * 128;
        r.O = C.out + (t0 + qb * 256) * DM + h * 128; r.sel = C.sel + (size_t)(b * HA + h) * SEQ; r.P0 = qb * 256; r.a = slope * (1.0f / SCALE); r.jlo = C.jt[(b - C.qb0) * 128 + h * 8 + qb]; }
    else { const int h = hh >> 2, c = (hh >> 1) & 1, vh = hh & 1; const float slope = __builtin_amdgcn_exp2f(-(float)(h + 1));
        r.Q = C.qkv + (t0 + qb * 256) * NQKV + 2 * DM + h * 256 + c * 128; r.K = C.qkv + t0 * NQKV + h * 256 + c * 128; r.V = C.qkv + t0 * NQKV + DM + h * 256 + vh * 128;
        r.O = C.out + (size_t)c * MTOK * DM + (t0 + qb * 256) * DM + h * 256 + vh * 128; r.sel = nullptr; r.P0 = qb * 256; r.a = slope * (1.0f / SCALE); r.jlo = C.jt[(b - C.qb0) * 128 + (2 * h + c) * 8 + qb]; }
    return r;
}
__device__ __forceinline__ int attn_pull_from(unsigned* qctr, int q0, int k0, int npb, int qb0, int nq) {
    for (int k = k0; k < nq; ++k) { const int q = qb0 + ((q0 - qb0 + k) & (nq - 1)); if (xb_ld(qctr + 64 * q) >= (unsigned)npb) continue;
        const unsigned i = xb_add(qctr + 64 * q, 1u); if (i < (unsigned)npb) return q * npb + (int)i; }
    return -1;
}
__device__ __forceinline__ void attn_prime(const BlockRef& cur, char* lds, Seam& S) {
    int tid_ = threadIdx.x; asm volatile("" : "+v"(tid_));
    const int tid = tid_, wid = __builtin_amdgcn_readfirstlane(tid >> 6), lane = tid & 63, r32 = lane & 31, hi = lane >> 5;
    const int sr = tid >> 4, sc = (tid & 15) * 8, kws = KSWZ(sr, sc * 2); char* K_lds = lds + 2 * SHM_V; const unsigned toff = (unsigned)(sr * LDQ + sc);
    { const unsigned qoff = (unsigned)(r32 * LDQ + hi * 8); const bf16_t* qb_ = cur.Q + (size_t)(wid * QBLK) * LDQ;
      for (int d0 = 0; d0 < 8; ++d0) S.qr[d0] = ld8(qb_ + qoff + d0 * 16); }
    SLOAD_H(cur.K, cur.V, cur.jlo * KVBLK); VMW(); SWRITE_HK(0);
    __syncthreads();
}
template <bool MOBA>
__device__ __forceinline__ int attn_block(const BlockRef& cur, const DynCtx& C, char* lds, Seam& S) {
    int tid_ = threadIdx.x; asm volatile("" : "+v"(tid_));
    const int tid = tid_, wid = __builtin_amdgcn_readfirstlane(tid >> 6), lane = tid & 63, r32 = lane & 31, hi = lane >> 5;
    const int NT = (cur.P0 + QB) / KVBLK - cur.jlo;
    const int qlo = cur.P0 + wid * QBLK, qm = qlo + r32 - 4 * hi;
    char* V_lds = lds; char* K_lds = lds + 2 * SHM_V;
    float* ws = (float*)(lds + 2 * SHM_V + 2 * SHM_K) + wid * 64; float* li_l = ws, * al_l = ws + 32;
    float m_reg = -1e30f, l_reg = 0; f32x16 o[4] = {};
    const int sr = tid >> 4, sc = (tid & 15) * 8, vst0 = v_st(sr, sc), vst1 = v_st(32 + sr, sc), kws = KSWZ(sr, sc * 2); const unsigned toff = (unsigned)(sr * LDQ + sc);
    const int vb0 = (int)(uintptr_t)V_lds + v_rd_base(lane);
    const bf16_t* Kh = cur.K; const bf16_t* Vh = cur.V;
    unsigned selm = 0xffu; if (MOBA) selm = cur.sel[cur.P0 + wid * QBLK + r32];
    const float aa = cur.a, abase = -aa * (float)qm;
#define RESC(a) do { if (__any((a) < 1.f)) { if (hi == 0) al_l[r32] = (a); asm volatile("s_waitcnt lgkmcnt(0)" ::: "memory");              \
                     for (int d_ = 0; d_ < 4; ++d_) for (int r = 0; r < 16; ++r) o[d_][r] *= al_l[crow(r, hi)]; } } while (0)
#define KBASE(t) ((cur.jlo + (t)) * KVBLK)
#define BIAS(t) fmaf(aa, (float)KBASE(t), abase)
#define MASKT(P0_, P1_, t) do { const int kb_ = KBASE(t); \
        if (!MOBA || kb_ >= cur.P0) { if (kb_ + KVBLK - 1 > qlo) mask_tile(P0_, P1_, qm - kb_); } \
        else { const bool keep_ = ((selm >> (kb_ >> 8)) & 1u) != 0u; if (!__all(keep_)) mask_lane(P0_, P1_, keep_); } } while (0)
#define SEAM_K0() do { VMWN(8); SWRITE_HK(0); SBAR(); } while (0)
    f32x16 pA0, pA1, pB0, pB1; float mnA, mnB, alA, alB; bf16x8 pa0, pa1, pa2, pa3;
    SWRITE_HV(0); SBAR();
    if (NT > 1) { SLOAD_H(Kh, Vh, KBASE(1)); }
    constexpr int NPB_ = (MOBA ? HA : HB * 4) * 8; unsigned pi_ = 0u; if (tid == 0) pi_ = xb_add(C.qctr + 64 * C.q0, 1u);
    SBAR(); qkt<0>(pA0, pA1, K_lds, r32, hi, S.qr, aa, BIAS(0));
    MASKT(pA0, pA1, 0); partialSM(pA0, pA1, m_reg, mnA, alA);
    if (NT > 1) { VMW(); SWRITE_H(1); }
    if (tid == 0) *C.nw = pi_ < (unsigned)NPB_ ? C.q0 * NPB_ + (int)pi_ : attn_pull_from(C.qctr, C.q0, 1, NPB_, C.qb0, C.nq);
    __syncthreads();
#define HALF_STEP(PX0, PX1, mnX, alX, PY0, PY1, alY, t, KB, VB, SB) do {                                                      \
        SBAR(); qkt<KB>(PX0, PX1, K_lds, r32, hi, S.qr, aa, BIAS(t));                                                         \
        finishSM(PY0, PY1, alY, l_reg, pa0, pa1, pa2, pa3); SBAR();                                                           \
        if ((t) + 1 < NT) { SLOAD_H(Kh, Vh, KBASE((t) + 1)); SBAR(); }                                                        \
        pv_tile<VB>(o, vb0, pa0, pa1, pa2, pa3); MASKT(PX0, PX1, (t)); partialSM(PX0, PX1, m_reg, mnX, alX);                  \
        __syncthreads();                                                                                                      \
        if ((t) + 1 < NT) { VMW(); SWRITE_H(SB); }                                                                            \
        RESC(alX); __syncthreads(); } while (0)
    for (int t = 1; t + 1 < NT; t += 2) {
        HALF_STEP(pB0, pB1, mnB, alB, pA0, pA1, alA, t, 1, 0, 0);
        HALF_STEP(pA0, pA1, mnA, alA, pB0, pB1, alB, t + 1, 0, 1, 1);
    }
    const bool even = (NT & 1) == 0;
    if (even) { SBAR(); qkt<1>(pB0, pB1, K_lds, r32, hi, S.qr, aa, BIAS(NT - 1)); SBAR(); }
    const int nc_ = __builtin_amdgcn_readfirstlane(*C.nw); const BlockRef nxt = nc_ >= 0 ? attn_ref_blk<MOBA>(nc_, C) : cur;
    SLOAD_H(nxt.K, nxt.V, nxt.jlo * KVBLK); SBAR();
    { const unsigned qoff = (unsigned)(r32 * LDQ + hi * 8); const bf16_t* qb_ = nxt.Q + (size_t)(wid * QBLK) * LDQ;
      _Pragma("unroll") for (int d0 = 0; d0 < 8; ++d0) S.qr[d0] = ld8(qb_ + qoff + d0 * 16); }
    SBAR();
    finishSM(pA0, pA1, alA, l_reg, pa0, pa1, pa2, pa3); SBAR();
    pv_tile<0>(o, vb0, pa0, pa1, pa2, pa3);
    if (even) { MASKT(pB0, pB1, NT - 1); partialSM(pB0, pB1, m_reg, mnB, alB); __syncthreads(); RESC(alB);
        finishSM(pB0, pB1, alB, l_reg, pa0, pa1, pa2, pa3); SBAR(); pv_tile<1>(o, vb0, pa0, pa1, pa2, pa3); }
    SBAR(); SEAM_K0();
    if (hi == 0) li_l[r32] = l_reg; asm volatile("s_waitcnt lgkmcnt(0)" ::: "memory");
    float rli[16];
#pragma unroll
    for (int r = 0; r < 16; ++r) rli[r] = __builtin_amdgcn_rcpf(li_l[crow(r, hi)]);
    bf16_t* Ow = cur.O + (size_t)(wid * QBLK) * LDO;
#pragma unroll
    for (int r = 0; r < 16; ++r) { const int orow = crow(r, hi);
#pragma unroll
        for (int d0 = 0; d0 < 4; ++d0) { const float v = o[d0][r] * rli[r];
            const float vn = xor1_get(v);
            if ((r32 & 1) == 0) *(unsigned*)(Ow + (size_t)orow * LDO + d0 * 32 + r32) = cvt_pk_bf16(v, vn); } }
    __syncthreads();
    return nc_;
#undef RESC
#undef KBASE
#undef BIAS
#undef MASKT
#undef SEAM_K0
#undef HALF_STEP
}
#undef AROW
#undef VMW
#undef VMWN
#undef SLOAD_H
#undef SWRITE_HK
#undef SWRITE_HV
#undef SWRITE_H
}

constexpr int NWAVES = 8, NTHREADS = NWAVES * 64, NPHASE = 17;
struct Args { const float* in[23]; float* out; unsigned char* ws; int ph_lo, ph_hi; };
struct Frame { LAS unsigned char* lds; int tid, lane, wave, G, vc, gw, NGW; };
typedef const __attribute__((address_space(4))) Args* KAP;

struct WJob { const float* src; void* dst; const float* gain; float sc; int K, N, mode, kb, nb, f8; };
__device__ __forceinline__ int wdrow(int n, int mode) { return mode == 0 ? n : ((n >> 7) * 256 + (mode == 2 ? 128 : 0) + (n & 127)); }
constexpr int I_QKV = 32 * 24, I_OA = 32 * 8, I_G = 32 * 22, I_DN = 88 * 8, I_KV = 32 * 16, I_QB = 32 * 8, I_OB = 32 * 8, I_E1 = 32 * 28, I_EG = 8 * I_E1, I_ED1 = 112 * 8, I_ED = 8 * I_ED1;
constexpr int W_NITEMS0 = I_QKV + I_OA + 2 * I_G + I_DN + I_KV + I_QB + I_OB;
constexpr int W_NEXP = 2 * I_EG + I_ED, W_NITEMS = W_NITEMS0 + W_NEXP;
__device__ __forceinline__ void wjob_decode(KAP ap, int item, WJob& j) {
    unsigned char* ws = ap->ws; int r = item; int nbn; j.f8 = 0; j.sc = 1.0f;
    if (r < I_QKV) { j.src = ap->in[2]; j.dst = (bf16_t*)(ws + WS_WQKV); j.gain = ap->in[1]; j.K = DM; j.N = NQKV; j.mode = 0; }
    else if ((r -= I_QKV) < I_OA) { j.src = ap->in[3]; j.dst = (bf16_t*)(ws + WS_WOA); j.gain = nullptr; j.K = DM; j.N = DM; j.mode = 0; }
    else if ((r -= I_OA) < I_G) { j.src = ap->in[15]; j.dst = (bf16_t*)(ws + WS_WGU); j.gain = ap->in[14]; j.K = DM; j.N = FF; j.mode = 1; }
    else if ((r -= I_G) < I_G) { j.src = ap->in[16]; j.dst = (bf16_t*)(ws + WS_WGU); j.gain = ap->in[14]; j.K = DM; j.N = FF; j.mode = 2; }
    else if ((r -= I_G) < I_DN) { j.src = ap->in[17]; j.dst = (bf16_t*)(ws + WS_WDN); j.gain = nullptr; j.K = FF; j.N = DM; j.mode = 0; }
    else if ((r -= I_DN) < I_KV) { j.src = ap->in[5]; j.dst = (bf16_t*)(ws + WS_WKVQ); j.gain = ap->in[4]; j.K = DM; j.N = 2 * DM; j.mode = 0; }
    else if ((r -= I_KV) < I_QB) { j.src = ap->in[7]; j.dst = (bf16_t*)(ws + WS_WKVQ) + (size_t)2 * DM * DM; j.gain = ap->in[6]; j.K = DM; j.N = DM; j.mode = 0; }
    else if ((r -= I_QB) < I_OB) { j.src = ap->in[13]; j.dst = (bf16_t*)(ws + WS_WOB); j.gain = nullptr; j.K = DM; j.N = DM; j.mode = 0; }
    else if ((r -= I_OB) < I_EG) { const int e = r / I_E1; r -= e * I_E1; j.src = ap->in[19] + (size_t)e * DM * FE; j.dst = ws + WS_WEGU + (size_t)e * 2 * FE * DM; j.gain = ap->in[14] + DM; j.K = DM; j.N = FE; j.mode = 1; j.f8 = 1; j.sc = WEGU_SC; }
    else if ((r -= I_EG) < I_EG) { const int e = r / I_E1; r -= e * I_E1; j.src = ap->in[20] + (size_t)e * DM * FE; j.dst = ws + WS_WEGU + (size_t)e * 2 * FE * DM; j.gain = ap->in[14] + DM; j.K = DM; j.N = FE; j.mode = 2; j.f8 = 1; j.sc = WEGU_SC; }
    else { r -= I_EG; const int e = r / I_ED1; r -= e * I_ED1; j.src = ap->in[21] + (size_t)e * FE * DM; j.dst = ws + WS_WEDN + (size_t)e * DM * FE; j.gain = nullptr; j.K = FE; j.N = DM; j.mode = 0; j.f8 = 1; j.sc = WEDN_SC; }
    nbn = j.N >> 8; j.kb = r / nbn; j.nb = r - j.kb * nbn;
}
__device__ __forceinline__ void p0_weights(KAP a, Frame& F, int first, const int end, const int stride) {
    LAS float* tile = (LAS float*)F.lds;
    const int w = F.wave, l = F.lane;
    float v[32];
    int item = first; bool have = item < end; WJob j;
#define W_LOAD() do { const float* sp = j.src + (size_t)(j.kb * 64 + w) * j.N + j.nb * 256 + l; \
        _Pragma("unroll") for (int i = 0; i < 8; ++i) _Pragma("unroll") for (int c = 0; c < 4; ++c) v[i * 4 + c] = __builtin_nontemporal_load(sp + (size_t)(8 * i) * j.N + 64 * c); } while (0)
    if (have) { wjob_decode(a, item, j); W_LOAD(); }
    while (have) {
        __syncthreads();
#pragma unroll
        for (int i = 0; i < 8; ++i) { const int k = w + 8 * i; const float g = (j.gain ? j.gain[j.kb * 64 + k] : 1.0f) * j.sc;
#pragma unroll
            for (int c = 0; c < 4; ++c) tile[k * 257 + l + 64 * c] = v[i * 4 + c] * g; }
        void* cdst = j.dst; const int cK = j.K, cmode = j.mode, ckb = j.kb, cnb = j.nb, cf8 = j.f8;
        item += stride; const bool have_next = item < end;
        if (have_next) { wjob_decode(a, item, j); W_LOAD(); }
        __syncthreads();
        if (cf8) {
            const int c4 = l >> 4, n16 = l & 15;
#pragma unroll
            for (int jj = 0; jj < 2; ++jj) { const int n = n16 + 16 * w + 128 * jj; const LAS float* s = tile + (16 * c4) * 257 + n;
                u32x4 o; o.x = pg8::pk4_fp8(s[0], s[257], s[2 * 257], s[3 * 257]); o.y = pg8::pk4_fp8(s[4 * 257], s[5 * 257], s[6 * 257], s[7 * 257]);
                o.z = pg8::pk4_fp8(s[8 * 257], s[9 * 257], s[10 * 257], s[11 * 257]); o.w = pg8::pk4_fp8(s[12 * 257], s[13 * 257], s[14 * 257], s[15 * 257]);
                *(u32x4*)((unsigned char*)cdst + (size_t)wdrow(cnb * 256 + n, cmode) * cK + ckb * 64 + 16 * c4) = o; }
        } else {
        const int c8 = l >> 3, nn = l & 7;
#pragma unroll
        for (int jj = 0; jj < 4; ++jj) { const int n = nn + 8 * w + 64 * jj; const LAS float* s = tile + (8 * c8) * 257 + n;
            u32x4 o; o.x = cvt_pk_bf16(s[0], s[257]); o.y = cvt_pk_bf16(s[2 * 257], s[3 * 257]); o.z = cvt_pk_bf16(s[4 * 257], s[5 * 257]); o.w = cvt_pk_bf16(s[6 * 257], s[7 * 257]);
            *(u32x4*)((bf16_t*)cdst + (size_t)wdrow(cnb * 256 + n, cmode) * cK + ckb * 64 + 8 * c8) = o; }
        }
        have = have_next;
    }
#undef W_LOAD
    __syncthreads();
}
#ifndef W_DEEP4
#define W_DEEP4 1
#endif
__device__ __forceinline__ void p0_weights2(KAP a, Frame& F, int first, const int end, const int stride) {
    const int w = F.wave, l = F.lane;
    float va[32], vb[32];
    WJob ja, jb;
#define W_LOAD2(J, V) do { const float* sp = (J).src + (size_t)((J).kb * 64 + w) * (J).N + (J).nb * 256 + l; \
        _Pragma("unroll") for (int i = 0; i < 8; ++i) _Pragma("unroll") for (int c = 0; c < 4; ++c) (V)[i * 4 + c] = __builtin_nontemporal_load(sp + (size_t)(8 * i) * (J).N + 64 * c); } while (0)
#define W_ITEM2(J, V, TILE, NEXT_ITEM) do { \
        LAS float* tile = (LAS float*)F.lds + (TILE) * (64 * 257); \
        _Pragma("unroll") for (int i = 0; i < 8; ++i) { const int k = w + 8 * i; const float g = ((J).gain ? (J).gain[(J).kb * 64 + k] : 1.0f) * (J).sc; \
            _Pragma("unroll") for (int c = 0; c < 4; ++c) tile[k * 257 + l + 64 * c] = (V)[i * 4 + c] * g; } \
        void* cdst = (J).dst; const int cK = (J).K, cmode = (J).mode, ckb = (J).kb, cnb = (J).nb, cf8 = (J).f8; \
        if ((NEXT_ITEM) < end) { wjob_decode(a, (NEXT_ITEM), (J)); W_LOAD2(J, V); } \
        __syncthreads(); \
        if (cf8) { const int c4 = l >> 4, n16 = l & 15; \
            _Pragma("unroll") for (int jj = 0; jj < 2; ++jj) { const int n = n16 + 16 * w + 128 * jj; const LAS float* s = tile + (16 * c4) * 257 + n; \
                u32x4 o; o.x = pg8::pk4_fp8(s[0], s[257], s[2 * 257], s[3 * 257]); o.y = pg8::pk4_fp8(s[4 * 257], s[5 * 257], s[6 * 257], s[7 * 257]); \
                o.z = pg8::pk4_fp8(s[8 * 257], s[9 * 257], s[10 * 257], s[11 * 257]); o.w = pg8::pk4_fp8(s[12 * 257], s[13 * 257], s[14 * 257], s[15 * 257]); \
                *(u32x4*)((unsigned char*)cdst + (size_t)wdrow(cnb * 256 + n, cmode) * cK + ckb * 64 + 16 * c4) = o; } \
        } else { const int c8 = l >> 3, nn = l & 7; \
            _Pragma("unroll") for (int jj = 0; jj < 4; ++jj) { const int n = nn + 8 * w + 64 * jj; const LAS float* s = tile + (8 * c8) * 257 + n; \
                u32x4 o; o.x = cvt_pk_bf16(s[0], s[257]); o.y = cvt_pk_bf16(s[2 * 257], s[3 * 257]); o.z = cvt_pk_bf16(s[4 * 257], s[5 * 257]); o.w = cvt_pk_bf16(s[6 * 257], s[7 * 257]); \
                *(u32x4*)((bf16_t*)cdst + (size_t)wdrow(cnb * 256 + n, cmode) * cK + ckb * 64 + 8 * c8) = o; } } \
    } while (0)
    int item = first;
    __syncthreads();
#if W_DEEP4
    float vc[32], vd[32]; WJob jc, jd;
    if (item < end) { wjob_decode(a, item, ja); W_LOAD2(ja, va); }
    if (item + stride < end) { wjob_decode(a, item + stride, jb); W_LOAD2(jb, vb); }
    if (item + 2 * stride < end) { wjob_decode(a, item + 2 * stride, jc); W_LOAD2(jc, vc); }
    if (item + 3 * stride < end) { wjob_decode(a, item + 3 * stride, jd); W_LOAD2(jd, vd); }
    for (; item < end; item += 4 * stride) {
        W_ITEM2(ja, va, 0, item + 4 * stride);
        if (item + stride < end) W_ITEM2(jb, vb, 1, item + 5 * stride);
        if (item + 2 * stride < end) W_ITEM2(jc, vc, 0, item + 6 * stride);
        if (item + 3 * stride < end) W_ITEM2(jd, vd, 1, item + 7 * stride);
    }
#else
    if (item < end) { wjob_decode(a, item, ja); W_LOAD2(ja, va); }
    if (item + stride < end) { wjob_decode(a, item + stride, jb); W_LOAD2(jb, vb); }
    for (; item < end; item += 2 * stride) {
        W_ITEM2(ja, va, 0, item + 2 * stride);
        if (item + stride < end) W_ITEM2(jb, vb, 1, item + 3 * stride);
    }
#endif
#undef W_LOAD2
#undef W_ITEM2
    __syncthreads();
}
__device__ __forceinline__ void p0_weights_r(KAP a, Frame& F, int first, const int end, const int wg, const int nwg) {
    const int t = F.tid & 255, half = __builtin_amdgcn_readfirstlane(F.tid >> 8), nq = t & 15, kq = (t >> 4) & 3, ng = t >> 6;
    const int n0 = ng * 64 + nq * 4, k0 = kq * 16, nworkers = 2 * nwg;
    f32x4 va[16], vb[16], ga[4], gb[4]; WJob ja, jb;
#define WR_LOAD(J, V, G) do { const char* ub = (const char*)((J).src + (size_t)(J).kb * 64 * (J).N + (J).nb * 256); const unsigned loff = (unsigned)(k0 * (J).N + n0) * 4u; \
        _Pragma("unroll") for (int i = 0; i < 16; ++i) (V)[i] = __builtin_nontemporal_load((const f32x4*)(ub + (size_t)i * (J).N * 4 + loff)); \
        _Pragma("unroll") for (int i = 0; i < 4; ++i) (G)[i] = (J).gain ? *(const f32x4*)((J).gain + (J).kb * 64 + k0 + 4 * i) : (f32x4){1.f, 1.f, 1.f, 1.f}; } while (0)
#define WR_ITEM(J, V, G, NEXT_ITEM) do { \
        _Pragma("unroll") for (int i = 0; i < 4; ++i) (G)[i] = (G)[i] * (J).sc; \
        unsigned char* cdst = (unsigned char*)(J).dst; const int cK = (J).K, cmode = (J).mode, ckb = (J).kb, cnb = (J).nb; \
        _Pragma("unroll") for (int j = 0; j < 4; ++j) { u32x4 o; \
            o.x = pg8::pk4_fp8((V)[0][j] * (G)[0][0], (V)[1][j] * (G)[0][1], (V)[2][j] * (G)[0][2], (V)[3][j] * (G)[0][3]); o.y = pg8::pk4_fp8((V)[4][j] * (G)[1][0], (V)[5][j] * (G)[1][1], (V)[6][j] * (G)[1][2], (V)[7][j] * (G)[1][3]); \
            o.z = pg8::pk4_fp8((V)[8][j] * (G)[2][0], (V)[9][j] * (G)[2][1], (V)[10][j] * (G)[2][2], (V)[11][j] * (G)[2][3]); o.w = pg8::pk4_fp8((V)[12][j] * (G)[3][0], (V)[13][j] * (G)[3][1], (V)[14][j] * (G)[3][2], (V)[15][j] * (G)[3][3]); \
            *(u32x4*)(cdst + (size_t)wdrow(cnb * 256 + n0 + j, cmode) * cK + ckb * 64 + k0) = o; } \
        if ((NEXT_ITEM) < end) { wjob_decode(a, (NEXT_ITEM), (J)); WR_LOAD(J, V, G); } \
    } while (0)
    int item = first + 2 * wg + half;
    if (item < end) { wjob_decode(a, item, ja); WR_LOAD(ja, va, ga); }
    if (item + nworkers < end) { wjob_decode(a, item + nworkers, jb); WR_LOAD(jb, vb, gb); }
    for (; item < end; item += 2 * nworkers) {
        WR_ITEM(ja, va, ga, item + 2 * nworkers);
        if (item + nworkers < end) WR_ITEM(jb, vb, gb, item + 3 * nworkers);
    }
#undef WR_LOAD
#undef WR_ITEM
}
__device__ __forceinline__ void p0_x(const float* x, bf16_t* xb, u64* ss0, Frame& F) {
    for (int row = F.gw; row < MTOK; row += F.NGW) {
        const f32x4* xr = (const f32x4*)(x + (size_t)row * DM) + F.lane; f32x4 v[8]; float s = 0.f;
#pragma unroll
        for (int j = 0; j < 8; ++j) { v[j] = __builtin_nontemporal_load(xr + 64 * j); s += (v[j].x * v[j].x + v[j].y * v[j].y) + (v[j].z * v[j].z + v[j].w * v[j].w); }
        s = wave_sum(s);
        u32x2* o8 = (u32x2*)(xb + (size_t)row * DM) + F.lane;
#pragma unroll
        for (int j = 0; j < 8; ++j) { u32x2 w; w.x = cvt_pk_bf16(v[j].x, v[j].y); w.y = cvt_pk_bf16(v[j].z, v[j].w); o8[64 * j] = w; }
        if (F.lane == 0) ss0[row] = ss_fix(s);
    }
}
__device__ __forceinline__ void p2_kmean(const bf16_t* qkv, float* kmean, Frame& F, int u0, int nu) {
    const int c16 = F.lane & 15, rg = F.lane >> 4;
    for (int u = u0 + F.gw; u < u0 + nu; u += F.NGW) {
        const int bh = u >> 3, jb = u & 7, b = bh / HA, h = bh % HA;
        const bf16_t* kp = qkv + (size_t)(b * SEQ + jb * 256 + rg) * NQKV + DM + h * 128 + 8 * c16;
        float s[8] = {0.f, 0.f, 0.f, 0.f, 0.f, 0.f, 0.f, 0.f};
#pragma unroll 8
        for (int i = 0; i < 64; ++i) { const u32x4 q = *(const u32x4*)(kp + (size_t)(4 * i) * NQKV);
            s[0] += __uint_as_float(q.x << 16); s[1] += __uint_as_float(q.x & 0xffff0000u); s[2] += __uint_as_float(q.y << 16); s[3] += __uint_as_float(q.y & 0xffff0000u);
            s[4] += __uint_as_float(q.z << 16); s[5] += __uint_as_float(q.z & 0xffff0000u); s[6] += __uint_as_float(q.w << 16); s[7] += __uint_as_float(q.w & 0xffff0000u); }
#pragma unroll
        for (int e = 0; e < 8; ++e) s[e] = sum_xor32(sum_xor16(s[e]));
        if (rg == 0) { float* kd = kmean + (size_t)u * 128 + 8 * c16;
            *(f32x4*)kd = (f32x4){s[0], s[1], s[2], s[3]} * (1.0f / 256.0f); *(f32x4*)(kd + 4) = (f32x4){s[4], s[5], s[6], s[7]} * (1.0f / 256.0f); }
    }
}
__device__ __forceinline__ void p3_select(const bf16_t* qkv, const float* kmean, unsigned char* sel, Frame& F, int u0, int nu) {
    LAS float* km = (LAS float*)F.lds;
    for (int u = u0 + F.vc; u < u0 + nu; u += F.G) {
        const int bh = u >> 2, ch = u & 3, b = bh / HA, h = bh % HA;
        __syncthreads();
        km[F.tid] = kmean[(size_t)bh * 1024 + F.tid]; km[F.tid + 512] = kmean[(size_t)bh * 1024 + 512 + F.tid];
        __syncthreads();
        const int s = ch * 512 + F.tid, own = s >> 8;
        const bf16_t* qp = qkv + (size_t)(b * SEQ + s) * NQKV + h * 128;
        float gate[8] = {0.f, 0.f, 0.f, 0.f, 0.f, 0.f, 0.f, 0.f};
        if (own > 0) {
#pragma unroll 4
            for (int c = 0; c < 16; ++c) { const u32x4 q = *(const u32x4*)(qp + 8 * c);
                const float q0 = __uint_as_float(q.x << 16), q1 = __uint_as_float(q.x & 0xffff0000u), q2 = __uint_as_float(q.y << 16), q3 = __uint_as_float(q.y & 0xffff0000u);
                const float q4 = __uint_as_float(q.z << 16), q5 = __uint_as_float(q.z & 0xffff0000u), q6 = __uint_as_float(q.w << 16), q7 = __uint_as_float(q.w & 0xffff0000u);
#pragma unroll
                for (int jb = 0; jb < 8; ++jb) { const f32x4 k0 = *(const LAS f32x4*)(km + jb * 128 + 8 * c), k1 = *(const LAS f32x4*)(km + jb * 128 + 8 * c + 4);
                    gate[jb] += (q0 * k0.x + q1 * k0.y) + (q2 * k0.z + q3 * k0.w) + (q4 * k1.x + q5 * k1.y) + (q6 * k1.z + q7 * k1.w); } }
        }
        unsigned mask = 0u; const int nsel = own < 3 ? own : 3;
#pragma unroll
        for (int it = 0; it < 3; ++it) { if (it < nsel) { int best = -1; float bv = -__builtin_inff();
#pragma unroll
                for (int jb = 0; jb < 8; ++jb) { const bool ok = (jb < own) && (((mask >> jb) & 1u) == 0u) && (best < 0 || gate[jb] > bv); if (ok) { bv = gate[jb]; best = jb; } }
                if (best >= 0) mask |= 1u << best; } }
        sel[(size_t)bh * SEQ + s] = (unsigned char)mask;
    }
    __syncthreads();
}
template <bool MOBA> __device__ __forceinline__ void attn_phase(char* lds, const bf16_t* qkv, bf16_t* out, const unsigned char* sel, const unsigned* bnd, unsigned* qctr, int qb0, int nq, Frame& F) {
    constexpr int NPB = (MOBA ? HA : HB * 4) * 8;
    LAS int* jt = (LAS int*)(F.lds + 70016);
    att::DynCtx C{qkv, out, sel, bnd, qctr, (volatile LAS int*)(F.lds + 70000), qb0 + (int)(xb_xcc_id() & (unsigned)(nq - 1)), qb0, nq, jt};
    __syncthreads();
    for (int i = F.tid; i < nq * 128; i += NTHREADS) { const int b = qb0 + (i >> 7), seg = (i >> 3) & 15, qb = i & 7;
        if (MOBA) jt[i] = att::attn_jlo(bnd, seg, 16 + seg, b, qb, __builtin_amdgcn_exp2f(-0.5f * (float)(seg + 1)));
        else jt[i] = att::attn_jlo(bnd, 32 + seg, seg, b, qb, __builtin_amdgcn_exp2f(-(float)((seg >> 1) + 1))); }
    if (F.tid == 0) *C.nw = att::attn_pull_from(qctr, C.q0, 0, NPB, qb0, nq);
    __syncthreads();
    int code = __builtin_amdgcn_readfirstlane(*C.nw); if (code < 0) return;
    att::BlockRef cur = att::attn_ref_blk<MOBA>(code, C); att::Seam S;
    att::attn_prime(cur, lds, S);
    for (;;) {
        code = att::attn_block<MOBA>(cur, C, lds, S);
        if (code < 0) break;
        cur = att::attn_ref_blk<MOBA>(code, C);
    }
}
__device__ __forceinline__ void p10_combine(KAP a, const bf16_t* omap, bf16_t* ao, Frame& F, int t0, int nt) {
    const int l = F.lane;
    float d1 = a->in[8][l] * a->in[9][l] + a->in[8][l + 64] * a->in[9][l + 64], d2 = a->in[10][l] * a->in[11][l] + a->in[10][l + 64] * a->in[11][l + 64];
    d1 = wave_sum(d1); d2 = wave_sum(d2);
    const float lam = __expf(d1) - __expf(d2) + LAM_INIT;
    const f32x4 g = *(const f32x4*)(a->in[12] + 4 * l);
    u32x2 x1v[HB], x2v[HB];
    int tok = t0 + F.gw;
    if (tok < t0 + nt) { const bf16_t* p1 = omap + (size_t)tok * DM + 4 * l; const bf16_t* p2 = p1 + (size_t)MTOK * DM;
#pragma unroll
        for (int h = 0; h < HB; ++h) { x1v[h] = *(const u32x2*)(p1 + h * 256); x2v[h] = *(const u32x2*)(p2 + h * 256); } }
    for (; tok < t0 + nt; tok += F.NGW) {
        bf16_t* po = ao + (size_t)tok * DM + 4 * l;
        u32x2 n1v[HB], n2v[HB]; const int nxt = tok + F.NGW;
        if (nxt < t0 + nt) { const bf16_t* p1 = omap + (size_t)nxt * DM + 4 * l; const bf16_t* p2 = p1 + (size_t)MTOK * DM;
#pragma unroll
            for (int h = 0; h < HB; ++h) { n1v[h] = *(const u32x2*)(p1 + h * 256); n2v[h] = *(const u32x2*)(p2 + h * 256); } }
        else {
#pragma unroll
            for (int h = 0; h < HB; ++h) { n1v[h] = (u32x2){0u, 0u}; n2v[h] = (u32x2){0u, 0u}; } }
#pragma unroll
        for (int h = 0; h < HB; ++h) { const u32x2 x1 = x1v[h], x2 = x2v[h];
            f32x4 d; d.x = __uint_as_float(x1.x << 16) - lam * __uint_as_float(x2.x << 16); d.y = __uint_as_float(x1.x & 0xffff0000u) - lam * __uint_as_float(x2.x & 0xffff0000u);
            d.z = __uint_as_float(x1.y << 16) - lam * __uint_as_float(x2.y << 16); d.w = __uint_as_float(x1.y & 0xffff0000u) - lam * __uint_as_float(x2.y & 0xffff0000u);
            float ss = wave_sum((d.x * d.x + d.y * d.y) + (d.z * d.z + d.w * d.w));
            const float r = __builtin_amdgcn_rsqf(ss * (1.0f / 256.0f) + RMS_EPS) * (1.0f - LAM_INIT);
            u32x2 w; w.x = cvt_pk_bf16(d.x * r * g.x, d.y * r * g.y); w.y = cvt_pk_bf16(d.z * r * g.z, d.w * r * g.w); *(u32x2*)(po + h * 256) = w; }
#pragma unroll
        for (int h = 0; h < HB; ++h) { x1v[h] = n1v[h]; x2v[h] = n2v[h]; }
    }
}
__device__ __forceinline__ void p12_router(KAP a, const bf16_t* xb, const u64* ss3, unsigned* gcnt, int* tokinfo, unsigned char* xs, Frame& F, int c0, int nc) {
    LAS float* gwt = (LAS float*)F.lds;
    LAS unsigned* cnt = (LAS unsigned*)(F.lds + 65536); LAS unsigned* base = cnt + 8;
    const float* wr = a->in[18]; const float* g1 = a->in[14] + DM;
    __syncthreads();
    for (int idx = F.tid; idx < DM * NE; idx += NTHREADS) gwt[idx] = wr[idx] * g1[idx >> 3];
    if (F.tid < 8) cnt[F.tid] = 0u;
    __syncthreads();
    const int l = F.lane;
    for (int chunk = c0 + F.vc; chunk < c0 + nc; chunk += F.G) {
        int e0v = 0, e1v = 0, i0v = 0, i1v = 0; float g0v = 0.f, g1v = 0.f;
        float lgs[8][8];
#pragma unroll
        for (int i = 0; i < 8; ++i)
#pragma unroll
            for (int e = 0; e < 8; ++e) lgs[i][e] = 0.f;
        { const bf16_t* xp0 = xb + (size_t)(chunk * 64 + F.wave * 8) * DM + l;
#pragma unroll 4
          for (int j = 0; j < 32; ++j) { const LAS f32x4* wp = (const LAS f32x4*)(gwt + (l + 64 * j) * 8); const f32x4 w0 = wp[0], w1 = wp[1];
#pragma unroll
              for (int i = 0; i < 8; ++i) { const float xv = bf2f(xp0[(size_t)i * DM + 64 * j]);
                  lgs[i][0] += xv * w0.x; lgs[i][1] += xv * w0.y; lgs[i][2] += xv * w0.z; lgs[i][3] += xv * w0.w; lgs[i][4] += xv * w1.x; lgs[i][5] += xv * w1.y; lgs[i][6] += xv * w1.z; lgs[i][7] += xv * w1.w; } } }
#pragma unroll
        for (int i = 0; i < 8; ++i) {
            const int tok = chunk * 64 + F.wave * 8 + i;
            float lg[8];
            const float rs = rstd_q(ss3[tok]);
#pragma unroll
            for (int e = 0; e < 8; ++e) lg[e] = wave_sum(lgs[i][e]) * rs;
            int b0 = 0; float v0 = lg[0];
#pragma unroll
            for (int e = 1; e < 8; ++e) if (lg[e] > v0) { v0 = lg[e]; b0 = e; }
            int b1 = -1; float v1 = -__builtin_inff();
#pragma unroll
            for (int e = 0; e < 8; ++e) if (e != b0 && (b1 < 0 || lg[e] > v1)) { v1 = lg[e]; b1 = e; }
            const float ga = 1.0f / (1.0f + __expf(v1 - v0));
            unsigned i0 = 0u, i1 = 0u;
            if (l == 0) { i0 = __hip_atomic_fetch_add(&cnt[b0], 1u, __ATOMIC_RELAXED, __HIP_MEMORY_SCOPE_WORKGROUP); i1 = __hip_atomic_fetch_add(&cnt[b1], 1u, __ATOMIC_RELAXED, __HIP_MEMORY_SCOPE_WORKGROUP); }
            i0 = __builtin_amdgcn_readfirstlane(i0); i1 = __builtin_amdgcn_readfirstlane(i1);
            if (l == i) { e0v = b0; e1v = b1; i0v = (int)i0; i1v = (int)i1; g0v = ga; g1v = 1.0f - ga; }
        }
        __syncthreads();
        if (F.tid < 8) base[F.tid] = __hip_atomic_fetch_add(gcnt + 64 * F.tid, cnt[F.tid], __ATOMIC_RELAXED, __HIP_MEMORY_SCOPE_AGENT);
        __syncthreads();
        if (l < 8) { const int tok = chunk * 64 + F.wave * 8 + l; int* ti = tokinfo + (size_t)tok * 8;
            ti[0] = e0v; ti[1] = e1v; ti[2] = (int)base[e0v] + i0v; ti[3] = (int)base[e1v] + i1v; ti[4] = __float_as_int(g0v); ti[5] = __float_as_int(g1v); }
#pragma unroll
        for (int h = 0; h < 2; ++h) { u32x2 xv[4][8];
#pragma unroll
            for (int i = 0; i < 4; ++i) { const u32x2* sp = (const u32x2*)(xb + (size_t)(chunk * 64 + F.wave * 8 + 4 * h + i) * DM) + l;
#pragma unroll
                for (int j = 0; j < 8; ++j) xv[i][j] = sp[64 * j]; }
#pragma unroll
            for (int i = 0; i < 4; ++i) { const int ii = 4 * h + i, tok = chunk * 64 + F.wave * 8 + ii;
                const int e0 = __builtin_amdgcn_readlane(e0v, ii), e1 = __builtin_amdgcn_readlane(e1v, ii), q0 = __builtin_amdgcn_readlane(i0v, ii), q1 = __builtin_amdgcn_readlane(i1v, ii);
                const size_t row0 = (size_t)e0 * MTOK + base[e0] + q0, row1 = (size_t)e1 * MTOK + base[e1] + q1;
                const float rs = rstd_q(ss3[tok]) * XS_SC;
                unsigned* d0 = (unsigned*)(xs + row0 * DM) + l; unsigned* d1 = (unsigned*)(xs + row1 * DM) + l;
#pragma unroll
                for (int j = 0; j < 8; ++j) { const u32x2 b = xv[i][j];
                    const unsigned q = pg8::pk4_fp8(__uint_as_float(b.x << 16) * rs, __uint_as_float(b.x & 0xffff0000u) * rs, __uint_as_float(b.y << 16) * rs, __uint_as_float(b.y & 0xffff0000u) * rs); d0[64 * j] = q; d1[64 * j] = q; } } }
        __syncthreads();
        if (F.tid < 8) cnt[F.tid] = 0u;
        __syncthreads();
    }
}
__device__ __forceinline__ void p13_gather(const bf16_t* xb, const u64* ss3, unsigned* gcnt, int* tiles, int* tokinfo, unsigned char* xs, Frame& F) {
    LAS int* pst = (LAS int*)F.lds;
    __syncthreads();
    if (F.tid == 0) { int acc = 0;
        for (int e = 0; e < NE; ++e) { const int c = (int)__hip_atomic_load(gcnt + 64 * e, __ATOMIC_RELAXED, __HIP_MEMORY_SCOPE_AGENT); const int p = (c + 255) & ~255;
            pst[e] = acc; pst[8 + e] = c; pst[16 + e] = p;
            if (blockIdx.x == 0) for (int t = acc >> 8; t < (acc + p) >> 8; ++t) tiles[1 + t] = e;
            acc += p; }
        if (blockIdx.x == 0) tiles[0] = acc >> 8; }
    __syncthreads();
    const int l = F.lane;
    for (int tok = F.gw; tok < MTOK; tok += F.NGW) {
        int* ti = tokinfo + (size_t)tok * 8;
        const int row0 = pst[ti[0]] + ti[2], row1 = pst[ti[1]] + ti[3];
        if (l == 0) { ti[6] = row0; ti[7] = row1; }
        const float rs = rstd_q(ss3[tok]) * XS_SC;
        const u32x2* sp = (const u32x2*)(xb + (size_t)tok * DM) + l; unsigned* d0 = (unsigned*)(xs + (size_t)row0 * DM) + l; unsigned* d1 = (unsigned*)(xs + (size_t)row1 * DM) + l;
#pragma unroll
        for (int j = 0; j < 8; ++j) { const u32x2 b = sp[64 * j];
            const unsigned q = pg8::pk4_fp8(__uint_as_float(b.x << 16) * rs, __uint_as_float(b.x & 0xffff0000u) * rs, __uint_as_float(b.y << 16) * rs, __uint_as_float(b.y & 0xffff0000u) * rs); d0[64 * j] = q; d1[64 * j] = q; }
    }
    for (int e = 0; e < NE; ++e) { const int lo = pst[e] + pst[8 + e], hi = pst[e] + pst[16 + e];
        for (int r = lo + F.gw; r < hi; r += F.NGW) { u32x4* d = (u32x4*)(xs + (size_t)r * DM) + l; d[0] = (u32x4){0u, 0u, 0u, 0u}; d[64] = (u32x4){0u, 0u, 0u, 0u}; } }
    __syncthreads();
}
__device__ __forceinline__ void ys_row(const bf16_t* ys, const float* slab, int split0, size_t ks_stride, int row, int l, f32x4 (&a)[8]) {
    if (row >= split0) { const float* p = slab + (size_t)(row - split0) * DM + 4 * l;
#pragma unroll
        for (int j = 0; j < 8; ++j) { f32x4 t = *(const f32x4*)(p + 256 * j);
#pragma unroll
            for (int ks = 1; ks < TAIL_NS; ++ks) t = t + *(const f32x4*)(p + 256 * j + (size_t)ks * ks_stride);
            a[j] = t * (1.0f / (ACT_SC * WEDN_SC)); } }
    else { const u32x2* p = (const u32x2*)(ys + (size_t)row * DM) + l;
#pragma unroll
        for (int j = 0; j < 8; ++j) { const u32x2 q = p[64 * j]; a[j] = (f32x4){__uint_as_float(q.x << 16), __uint_as_float(q.x & 0xffff0000u), __uint_as_float(q.y << 16), __uint_as_float(q.y & 0xffff0000u)}; } }
}
constexpr int MOE_T_OFF = 131072;
__device__ __forceinline__ void moe_tables(const unsigned* gcnt, LAS int* T, Frame& F) {
    __syncthreads();
    if (F.tid == 0) { int acc = 0;
        for (int e = 0; e < NE; ++e) { const int c = (int)__hip_atomic_load(gcnt + 64 * e, __ATOMIC_RELAXED, __HIP_MEMORY_SCOPE_AGENT); const int p = (c + 255) & ~255;
            T[256 + e] = acc;
            for (int j = 0; j < (p >> 8); ++j) T[1 + (acc >> 8) + j] = e + 16 * (e * (MTOK / 256) + j);
            acc += p; }
        T[0] = acc >> 8; }
    __syncthreads();
}
__device__ __forceinline__ void p16_final(const bf16_t* xb, const bf16_t* ys, const float* slab, const int* tiles, const int* tokinfo, const float* fg, float* out, Frame& F) {
    const int l = F.lane; const int nT = tiles[0]; int rt = nT & 31; if (rt > 7) rt = 0; const int split0 = (nT - rt) * 256; const size_t ks_stride = (size_t)rt * 256 * DM;
    for (int tok = F.gw; tok < MTOK; tok += F.NGW) {
        const int* ti = tokinfo + (size_t)tok * 8; const float g0 = __int_as_float(ti[4]), g1 = __int_as_float(ti[5]); const int row0 = tiles[256 + ti[0]] + ti[2], row1 = tiles[256 + ti[1]] + ti[3];
        const u32x2* xp = (const u32x2*)(xb + (size_t)tok * DM) + l;
        f32x4 v[8], a0[8], a1[8]; float s = 0.f;
#pragma unroll
        for (int j = 0; j < 8; ++j) { const u32x2 q = xp[64 * j]; v[j] = (f32x4){__uint_as_float(q.x << 16), __uint_as_float(q.x & 0xffff0000u), __uint_as_float(q.y << 16), __uint_as_float(q.y & 0xffff0000u)}; }
        ys_row(ys, slab, split0, ks_stride, row0, l, a0); ys_row(ys, slab, split0, ks_stride, row1, l, a1);
#pragma unroll
        for (int j = 0; j < 8; ++j) { v[j] = v[j] + g0 * a0[j] + g1 * a1[j]; s += (v[j].x * v[j].x + v[j].y * v[j].y) + (v[j].z * v[j].z + v[j].w * v[j].w); }
        const float r = rstd_of(wave_sum(s));
        f32x4* op = (f32x4*)(out + (size_t)tok * DM) + l; const f32x4* gp = (const f32x4*)fg + l;
#pragma unroll
        for (int j = 0; j < 8; ++j) op[64 * j] = v[j] * r * gp[64 * j];
    }
}

#ifndef PH_MASK
#define PH_MASK 0x1ffff
#endif
__global__ void __launch_bounds__(NTHREADS, 2) mega_fwd(Args args_by_value) {
    extern __shared__ __attribute__((aligned(16))) unsigned char lds[];
    (void)args_by_value;
    const KAP kap0 = (KAP)__builtin_amdgcn_kernarg_segment_ptr();
#define KARGS() ({ KAP p_ = kap0; asm volatile("" : "+s"(p_)); p_; })
    Frame F0;
#define F F0
    F.lds = (LAS unsigned char*)lds;
    F.tid = threadIdx.x; F.lane = F.tid & 63; F.wave = __builtin_amdgcn_readfirstlane(F.tid >> 6);
    F.G = gridDim.x; { const int bx = blockIdx.x; F.vc = (F.G % 8 == 0) ? (bx % 8) * (F.G / 8) + bx / 8 : bx; }
    F.gw = F.vc * NWAVES + F.wave; F.NGW = F.G * NWAVES;
    volatile LAS unsigned* MISC = (volatile LAS unsigned*)(F.lds + LDSCTL_OFF);
    for (int u = F.tid; u < (LDS_BYTES - LDSCTL_OFF) / 4; u += NTHREADS) ((LAS unsigned*)(F.lds + LDSCTL_OFF))[u] = 0u;
    __syncthreads();
    const int lo = kap0->ph_lo, hi = kap0->ph_hi;
    const bool use_bar = (hi - lo) > 1;
    XcdBarrier bar; bar.bar = (unsigned*)(kap0->ws + CTL_BAR); bar.x = 0; bar.st = MISC + 8;
    if (use_bar) bar = xcd_barrier_post((unsigned*)(kap0->ws + CTL_BAR), MISC + 8, (unsigned)F.G);
#ifndef DUP_MASK
#define DUP_MASK 0
#endif
#ifndef PROBE_SKIP_EPI
#define PROBE_SKIP_EPI 0
#endif
#ifndef PROBE_KIND
#define PROBE_KIND 4
#endif
#ifndef PROBE_PH
#define PROBE_PH 6
#endif
#ifndef PROBE_AMP
#define PROBE_AMP 4
#endif
#ifndef PROBE_PHM
#define PROBE_PHM (1 << PROBE_PH)
#endif
#define PROBE_SEL(k) ((PROBE_KIND == 2 || PROBE_KIND == 3) ? ((PROBE_PHM >> (k)) & 1) : ((k) == PROBE_PH))
#if PROBE_KIND
#define PROBE_ME (blockIdx.x == 0 && F0.tid == 0)
#define PROBE_B(k) do { if (PROBE_SEL(k) && PROBE_ME) { const unsigned long long r_ = __builtin_amdgcn_s_memrealtime(), t_ = __builtin_amdgcn_s_memtime(); MISC[16] = (unsigned)r_; MISC[17] = (unsigned)(r_ >> 32); MISC[18] = (unsigned)t_; MISC[19] = (unsigned)(t_ >> 32); } } while (0)
#define PROBE_E(k) do { if (PROBE_SEL(k) && PROBE_ME) { const unsigned long long r_ = __builtin_amdgcn_s_memrealtime(), t_ = __builtin_amdgcn_s_memtime(); \
        const unsigned long long r0_ = ((unsigned long long)MISC[17] << 32) | MISC[16], t0_ = ((unsigned long long)MISC[19] << 32) | MISC[18]; const unsigned long long dr_ = r_ - r0_, dt_ = t_ - t0_; \
        if (PROBE_KIND == 1) MISC[20] = (unsigned)((dt_ * 10000ull) / (dr_ ? dr_ : 1ull));   \
        if (PROBE_KIND == 2) MISC[20] = MISC[20] + (unsigned)(dr_ * PROBE_AMP); \
        if (PROBE_KIND == 3) { MISC[16] = (unsigned)r_; MISC[17] = (unsigned)(r_ >> 32); } } } while (0)
#define PROBE_S(k) do { if (PROBE_KIND == 3 && PROBE_SEL(k) && PROBE_ME) { const unsigned long long r_ = __builtin_amdgcn_s_memrealtime(); const unsigned long long r0_ = ((unsigned long long)MISC[17] << 32) | MISC[16]; MISC[20] = MISC[20] + (unsigned)((r_ - r0_) * PROBE_AMP); } } while (0)
#define PROBE_FIN() do { if (PROBE_ME) { const unsigned long long r0_ = __builtin_amdgcn_s_memrealtime(); const unsigned long long d_ = MISC[20]; while (__builtin_amdgcn_s_memrealtime() - r0_ < d_) __builtin_amdgcn_s_sleep(8); } } while (0)
#else
#define PROBE_B(k) do { } while (0)
#define PROBE_E(k) do { } while (0)
#define PROBE_S(k) do { } while (0)
#define PROBE_FIN() do { } while (0)
#endif
#define PRB(k) (((PROBE_KIND == 4 || PROBE_KIND == 5) && (k) == PROBE_PH) ? MISC : (volatile LAS unsigned*)nullptr)
#define IN(k) (((PH_MASK >> (k)) & 1) && lo <= (k) && (k) < hi)
#define REP(k) for (int rep_ = 0; rep_ < (((DUP_MASK >> (k)) & 1) ? 2 : 1); ++rep_)
#define SEAM(k) do { if (IN(k) && IN((k) + 1)) { if ((k) >= 1 && (k) <= 10) xcd_barrier(barh); else xcd_barrier(bar); } } while (0)
#define WSP(T, off) ((T*)(ws + (off)))
#define FRL() ({ Frame f_ = F0; asm volatile("" : "+v"(f_.tid), "+v"(f_.lane)); f_; })
#undef F
    const int bx = blockIdx.x;
    const int ngrp = (F0.G % 8 == 0) ? 8 : 1, hb = (ngrp == 8) ? (bx & 7) : 0, nxh = 8 / ngrp, Gh = F0.G / ngrp;
    const int hidx = (ngrp == 8) ? (bx >> 3) : bx;
    const int Mh = MTOK / ngrp, R0 = hb * Mh, nMh = Mh / 256, pm0 = hb * nMh;
    Frame FH0 = F0; FH0.G = Gh; FH0.vc = (Gh % nxh == 0) ? (hidx % nxh) * (Gh / nxh) + hidx / nxh : hidx; FH0.gw = FH0.vc * NWAVES + F0.wave; FH0.NGW = Gh * NWAVES;
#define FRH() ({ Frame f_ = FH0; asm volatile("" : "+v"(f_.tid), "+v"(f_.lane)); f_; })
    const int shn = W_NEXP / ngrp, sh0 = W_NITEMS0 + hb * shn;
    const int per = (shn + Gh - 1) / Gh, nbef = (ngrp == 8) ? (per * hb) / 7 : per;
    XcdBarrier barh = bar;
    if (use_bar) barh = xcd_barrier_post((unsigned*)(kap0->ws + CTL_BARH + (size_t)hb * CTL_BARH_STRIDE), MISC + 10, (unsigned)Gh);

    PROBE_B(0); if (IN(0)) REP(0) { KAP ap = KARGS(); Frame F = FRL(); unsigned char* ws = ap->ws; p0_weights(ap, F, F.vc, W_NITEMS0, F.G); p0_x(ap->in[0], WSP(bf16_t, WS_XB), WSP(u64, CTL_SS), F); }
    PROBE_E(0); SEAM(0); PROBE_S(0);
    if (IN(0)) { KAP ap = KARGS(); Frame F = FRH(); const int e_ = sh0 + nbef * Gh < sh0 + shn ? sh0 + nbef * Gh : sh0 + shn; p0_weights_r(ap, F, sh0, e_, hidx, Gh); }
    PROBE_B(1); if (IN(1)) REP(1) {
        KAP ap = KARGS(); Frame F = FRH(); unsigned char* ws = ap->ws;
        pg8::Order S; S.init(nMh, NQKV / 256, 2 * DM, F.G, hidx, ws + WS_XB + (size_t)R0 * DM * 2, ws + WS_WQKV, 0, nullptr, nxh);
        pg8::EpiBf16Out<true, true> E{WSP(bf16_t, WS_QKV) + (size_t)R0 * NQKV, NQKV, WSP(u64, CTL_SS) + R0, 1.f, WSP(unsigned, CTL_BND1), pm0};
        pg8::gemm_phase<pg8::EpiBf16Out<true, true>, GEMM_ALIGN, GEMM_SP2>(F.lds, 2 * DM, S, E, 0, PRB(1));
    }
    PROBE_E(1); SEAM(1); PROBE_S(1);
    PROBE_B(2); if (IN(2)) REP(2) { KAP ap = KARGS(); Frame F = FRH(); unsigned char* ws = ap->ws; p2_kmean(WSP(bf16_t, WS_QKV), WSP(float, WS_KMEAN), F, hb * nxh * HA * 8, nxh * HA * 8); }
    PROBE_E(2); SEAM(2); PROBE_S(2);
    PROBE_B(3); if (IN(3)) REP(3) { KAP ap = KARGS(); Frame F = FRH(); unsigned char* ws = ap->ws; p3_select(WSP(bf16_t, WS_QKV), WSP(float, WS_KMEAN), WSP(unsigned char, WS_SEL), F, hb * nxh * HA * 4, nxh * HA * 4); }
    PROBE_E(3); SEAM(3); PROBE_S(3);
    PROBE_B(4); if (IN(4)) REP(4) { KAP ap = KARGS(); Frame F = FRH(); unsigned char* ws = ap->ws; attn_phase<true>((char*)lds, WSP(bf16_t, WS_QKV), WSP(bf16_t, WS_AO), WSP(unsigned char, WS_SEL), WSP(unsigned, CTL_BND1), WSP(unsigned, CTL_AQ), hb * nxh, nxh, F); }
    PROBE_E(4); SEAM(4); PROBE_S(4);
    PROBE_B(5); if (IN(5)) REP(5) {
        KAP ap = KARGS(); Frame F = FRH(); unsigned char* ws = ap->ws;
        pg8::Order S; S.init(nMh, DM / 256, 2 * DM, F.G, hidx, ws + WS_AO + (size_t)R0 * DM * 2, ws + WS_WOA, 0, nullptr, nxh);
        pg8::EpiResid<true, false> E{WSP(bf16_t, WS_XB) + (size_t)R0 * DM, nullptr, WSP(bf16_t, WS_XB) + (size_t)R0 * DM, WSP(u64, CTL_SS) + MTOK + R0};
        pg8::gemm_phase<pg8::EpiResid<true, false>, GEMM_ALIGN, GEMM_SP2>(F.lds, 2 * DM, S, E);
    }
    PROBE_E(5); SEAM(5); PROBE_S(5);
    PROBE_B(6); if (IN(6)) REP(6) {
        KAP ap = KARGS(); Frame F = FRH(); unsigned char* ws = ap->ws;
        pg8::Order S; S.init(nMh, 2 * FF / 256, 2 * DM, F.G, hidx, ws + WS_XB + (size_t)R0 * DM * 2, ws + WS_WGU, 0, nullptr, nxh);
        pg8::EpiSwiGLU<false> E{WSP(bf16_t, WS_ACT) + (size_t)R0 * FF, FF, WSP(u64, CTL_SS) + MTOK + R0};
        pg8::gemm_phase<pg8::EpiSwiGLU<false>, GEMM_ALIGN, GEMM_SP2>(F.lds, 2 * DM, S, E, 0, PRB(6));
    }
    PROBE_E(6); SEAM(6); PROBE_S(6);
    PROBE_B(7); if (IN(7)) REP(7) {
        KAP ap = KARGS(); Frame F = FRH(); unsigned char* ws = ap->ws;
        pg8::Order S; S.init(nMh, DM / 256, 2 * FF, F.G, hidx, ws + WS_ACT + (size_t)R0 * FF * 2, ws + WS_WDN, 0, nullptr, nxh);
        pg8::EpiResid<true, false> E{WSP(bf16_t, WS_XB) + (size_t)R0 * DM, nullptr, WSP(bf16_t, WS_XB) + (size_t)R0 * DM, WSP(u64, CTL_SS) + 2 * MTOK + R0};
        pg8::gemm_phase<pg8::EpiResid<true, false>, GEMM_ALIGN, GEMM_SP2>(F.lds, 2 * FF, S, E);
    }
    PROBE_E(7); SEAM(7); PROBE_S(7);
    PROBE_B(8); if (IN(8)) REP(8) {
        KAP ap = KARGS(); Frame F = FRH(); unsigned char* ws = ap->ws;
        pg8::Order S; S.init(nMh, NQKV / 256, 2 * DM, F.G, hidx, ws + WS_XB + (size_t)R0 * DM * 2, ws + WS_WKVQ, 0, nullptr, nxh);
        pg8::EpiBf16Out<true, true> E{WSP(bf16_t, WS_QKV) + (size_t)R0 * NQKV, NQKV, WSP(u64, CTL_SS) + 2 * MTOK + R0, 1.f, WSP(unsigned, CTL_BND2), pm0};
        pg8::gemm_phase<pg8::EpiBf16Out<true, true>, GEMM_ALIGN, GEMM_SP2>(F.lds, 2 * DM, S, E, 0, PRB(1));
    }
    PROBE_E(8); SEAM(8); PROBE_S(8);
    PROBE_B(9); if (IN(9)) REP(9) { KAP ap = KARGS(); Frame F = FRH(); unsigned char* ws = ap->ws; attn_phase<false>((char*)lds, WSP(bf16_t, WS_QKV), WSP(bf16_t, WS_XR), nullptr, WSP(unsigned, CTL_BND2), WSP(unsigned, CTL_AQ) + 8 * 64, hb * nxh, nxh, F); }
    PROBE_E(9); SEAM(9); PROBE_S(9);
    PROBE_B(10); if (IN(10)) REP(10) { KAP ap = KARGS(); Frame F = FRH(); unsigned char* ws = ap->ws; p10_combine(ap, WSP(bf16_t, WS_XR), WSP(bf16_t, WS_AO), F, R0, Mh); }
    PROBE_E(10); SEAM(10); PROBE_S(10);
    PROBE_B(11); if (IN(11)) REP(11) {
        KAP ap = KARGS(); Frame F = FRH(); unsigned char* ws = ap->ws;
        pg8::Order S; S.init(nMh, DM / 256, 2 * DM, F.G, hidx, ws + WS_AO + (size_t)R0 * DM * 2, ws + WS_WOB, 0, nullptr, nxh);
        pg8::EpiResid<true, false> E{WSP(bf16_t, WS_XB) + (size_t)R0 * DM, nullptr, WSP(bf16_t, WS_XB) + (size_t)R0 * DM, WSP(u64, CTL_SS) + 3 * MTOK + R0};
        pg8::gemm_phase<pg8::EpiResid<true, false>, GEMM_ALIGN, GEMM_SP2>(F.lds, 2 * DM, S, E);
    }
    PROBE_E(11); if (IN(11) && IN(12)) xcd_barrier(barh); PROBE_S(11);
    PROBE_B(12); if (IN(12)) REP(12) { KAP ap = KARGS(); Frame F = FRH(); unsigned char* ws = ap->ws; p12_router(ap, WSP(bf16_t, WS_XB), WSP(u64, CTL_SS) + 3 * MTOK, WSP(unsigned, CTL_CNT), WSP(int, CTL_TOKINFO), WSP(unsigned char, WS_XSC), F, hb * (Mh / 64), Mh / 64); }
    if (IN(12)) { KAP ap = KARGS(); Frame F = FRH(); p0_weights_r(ap, F, sh0 + nbef * Gh, sh0 + shn, hidx, Gh); }
    PROBE_E(12); SEAM(12); PROBE_S(12);
    PROBE_B(14); if (IN(14)) REP(14) {
        KAP ap = KARGS(); Frame F = FRL(); unsigned char* ws = ap->ws;
        moe_tables(WSP(unsigned, CTL_CNT), (LAS int*)(F.lds + MOE_T_OFF), F);
        const int* tiles = (const int*)(LAS int*)(F.lds + MOE_T_OFF); const int nT = tiles[0];
        pg8::Order S; S.init(nT, 2 * FE / 256, DM, F.G, bx, ws + WS_XSC, ws + WS_WEGU, (size_t)2 * FE * DM, tiles + 1, pg8::NXCD, 1); S.tile_l = (const LAS int*)(F.lds + MOE_T_OFF) + 1;
        pg8::EpiSwiGLU8 E{WSP(unsigned char, WS_ACTE), FE, 1.0f / (XS_SC * WEGU_SC), ACT_SC, (PROBE_SKIP_EPI && rep_ == 1) ? 1 : 0};
        pg8::gemm_phase<pg8::EpiSwiGLU8, GEMM_ALIGN, false, true>(F.lds, DM, S, E, 0, PRB(14));
    }
    PROBE_E(14); SEAM(14); PROBE_S(14);
    PROBE_B(15); if (IN(15)) REP(15) {
        KAP ap = KARGS(); Frame F = FRL(); unsigned char* ws = ap->ws;
        if (!IN(14)) moe_tables(WSP(unsigned, CTL_CNT), (LAS int*)(F.lds + MOE_T_OFF), F);
        const int* tiles = (const int*)(LAS int*)(F.lds + MOE_T_OFF); const int nT = tiles[0];
        int rt = nT & 31; if (rt > 7) rt = 0;
        pg8::Order S; S.init(nT - rt, DM / 256, FE, F.G, bx, ws + WS_ACTE, ws + WS_WEDN, (size_t)DM * FE, tiles + 1); S.tile_l = (const LAS int*)(F.lds + MOE_T_OFF) + 1;
        pg8::EpiBf16Out<false> E{WSP(bf16_t, WS_YS), DM, nullptr, 1.0f / (ACT_SC * WEDN_SC), nullptr, 0};
        pg8::gemm_phase<pg8::EpiBf16Out<false>, GEMM_ALIGN, false, true>(F.lds, FE, S, E);
        if (rt) { pg8::TailOrder S2{rt * 8 * TAIL_NS, F.G, bx, nT - rt, TAIL_NS, (const char*)(ws + WS_ACTE), (const char*)(ws + WS_WEDN), (size_t)256 * FE, (size_t)DM * FE, (size_t)(FE / TAIL_NS), tiles + 1}; S2.tile_l = (const LAS int*)(F.lds + MOE_T_OFF) + 1;
            pg8::EpiPart E2{WSP(float, WS_SLAB), (nT - rt) * 256, (size_t)rt * 256 * DM};
            pg8::gemm_phase<pg8::EpiPart, GEMM_ALIGN, false, true, pg8::TailOrder>(F.lds, FE, S2, E2, FE / TAIL_NS / 128); }
    }
    PROBE_E(15); SEAM(15); PROBE_S(15);
    PROBE_B(16); if (IN(16)) REP(16) { KAP ap = KARGS(); Frame F = FRL(); unsigned char* ws = ap->ws; if (!IN(14)) moe_tables(WSP(unsigned, CTL_CNT), (LAS int*)(F.lds + MOE_T_OFF), F);
        p16_final(WSP(bf16_t, WS_XB), WSP(bf16_t, WS_YS), WSP(float, WS_SLAB), (const int*)(LAS int*)(F.lds + MOE_T_OFF), WSP(int, CTL_TOKINFO), ap->in[22], ap->out, F); }
PROBE_E(16); PROBE_FIN();
#undef IN
#undef REP
#undef SEAM
#undef WSP
#undef FRL
#undef FRH
#undef KARGS
}

#ifndef MK_ONE_LAUNCH
#define MK_ONE_LAUNCH 1
#endif
extern "C" void kernel_launch(void* const* d_in, const int* in_sizes, int n_in, void* d_out, int out_size, void* d_ws, size_t ws_size, hipStream_t stream) {
    static int grid = 0;
    if (grid == 0) {
        if (n_in != 23 || out_size != MTOK * DM || ws_size < WS_END) { fprintf(stderr, "kernel_launch: unexpected shapes (n_in %d, out %d, ws %zu)\n", n_in, out_size, ws_size); grid = -1; return; }
        int dev = 0, cus = 0, per_cu = 0;
        if (hipGetDevice(&dev) != hipSuccess || hipDeviceGetAttribute(&cus, hipDeviceAttributeMultiprocessorCount, dev) != hipSuccess) { grid = -1; return; }
        if (hipFuncSetAttribute((const void*)mega_fwd, hipFuncAttributeMaxDynamicSharedMemorySize, LDS_BYTES) != hipSuccess) { fprintf(stderr, "kernel_launch: hipFuncSetAttribute failed\n"); grid = -1; return; }
        if (hipOccupancyMaxActiveBlocksPerMultiprocessor(&per_cu, (const void*)mega_fwd, NTHREADS, LDS_BYTES) != hipSuccess || per_cu < 1) { fprintf(stderr, "kernel_launch: occupancy query reports %d\n", per_cu); (void)hipGetLastError(); per_cu = 1; }
        grid = cus;
    }
    if (grid < 0) return;
    if (hipMemsetAsync((char*)d_ws + WS_CTL, 0, CTL_ZERO_BYTES, stream) != hipSuccess) return;
    Args a{};
    for (int i = 0; i < 23; ++i) a.in[i] = (const float*)d_in[i];
    a.out = (float*)d_out; a.ws = (unsigned char*)d_ws;
#if MK_ONE_LAUNCH
    a.ph_lo = 0; a.ph_hi = NPHASE;
    hipLaunchKernelGGL(mega_fwd, dim3(grid), dim3(NTHREADS), LDS_BYTES, stream, a);
#else
    for (int p = 0; p < NPHASE; ++p) { a.ph_lo = p; a.ph_hi = p + 1; hipLaunchKernelGGL(mega_fwd, dim3(grid), dim3(NTHREADS), LDS_BYTES, stream, a); }
#endif
}
```
